# Optimizing an MI355X kernel written in HIP

```python
import jax, jax.numpy as jnp
from jax import lax
import numpy as np

D_MODEL = 2048
BATCH = 2
SEQ = 4096
DEPTH = 4
DEC_BATCH = 8
DEC_SEQ = 8
PAST_LEN = 16384
PAGE_SIZE = 128

H_A = 6
HD_A = 128
D_A = H_A * HD_A
DILATED_PATTERNS = ((128, 1), (512, 4), (2048, 16))
WIN_MAX = 2048
POOL_WINDOWS = (2, 4, 8, 16)
N_POOL = 4
D_B = 512
POOL_GROUP = D_B // N_POOL
POOL_BUF = 15
H_C = 4
DK_C = 96
DV_C = 192
D_C = H_C * DV_C
GATE_RANK = 16
GATE_NORMALIZER = 16.0
GLA_CHUNK = 32
PROJ_SPLITS = (D_A, D_A, D_A, D_B, H_C * DK_C, H_C * DK_C, D_C, D_C, GATE_RANK)
D_IN = 3 * D_A + D_B + 2 * H_C * DK_C + 2 * D_C + GATE_RANK
D_MIX = D_A + D_B + D_C
D_FF = -(-8 * D_MODEL // (3 * 256)) * 256
EPS = 1e-6
NEG_INF = -1e30

kernel_name = 'hybrid_dilated_pool_gla_step'


def rmsnorm(x, g):
    xf = x.astype(jnp.float32)
    y = xf * lax.rsqrt(jnp.mean(xf * xf, axis=-1, keepdims=True) + EPS)
    return (y * g.astype(jnp.float32)).astype(x.dtype)


def dilated_band(q, k, v, window, dil):
    B, S, H, Dh = q.shape
    blk = window // dil
    span = dil * blk
    S_pad = -(-S // span) * span
    L = S_pad // dil
    nb = L // blk

    def to_blocks(t):
        t = jnp.pad(t.astype(jnp.float32), ((0, 0), (0, S_pad - S), (0, 0), (0, 0)))
        t = jnp.moveaxis(t.reshape(B, L, dil, H, Dh), 2, 1)
        return t.reshape(B, dil, nb, blk, H, Dh)

    def with_prev(t):
        prev = jnp.pad(t[:, :, :-1], ((0, 0), (0, 0), (1, 0), (0, 0), (0, 0), (0, 0)))
        return jnp.concatenate([prev, t], axis=3)

    qb, kb, vb = to_blocks(q), to_blocks(k), to_blocks(v)
    kk, vv = with_prev(kb), with_prev(vb)
    s = jnp.einsum('brnqhd,brnkhd->brnhqk', qb, kk) * (Dh ** -0.5)
    qi = jnp.arange(blk)[:, None]
    ki = jnp.arange(2 * blk)[None, :]
    dist = qi + blk - ki
    band = (dist >= 0) & (dist <= blk)
    exists = (jnp.arange(nb)[:, None, None] > 0) | (ki[None] >= blk)
    mask = band[None] & exists
    s = jnp.where(mask[None, None, :, None], s, NEG_INF)
    m = jnp.max(s, axis=-1, keepdims=True)
    p = jnp.exp(s - m)
    den = jnp.sum(p, axis=-1, keepdims=True)
    o = jnp.einsum('brnhqk,brnkhd->brnqhd', p, vv) / jnp.transpose(den, (0, 1, 2, 4, 3, 5))
    lse = jnp.transpose((m + jnp.log(den))[..., 0], (0, 1, 2, 4, 3))

    def from_blocks(t):
        t = t.reshape((B, dil, L) + t.shape[4:])
        t = jnp.moveaxis(t, 1, 2).reshape((B, S_pad) + t.shape[3:])
        return t[:, :S]

    return from_blocks(o), from_blocks(lse)


def dilated_gather(q, k_ext, v_ext, window, dil, P):
    T = q.shape[1]
    Dh = q.shape[-1]
    n = window // dil
    idx = P + jnp.arange(T)[:, None] - dil * jnp.arange(n + 1)[None, :]
    valid = idx >= 0
    idxc = jnp.maximum(idx, 0)
    kg = k_ext[:, idxc].astype(jnp.float32)
    vg = v_ext[:, idxc].astype(jnp.float32)
    s = jnp.einsum('bthd,btjhd->bthj', q.astype(jnp.float32), kg) * (Dh ** -0.5)
    s = jnp.where(valid[None, :, None, :], s, NEG_INF)
    m = jnp.max(s, axis=-1, keepdims=True)
    p = jnp.exp(s - m)
    den = jnp.sum(p, axis=-1, keepdims=True)
    o = jnp.einsum('bthj,btjhd->bthd', p, vg) / den
    return o, (m + jnp.log(den))[..., 0]


def pool_mix(u_ext, pos0, w_pool, scale):
    B, Lx, C = u_ext.shape
    T = Lx - POOL_BUF
    uf = u_ext.astype(jnp.float32)
    csum = jnp.concatenate([jnp.zeros((B, 1, C), jnp.float32), jnp.cumsum(uf, axis=1)], axis=1)
    end = csum[:, POOL_BUF + 1:]
    pos = pos0 + jnp.arange(T)
    means = []
    for gi, w in enumerate(POOL_WINDOWS):
        lo, hi = gi * POOL_GROUP, (gi + 1) * POOL_GROUP
        start = csum[:, POOL_BUF + 1 - w: POOL_BUF + 1 - w + T, lo:hi]
        cnt = jnp.minimum(w, pos + 1).astype(jnp.float32)[None, :, None]
        means.append((end[..., lo:hi] - start) / cnt)
    pooled = (jnp.concatenate(means, axis=-1) - uf[:, POOL_BUF:]).reshape(B, T, N_POOL, POOL_GROUP)
    out = jnp.einsum('btgc,gcd->btgd', pooled, w_pool.astype(jnp.float32)).reshape(B, T, D_B)
    return (out * scale.astype(jnp.float32)).astype(u_ext.dtype)


def gla_chunked(q, k, v, g, S0):
    B, T, H, DK = q.shape
    DV = v.shape[-1]
    c = min(GLA_CHUNK, T)
    Tp = -(-T // c) * c
    n = Tp // c

    def prep(t):
        t = jnp.pad(t.astype(jnp.float32), ((0, 0), (0, Tp - T), (0, 0), (0, 0)))
        return jnp.transpose(t.reshape(B, n, c, H, t.shape[-1]), (1, 0, 3, 2, 4))

    tril = jnp.tril(jnp.ones((c, c), dtype=bool))

    def step(S, inp):
        qc, kc, vc, gc = inp
        b = jnp.cumsum(gc, axis=2)
        qe = qc * jnp.exp(b)
        ke = kc * jnp.exp(-b)
        A = jnp.where(tril, jnp.einsum('bhid,bhjd->bhij', qe, ke), 0.0)
        o = jnp.einsum('bhij,bhjv->bhiv', A, vc) + jnp.einsum('bhid,bhdv->bhiv', qe, S)
        bl = b[:, :, -1:, :]
        S = jnp.exp(bl)[:, :, 0, :, None] * S + jnp.einsum('bhjd,bhjv->bhdv', kc * jnp.exp(bl - b), vc)
        return S, o

    S, o = lax.scan(step, S0.astype(jnp.float32), (prep(q), prep(k), prep(v), prep(g)))
    o = jnp.transpose(o, (1, 0, 3, 2, 4)).reshape(B, Tp, H, DV)[:, :T]
    return o, S


def layer(x, kv_buf, pool_buf, gla_s0, pos0, norm1_g, w_in, w_gate2, b_gate, w_pool, pool_scale,
          gla_norm_g, w_o, norm2_g, w_ffn_gate, w_ffn_up, w_ffn_down):
    B, T, _ = x.shape
    h = rmsnorm(x, norm1_g)
    proj = jnp.einsum('btd,de->bte', h, w_in)
    points = [int(p) for p in np.cumsum(PROJ_SPLITS)[:-1]]
    qa, ka, va, ub, qc, kc, vc, rc, ga = jnp.split(proj, points, axis=-1)
    qa = qa.reshape(B, T, H_A, HD_A)
    ka = ka.reshape(B, T, H_A, HD_A)
    va = va.reshape(B, T, H_A, HD_A)
    if kv_buf is None:
        outs = [dilated_band(qa, ka, va, w, d) for (w, d) in DILATED_PATTERNS]
    else:
        k_buf, v_buf = kv_buf
        P = k_buf.shape[1]
        k_ext = jnp.concatenate([k_buf.astype(ka.dtype), ka], axis=1)
        v_ext = jnp.concatenate([v_buf.astype(va.dtype), va], axis=1)
        outs = [dilated_gather(qa, k_ext, v_ext, w, d, P) for (w, d) in DILATED_PATTERNS]
    o_stack = jnp.stack([o for o, _ in outs])
    lse_stack = jnp.stack([l for _, l in outs])
    wts = jax.nn.softmax(lse_stack, axis=0)
    out_a = jnp.sum(wts[..., None] * o_stack, axis=0).reshape(B, T, D_A).astype(x.dtype)
    if pool_buf is None:
        pool_buf = jnp.zeros((B, POOL_BUF, D_B), ub.dtype)
    u_ext = jnp.concatenate([pool_buf.astype(ub.dtype), ub], axis=1)
    out_b = pool_mix(u_ext, pos0, w_pool, pool_scale).astype(x.dtype)
    new_pool = u_ext[:, -POOL_BUF:]
    qc = qc.reshape(B, T, H_C, DK_C) * (DK_C ** -0.5)
    kc = kc.reshape(B, T, H_C, DK_C)
    vc = vc.reshape(B, T, H_C, DV_C)
    g = jax.nn.log_sigmoid(jnp.einsum('btr,re->bte', ga, w_gate2).astype(jnp.float32)
                           + b_gate.astype(jnp.float32)) / GATE_NORMALIZER
    g = g.reshape(B, T, H_C, DK_C)
    oc, S_new = gla_chunked(qc, kc, vc, g, gla_s0)
    oc = oc * lax.rsqrt(jnp.mean(oc * oc, axis=-1, keepdims=True) + EPS) * gla_norm_g.astype(jnp.float32)
    out_c = (oc.reshape(B, T, D_C) * jax.nn.silu(rc.astype(jnp.float32))).astype(x.dtype)
    mix = jnp.concatenate([out_a, out_b, out_c], axis=-1)
    x = x + jnp.einsum('btm,md->btd', mix, w_o)
    h2 = rmsnorm(x, norm2_g)
    f = jax.nn.silu(jnp.einsum('btd,df->btf', h2, w_ffn_gate)) * jnp.einsum('btd,df->btf', h2, w_ffn_up)
    x = x + jnp.einsum('btf,fd->btd', f, w_ffn_down)
    return x, ka, va, new_pool, S_new.astype(x.dtype)


def setup_inputs(seed: int = 0) -> dict:
    key = jax.random.key(seed)
    ks = jax.random.split(key, 20)
    f32 = jnp.float32

    def nrm(k, shape, scale):
        return jax.random.normal(k, shape, f32) * scale

    w_buf = min(WIN_MAX, PAST_LEN)
    return {
        'x_prompt': nrm(ks[0], (BATCH, SEQ, D_MODEL), 1.0),
        'x_sample': nrm(ks[1], (DEC_BATCH, DEC_SEQ, D_MODEL), 1.0),
        'cache_win_k': nrm(ks[2], (DEPTH, DEC_BATCH, w_buf, H_A, HD_A), 1.0),
        'cache_win_v': nrm(ks[3], (DEPTH, DEC_BATCH, w_buf, H_A, HD_A), 1.0),
        'state_pool': nrm(ks[4], (DEPTH, DEC_BATCH, POOL_BUF, D_B), 1.0),
        'state_gla': nrm(ks[5], (DEPTH, DEC_BATCH, H_C, DK_C, DV_C), 0.3),
        'norm1_g': 1.0 + nrm(ks[6], (DEPTH, D_MODEL), 0.02),
        'w_in': nrm(ks[7], (DEPTH, D_MODEL, D_IN), D_MODEL ** -0.5),
        'w_gate2': nrm(ks[8], (DEPTH, GATE_RANK, H_C * DK_C), GATE_RANK ** -0.5),
        'b_gate': nrm(ks[9], (DEPTH, H_C * DK_C), 0.1),
        'w_pool': nrm(ks[10], (DEPTH, N_POOL, POOL_GROUP, POOL_GROUP), POOL_GROUP ** -0.5),
        'pool_scale': 1.0 + nrm(ks[11], (DEPTH, D_B), 0.02),
        'gla_norm_g': 1.0 + nrm(ks[12], (DEPTH, DV_C), 0.02),
        'w_o': nrm(ks[13], (DEPTH, D_MIX, D_MODEL), D_MIX ** -0.5),
        'norm2_g': 1.0 + nrm(ks[14], (DEPTH, D_MODEL), 0.02),
        'w_ffn_gate': nrm(ks[15], (DEPTH, D_MODEL, D_FF), D_MODEL ** -0.5),
        'w_ffn_up': nrm(ks[16], (DEPTH, D_MODEL, D_FF), D_MODEL ** -0.5),
        'w_ffn_down': nrm(ks[17], (DEPTH, D_FF, D_MODEL), D_FF ** -0.5),
        'final_norm_g': 1.0 + nrm(ks[18], (D_MODEL,), 0.02),
    }


def reference(x_prompt, x_sample, cache_win_k, cache_win_v, state_pool, state_gla, norm1_g, w_in,
              w_gate2, b_gate, w_pool, pool_scale, gla_norm_g, w_o, norm2_g, w_ffn_gate, w_ffn_up,
              w_ffn_down, final_norm_g):
    xp, xs = x_prompt, x_sample
    Bp = xp.shape[0]
    keep = min(WIN_MAX, xp.shape[1])
    p_k, p_v, p_pool, p_gla = [], [], [], []
    s_k, s_v, s_pool, s_gla = [], [], [], []
    for l in range(DEPTH):
        wl = (norm1_g[l], w_in[l], w_gate2[l], b_gate[l], w_pool[l], pool_scale[l], gla_norm_g[l],
              w_o[l], norm2_g[l], w_ffn_gate[l], w_ffn_up[l], w_ffn_down[l])
        s0 = jnp.zeros((Bp, H_C, DK_C, DV_C), jnp.float32)
        xp, ka, va, pool_new, S = layer(xp, None, None, s0, 0, *wl)
        p_k.append(ka[:, -keep:])
        p_v.append(va[:, -keep:])
        p_pool.append(pool_new)
        p_gla.append(S)
        xs, ka, va, pool_new, S = layer(xs, (cache_win_k[l], cache_win_v[l]), state_pool[l], state_gla[l],
                                        PAST_LEN, *wl)
        s_k.append(ka)
        s_v.append(va)
        s_pool.append(pool_new)
        s_gla.append(S)
    y_prompt = rmsnorm(xp, final_norm_g)
    y_sample = rmsnorm(xs, final_norm_g)
    return (y_prompt, y_sample, jnp.stack(p_k), jnp.stack(p_v), jnp.stack(p_pool), jnp.stack(p_gla),
            jnp.stack(s_k), jnp.stack(s_v), jnp.stack(s_pool), jnp.stack(s_gla))
```

```cpp
#include <hip/hip_runtime.h>
#include <cstdio>
#include <cstdint>
namespace pg8 {
#define PG8_LAS __attribute__((address_space(3)))
typedef unsigned short bf16_t;
typedef PG8_LAS float* PG8_LAS_T;
typedef short bf16x8 __attribute__((ext_vector_type(8)));
typedef float f32x4 __attribute__((ext_vector_type(4)));
typedef unsigned u32x4 __attribute__((ext_vector_type(4)));
constexpr int BM = 256, BK = 64, HALF = 128, HTB = HALF * BK * 2  , STAGE_BYTES = 8 * HTB, NXCD = 8, WGM = 8;

__host__ __device__ __forceinline__ int lds_byte(int r, int c) { const int st = (r >> 4) * 2 + (c >> 5), rr = r & 15, cc = c & 31, ob = rr * 64 + cc * 2; return st * 1024 + (ob ^ (((ob >> 9) & 1) << 5)); }
__host__ __device__ __forceinline__ void stage_rc(int b, int& R, int& C) { const int st = b / 1024, sb = b % 1024, swz = sb ^ (((sb >> 9) & 1) << 5); R = (st >> 1) * 16 + swz / 64; C = (st & 1) * 32 + (swz % 64) / 2; }
__host__ __device__ __forceinline__ int perm32(int rho) { const int n = rho >> 4, i = rho & 15; return 8 * (i >> 2) + 4 * n + (i & 3); }

struct Unit { int pm, pn; };
struct Gemm { const bf16_t* A; const bf16_t* Bt; int M, N, K; };

struct StaticOrder {
    int nM, nN, nwg, G, c;
    __host__ __device__ void init(int M, int N, int G_, int c_) { nM = M / BM; nN = N / BM; nwg = nM * nN; G = G_; c = c_; }
    __host__ __device__ bool next(int i, Unit& u) const {
        const long L = (long)i * G + c; if (L >= nwg) return false;
        int wgid = (int)L; { const int q = nwg / NXCD, r = nwg % NXCD, xcd = wgid % NXCD, off = wgid / NXCD; wgid = (xcd < r ? xcd * (q + 1) : r * (q + 1) + (xcd - r) * q) + off; }
        const int nig = WGM * nN, gid = wgid / nig, fm = gid * WGM, gsz = (nM - fm) < WGM ? (nM - fm) : WGM;
        u.pm = fm + ((wgid % nig) % gsz); u.pn = (wgid % nig) / gsz; return true;
    }
    __device__ __forceinline__ void a_ready(const Unit&) const {}
    __device__ __forceinline__ void done(const Unit&) const {}
};


__device__ __forceinline__ unsigned cvt_pk_bf16(float lo, float hi) { unsigned r; asm volatile("v_cvt_pk_bf16_f32 %0, %1, %2" : "=v"(r) : "v"(lo), "v"(hi)); return r; }
__device__ __forceinline__ float silu_f(float x) { return x * __builtin_amdgcn_rcpf(1.0f + __expf(-x)); }

struct EpiInProj {
    static constexpr bool PERM = true, AFTER_DRAIN = false;
    bf16_t* P; const float* part; float* ga; float* pk; float* pv; float* pp;
    __device__ __forceinline__ void operator()(const f32x4 (&acc)[2][2][4][2], const Unit& u, int wr, int wc, int fr, int fq) const {
        const int row0 = u.pm * BM + wr * 64 + fr, col0 = u.pn * BM + wc * 32 + 8 * fq;
        const int tp = (u.pm & 15) * 256;
        const bool kv_out = (u.pn >= 3 && u.pn < 9) && (tp >= 2048);
        const bool u_out = (u.pn == 9 || u.pn == 10) && (tp == 3840);
        const bool g_out = (u.pn == 20) && (wc == 0) && (fq < 2);
#pragma unroll
        for (int ai = 0; ai < 2; ++ai)
#pragma unroll
            for (int m = 0; m < 4; ++m) {
                const int r = row0 + ai * HALF + m * 16;
                const f32x4 q0 = *(const f32x4*)(part + (size_t)r * 8), q1 = *(const f32x4*)(part + (size_t)r * 8 + 4);
                const float rs = rsqrtf((((q0[0] + q0[1]) + (q0[2] + q0[3])) + ((q1[0] + q1[1]) + (q1[2] + q1[3]))) * (1.0f / 2048.0f) + 1e-6f);
                bf16_t* rowp = P + (size_t)r * 5376 + col0;
                const int b = r >> 12, t = r & 4095;
#pragma unroll
                for (int bj = 0; bj < 2; ++bj) {
                    const f32x4 v0 = acc[ai][bj][m][0] * rs, v1 = acc[ai][bj][m][1] * rs;
                    u32x4 w; w.x = cvt_pk_bf16(v0[0], v0[1]); w.y = cvt_pk_bf16(v0[2], v0[3]); w.z = cvt_pk_bf16(v1[0], v1[1]); w.w = cvt_pk_bf16(v1[2], v1[3]);
                    *(u32x4*)(rowp + bj * HALF) = w;
                    const int c = col0 + bj * HALF;
                    if (kv_out) {
                        float* dst = (u.pn < 6) ? (pk + ((size_t)(b * 2048 + (t - 2048)) * 768 + (c - 768))) : (pv + ((size_t)(b * 2048 + (t - 2048)) * 768 + (c - 1536)));
                        *(f32x4*)dst = v0; *(f32x4*)(dst + 4) = v1;
                    }
                    if (u_out && t >= 4081) {
                        float* dst = pp + ((size_t)(b * 15 + (t - 4081)) * 512 + (c - 2304));
                        *(f32x4*)dst = v0; *(f32x4*)(dst + 4) = v1;
                    }
                    if (g_out && bj == 0) {
                        float* dst = ga + (size_t)r * 16 + 8 * fq;
                        *(f32x4*)dst = v0; *(f32x4*)(dst + 4) = v1;
                    }
                }
            }
    }
};
struct EpiResid {
    static constexpr bool PERM = true, AFTER_DRAIN = false;
    const float* xin; float* xout; bf16_t* xb; float* part; PG8_LAS float* xch;
    __device__ __forceinline__ void operator()(const f32x4 (&acc)[2][2][4][2], const Unit& u, int wr, int wc, int fr, int fq) const {
        const int row0 = u.pm * BM + wr * 64 + fr, col0 = u.pn * BM + wc * 32 + 8 * fq;
#pragma unroll
        for (int ai = 0; ai < 2; ++ai)
#pragma unroll
            for (int m = 0; m < 4; ++m) {
                const int r = row0 + ai * HALF + m * 16;
                const size_t off = (size_t)r * 2048 + col0;
                float s = 0.f;
#pragma unroll
                for (int bj = 0; bj < 2; ++bj) {
                    const f32x4 a0 = *(const f32x4*)(xin + off + bj * HALF), a1 = *(const f32x4*)(xin + off + bj * HALF + 4);
                    const f32x4 v0 = acc[ai][bj][m][0] + a0, v1 = acc[ai][bj][m][1] + a1;
                    *(f32x4*)(xout + off + bj * HALF) = v0; *(f32x4*)(xout + off + bj * HALF + 4) = v1;
                    u32x4 w; w.x = cvt_pk_bf16(v0[0], v0[1]); w.y = cvt_pk_bf16(v0[2], v0[3]); w.z = cvt_pk_bf16(v1[0], v1[1]); w.w = cvt_pk_bf16(v1[2], v1[3]);
                    *(u32x4*)(xb + off + bj * HALF) = w;
                    s += (v0[0] * v0[0] + v0[1] * v0[1]) + (v0[2] * v0[2] + v0[3] * v0[3]) + (v1[0] * v1[0] + v1[1] * v1[1]) + (v1[2] * v1[2] + v1[3] * v1[3]);
                }
                s += __shfl_xor(s, 16); s += __shfl_xor(s, 32);
                if (fq == 0) xch[(ai * HALF + wr * 64 + m * 16 + fr) * 4 + wc] = s;
                asm volatile("" ::: "memory");
            }
        asm volatile("s_waitcnt lgkmcnt(0)" ::: "memory"); __builtin_amdgcn_s_barrier(); asm volatile("" ::: "memory");
        if (wr == 0) { const int row = wc * 64 + fq * 16 + fr; const f32x4 q = *(const PG8_LAS f32x4*)(xch + row * 4);
            part[(size_t)(u.pm * BM + row) * 8 + u.pn] = (q[0] + q[1]) + (q[2] + q[3]); }
    }
};
struct EpiGateUp {
    static constexpr bool PERM = true, AFTER_DRAIN = false;
    bf16_t* F; const float* part;
    __device__ __forceinline__ void operator()(const f32x4 (&acc)[2][2][4][2], const Unit& u, int wr, int wc, int fr, int fq) const {
        const int row0 = u.pm * BM + wr * 64 + fr, col0 = u.pn * HALF + wc * 32 + 8 * fq;
#pragma unroll
        for (int ai = 0; ai < 2; ++ai)
#pragma unroll
            for (int m = 0; m < 4; ++m) {
                const int r = row0 + ai * HALF + m * 16;
                const f32x4 q0 = *(const f32x4*)(part + (size_t)r * 8), q1 = *(const f32x4*)(part + (size_t)r * 8 + 4);
                const float rs = rsqrtf((((q0[0] + q0[1]) + (q0[2] + q0[3])) + ((q1[0] + q1[1]) + (q1[2] + q1[3]))) * (1.0f / 2048.0f) + 1e-6f);
                const f32x4 g0 = acc[ai][0][m][0] * rs, g1 = acc[ai][0][m][1] * rs, u0 = acc[ai][1][m][0] * rs, u1 = acc[ai][1][m][1] * rs;
                u32x4 w;
                w.x = cvt_pk_bf16(silu_f(g0[0]) * u0[0], silu_f(g0[1]) * u0[1]); w.y = cvt_pk_bf16(silu_f(g0[2]) * u0[2], silu_f(g0[3]) * u0[3]);
                w.z = cvt_pk_bf16(silu_f(g1[0]) * u1[0], silu_f(g1[1]) * u1[1]); w.w = cvt_pk_bf16(silu_f(g1[2]) * u1[2], silu_f(g1[3]) * u1[3]);
                *(u32x4*)(F + (size_t)r * 5632 + col0) = w;
            }
    }
};

template <class Epi, class Sched, bool ALIGN_EPI = false, bool SP2 = false>
__device__ __forceinline__ void gemm_phase(PG8_LAS unsigned char* lds, const Gemm g, const Sched& S, const Epi& E) {
    int tid = threadIdx.x; asm volatile("" : "+v"(tid)); const int wid = __builtin_amdgcn_readfirstlane(tid >> 6), lane = tid & 63, wr = wid >> 2, wc = wid & 3, fr = lane & 15, fq = lane >> 4;
    const int K = g.K, nt = K / BK;
    unsigned voffA[2], voffB[2];
#pragma unroll
    for (int i = 0; i < 2; ++i) { int R, C; stage_rc(tid * 16 + i * 8192, R, C); const int Rb = Epi::PERM ? ((R & ~31) + perm32(R & 31)) : R;
        voffA[i] = (unsigned)(R * K + C) * 2u; voffB[i] = (unsigned)(Rb * K + C) * 2u; }
    const size_t kstep = (size_t)(BK * 2);
    const size_t hstep = (size_t)HALF * K * 2;
    const size_t tstep = 2 * hstep;
    const unsigned ldsw = (unsigned)wid * 1024u;
    const int aoff = lds_byte(wr * 64 + fr, fq * 8), boff = lds_byte(wc * 32 + fr, fq * 8);
#define PG8_SA(b, h) (((b) * 2 + (h)) * HTB)
#define PG8_SB(b, h) ((4 + (b) * 2 + (h)) * HTB)
#define PG8_STAGE(bufoff, gbase, voff) do { _Pragma("unroll") for (int _i = 0; _i < 2; ++_i) \
        __builtin_amdgcn_global_load_lds((const unsigned*)((const char*)(gbase) + (voff)[_i]), (PG8_LAS unsigned*)(lds + (bufoff) + ldsw + _i * 8192), 16, 0, 0); } while (0)
#define PG8_LDA(dst, b, h) do { _Pragma("unroll") for (int m = 0; m < 4; ++m) _Pragma("unroll") for (int k = 0; k < 2; ++k) dst[m][k] = *(const PG8_LAS bf16x8*)(lds + PG8_SA(b, h) + aoff + m * 2048 + k * 1024); } while (0)
#define PG8_LDB(dst, b, h) do { _Pragma("unroll") for (int n = 0; n < 2; ++n) _Pragma("unroll") for (int k = 0; k < 2; ++k) dst[n][k] = *(const PG8_LAS bf16x8*)(lds + PG8_SB(b, h) + boff + n * 2048 + k * 1024); } while (0)
#define PG8_MMA(ai, bj, At, Bt) do { __builtin_amdgcn_s_setprio(1); _Pragma("unroll") for (int m = 0; m < 4; ++m) _Pragma("unroll") for (int n = 0; n < 2; ++n) _Pragma("unroll") for (int k = 0; k < 2; ++k) \
        acc[ai][bj][m][n] = __builtin_amdgcn_mfma_f32_16x16x32_bf16(Bt[n][k], At[m][k], acc[ai][bj][m][n], 0, 0, 0); __builtin_amdgcn_s_setprio(0); } while (0)
#define PG8_WAIT_V(n) asm volatile("s_waitcnt vmcnt(" #n ")" ::: "memory")
#define PG8_WAIT_L(n) asm volatile("s_waitcnt lgkmcnt(" #n ")" ::: "memory")
#define PG8_BAR __builtin_amdgcn_s_barrier()
#define PG8_SCHED __builtin_amdgcn_sched_barrier(0)
    Unit cur, nxt; int ui = 0;
    if (!S.next(0, cur)) return;
    f32x4 acc[2][2][4][2];
#pragma unroll
    for (int a = 0; a < 2; ++a)
#pragma unroll
        for (int b = 0; b < 2; ++b)
#pragma unroll
            for (int m = 0; m < 4; ++m)
#pragma unroll
                for (int n = 0; n < 2; ++n) acc[a][b][m][n] = (f32x4){0.f, 0.f, 0.f, 0.f};
    bf16x8 At[4][2], B0[2][2], B1[2][2];
    const char* cA = (const char*)g.A + (size_t)cur.pm * tstep; const char* cB = (const char*)g.Bt + (size_t)cur.pn * tstep;
    S.a_ready(cur);
    if constexpr (SP2) {
        PG8_STAGE(PG8_SB(0, 0), cB, voffB); PG8_STAGE(PG8_SB(0, 1), cB + hstep, voffB); PG8_STAGE(PG8_SA(0, 0), cA, voffA); PG8_STAGE(PG8_SA(0, 1), cA + hstep, voffA);
        if (wr == 1) PG8_BAR;
        PG8_WAIT_V(2); PG8_BAR;
        PG8_STAGE(PG8_SB(1, 0), cB + kstep, voffB); PG8_STAGE(PG8_SA(1, 0), cA + kstep, voffA); PG8_STAGE(PG8_SB(1, 1), cB + hstep + kstep, voffB);
        PG8_WAIT_V(6); PG8_BAR;
    } else {
        PG8_STAGE(PG8_SB(0, 0), cB, voffB); PG8_STAGE(PG8_SA(0, 0), cA, voffA); PG8_STAGE(PG8_SB(0, 1), cB + hstep, voffB); PG8_STAGE(PG8_SA(0, 1), cA + hstep, voffA);
        if (wr == 1) PG8_BAR;
        PG8_WAIT_V(4); PG8_BAR;
        PG8_STAGE(PG8_SB(1, 0), cB + kstep, voffB); PG8_STAGE(PG8_SA(1, 0), cA + kstep, voffA); PG8_STAGE(PG8_SB(1, 1), cB + hstep + kstep, voffB);
        PG8_WAIT_V(6); PG8_BAR;
    }
    for (;;) {
        const bool has_next = S.next(ui + 1, nxt);
        const char* nA = has_next ? (const char*)g.A + (size_t)nxt.pm * tstep : cA; const char* nB = has_next ? (const char*)g.Bt + (size_t)nxt.pn * tstep : cB;
        for (int t = 0; t < nt; t += 2) {
            const bool last = (t == nt - 2);
            const char* a1 = cA + (size_t)(t + 1) * kstep;
            const char* a2 = last ? nA : cA + (size_t)(t + 2) * kstep; const char* b2 = last ? nB : cB + (size_t)(t + 2) * kstep;
            const char* a3 = a2 + kstep; const char* b3 = b2 + kstep;
            if (last && has_next) S.a_ready(nxt);
            if constexpr (SP2) {
            PG8_LDB(B0, 0, 0); PG8_LDB(B1, 0, 1); PG8_SCHED; PG8_LDA(At, 0, 0); PG8_STAGE(PG8_SA(1, 1), a1 + hstep, voffA);
            PG8_WAIT_V(8); PG8_WAIT_L(0); PG8_BAR; PG8_MMA(0, 0, At, B0); PG8_MMA(0, 1, At, B1); PG8_BAR; PG8_SCHED;
            PG8_LDA(At, 0, 1); PG8_STAGE(PG8_SB(0, 0), b2, voffB); PG8_STAGE(PG8_SB(0, 1), b2 + hstep, voffB); PG8_STAGE(PG8_SA(0, 0), a2, voffA);
            PG8_WAIT_V(8); PG8_WAIT_L(0); PG8_BAR; PG8_MMA(1, 0, At, B0); PG8_MMA(1, 1, At, B1); PG8_BAR; PG8_SCHED;
            PG8_LDB(B0, 1, 0); PG8_LDB(B1, 1, 1); PG8_SCHED; PG8_LDA(At, 1, 0); PG8_STAGE(PG8_SA(0, 1), a2 + hstep, voffA);
            PG8_WAIT_V(8); PG8_WAIT_L(0); PG8_BAR; PG8_MMA(0, 0, At, B0); PG8_MMA(0, 1, At, B1); PG8_BAR; PG8_SCHED;
            PG8_LDA(At, 1, 1); PG8_STAGE(PG8_SB(1, 0), b3, voffB); PG8_STAGE(PG8_SB(1, 1), b3 + hstep, voffB); PG8_STAGE(PG8_SA(1, 0), a3, voffA);
            PG8_WAIT_V(8); PG8_WAIT_L(0); PG8_BAR; PG8_MMA(1, 0, At, B0); PG8_MMA(1, 1, At, B1); PG8_BAR; PG8_SCHED;
            } else {
            PG8_LDB(B0, 0, 0); PG8_SCHED; PG8_LDA(At, 0, 0); PG8_STAGE(PG8_SA(1, 1), a1 + hstep, voffA);
            PG8_WAIT_L(8); PG8_BAR; PG8_WAIT_L(0); PG8_MMA(0, 0, At, B0); PG8_BAR; PG8_SCHED;
            PG8_LDB(B1, 0, 1); PG8_STAGE(PG8_SB(0, 0), b2, voffB);
            PG8_BAR; PG8_WAIT_L(0); PG8_MMA(0, 1, At, B1); PG8_BAR;
            PG8_LDA(At, 0, 1); PG8_STAGE(PG8_SA(0, 0), a2, voffA);
            PG8_BAR; PG8_WAIT_L(0); PG8_MMA(1, 0, At, B0); PG8_BAR; PG8_SCHED;
            PG8_STAGE(PG8_SB(0, 1), b2 + hstep, voffB);
            PG8_WAIT_V(6); PG8_BAR; PG8_MMA(1, 1, At, B1); PG8_BAR;
            PG8_LDB(B0, 1, 0); PG8_SCHED; PG8_LDA(At, 1, 0); PG8_STAGE(PG8_SA(0, 1), a2 + hstep, voffA);
            PG8_WAIT_L(8); PG8_BAR; PG8_WAIT_L(0); PG8_MMA(0, 0, At, B0); PG8_BAR; PG8_SCHED;
            PG8_LDB(B1, 1, 1); PG8_STAGE(PG8_SB(1, 0), b3, voffB);
            PG8_BAR; PG8_WAIT_L(0); PG8_MMA(0, 1, At, B1); PG8_BAR;
            PG8_LDA(At, 1, 1); PG8_STAGE(PG8_SA(1, 0), a3, voffA);
            PG8_BAR; PG8_WAIT_L(0); PG8_MMA(1, 0, At, B0); PG8_BAR; PG8_SCHED;
            PG8_STAGE(PG8_SB(1, 1), b3 + hstep, voffB);
            PG8_WAIT_V(6); PG8_BAR; PG8_MMA(1, 1, At, B1); PG8_BAR;
            }
        }
        if constexpr (ALIGN_EPI) { if (wr == 0) PG8_BAR; }
        if constexpr (!Epi::AFTER_DRAIN) { E(acc, cur, wr, wc, fr, fq); S.done(cur); }
        if (!has_next) break;
#pragma unroll
        for (int a = 0; a < 2; ++a)
#pragma unroll
            for (int b = 0; b < 2; ++b)
#pragma unroll
                for (int m = 0; m < 4; ++m)
#pragma unroll
                    for (int n = 0; n < 2; ++n) acc[a][b][m][n] = (f32x4){0.f, 0.f, 0.f, 0.f};
        cur = nxt; cA = nA; cB = nB; ++ui;
        if constexpr (ALIGN_EPI) { if (wr == 1) PG8_BAR; }
    }
    PG8_WAIT_V(0);
    if constexpr (!ALIGN_EPI) { if (wr == 0) PG8_BAR; }
    PG8_BAR;
    if constexpr (Epi::AFTER_DRAIN) { E.fused(acc, cur, wr, wc, fr, fq, lds, wid, lane); S.done(cur); }
#undef PG8_SA
#undef PG8_SB
#undef PG8_STAGE
#undef PG8_LDA
#undef PG8_LDB
#undef PG8_MMA
#undef PG8_WAIT_V
#undef PG8_WAIT_L
#undef PG8_BAR
#undef PG8_SCHED
}
}

#define GAS __attribute__((address_space(1)))
#define LAS __attribute__((address_space(3)))
typedef unsigned short bf16;
typedef float f32x4 __attribute__((ext_vector_type(4)));
typedef float f32x2 __attribute__((ext_vector_type(2)));
typedef short bf16x8 __attribute__((ext_vector_type(8)));
typedef unsigned u32x4 __attribute__((ext_vector_type(4)));
typedef unsigned u32x2 __attribute__((ext_vector_type(2)));
typedef GAS unsigned gu32;

constexpr int NWAVES = 8, NTHR = 512;
constexpr int D = 2048, SEQ = 4096, MP = 8192, MS = 64, MT = MP + MS, DEPTH = 4;
constexpr int DIN = 5136, NINP = 5376, DFF = 5632, NGU = 2 * DFF;
constexpr int C_QA = 0, C_KA = 768, C_VA = 1536, C_UB = 2304, C_QC = 2816, C_KC = 3200, C_VC = 3584, C_RC = 4352, C_GC = 5120;
constexpr int M_A = 0, M_B = 768, M_C = 1280;
constexpr float EPS = 1e-6f;
constexpr int NCH = 64, CH = 64;
constexpr int SELEMS = 96 * 192;

enum { I_XP = 0, I_XS, I_CK, I_CV, I_SPOOL, I_SGLA, I_N1G, I_WIN, I_WG2, I_BG, I_WPOOL, I_PSCALE, I_GNG, I_WO, I_N2G, I_WFG, I_WFU, I_WFD, I_FNG, N_IN };
constexpr size_t O_YP = 0, O_YS = 16777216, O_PK = 16908288, O_PV = 29491200, O_PP = 42074112, O_PG = 42135552, O_SK = 42725376, O_SV = 42921984, O_SP = 43118592, O_SG = 43364352, O_END = 45723648;
constexpr size_t MiB = 1u << 20;
constexpr size_t WS_CTL = 0, CTL_ZERO_BYTES = 1 * MiB;
constexpr size_t WS_PART1 = 1 * MiB, WS_PART2 = 1 * MiB + 262144, WS_SPART1 = 1 * MiB + 524288, WS_SPART2 = 1 * MiB + 589824;
constexpr size_t WS_GA = 2 * MiB, WS_DEC = 3 * MiB, WS_PROJS = 4 * MiB;
constexpr size_t WS_W = 8 * MiB;
constexpr size_t LW_IN = 0, LW_O = (size_t)NINP * D * 2, LW_GU = LW_O + (size_t)D * D * 2, LW_D = LW_GU + (size_t)NGU * D * 2, LW_SZ = LW_D + (size_t)D * DFF * 2;
static_assert(LW_SZ == 99614720, "layer weight bytes");
constexpr size_t WS_X = 388 * MiB, WS_XB = 453 * MiB, WS_MIX = 486 * MiB, WS_PROJ = 519 * MiB, WS_F = 603 * MiB, WS_SLOC = 692 * MiB, WS_SST = 728 * MiB, WS_END = 764 * MiB;
static_assert(WS_W + 4 * LW_SZ <= WS_X && WS_X + (size_t)MT * D * 4 <= WS_XB && WS_XB + (size_t)MT * D * 2 <= WS_MIX && WS_MIX + (size_t)MT * D * 2 <= WS_PROJ, "ws map 1");
static_assert(WS_PROJ + (size_t)MP * NINP * 2 <= WS_F && WS_F + (size_t)MT * DFF * 2 <= WS_SLOC && WS_SLOC + (size_t)512 * SELEMS * 4 <= WS_SST && WS_SST + (size_t)512 * SELEMS * 4 <= WS_END, "ws map 2");
constexpr int CW_BAR = 4096;
constexpr int RING_BYTES = 131072, XCH_OFF = RING_BYTES, SCRATCH_BYTES = 139264, LDSCTL_OFF = SCRATCH_BYTES, MISC_OFF = LDSCTL_OFF + 320, LDS_BYTES = 147456;

#define RLX_AGENT __ATOMIC_RELAXED, __HIP_MEMORY_SCOPE_AGENT
__device__ __forceinline__ float bf2f(unsigned b) { return __uint_as_float(b << 16); }
__device__ __forceinline__ unsigned f2bf(float f) { unsigned u = __float_as_uint(f); return (u + 0x7fffu + ((u >> 16) & 1u)) >> 16; }
__device__ __forceinline__ unsigned pk2(float lo, float hi) { return f2bf(lo) | (f2bf(hi) << 16); }
__device__ __forceinline__ float wave_sum(float v) {
#pragma unroll
    for (int o = 1; o < 64; o <<= 1) v += __shfl_xor(v, o);
    return v;
}
__device__ __forceinline__ float wave_max(float v) {
#pragma unroll
    for (int o = 1; o < 64; o <<= 1) v = fmaxf(v, __shfl_xor(v, o));
    return v;
}
__device__ __forceinline__ float logsig(float z) { return fminf(z, 0.f) - log1pf(__expf(-fabsf(z))); }
__device__ __forceinline__ float silu(float x) { return x / (1.0f + __expf(-x)); }

#define XB_TMO      128
#define XB_XCNT(j)  (256  + 64 * (j))
#define XB_XSUB(j)  (1280 + 64 * (j))
#define XB_XGEN(j)  (2304 + 64 * (j))
#define XB_TOP      3328
#define XB_TOPGEN   3392
#define XCD_BAR_WORDS 3456
#define XB_SPIN_CAP (1u << 18)

__device__ __forceinline__ unsigned xb_ld(unsigned* p)              { return __hip_atomic_load(p, __ATOMIC_RELAXED, __HIP_MEMORY_SCOPE_AGENT); }
__device__ __forceinline__ unsigned xb_add(unsigned* p, unsigned v) { return __hip_atomic_fetch_add(p, v, __ATOMIC_RELAXED, __HIP_MEMORY_SCOPE_AGENT); }
__device__ __forceinline__ unsigned xb_xcc_id() { return (unsigned)__builtin_amdgcn_s_getreg((3 << 11) | 20) & 0xFu; }
#define XB_SPIN(cond, bar) do { unsigned _sp = 0; while (cond) { __builtin_amdgcn_s_sleep(1); \
    if ((++_sp & 255u) == 0u) { if (xb_ld(&(bar)[XB_TMO])) break; if (_sp > XB_SPIN_CAP) { atomicAdd(&(bar)[XB_TMO], 1u); break; } } } } while (0)

struct XcdBarrier {
    unsigned* bar; unsigned x;
    volatile LAS unsigned* st;
};

__device__ __forceinline__ XcdBarrier xcd_barrier_post(unsigned* bar, volatile LAS unsigned* st) {
    XcdBarrier b; b.bar = bar; b.x = xb_xcc_id(); b.st = st;
    if (threadIdx.x == 0) (void)xb_add(&bar[XB_XCNT(b.x)], 1u);
    return b;
}
__device__ __forceinline__ void xcd_barrier_complete(unsigned* bar, unsigned x, unsigned& nloc, unsigned& nx) {
    const unsigned G = gridDim.x * gridDim.y * gridDim.z;
    unsigned sum, cnt, mine, sp = 0u;
    for (;;) {
        sum = 0u; cnt = 0u; mine = 0u;
#pragma unroll
        for (unsigned j = 0; j < 16; ++j) { const unsigned c = xb_ld(&bar[XB_XCNT(j)]); sum += c; cnt += (c > 0u) ? 1u : 0u; mine = (j == x) ? c : mine; }
        if (sum == G) break;
        __builtin_amdgcn_s_sleep(1);
        if ((++sp & 255u) == 0u) { if (xb_ld(&bar[XB_TMO])) break; if (sp > XB_SPIN_CAP) { atomicAdd(&bar[XB_TMO], 1u); break; } }
    }
    nloc = mine > 0u ? mine : 1u; nx = cnt > 0u ? cnt : 1u;
}

__device__ __forceinline__ void xcd_barrier(const XcdBarrier& b) {
    asm volatile("s_waitcnt vmcnt(0)" ::: "memory");
    __syncthreads();
    if (threadIdx.x == 0) {
        unsigned* bar = b.bar;
        __builtin_amdgcn_s_waitcnt(0);
        unsigned nloc = b.st[0], nx = b.st[1];
        if (nloc == 0u) { xcd_barrier_complete(bar, b.x, nloc, nx); b.st[0] = nloc; b.st[1] = nx; }
        const unsigned old = xb_add(&bar[XB_XSUB(b.x)], 1u);
        const unsigned gen = old / nloc;
        if (old + 1u == (gen + 1u) * nloc) {
            __builtin_amdgcn_fence(__ATOMIC_RELEASE, "agent");
            asm volatile("s_waitcnt vmcnt(0)" ::: "memory");
            const unsigned og = xb_add(&bar[XB_TOP], 1u);
            const unsigned tg = og / nx;
            if (og + 1u == (tg + 1u) * nx) xb_add(&bar[XB_TOPGEN], 1u);
            else XB_SPIN(xb_ld(&bar[XB_TOPGEN]) == tg, bar);
            __builtin_amdgcn_fence(__ATOMIC_ACQUIRE, "agent");
            xb_add(&bar[XB_XGEN(b.x)], 1u);
            asm volatile("s_waitcnt vmcnt(0)" ::: "memory");
        } else {
            XB_SPIN(xb_ld(&bar[XB_XGEN(b.x)]) == gen, bar);
            __builtin_amdgcn_fence(__ATOMIC_ACQUIRE, "agent");
            asm volatile("s_waitcnt vmcnt(0)" ::: "memory");
        }
    }
    __syncthreads();
}

struct RowId { __device__ __forceinline__ int operator()(int n) const { return n; } };
struct RowGate { int up; __device__ __forceinline__ int operator()(int f) const { return 256 * (f >> 7) + 128 * up + (f & 127); } };
template <class RM>
__device__ __forceinline__ void cvt_tile(const float* __restrict__ W, int K, int N, int k0, int n0, const float* __restrict__ gk, bf16* Wt, RM rowmap, LAS float* scr, int lane) {
    const int cl = 4 * (lane & 15), kr = lane >> 4;
    f32x4 v[16];
#pragma unroll
    for (int i = 0; i < 16; ++i) {
        const int kk = 4 * i + kr, n = n0 + cl;
        v[i] = (n + 3 < N) ? *(const f32x4*)(W + (size_t)(k0 + kk) * N + n) : (f32x4){0.f, 0.f, 0.f, 0.f};
    }
#pragma unroll
    for (int i = 0; i < 16; ++i) {
        const int kk = 4 * i + kr; const float g = gk ? gk[k0 + kk] : 1.0f;
        LAS float* s = scr + kk * 65 + cl;
        s[0] = v[i][0] * g; s[1] = v[i][1] * g; s[2] = v[i][2] * g; s[3] = v[i][3] * g;
    }
    asm volatile("s_waitcnt lgkmcnt(0)" ::: "memory");
    const int c = lane & 7;
#pragma unroll
    for (int i = 0; i < 8; ++i) {
        const int nl = 8 * i + (lane >> 3), n = n0 + nl;
        const LAS float* s = scr + (8 * c) * 65 + nl;
        u32x4 o; o.x = pk2(s[0 * 65], s[1 * 65]); o.y = pk2(s[2 * 65], s[3 * 65]); o.z = pk2(s[4 * 65], s[5 * 65]); o.w = pk2(s[6 * 65], s[7 * 65]);
        if (n < N) *(u32x4*)(Wt + (size_t)rowmap(n) * K + k0 + 8 * c) = o;
    }
    asm volatile("s_waitcnt lgkmcnt(0)" ::: "memory");
}

struct Ptrs {
    const float* in[N_IN]; float* out; unsigned char* ws;
};

__device__ __forceinline__ void prologue(const Ptrs& P, LAS unsigned char* lds, int bx, int G, int wave, int lane, int tid) {
    LAS float* scr = (LAS float*)(lds + wave * 16640);
    const int gw = bx * NWAVES + wave, NGW = G * NWAVES;
    constexpr int I_IN = 32 * 81, I_O = 32 * 32, I_G = 32 * 88, I_D = 88 * 32, I_L = I_IN + I_O + 2 * I_G + I_D;
    for (int it = gw; it < DEPTH * I_L; it += NGW) {
        const int l = it / I_L; int r = it - l * I_L;
        unsigned char* wl = P.ws + WS_W + (size_t)l * LW_SZ;
        if (r < I_IN) { const int kb = r / 81, nb = r % 81; cvt_tile(P.in[I_WIN] + (size_t)l * D * DIN, D, DIN, 64 * kb, 64 * nb, P.in[I_N1G] + l * D, (bf16*)(wl + LW_IN), RowId{}, scr, lane); continue; } r -= I_IN;
        if (r < I_O) { const int kb = r / 32, nb = r % 32; cvt_tile(P.in[I_WO] + (size_t)l * D * D, D, D, 64 * kb, 64 * nb, (const float*)nullptr, (bf16*)(wl + LW_O), RowId{}, scr, lane); continue; } r -= I_O;
        if (r < I_G) { const int kb = r / 88, nb = r % 88; cvt_tile(P.in[I_WFG] + (size_t)l * D * DFF, D, DFF, 64 * kb, 64 * nb, P.in[I_N2G] + l * D, (bf16*)(wl + LW_GU), RowGate{0}, scr, lane); continue; } r -= I_G;
        if (r < I_G) { const int kb = r / 88, nb = r % 88; cvt_tile(P.in[I_WFU] + (size_t)l * D * DFF, D, DFF, 64 * kb, 64 * nb, P.in[I_N2G] + l * D, (bf16*)(wl + LW_GU), RowGate{1}, scr, lane); continue; } r -= I_G;
        { const int kb = r / 32, nb = r % 32; cvt_tile(P.in[I_WFD] + (size_t)l * DFF * D, DFF, D, 64 * kb, 64 * nb, (const float*)nullptr, (bf16*)(wl + LW_D), RowId{}, scr, lane); }
    }
    for (int i = bx * NTHR + tid; i < DEPTH * 61440; i += G * NTHR) {
        const int l = i / 61440, j = i % 61440;
        *(u32x4*)(P.ws + WS_W + (size_t)l * LW_SZ + LW_IN + (size_t)DIN * D * 2 + (size_t)j * 16) = (u32x4){0u, 0u, 0u, 0u};
    }
    float* part2 = (float*)(P.ws + WS_PART2); float* spart2 = (float*)(P.ws + WS_SPART2); bf16* XB = (bf16*)(P.ws + WS_XB);
    for (int row = gw; row < MT; row += NGW) {
        const float* xr = (row < MP) ? P.in[I_XP] + (size_t)row * D : P.in[I_XS] + (size_t)(row - MP) * D;
        float s = 0.f;
#pragma unroll
        for (int j = 0; j < 8; ++j) {
            const f32x4 v = *(const f32x4*)(xr + 4 * lane + 256 * j);
            s += (v[0] * v[0] + v[1] * v[1]) + (v[2] * v[2] + v[3] * v[3]);
            u32x2 o; o.x = pk2(v[0], v[1]); o.y = pk2(v[2], v[3]);
            *(u32x2*)(XB + (size_t)row * D + 4 * lane + 256 * j) = o;
        }
        s = wave_sum(s);
        if (row < MP) { if (lane < 8) part2[(size_t)row * 8 + lane] = (lane == 0) ? s : 0.f; }
        else { spart2[(size_t)(row - MP) * 128 + lane] = (lane == 0) ? s : 0.f; spart2[(size_t)(row - MP) * 128 + 64 + lane] = 0.f; }
    }
}
__device__ __forceinline__ float skinny_rs(const float* spart, int rh, int tid) {
    const float* p = spart + (size_t)(32 * rh + (tid >> 4)) * 128 + (tid & 15) * 8;
    const f32x4 a = *(const f32x4*)p, b = *(const f32x4*)(p + 4);
    float s = ((a[0] + a[1]) + (a[2] + a[3])) + ((b[0] + b[1]) + (b[2] + b[3]));
    s += __shfl_xor(s, 1); s += __shfl_xor(s, 2); s += __shfl_xor(s, 4); s += __shfl_xor(s, 8);
    return rsqrtf(s * (1.0f / 2048.0f) + EPS);
}

template <int NB, class EPI>
__device__ __forceinline__ void skinny_unit(LAS unsigned char* lds, const bf16* __restrict__ A, const bf16* __restrict__ B0, const bf16* __restrict__ B1, int K, int rh, const EPI& epi, int wave, int lane, int tid) {
    const int fr = lane & 15, fq = lane >> 4, ks = K / 8, kb = wave * ks;
    f32x4 acc[2][NB];
#pragma unroll
    for (int a = 0; a < 2; ++a)
#pragma unroll
        for (int b = 0; b < NB; ++b) acc[a][b] = (f32x4){0.f, 0.f, 0.f, 0.f};
    const bf16* a0p = A + (size_t)(32 * rh + fr) * K + kb + 8 * fq; const bf16* a1p = a0p + (size_t)16 * K;
    const bf16* b0p = B0 + (size_t)fr * K + kb + 8 * fq; const bf16* b1p = B1 + (size_t)fr * K + kb + 8 * fq;
#pragma unroll 4
    for (int kk = 0; kk < ks; kk += 32) {
        const bf16x8 a0 = *(const bf16x8*)(a0p + kk), a1 = *(const bf16x8*)(a1p + kk), b0 = *(const bf16x8*)(b0p + kk);
        acc[0][0] = __builtin_amdgcn_mfma_f32_16x16x32_bf16(a0, b0, acc[0][0], 0, 0, 0);
        acc[1][0] = __builtin_amdgcn_mfma_f32_16x16x32_bf16(a1, b0, acc[1][0], 0, 0, 0);
        if (NB == 2) { const bf16x8 b1 = *(const bf16x8*)(b1p + kk);
            acc[0][NB - 1] = __builtin_amdgcn_mfma_f32_16x16x32_bf16(a0, b1, acc[0][NB - 1], 0, 0, 0);
            acc[1][NB - 1] = __builtin_amdgcn_mfma_f32_16x16x32_bf16(a1, b1, acc[1][NB - 1], 0, 0, 0); }
    }
    LAS float* red = (LAS float*)lds;
#pragma unroll
    for (int mt = 0; mt < 2; ++mt)
#pragma unroll
        for (int nb = 0; nb < NB; ++nb)
#pragma unroll
            for (int rg = 0; rg < 4; ++rg) red[((wave * NB + nb) * 32 + mt * 16 + 4 * fq + rg) * 16 + fr] = acc[mt][nb][rg];
    __syncthreads();
    float v0 = 0.f, v1 = 0.f;
#pragma unroll
    for (int w = 0; w < 8; ++w) { v0 += red[(w * NB) * 512 + tid]; if (NB == 2) v1 += red[(w * NB + 1) * 512 + tid]; }
    epi(32 * rh + (tid >> 4), tid & 15, v0, v1);
    __syncthreads();
}
struct SEpiInProj {
    float* projs; float rs; float* sk; float* sv; float* sp; int n0;
    __device__ __forceinline__ void operator()(int row, int cl, float v0, float) const {
        const int col = n0 + cl; const float v = v0 * rs;
        projs[(size_t)row * DIN + col] = v;
        if (col >= C_KA && col < C_VA) sk[(size_t)row * 768 + (col - C_KA)] = v;
        else if (col >= C_VA && col < C_UB) sv[(size_t)row * 768 + (col - C_VA)] = v;
        else if (col >= C_UB && col < C_QC) sp[(size_t)((row >> 3) * 15 + 7 + (row & 7)) * 512 + (col - C_UB)] = v;
    }
};
struct SEpiResid {
    const float* xin; float* xout; bf16* xb; float* spart; int n0;
    __device__ __forceinline__ void operator()(int row, int cl, float v0, float) const {
        const size_t o = (size_t)row * D + n0 + cl; const float v = xin[o] + v0;
        xout[o] = v; xb[o] = (bf16)f2bf(v);
        float s = v * v; s += __shfl_xor(s, 1); s += __shfl_xor(s, 2); s += __shfl_xor(s, 4); s += __shfl_xor(s, 8);
        if (cl == 0) spart[(size_t)row * 128 + (n0 >> 4)] = s;
    }
};
struct SEpiGateUp {
    bf16* F; float rs; int f0;
    __device__ __forceinline__ void operator()(int row, int cl, float v0, float v1) const {
        F[(size_t)(MP + row) * DFF + f0 + cl] = (bf16)f2bf(silu(v0 * rs) * (v1 * rs));
    }
};

__device__ __forceinline__ void s_attn_unit(const Ptrs& P, LAS unsigned char* lds, int l, int unit, int wave, int lane, int tid) {
    const int h = unit % 6, row = unit / 6, b = row >> 3, t = row & 7;
    const float* projs = (const float*)(P.ws + WS_PROJS);
    LAS float* qs = (LAS float*)lds;
    LAS float* ps = qs + 128;
    LAS float* red = ps + 512;
    LAS float* part = red + 16;
    if (tid < 128) qs[tid] = projs[(size_t)row * DIN + C_QA + h * 128 + tid] * 0.08838834764831845f;
    __syncthreads();
    const float* krow = nullptr;
    float sc = -1e30f;
    if (tid < 387) {
        const int p = tid / 129, j = tid - p * 129, dil = (p == 0) ? 1 : (p == 1 ? 4 : 16), idx = 2048 + t - dil * j;
        krow = (idx >= 2048) ? projs + (size_t)(b * 8 + idx - 2048) * DIN + C_KA + h * 128
                             : P.in[I_CK] + ((size_t)((l * 8 + b) * 2048 + idx) * 6 + h) * 128;
        float a = 0.f;
#pragma unroll 8
        for (int d = 0; d < 128; d += 4) { const f32x4 kv = *(const f32x4*)(krow + d); a += kv[0] * qs[d] + kv[1] * qs[d + 1] + kv[2] * qs[d + 2] + kv[3] * qs[d + 3]; }
        sc = a;
    }
    float m = wave_max(sc);
    if (lane == 0) red[wave] = m;
    __syncthreads();
    m = red[0];
#pragma unroll
    for (int w = 1; w < 8; ++w) m = fmaxf(m, red[w]);
    const float e = (tid < 387) ? __expf(sc - m) : 0.f;
    ps[tid] = e;
    float s = wave_sum(e);
    if (lane == 0) red[8 + wave] = s;
    __syncthreads();
    float den = 0.f;
#pragma unroll
    for (int w = 0; w < 8; ++w) den += red[8 + w];
    float o0 = 0.f, o1 = 0.f;
    for (int s2 = wave; s2 < 387; s2 += 8) {
        const int p = s2 / 129, j = s2 - p * 129, dil = (p == 0) ? 1 : (p == 1 ? 4 : 16), idx = 2048 + t - dil * j;
        const float* vr = (idx >= 2048) ? projs + (size_t)(b * 8 + idx - 2048) * DIN + C_VA + h * 128
                                        : P.in[I_CV] + ((size_t)((l * 8 + b) * 2048 + idx) * 6 + h) * 128;
        const f32x2 vv = *(const f32x2*)(vr + 2 * lane); const float pe = ps[s2];
        o0 += pe * vv[0]; o1 += pe * vv[1];
    }
    part[wave * 128 + 2 * lane] = o0; part[wave * 128 + 2 * lane + 1] = o1;
    __syncthreads();
    if (tid < 128) {
        float o = 0.f;
#pragma unroll
        for (int w = 0; w < 8; ++w) o += part[w * 128 + tid];
        ((bf16*)(P.ws + WS_MIX))[(size_t)(MP + row) * D + M_A + h * 128 + tid] = (bf16)f2bf(o / den);
    }
    __syncthreads();
}
__device__ __forceinline__ void s_pool_unit(const Ptrs& P, LAS unsigned char* lds, int l, int row, int tid) {
    const int b = row >> 3, t = row & 7;
    const float* projs = (const float*)(P.ws + WS_PROJS);
    const float* sp = P.in[I_SPOOL] + (size_t)(l * 8 + b) * 15 * 512;
    LAS float* pl = (LAS float*)lds;
    {
        const int c = tid, g = c >> 7, w = 2 << g; float sum = 0.f, cur = 0.f;
        for (int i = 0; i < w; ++i) { const int e = 15 + t - i;
            const float uv = (e < 15) ? sp[(size_t)e * 512 + c] : projs[(size_t)(b * 8 + e - 15) * DIN + C_UB + c];
            sum += uv; if (i == 0) cur = uv; }
        pl[c] = sum / (float)w - cur;
        if (t == 0) { float* dst = P.out + O_SP + (size_t)(l * 8 + b) * 15 * 512;
            for (int i = 0; i < 7; ++i) dst[(size_t)i * 512 + c] = sp[(size_t)(8 + i) * 512 + c]; }
    }
    __syncthreads();
    {
        const int g = tid >> 7, d = tid & 127; const float* wp = P.in[I_WPOOL] + (size_t)(l * 4 + g) * 128 * 128;
        float a = 0.f;
#pragma unroll 8
        for (int c = 0; c < 128; ++c) a += pl[g * 128 + c] * wp[(size_t)c * 128 + d];
        a *= P.in[I_PSCALE][l * 512 + tid];
        ((bf16*)(P.ws + WS_MIX))[(size_t)(MP + row) * D + M_B + tid] = (bf16)f2bf(a);
    }
    __syncthreads();
}
__device__ __forceinline__ void s_gla_unit(const Ptrs& P, LAS unsigned char* lds, int l, int unit, int tid) {
    const int b = unit >> 2, h = unit & 3;
    const float* projs = (const float*)(P.ws + WS_PROJS);
    LAS float* eg = (LAS float*)lds;
    LAS float* qL = eg + 768;
    LAS float* kL = qL + 768;
    LAS float* vL = kL + 768;
    LAS float* op = vL + 1536;
    LAS float* oc = op + 384;
    LAS float* rs = oc + 1536;
    for (int i = tid; i < 768; i += NTHR) {
        const int t = i / 96, dk = i % 96; const float* pr = projs + (size_t)(b * 8 + t) * DIN;
        float z = P.in[I_BG][l * 384 + h * 96 + dk];
#pragma unroll
        for (int r = 0; r < 16; ++r) z += pr[C_GC + r] * P.in[I_WG2][(size_t)(l * 16 + r) * 384 + h * 96 + dk];
        eg[i] = __expf(logsig(z) * (1.0f / 16.0f));
        qL[i] = pr[C_QC + h * 96 + dk] * 0.10206207261596575f;
        kL[i] = pr[C_KC + h * 96 + dk];
    }
    for (int i = tid; i < 1536; i += NTHR) { const int t = i / 192, dv = i % 192; vL[i] = projs[(size_t)(b * 8 + t) * DIN + C_VC + h * 192 + dv]; }
    __syncthreads();
    const int dv = tid % 192, hf = tid / 192;
    float S[48];
    const float* s0 = P.in[I_SGLA] + (size_t)((l * 8 + b) * 4 + h) * SELEMS;
    if (tid < 384) {
#pragma unroll
        for (int i = 0; i < 48; ++i) S[i] = s0[(size_t)(48 * hf + i) * 192 + dv];
    }
    for (int t = 0; t < 8; ++t) {
        if (tid < 384) {
            float o = 0.f; const float vv = vL[t * 192 + dv];
#pragma unroll
            for (int i = 0; i < 48; ++i) { const int dk = 48 * hf + i; S[i] = eg[t * 96 + dk] * S[i] + kL[t * 96 + dk] * vv; o += qL[t * 96 + dk] * S[i]; }
            op[hf * 192 + dv] = o;
        }
        __syncthreads();
        if (tid < 192) oc[t * 192 + tid] = op[tid] + op[192 + tid];
        __syncthreads();
    }
    if (tid < 384) { float* dst = P.out + O_SG + (size_t)((l * 8 + b) * 4 + h) * SELEMS;
#pragma unroll
        for (int i = 0; i < 48; ++i) dst[(size_t)(48 * hf + i) * 192 + dv] = S[i]; }
    {
        const int w = tid >> 6, ln = tid & 63; float s = 0.f;
        for (int i = ln; i < 192; i += 64) { const float x = oc[w * 192 + i]; s += x * x; }
        s = wave_sum(s);
        if (ln == 0) rs[w] = rsqrtf(s * (1.0f / 192.0f) + EPS);
    }
    __syncthreads();
    for (int i = tid; i < 1536; i += NTHR) {
        const int t = i / 192, d2 = i % 192; const int row = b * 8 + t;
        const float r = projs[(size_t)row * DIN + C_RC + h * 192 + d2];
        const float val = oc[i] * rs[t] * P.in[I_GNG][l * 192 + d2] * silu(r);
        ((bf16*)(P.ws + WS_MIX))[(size_t)(MP + row) * D + M_C + h * 192 + d2] = (bf16)f2bf(val);
    }
    __syncthreads();
}

__device__ __forceinline__ void p_attn_scalar_unit(const Ptrs& P, LAS unsigned char* lds, int unit, int wave, int lane) {
    const bf16* PROJ = (const bf16*)(P.ws + WS_PROJ);
    const int t8 = unit & 511, bh = unit >> 9, h = bh % 6, b = bh / 6, t = t8 * 8 + wave;
    const size_t r = (size_t)b * SEQ + t;
    LAS float* qs = (LAS float*)(lds + wave * 4096);
    LAS float* ps = qs + 128;
    LAS int* ks = (LAS int*)(ps + 448);
    { const unsigned w = *(const unsigned*)(PROJ + r * NINP + C_QA + h * 128 + 2 * lane);
      qs[2 * lane] = bf2f(w & 0xffffu) * 0.08838834764831845f; qs[2 * lane + 1] = bf2f(w >> 16) * 0.08838834764831845f; }
    asm volatile("s_waitcnt lgkmcnt(0)" ::: "memory");
    float sc[7]; float mx = -1e30f;
#pragma unroll
    for (int it = 0; it < 7; ++it) {
        const int s = it * 64 + lane, p = s / 129, j = s - p * 129, dil = (p == 0) ? 1 : (p == 1 ? 4 : 16), kp = t - dil * j;
        const bool valid = (s < 387) && (kp >= 0); const int kpc = valid ? kp : 0;
        const bf16* kr = PROJ + ((size_t)b * SEQ + kpc) * NINP + C_KA + h * 128;
        float a = 0.f;
#pragma unroll 4
        for (int d8 = 0; d8 < 16; ++d8) {
            const u32x4 w = *(const u32x4*)(kr + 8 * d8); const LAS float* q = qs + 8 * d8;
            a += bf2f(w.x & 0xffffu) * q[0] + bf2f(w.x >> 16) * q[1] + bf2f(w.y & 0xffffu) * q[2] + bf2f(w.y >> 16) * q[3]
               + bf2f(w.z & 0xffffu) * q[4] + bf2f(w.z >> 16) * q[5] + bf2f(w.w & 0xffffu) * q[6] + bf2f(w.w >> 16) * q[7];
        }
        sc[it] = valid ? a : -1e30f; ks[s] = valid ? kpc : -1; mx = fmaxf(mx, sc[it]);
    }
    mx = wave_max(mx);
    float sum = 0.f;
#pragma unroll
    for (int it = 0; it < 7; ++it) { const float e = (sc[it] > -1e29f) ? __expf(sc[it] - mx) : 0.f; ps[it * 64 + lane] = e; sum += e; }
    sum = wave_sum(sum);
    asm volatile("s_waitcnt lgkmcnt(0)" ::: "memory");
    float o0 = 0.f, o1 = 0.f;
    for (int s = 0; s < 387; ++s) {
        const int kp = ks[s];
        if (kp >= 0) { const unsigned w = *(const unsigned*)(PROJ + ((size_t)b * SEQ + kp) * NINP + C_VA + h * 128 + 2 * lane); const float pe = ps[s];
            o0 += pe * bf2f(w & 0xffffu); o1 += pe * bf2f(w >> 16); }
    }
    const float inv = 1.0f / sum;
    *(unsigned*)((bf16*)(P.ws + WS_MIX) + r * D + M_A + h * 128 + 2 * lane) = pk2(o0 * inv, o1 * inv);
    asm volatile("s_waitcnt lgkmcnt(0)" ::: "memory");
}
__device__ __forceinline__ void p_pool_unit(const Ptrs& P, LAS unsigned char* lds, int l, int unit, int tid) {
    const bf16* PROJ = (const bf16*)(P.ws + WS_PROJ);
    const int b = unit >> 8, t0 = (unit & 255) * 16;
    LAS float* pl = (LAS float*)lds;
    {
        const int c = tid, g = c >> 7, w = 2 << g;
        const bf16* up = PROJ + (size_t)b * SEQ * NINP + C_UB + c;
#pragma unroll 4
        for (int tt = 0; tt < 16; ++tt) {
            const int t = t0 + tt; float sum = 0.f;
            for (int i = 0; i < w; ++i) { const int tp = t - i; if (tp >= 0) sum += bf2f(up[(size_t)tp * NINP]); }
            const int cnt = (t + 1 < w) ? (t + 1) : w;
            pl[c * 16 + tt] = sum / (float)cnt - bf2f(up[(size_t)t * NINP]);
        }
    }
    __syncthreads();
    {
        const int g = tid >> 7, d = tid & 127; const float* wp = P.in[I_WPOOL] + (size_t)(l * 4 + g) * 128 * 128;
        float a[16];
#pragma unroll
        for (int i = 0; i < 16; ++i) a[i] = 0.f;
        for (int c = 0; c < 128; ++c) {
            const float wv = wp[(size_t)c * 128 + d]; const LAS f32x4* pv = (const LAS f32x4*)(pl + (g * 128 + c) * 16);
#pragma unroll
            for (int q = 0; q < 4; ++q) { const f32x4 x = pv[q]; a[4 * q] += x[0] * wv; a[4 * q + 1] += x[1] * wv; a[4 * q + 2] += x[2] * wv; a[4 * q + 3] += x[3] * wv; }
        }
        const float sc = P.in[I_PSCALE][l * 512 + tid];
        bf16* mx = (bf16*)(P.ws + WS_MIX) + ((size_t)b * SEQ + t0) * D + M_B + tid;
#pragma unroll
        for (int i = 0; i < 16; ++i) mx[(size_t)i * D] = (bf16)f2bf(a[i] * sc);
    }
    __syncthreads();
}
__device__ __forceinline__ void gla_gate_cumsum(const Ptrs& P, int l, int b, int h, int t0, int tid, LAS float* bL, LAS float* gaL, LAS float* wgL) {
    const float* GA = (const float*)(P.ws + WS_GA) + ((size_t)b * SEQ + t0) * 16;
    for (int i = tid; i < 1024; i += NTHR) gaL[i] = GA[i];
    for (int i = tid; i < 1536; i += NTHR) { const int r = i / 96, dk = i % 96; wgL[i] = P.in[I_WG2][(size_t)(l * 16 + r) * 384 + h * 96 + dk]; }
    if (tid < 96) wgL[1536 + tid] = P.in[I_BG][l * 384 + h * 96 + tid];
    __syncthreads();
    for (int i = tid; i < 6144; i += NTHR) {
        const int j = i / 96, dk = i % 96; float z = wgL[1536 + dk];
#pragma unroll
        for (int r = 0; r < 16; ++r) z += gaL[j * 16 + r] * wgL[r * 96 + dk];
        bL[j * 97 + dk] = logsig(z) * (1.0f / 16.0f);
    }
    __syncthreads();
    const int dk = tid % 96, seg = tid / 96;
    if (tid < 384) { float run = 0.f;
        for (int jj = 0; jj < 16; ++jj) { const int idx = (16 * seg + jj) * 97 + dk; run += bL[idx]; bL[idx] = run; } }
    __syncthreads();
    float off = 0.f;
    if (tid < 384) { for (int s = 0; s < seg; ++s) off += bL[(16 * s + 15) * 97 + dk]; }
    __syncthreads();
    if (tid < 384 && seg > 0) { for (int jj = 0; jj < 16; ++jj) bL[(16 * seg + jj) * 97 + dk] += off; }
    __syncthreads();
}
__device__ __forceinline__ void gla1_unit(const Ptrs& P, LAS unsigned char* lds, int l, int unit, int tid) {
    const bf16* PROJ = (const bf16*)(P.ws + WS_PROJ);
    const int bh = unit >> 6, n = unit & 63, b = bh >> 2, h = bh & 3, t0 = n * CH;
    LAS float* bL = (LAS float*)lds; LAS float* kt = (LAS float*)(lds + 24832); LAS float* vL = (LAS float*)(lds + 49408);
    LAS float* gaL = (LAS float*)(lds + 98560); LAS float* wgL = (LAS float*)(lds + 102656);
    gla_gate_cumsum(P, l, b, h, t0, tid, bL, gaL, wgL);
    const bf16* pr = PROJ + ((size_t)b * SEQ + t0) * NINP;
    for (int i = tid; i < 6144; i += NTHR) { const int j = i / 96, dk = i % 96;
        kt[i] = bf2f(pr[(size_t)j * NINP + C_KC + h * 96 + dk]) * __expf(bL[63 * 97 + dk] - bL[j * 97 + dk]); }
    for (int i = tid; i < 12288; i += NTHR) { const int j = i / 192, dv = i % 192; vL[i] = bf2f(pr[(size_t)j * NINP + C_VC + h * 192 + dv]); }
    if (tid < 96) ((float*)(P.ws + WS_DEC))[(size_t)unit * 96 + tid] = __expf(bL[63 * 97 + tid]);
    __syncthreads();
    const int bi = tid >> 5, bj = tid & 31;
    float acc[6][6];
#pragma unroll
    for (int a = 0; a < 6; ++a)
#pragma unroll
        for (int c = 0; c < 6; ++c) acc[a][c] = 0.f;
    for (int j = 0; j < CH; ++j) {
        float kk[6], vv[6];
#pragma unroll
        for (int a = 0; a < 6; ++a) { kk[a] = kt[j * 96 + 6 * bi + a]; vv[a] = vL[j * 192 + 6 * bj + a]; }
#pragma unroll
        for (int a = 0; a < 6; ++a)
#pragma unroll
            for (int c = 0; c < 6; ++c) acc[a][c] += kk[a] * vv[c];
    }
    float* sl = (float*)(P.ws + WS_SLOC) + (size_t)unit * SELEMS;
#pragma unroll
    for (int a = 0; a < 6; ++a)
#pragma unroll
        for (int c = 0; c < 6; ++c) sl[(size_t)(6 * bi + a) * 192 + 6 * bj + c] = acc[a][c];
    __syncthreads();
}
__device__ __forceinline__ void gla2_scan(const Ptrs& P, int l, int bx, int G, int tid) {
    const float* SL = (const float*)(P.ws + WS_SLOC); float* ST = (float*)(P.ws + WS_SST); const float* DEC = (const float*)(P.ws + WS_DEC);
    for (int e = bx * NTHR + tid; e < 8 * SELEMS; e += G * NTHR) {
        const int bh = e / SELEMS, rem = e % SELEMS, dk = rem / 192;
        float S = 0.f;
#pragma unroll 8
        for (int n = 0; n < NCH; ++n) {
            const size_t idx = (size_t)(bh * NCH + n) * SELEMS + rem;
            const float sl = SL[idx], dc = DEC[(size_t)(bh * NCH + n) * 96 + dk];
            ST[idx] = S; S = dc * S + sl;
        }
        P.out[O_PG + (size_t)(l * 8 + bh) * SELEMS + rem] = S;
    }
}
__device__ __forceinline__ void gla3_unit(const Ptrs& P, LAS unsigned char* lds, int l, int unit, int tid) {
    const bf16* PROJ = (const bf16*)(P.ws + WS_PROJ);
    const int bh = unit >> 6, n = unit & 63, b = bh >> 2, h = bh & 3, t0 = n * CH;
    LAS float* qe = (LAS float*)lds; LAS float* ke = (LAS float*)(lds + 24832); LAS float* Am = (LAS float*)(lds + 49664); LAS float* vL = (LAS float*)(lds + 66304);
    LAS float* gaL = (LAS float*)(lds + 115456); LAS float* wgL = (LAS float*)(lds + 119552);
    gla_gate_cumsum(P, l, b, h, t0, tid, qe, gaL, wgL);
    const bf16* pr = PROJ + ((size_t)b * SEQ + t0) * NINP;
    for (int i = tid; i < 6144; i += NTHR) { const int j = i / 96, dk = i % 96; const float bb = qe[j * 97 + dk];
        const float q = bf2f(pr[(size_t)j * NINP + C_QC + h * 96 + dk]) * 0.10206207261596575f, k = bf2f(pr[(size_t)j * NINP + C_KC + h * 96 + dk]);
        qe[j * 97 + dk] = q * __expf(bb); ke[j * 97 + dk] = k * __expf(-bb); }
    for (int i = tid; i < 12288; i += NTHR) { const int j = i / 192, dv = i % 192; vL[i] = bf2f(pr[(size_t)j * NINP + C_VC + h * 192 + dv]); }
    __syncthreads();
    const int ti = tid >> 5, tj = tid & 31;
    {
        float a[4][2];
#pragma unroll
        for (int i = 0; i < 4; ++i) { a[i][0] = 0.f; a[i][1] = 0.f; }
        for (int dk = 0; dk < 96; ++dk) {
            const float k0 = ke[(2 * tj) * 97 + dk], k1 = ke[(2 * tj + 1) * 97 + dk];
#pragma unroll
            for (int i = 0; i < 4; ++i) { const float q = qe[(4 * ti + i) * 97 + dk]; a[i][0] += q * k0; a[i][1] += q * k1; }
        }
#pragma unroll
        for (int i = 0; i < 4; ++i) { const int ri = 4 * ti + i;
            Am[ri * 65 + 2 * tj] = (2 * tj <= ri) ? a[i][0] : 0.f; Am[ri * 65 + 2 * tj + 1] = (2 * tj + 1 <= ri) ? a[i][1] : 0.f; }
    }
    __syncthreads();
    float o[4][6];
#pragma unroll
    for (int i = 0; i < 4; ++i)
#pragma unroll
        for (int c = 0; c < 6; ++c) o[i][c] = 0.f;
    for (int j = 0; j < CH; ++j) {
        float vv[6];
#pragma unroll
        for (int c = 0; c < 6; ++c) vv[c] = vL[j * 192 + 6 * tj + c];
#pragma unroll
        for (int i = 0; i < 4; ++i) { const float a = Am[(4 * ti + i) * 65 + j];
#pragma unroll
            for (int c = 0; c < 6; ++c) o[i][c] += a * vv[c]; }
    }
    const float* ST = (const float*)(P.ws + WS_SST) + (size_t)unit * SELEMS;
#pragma unroll 2
    for (int dk = 0; dk < 96; ++dk) {
        float sv[6];
#pragma unroll
        for (int c = 0; c < 6; ++c) sv[c] = ST[(size_t)dk * 192 + 6 * tj + c];
#pragma unroll
        for (int i = 0; i < 4; ++i) { const float q = qe[(4 * ti + i) * 97 + dk];
#pragma unroll
            for (int c = 0; c < 6; ++c) o[i][c] += q * sv[c]; }
    }
    bf16* MIX = (bf16*)(P.ws + WS_MIX);
#pragma unroll
    for (int i = 0; i < 4; ++i) {
        float ss = 0.f;
#pragma unroll
        for (int c = 0; c < 6; ++c) ss += o[i][c] * o[i][c];
        ss += __shfl_xor(ss, 1); ss += __shfl_xor(ss, 2); ss += __shfl_xor(ss, 4); ss += __shfl_xor(ss, 8); ss += __shfl_xor(ss, 16);
        const float rstd = rsqrtf(ss * (1.0f / 192.0f) + EPS);
        const size_t r = (size_t)b * SEQ + t0 + 4 * ti + i;
#pragma unroll
        for (int c = 0; c < 6; ++c) { const int dv = 6 * tj + c;
            const float rc = bf2f(PROJ[r * NINP + C_RC + h * 192 + dv]);
            MIX[r * D + M_C + h * 192 + dv] = (bf16)f2bf(o[i][c] * rstd * P.in[I_GNG][l * 192 + dv] * silu(rc)); }
    }
    __syncthreads();
}
__device__ __forceinline__ void final_norm(const Ptrs& P, int bx, int G, int wave, int lane) {
    const float* X = (const float*)(P.ws + WS_X); const float* part2 = (const float*)(P.ws + WS_PART2); const float* spart2 = (const float*)(P.ws + WS_SPART2); const float* g = P.in[I_FNG];
    for (int row = bx * NWAVES + wave; row < MT; row += G * NWAVES) {
        float ss;
        if (row < MP) ss = (lane < 8) ? part2[(size_t)row * 8 + lane] : 0.f;
        else ss = spart2[(size_t)(row - MP) * 128 + lane] + spart2[(size_t)(row - MP) * 128 + 64 + lane];
        const float rs = rsqrtf(wave_sum(ss) * (1.0f / 2048.0f) + EPS);
#pragma unroll
        for (int j = 0; j < 8; ++j) {
            const f32x4 v = *(const f32x4*)(X + (size_t)row * D + 4 * lane + 256 * j), gg = *(const f32x4*)(g + 4 * lane + 256 * j);
            *(f32x4*)(P.out + (size_t)row * D + 4 * lane + 256 * j) = v * rs * gg;
        }
    }
}

#ifndef MK_PER_PHASE
#define MK_PER_PHASE 0
#endif
constexpr int NPH = 30;
struct Args { const float* in[N_IN]; float* out; unsigned char* ws; int ph_lo, ph_hi, li, pad; };

__global__ void __launch_bounds__(NTHR, 2) fwd(Args args) {
    extern __shared__ __attribute__((aligned(16))) unsigned char lds_raw[];
    LAS unsigned char* lds = (LAS unsigned char*)lds_raw;
    const int tid = threadIdx.x, lane = tid & 63, wave = __builtin_amdgcn_readfirstlane(tid >> 6);
    const int G = gridDim.x, bx = blockIdx.x;
    Ptrs P;
#pragma unroll
    for (int i = 0; i < N_IN; ++i) P.in[i] = args.in[i];
    P.out = args.out; P.ws = args.ws;
    for (int u = tid; u < (LDS_BYTES - LDSCTL_OFF) / 4; u += NTHR) ((LAS unsigned*)(lds + LDSCTL_OFF))[u] = 0u;
    __syncthreads();
    unsigned* ctl = (unsigned*)(args.ws + WS_CTL);
    XcdBarrier bar; bar.bar = ctl + CW_BAR; bar.x = 0; bar.st = nullptr;
    if (!MK_PER_PHASE) bar = xcd_barrier_post(ctl + CW_BAR, (volatile LAS unsigned*)(lds + MISC_OFF) + 8);
    const int lo = args.ph_lo, hi = args.ph_hi;
#define IN(k) (lo <= (k) && (k) < hi)
#define LAUNDER() int tid_ = tid; asm volatile("" : "+v"(tid_)); const int lane_ = tid_ & 63, wave_ = __builtin_amdgcn_readfirstlane(tid_ >> 6); (void)lane_; (void)wave_
#define SEAM(k) do { if (IN((k) + 1)) { if (!MK_PER_PHASE) xcd_barrier(bar); } } while (0)

    float* part1 = (float*)(args.ws + WS_PART1); float* part2 = (float*)(args.ws + WS_PART2); float* spart1 = (float*)(args.ws + WS_SPART1); float* spart2 = (float*)(args.ws + WS_SPART2);
    pg8::PG8_LAS_T xch = (pg8::PG8_LAS_T)(lds + XCH_OFF);
    bf16* XB = (bf16*)(args.ws + WS_XB); bf16* MIXB = (bf16*)(args.ws + WS_MIX); bf16* PROJ = (bf16*)(args.ws + WS_PROJ); bf16* FB = (bf16*)(args.ws + WS_F);
    float* X = (float*)(args.ws + WS_X); float* projs = (float*)(args.ws + WS_PROJS);

    if (IN(0)) { LAUNDER(); prologue(P, lds, bx, G, wave_, lane_, tid_); SEAM(0); }

    for (int l = 0; l < DEPTH; ++l) {
        const int pb = 1 + 7 * l;
        unsigned char* wl = args.ws + WS_W + (size_t)l * LW_SZ;
        const bf16* Win = (const bf16*)(wl + LW_IN); const bf16* Wo = (const bf16*)(wl + LW_O); const bf16* Wgu = (const bf16*)(wl + LW_GU); const bf16* Wd = (const bf16*)(wl + LW_D);
        const float* xin_p = (l == 0) ? P.in[I_XP] : X; const float* xin_s = (l == 0) ? P.in[I_XS] : X + (size_t)MP * D;

        if (IN(pb + 0)) {
            LAUNDER();
            {
                pg8::Gemm g{XB, Win, MP, NINP, D}; pg8::StaticOrder S; S.init(MP, NINP, G, bx);
                pg8::EpiInProj E{PROJ, part2, (float*)(args.ws + WS_GA), P.out + O_PK + (size_t)l * 3145728, P.out + O_PV + (size_t)l * 3145728, P.out + O_PP + (size_t)l * 15360};
                pg8::gemm_phase<pg8::EpiInProj, pg8::StaticOrder, true, true>(lds, g, S, E);
            }
            for (int u = G - 1 - bx; u < 642; u += G) {
                const int rh = u & 1, ct = u >> 1;
                SEpiInProj E{projs, skinny_rs(spart2, rh, tid_), P.out + O_SK + (size_t)l * 49152, P.out + O_SV + (size_t)l * 49152, P.out + O_SP + (size_t)l * 61440, 16 * ct};
                skinny_unit<1>(lds, XB + (size_t)MP * D, Win + (size_t)16 * ct * D, Win, D, rh, E, wave_, lane_, tid_);
            }
            SEAM(pb + 0);
        }
        if (IN(pb + 1)) {
            { LAUNDER(); for (int u = bx; u < 384; u += G) s_attn_unit(P, lds, l, u, wave_, lane_, tid_); }
            { LAUNDER(); for (int u = bx; u < 64; u += G) s_pool_unit(P, lds, l, u, tid_); }
            { LAUNDER(); for (int u = bx; u < 32; u += G) s_gla_unit(P, lds, l, u, tid_); }
            { LAUNDER(); for (int u = bx; u < 512; u += G) gla1_unit(P, lds, l, u, tid_); }
            { LAUNDER(); for (int u = bx; u < 512; u += G) p_pool_unit(P, lds, l, u, tid_); }
            { LAUNDER(); for (int u = bx; u < 6144; u += G) p_attn_scalar_unit(P, lds, u, wave_, lane_); }
            SEAM(pb + 1);
        }
        if (IN(pb + 2)) { LAUNDER(); gla2_scan(P, l, bx, G, tid_); SEAM(pb + 2); }
        if (IN(pb + 3)) { LAUNDER(); for (int u = bx; u < 512; u += G) gla3_unit(P, lds, l, u, tid_); SEAM(pb + 3); }
        if (IN(pb + 4)) {
            LAUNDER();
            {
                pg8::Gemm g{MIXB, Wo, MP, D, D}; pg8::StaticOrder S; S.init(MP, D, G, bx);
                pg8::EpiResid E{xin_p, X, XB, part1, xch};
                pg8::gemm_phase<pg8::EpiResid, pg8::StaticOrder, true, true>(lds, g, S, E);
            }
            for (int u = G - 1 - bx; u < 256; u += G) {
                const int rh = u & 1, ct = u >> 1;
                SEpiResid E{xin_s, X + (size_t)MP * D, XB + (size_t)MP * D, spart1, 16 * ct};
                skinny_unit<1>(lds, MIXB + (size_t)MP * D, Wo + (size_t)16 * ct * D, Wo, D, rh, E, wave_, lane_, tid_);
            }
            SEAM(pb + 4);
        }
        if (IN(pb + 5)) {
            LAUNDER();
            {
                pg8::Gemm g{XB, Wgu, MP, NGU, D}; pg8::StaticOrder S; S.init(MP, NGU, G, bx);
                pg8::EpiGateUp E{FB, part1};
                pg8::gemm_phase<pg8::EpiGateUp, pg8::StaticOrder, true, true>(lds, g, S, E);
            }
            for (int u = G - 1 - bx; u < 704; u += G) {
                const int rh = u & 1, ft = u >> 1;
                const int f0 = 16 * ft; const size_t gr = (size_t)(256 * (f0 >> 7) + (f0 & 127));
                SEpiGateUp E{FB, skinny_rs(spart1, rh, tid_), f0};
                skinny_unit<2>(lds, XB + (size_t)MP * D, Wgu + gr * D, Wgu + (gr + 128) * D, D, rh, E, wave_, lane_, tid_);
            }
            SEAM(pb + 5);
        }
        if (IN(pb + 6)) {
            LAUNDER();
            {
                pg8::Gemm g{FB, Wd, MP, D, DFF}; pg8::StaticOrder S; S.init(MP, D, G, bx);
                pg8::EpiResid E{X, X, XB, part2, xch};
                pg8::gemm_phase<pg8::EpiResid, pg8::StaticOrder, true, true>(lds, g, S, E);
            }
            for (int u = G - 1 - bx; u < 256; u += G) {
                const int rh = u & 1, ct = u >> 1;
                SEpiResid E{X + (size_t)MP * D, X + (size_t)MP * D, XB + (size_t)MP * D, spart2, 16 * ct};
                skinny_unit<1>(lds, FB + (size_t)MP * DFF, Wd + (size_t)16 * ct * DFF, Wd, DFF, rh, E, wave_, lane_, tid_);
            }
            SEAM(pb + 6);
        }
    }
    if (IN(29)) { LAUNDER(); final_norm(P, bx, G, wave_, lane_); }
#undef IN
#undef SEAM
}

extern "C" void kernel_launch(void* const* d_in, const int* in_sizes, int n_in, void* d_out, int out_size, void* d_ws, size_t ws_size, hipStream_t stream) {
    static int grid = 0;
    if (grid == 0) {
        if (n_in != N_IN || (size_t)out_size != O_END || ws_size < WS_END) { fprintf(stderr, "kernel_launch: unexpected sizes n_in %d out %d ws %zu\n", n_in, out_size, ws_size); grid = -1; return; }
        int dev = 0, cus = 0, per_cu = 0;
        if (hipGetDevice(&dev) != hipSuccess || hipDeviceGetAttribute(&cus, hipDeviceAttributeMultiprocessorCount, dev) != hipSuccess) { grid = -1; return; }
        if (hipFuncSetAttribute((const void*)fwd, hipFuncAttributeMaxDynamicSharedMemorySize, LDS_BYTES) != hipSuccess) { fprintf(stderr, "kernel_launch: hipFuncSetAttribute failed\n"); grid = -1; return; }
        if (hipOccupancyMaxActiveBlocksPerMultiprocessor(&per_cu, (const void*)fwd, NTHR, LDS_BYTES) != hipSuccess || per_cu < 1) { fprintf(stderr, "kernel_launch: occupancy query says %d\n", per_cu); }
        (void)hipGetLastError();
        grid = cus;
    }
    if (grid < 0) return;
    (void)hipMemsetAsync((char*)d_ws + WS_CTL, 0, CTL_ZERO_BYTES, stream);
    Args a{};
    for (int i = 0; i < N_IN; ++i) a.in[i] = (const float*)d_in[i];
    a.out = (float*)d_out; a.ws = (unsigned char*)d_ws; a.li = 0; a.pad = 0;
#if MK_PER_PHASE
    for (int p = 0; p < NPH; ++p) { a.ph_lo = p; a.ph_hi = p + 1; hipLaunchKernelGGL(fwd, dim3(grid), dim3(NTHR), LDS_BYTES, stream, a); }
#else
    a.ph_lo = 0; a.ph_hi = NPH;
    hipLaunchKernelGGL(fwd, dim3(grid), dim3(NTHR), LDS_BYTES, stream, a);
#endif
    const hipError_t le = hipPeekAtLastError();
    if (le != hipSuccess) fprintf(stderr, "kernel_launch: launch failed: %s\n", hipGetErrorName(le));
}
```

```cpp
#include <hip/hip_runtime.h>
#include <cstdio>
#include <cstdint>
namespace pg8 {
#define PG8_LAS __attribute__((address_space(3)))
typedef unsigned short bf16_t;
typedef PG8_LAS float* PG8_LAS_T;
typedef short bf16x8 __attribute__((ext_vector_type(8)));
typedef float f32x4 __attribute__((ext_vector_type(4)));
typedef unsigned u32x4 __attribute__((ext_vector_type(4)));
constexpr int BM = 256, BK = 64, HALF = 128, HTB = HALF * BK * 2  , STAGE_BYTES = 8 * HTB, NXCD = 8, WGM = 8;

__host__ __device__ __forceinline__ int lds_byte(int r, int c) { const int st = (r >> 4) * 2 + (c >> 5), rr = r & 15, cc = c & 31, ob = rr * 64 + cc * 2; return st * 1024 + (ob ^ (((ob >> 9) & 1) << 5)); }
__host__ __device__ __forceinline__ void stage_rc(int b, int& R, int& C) { const int st = b / 1024, sb = b % 1024, swz = sb ^ (((sb >> 9) & 1) << 5); R = (st >> 1) * 16 + swz / 64; C = (st & 1) * 32 + (swz % 64) / 2; }
__host__ __device__ __forceinline__ int perm32(int rho) { const int n = rho >> 4, i = rho & 15; return 8 * (i >> 2) + 4 * n + (i & 3); }

struct Unit { int pm, pn; };
struct Gemm { const bf16_t* A; const bf16_t* Bt; int M, N, K; };

struct StaticOrder {
    int nM, nN, nwg, G, c;
    __host__ __device__ void init(int M, int N, int G_, int c_) { nM = M / BM; nN = N / BM; nwg = nM * nN; G = G_; c = c_; }
    __host__ __device__ bool next(int i, Unit& u) const {
        const long L = (long)i * G + c; if (L >= nwg) return false;
        int wgid = (int)L; { const int q = nwg / NXCD, r = nwg % NXCD, xcd = wgid % NXCD, off = wgid / NXCD; wgid = (xcd < r ? xcd * (q + 1) : r * (q + 1) + (xcd - r) * q) + off; }
        const int nig = WGM * nN, gid = wgid / nig, fm = gid * WGM, gsz = (nM - fm) < WGM ? (nM - fm) : WGM;
        u.pm = fm + ((wgid % nig) % gsz); u.pn = (wgid % nig) / gsz; return true;
    }
    __device__ __forceinline__ void a_ready(const Unit&) const {}
    __device__ __forceinline__ void done(const Unit&) const {}
};


__device__ __forceinline__ unsigned cvt_pk_bf16(float lo, float hi) { unsigned r; asm volatile("v_cvt_pk_bf16_f32 %0, %1, %2" : "=v"(r) : "v"(lo), "v"(hi)); return r; }
__device__ __forceinline__ float silu_f(float x) { return x * __builtin_amdgcn_rcpf(1.0f + __expf(-x)); }

struct EpiInProj {
    static constexpr bool PERM = true, AFTER_DRAIN = false;
    bf16_t* P; const float* part; float* ga; float* pk; float* pv; float* pp;
    __device__ __forceinline__ void operator()(const f32x4 (&acc)[2][2][4][2], const Unit& u, int wr, int wc, int fr, int fq) const {
        const int row0 = u.pm * BM + wr * 64 + fr, col0 = u.pn * BM + wc * 32 + 8 * fq;
        const int tp = (u.pm & 15) * 256;
        const bool kv_out = (u.pn >= 3 && u.pn < 9) && (tp >= 2048);
        const bool u_out = (u.pn == 9 || u.pn == 10) && (tp == 3840);
        const bool g_out = (u.pn == 20) && (wc == 0) && (fq < 2);
#pragma unroll
        for (int ai = 0; ai < 2; ++ai)
#pragma unroll
            for (int m = 0; m < 4; ++m) {
                const int r = row0 + ai * HALF + m * 16;
                const f32x4 q0 = *(const f32x4*)(part + (size_t)r * 8), q1 = *(const f32x4*)(part + (size_t)r * 8 + 4);
                const float rs = rsqrtf((((q0[0] + q0[1]) + (q0[2] + q0[3])) + ((q1[0] + q1[1]) + (q1[2] + q1[3]))) * (1.0f / 2048.0f) + 1e-6f);
                bf16_t* rowp = P + (size_t)r * 5376 + col0;
                const int b = r >> 12, t = r & 4095;
#pragma unroll
                for (int bj = 0; bj < 2; ++bj) {
                    const f32x4 v0 = acc[ai][bj][m][0] * rs, v1 = acc[ai][bj][m][1] * rs;
                    u32x4 w; w.x = cvt_pk_bf16(v0[0], v0[1]); w.y = cvt_pk_bf16(v0[2], v0[3]); w.z = cvt_pk_bf16(v1[0], v1[1]); w.w = cvt_pk_bf16(v1[2], v1[3]);
                    *(u32x4*)(rowp + bj * HALF) = w;
                    const int c = col0 + bj * HALF;
                    if (kv_out) {
                        float* dst = (u.pn < 6) ? (pk + ((size_t)(b * 2048 + (t - 2048)) * 768 + (c - 768))) : (pv + ((size_t)(b * 2048 + (t - 2048)) * 768 + (c - 1536)));
                        *(f32x4*)dst = v0; *(f32x4*)(dst + 4) = v1;
                    }
                    if (u_out && t >= 4081) {
                        float* dst = pp + ((size_t)(b * 15 + (t - 4081)) * 512 + (c - 2304));
                        *(f32x4*)dst = v0; *(f32x4*)(dst + 4) = v1;
                    }
                    if (g_out && bj == 0) {
                        float* dst = ga + (size_t)r * 16 + 8 * fq;
                        *(f32x4*)dst = v0; *(f32x4*)(dst + 4) = v1;
                    }
                }
            }
    }
};
struct EpiResid {
    static constexpr bool PERM = true, AFTER_DRAIN = false;
    const float* xin; float* xout; bf16_t* xb; float* part; PG8_LAS float* xch;
    __device__ __forceinline__ void operator()(const f32x4 (&acc)[2][2][4][2], const Unit& u, int wr, int wc, int fr, int fq) const {
        const int row0 = u.pm * BM + wr * 64 + fr, col0 = u.pn * BM + wc * 32 + 8 * fq;
#pragma unroll
        for (int ai = 0; ai < 2; ++ai)
#pragma unroll
            for (int m = 0; m < 4; ++m) {
                const int r = row0 + ai * HALF + m * 16;
                const size_t off = (size_t)r * 2048 + col0;
                float s = 0.f;
#pragma unroll
                for (int bj = 0; bj < 2; ++bj) {
                    const f32x4 a0 = *(const f32x4*)(xin + off + bj * HALF), a1 = *(const f32x4*)(xin + off + bj * HALF + 4);
                    const f32x4 v0 = acc[ai][bj][m][0] + a0, v1 = acc[ai][bj][m][1] + a1;
                    *(f32x4*)(xout + off + bj * HALF) = v0; *(f32x4*)(xout + off + bj * HALF + 4) = v1;
                    u32x4 w; w.x = cvt_pk_bf16(v0[0], v0[1]); w.y = cvt_pk_bf16(v0[2], v0[3]); w.z = cvt_pk_bf16(v1[0], v1[1]); w.w = cvt_pk_bf16(v1[2], v1[3]);
                    *(u32x4*)(xb + off + bj * HALF) = w;
                    s += (v0[0] * v0[0] + v0[1] * v0[1]) + (v0[2] * v0[2] + v0[3] * v0[3]) + (v1[0] * v1[0] + v1[1] * v1[1]) + (v1[2] * v1[2] + v1[3] * v1[3]);
                }
                s += __shfl_xor(s, 16); s += __shfl_xor(s, 32);
                if (fq == 0) xch[(ai * HALF + wr * 64 + m * 16 + fr) * 4 + wc] = s;
                asm volatile("" ::: "memory");
            }
        asm volatile("s_waitcnt lgkmcnt(0)" ::: "memory"); __builtin_amdgcn_s_barrier(); asm volatile("" ::: "memory");
        if (wr == 0) { const int row = wc * 64 + fq * 16 + fr; const f32x4 q = *(const PG8_LAS f32x4*)(xch + row * 4);
            part[(size_t)(u.pm * BM + row) * 8 + u.pn] = (q[0] + q[1]) + (q[2] + q[3]); }
    }
};
struct EpiGateUp {
    static constexpr bool PERM = true, AFTER_DRAIN = false;
    bf16_t* F; const float* part;
    __device__ __forceinline__ void operator()(const f32x4 (&acc)[2][2][4][2], const Unit& u, int wr, int wc, int fr, int fq) const {
        const int row0 = u.pm * BM + wr * 64 + fr, col0 = u.pn * HALF + wc * 32 + 8 * fq;
#pragma unroll
        for (int ai = 0; ai < 2; ++ai)
#pragma unroll
            for (int m = 0; m < 4; ++m) {
                const int r = row0 + ai * HALF + m * 16;
                const f32x4 q0 = *(const f32x4*)(part + (size_t)r * 8), q1 = *(const f32x4*)(part + (size_t)r * 8 + 4);
                const float rs = rsqrtf((((q0[0] + q0[1]) + (q0[2] + q0[3])) + ((q1[0] + q1[1]) + (q1[2] + q1[3]))) * (1.0f / 2048.0f) + 1e-6f);
                const f32x4 g0 = acc[ai][0][m][0] * rs, g1 = acc[ai][0][m][1] * rs, u0 = acc[ai][1][m][0] * rs, u1 = acc[ai][1][m][1] * rs;
                u32x4 w;
                w.x = cvt_pk_bf16(silu_f(g0[0]) * u0[0], silu_f(g0[1]) * u0[1]); w.y = cvt_pk_bf16(silu_f(g0[2]) * u0[2], silu_f(g0[3]) * u0[3]);
                w.z = cvt_pk_bf16(silu_f(g1[0]) * u1[0], silu_f(g1[1]) * u1[1]); w.w = cvt_pk_bf16(silu_f(g1[2]) * u1[2], silu_f(g1[3]) * u1[3]);
                *(u32x4*)(F + (size_t)r * 5632 + col0) = w;
            }
    }
};

template <class Epi, class Sched, bool ALIGN_EPI = false, bool SP2 = false>
__device__ __forceinline__ void gemm_phase(PG8_LAS unsigned char* lds, const Gemm g, const Sched& S, const Epi& E) {
    int tid = threadIdx.x; asm volatile("" : "+v"(tid)); const int wid = __builtin_amdgcn_readfirstlane(tid >> 6), lane = tid & 63, wr = wid >> 2, wc = wid & 3, fr = lane & 15, fq = lane >> 4;
    const int K = g.K, nt = K / BK;
    unsigned voffA[2], voffB[2];
#pragma unroll
    for (int i = 0; i < 2; ++i) { int R, C; stage_rc(tid * 16 + i * 8192, R, C); const int Rb = Epi::PERM ? ((R & ~31) + perm32(R & 31)) : R;
        voffA[i] = (unsigned)(R * K + C) * 2u; voffB[i] = (unsigned)(Rb * K + C) * 2u; }
    const size_t kstep = (size_t)(BK * 2);
    const size_t hstep = (size_t)HALF * K * 2;
    const size_t tstep = 2 * hstep;
    const unsigned ldsw = (unsigned)wid * 1024u;
    const int aoff = lds_byte(wr * 64 + fr, fq * 8), boff = lds_byte(wc * 32 + fr, fq * 8);
#define PG8_SA(b, h) (((b) * 2 + (h)) * HTB)
#define PG8_SB(b, h) ((4 + (b) * 2 + (h)) * HTB)
#define PG8_STAGE(bufoff, gbase, voff) do { _Pragma("unroll") for (int _i = 0; _i < 2; ++_i) \
        __builtin_amdgcn_global_load_lds((const unsigned*)((const char*)(gbase) + (voff)[_i]), (PG8_LAS unsigned*)(lds + (bufoff) + ldsw + _i * 8192), 16, 0, 0); } while (0)
#define PG8_LDA(dst, b, h) do { _Pragma("unroll") for (int m = 0; m < 4; ++m) _Pragma("unroll") for (int k = 0; k < 2; ++k) dst[m][k] = *(const PG8_LAS bf16x8*)(lds + PG8_SA(b, h) + aoff + m * 2048 + k * 1024); } while (0)
#define PG8_LDB(dst, b, h) do { _Pragma("unroll") for (int n = 0; n < 2; ++n) _Pragma("unroll") for (int k = 0; k < 2; ++k) dst[n][k] = *(const PG8_LAS bf16x8*)(lds + PG8_SB(b, h) + boff + n * 2048 + k * 1024); } while (0)
#define PG8_MMA(ai, bj, At, Bt) do { __builtin_amdgcn_s_setprio(1); _Pragma("unroll") for (int m = 0; m < 4; ++m) _Pragma("unroll") for (int n = 0; n < 2; ++n) _Pragma("unroll") for (int k = 0; k < 2; ++k) \
        acc[ai][bj][m][n] = __builtin_amdgcn_mfma_f32_16x16x32_bf16(Bt[n][k], At[m][k], acc[ai][bj][m][n], 0, 0, 0); __builtin_amdgcn_s_setprio(0); } while (0)
#define PG8_WAIT_V(n) asm volatile("s_waitcnt vmcnt(" #n ")" ::: "memory")
#define PG8_WAIT_L(n) asm volatile("s_waitcnt lgkmcnt(" #n ")" ::: "memory")
#define PG8_BAR __builtin_amdgcn_s_barrier()
#define PG8_SCHED __builtin_amdgcn_sched_barrier(0)
    Unit cur, nxt; int ui = 0;
    if (!S.next(0, cur)) return;
    f32x4 acc[2][2][4][2];
#pragma unroll
    for (int a = 0; a < 2; ++a)
#pragma unroll
        for (int b = 0; b < 2; ++b)
#pragma unroll
            for (int m = 0; m < 4; ++m)
#pragma unroll
                for (int n = 0; n < 2; ++n) acc[a][b][m][n] = (f32x4){0.f, 0.f, 0.f, 0.f};
    bf16x8 At[4][2], B0[2][2], B1[2][2];
    const char* cA = (const char*)g.A + (size_t)cur.pm * tstep; const char* cB = (const char*)g.Bt + (size_t)cur.pn * tstep;
    S.a_ready(cur);
    if constexpr (SP2) {
        PG8_STAGE(PG8_SB(0, 0), cB, voffB); PG8_STAGE(PG8_SB(0, 1), cB + hstep, voffB); PG8_STAGE(PG8_SA(0, 0), cA, voffA); PG8_STAGE(PG8_SA(0, 1), cA + hstep, voffA);
        if (wr == 1) PG8_BAR;
        PG8_WAIT_V(2); PG8_BAR;
        PG8_STAGE(PG8_SB(1, 0), cB + kstep, voffB); PG8_STAGE(PG8_SA(1, 0), cA + kstep, voffA); PG8_STAGE(PG8_SB(1, 1), cB + hstep + kstep, voffB);
        PG8_WAIT_V(6); PG8_BAR;
    } else {
        PG8_STAGE(PG8_SB(0, 0), cB, voffB); PG8_STAGE(PG8_SA(0, 0), cA, voffA); PG8_STAGE(PG8_SB(0, 1), cB + hstep, voffB); PG8_STAGE(PG8_SA(0, 1), cA + hstep, voffA);
        if (wr == 1) PG8_BAR;
        PG8_WAIT_V(4); PG8_BAR;
        PG8_STAGE(PG8_SB(1, 0), cB + kstep, voffB); PG8_STAGE(PG8_SA(1, 0), cA + kstep, voffA); PG8_STAGE(PG8_SB(1, 1), cB + hstep + kstep, voffB);
        PG8_WAIT_V(6); PG8_BAR;
    }
    for (;;) {
        const bool has_next = S.next(ui + 1, nxt);
        const char* nA = has_next ? (const char*)g.A + (size_t)nxt.pm * tstep : cA; const char* nB = has_next ? (const char*)g.Bt + (size_t)nxt.pn * tstep : cB;
        for (int t = 0; t < nt; t += 2) {
            const bool last = (t == nt - 2);
            const char* a1 = cA + (size_t)(t + 1) * kstep;
            const char* a2 = last ? nA : cA + (size_t)(t + 2) * kstep; const char* b2 = last ? nB : cB + (size_t)(t + 2) * kstep;
            const char* a3 = a2 + kstep; const char* b3 = b2 + kstep;
            if (last && has_next) S.a_ready(nxt);
            if constexpr (SP2) {
            PG8_LDB(B0, 0, 0); PG8_LDB(B1, 0, 1); PG8_SCHED; PG8_LDA(At, 0, 0); PG8_STAGE(PG8_SA(1, 1), a1 + hstep, voffA);
            PG8_WAIT_V(8); PG8_WAIT_L(0); PG8_BAR; PG8_MMA(0, 0, At, B0); PG8_MMA(0, 1, At, B1); PG8_BAR; PG8_SCHED;
            PG8_LDA(At, 0, 1); PG8_STAGE(PG8_SB(0, 0), b2, voffB); PG8_STAGE(PG8_SB(0, 1), b2 + hstep, voffB); PG8_STAGE(PG8_SA(0, 0), a2, voffA);
            PG8_WAIT_V(8); PG8_WAIT_L(0); PG8_BAR; PG8_MMA(1, 0, At, B0); PG8_MMA(1, 1, At, B1); PG8_BAR; PG8_SCHED;
            PG8_LDB(B0, 1, 0); PG8_LDB(B1, 1, 1); PG8_SCHED; PG8_LDA(At, 1, 0); PG8_STAGE(PG8_SA(0, 1), a2 + hstep, voffA);
            PG8_WAIT_V(8); PG8_WAIT_L(0); PG8_BAR; PG8_MMA(0, 0, At, B0); PG8_MMA(0, 1, At, B1); PG8_BAR; PG8_SCHED;
            PG8_LDA(At, 1, 1); PG8_STAGE(PG8_SB(1, 0), b3, voffB); PG8_STAGE(PG8_SB(1, 1), b3 + hstep, voffB); PG8_STAGE(PG8_SA(1, 0), a3, voffA);
            PG8_WAIT_V(8); PG8_WAIT_L(0); PG8_BAR; PG8_MMA(1, 0, At, B0); PG8_MMA(1, 1, At, B1); PG8_BAR; PG8_SCHED;
            } else {
            PG8_LDB(B0, 0, 0); PG8_SCHED; PG8_LDA(At, 0, 0); PG8_STAGE(PG8_SA(1, 1), a1 + hstep, voffA);
            PG8_WAIT_L(8); PG8_BAR; PG8_WAIT_L(0); PG8_MMA(0, 0, At, B0); PG8_BAR; PG8_SCHED;
            PG8_LDB(B1, 0, 1); PG8_STAGE(PG8_SB(0, 0), b2, voffB);
            PG8_BAR; PG8_WAIT_L(0); PG8_MMA(0, 1, At, B1); PG8_BAR;
            PG8_LDA(At, 0, 1); PG8_STAGE(PG8_SA(0, 0), a2, voffA);
            PG8_BAR; PG8_WAIT_L(0); PG8_MMA(1, 0, At, B0); PG8_BAR; PG8_SCHED;
            PG8_STAGE(PG8_SB(0, 1), b2 + hstep, voffB);
            PG8_WAIT_V(6); PG8_BAR; PG8_MMA(1, 1, At, B1); PG8_BAR;
            PG8_LDB(B0, 1, 0); PG8_SCHED; PG8_LDA(At, 1, 0); PG8_STAGE(PG8_SA(0, 1), a2 + hstep, voffA);
            PG8_WAIT_L(8); PG8_BAR; PG8_WAIT_L(0); PG8_MMA(0, 0, At, B0); PG8_BAR; PG8_SCHED;
            PG8_LDB(B1, 1, 1); PG8_STAGE(PG8_SB(1, 0), b3, voffB);
            PG8_BAR; PG8_WAIT_L(0); PG8_MMA(0, 1, At, B1); PG8_BAR;
            PG8_LDA(At, 1, 1); PG8_STAGE(PG8_SA(1, 0), a3, voffA);
            PG8_BAR; PG8_WAIT_L(0); PG8_MMA(1, 0, At, B0); PG8_BAR; PG8_SCHED;
            PG8_STAGE(PG8_SB(1, 1), b3 + hstep, voffB);
            PG8_WAIT_V(6); PG8_BAR; PG8_MMA(1, 1, At, B1); PG8_BAR;
            }
        }
        if constexpr (ALIGN_EPI) { if (wr == 0) PG8_BAR; }
        if constexpr (!Epi::AFTER_DRAIN) { E(acc, cur, wr, wc, fr, fq); S.done(cur); }
        if (!has_next) break;
#pragma unroll
        for (int a = 0; a < 2; ++a)
#pragma unroll
            for (int b = 0; b < 2; ++b)
#pragma unroll
                for (int m = 0; m < 4; ++m)
#pragma unroll
                    for (int n = 0; n < 2; ++n) acc[a][b][m][n] = (f32x4){0.f, 0.f, 0.f, 0.f};
        cur = nxt; cA = nA; cB = nB; ++ui;
        if constexpr (ALIGN_EPI) { if (wr == 1) PG8_BAR; }
    }
    PG8_WAIT_V(0);
    if constexpr (!ALIGN_EPI) { if (wr == 0) PG8_BAR; }
    PG8_BAR;
    if constexpr (Epi::AFTER_DRAIN) { E.fused(acc, cur, wr, wc, fr, fq, lds, wid, lane); S.done(cur); }
#undef PG8_SA
#undef PG8_SB
#undef PG8_STAGE
#undef PG8_LDA
#undef PG8_LDB
#undef PG8_MMA
#undef PG8_WAIT_V
#undef PG8_WAIT_L
#undef PG8_BAR
#undef PG8_SCHED
}
}

#define GAS __attribute__((address_space(1)))
#define LAS __attribute__((address_space(3)))
typedef unsigned short bf16;
typedef float f32x4 __attribute__((ext_vector_type(4)));
typedef float f32x2 __attribute__((ext_vector_type(2)));
typedef short bf16x8 __attribute__((ext_vector_type(8)));
typedef unsigned u32x4 __attribute__((ext_vector_type(4)));
typedef unsigned u32x2 __attribute__((ext_vector_type(2)));
typedef GAS unsigned gu32;

constexpr int NWAVES = 8, NTHR = 512;
constexpr int D = 2048, SEQ = 4096, MP = 8192, MS = 64, MT = MP + MS, DEPTH = 4;
constexpr int DIN = 5136, NINP = 5376, DFF = 5632, NGU = 2 * DFF;
constexpr int C_QA = 0, C_KA = 768, C_VA = 1536, C_UB = 2304, C_QC = 2816, C_KC = 3200, C_VC = 3584, C_RC = 4352, C_GC = 5120;
constexpr int M_A = 0, M_B = 768, M_C = 1280;
constexpr float EPS = 1e-6f;
constexpr int NCH = 64, CH = 64;
constexpr int SELEMS = 96 * 192;

enum { I_XP = 0, I_XS, I_CK, I_CV, I_SPOOL, I_SGLA, I_N1G, I_WIN, I_WG2, I_BG, I_WPOOL, I_PSCALE, I_GNG, I_WO, I_N2G, I_WFG, I_WFU, I_WFD, I_FNG, N_IN };
constexpr size_t O_YP = 0, O_YS = 16777216, O_PK = 16908288, O_PV = 29491200, O_PP = 42074112, O_PG = 42135552, O_SK = 42725376, O_SV = 42921984, O_SP = 43118592, O_SG = 43364352, O_END = 45723648;
constexpr size_t MiB = 1u << 20;
constexpr size_t WS_CTL = 0, CTL_ZERO_BYTES = 1 * MiB;
constexpr size_t WS_PART1 = 1 * MiB, WS_PART2 = 1 * MiB + 262144, WS_SPART1 = 1 * MiB + 524288, WS_SPART2 = 1 * MiB + 589824;
constexpr size_t WS_GA = 2 * MiB, WS_DEC = 3 * MiB, WS_PROJS = 4 * MiB;
constexpr size_t WS_W = 8 * MiB;
constexpr size_t LW_IN = 0, LW_O = (size_t)NINP * D * 2, LW_GU = LW_O + (size_t)D * D * 2, LW_D = LW_GU + (size_t)NGU * D * 2, LW_SZ = LW_D + (size_t)D * DFF * 2;
static_assert(LW_SZ == 99614720, "layer weight bytes");
constexpr size_t WS_X = 388 * MiB, WS_XB = 453 * MiB, WS_MIX = 486 * MiB, WS_PROJ = 519 * MiB, WS_F = 603 * MiB, WS_SLOC = 692 * MiB, WS_SST = 728 * MiB, WS_BCUM = 764 * MiB, WS_END = 780 * MiB;
static_assert(WS_W + 4 * LW_SZ <= WS_X && WS_X + (size_t)MT * D * 4 <= WS_XB && WS_XB + (size_t)MT * D * 2 <= WS_MIX && WS_MIX + (size_t)MT * D * 2 <= WS_PROJ, "ws map 1");
static_assert(WS_PROJ + (size_t)MP * NINP * 2 <= WS_F && WS_F + (size_t)MT * DFF * 2 <= WS_SLOC && WS_SLOC + (size_t)512 * SELEMS * 4 <= WS_SST && WS_SST + (size_t)512 * SELEMS * 4 <= WS_BCUM && WS_BCUM + (size_t)MP * 384 * 4 <= WS_END, "ws map 2");
constexpr size_t WS_OP = WS_F, WS_LSE = WS_F + 40 * MiB;
static_assert((size_t)3 * MP * 768 * 2 <= 40 * MiB && WS_LSE + (size_t)3 * MP * 6 * 4 <= WS_SLOC, "attention partials fit");
constexpr int CW_BAR = 4096;
constexpr int RING_BYTES = 131072, XCH_OFF = RING_BYTES, SCRATCH_BYTES = 139264, LDSCTL_OFF = SCRATCH_BYTES, MISC_OFF = LDSCTL_OFF + 320, LDS_BYTES = 147456;

#define RLX_AGENT __ATOMIC_RELAXED, __HIP_MEMORY_SCOPE_AGENT
__device__ __forceinline__ float bf2f(unsigned b) { return __uint_as_float(b << 16); }
__device__ __forceinline__ unsigned f2bf(float f) { unsigned u = __float_as_uint(f); return (u + 0x7fffu + ((u >> 16) & 1u)) >> 16; }
__device__ __forceinline__ unsigned pk2(float lo, float hi) { return f2bf(lo) | (f2bf(hi) << 16); }
__device__ __forceinline__ float wave_sum(float v) {
#pragma unroll
    for (int o = 1; o < 64; o <<= 1) v += __shfl_xor(v, o);
    return v;
}
__device__ __forceinline__ float wave_max(float v) {
#pragma unroll
    for (int o = 1; o < 64; o <<= 1) v = fmaxf(v, __shfl_xor(v, o));
    return v;
}
__device__ __forceinline__ float logsig(float z) { return fminf(z, 0.f) - log1pf(__expf(-fabsf(z))); }
__device__ __forceinline__ float silu(float x) { return x / (1.0f + __expf(-x)); }

#define XB_TMO      128
#define XB_XCNT(j)  (256  + 64 * (j))
#define XB_XSUB(j)  (1280 + 64 * (j))
#define XB_XGEN(j)  (2304 + 64 * (j))
#define XB_TOP      3328
#define XB_TOPGEN   3392
#define XCD_BAR_WORDS 3456
#define XB_SPIN_CAP (1u << 18)

__device__ __forceinline__ unsigned xb_ld(unsigned* p)              { return __hip_atomic_load(p, __ATOMIC_RELAXED, __HIP_MEMORY_SCOPE_AGENT); }
__device__ __forceinline__ unsigned xb_add(unsigned* p, unsigned v) { return __hip_atomic_fetch_add(p, v, __ATOMIC_RELAXED, __HIP_MEMORY_SCOPE_AGENT); }
__device__ __forceinline__ unsigned xb_xcc_id() { return (unsigned)__builtin_amdgcn_s_getreg((3 << 11) | 20) & 0xFu; }
#define XB_SPIN(cond, bar) do { unsigned _sp = 0; while (cond) { __builtin_amdgcn_s_sleep(1); \
    if ((++_sp & 255u) == 0u) { if (xb_ld(&(bar)[XB_TMO])) break; if (_sp > XB_SPIN_CAP) { atomicAdd(&(bar)[XB_TMO], 1u); break; } } } } while (0)

struct XcdBarrier {
    unsigned* bar; unsigned x;
    volatile LAS unsigned* st;
};

__device__ __forceinline__ XcdBarrier xcd_barrier_post(unsigned* bar, volatile LAS unsigned* st) {
    XcdBarrier b; b.bar = bar; b.x = xb_xcc_id(); b.st = st;
    if (threadIdx.x == 0) (void)xb_add(&bar[XB_XCNT(b.x)], 1u);
    return b;
}
__device__ __forceinline__ void xcd_barrier_complete(unsigned* bar, unsigned x, unsigned& nloc, unsigned& nx) {
    const unsigned G = gridDim.x * gridDim.y * gridDim.z;
    unsigned sum, cnt, mine, sp = 0u;
    for (;;) {
        sum = 0u; cnt = 0u; mine = 0u;
#pragma unroll
        for (unsigned j = 0; j < 16; ++j) { const unsigned c = xb_ld(&bar[XB_XCNT(j)]); sum += c; cnt += (c > 0u) ? 1u : 0u; mine = (j == x) ? c : mine; }
        if (sum == G) break;
        __builtin_amdgcn_s_sleep(1);
        if ((++sp & 255u) == 0u) { if (xb_ld(&bar[XB_TMO])) break; if (sp > XB_SPIN_CAP) { atomicAdd(&bar[XB_TMO], 1u); break; } }
    }
    nloc = mine > 0u ? mine : 1u; nx = cnt > 0u ? cnt : 1u;
}

__device__ __forceinline__ void xcd_barrier(const XcdBarrier& b) {
    asm volatile("s_waitcnt vmcnt(0)" ::: "memory");
    __syncthreads();
    if (threadIdx.x == 0) {
        unsigned* bar = b.bar;
        __builtin_amdgcn_s_waitcnt(0);
        unsigned nloc = b.st[0], nx = b.st[1];
        if (nloc == 0u) { xcd_barrier_complete(bar, b.x, nloc, nx); b.st[0] = nloc; b.st[1] = nx; }
        const unsigned old = xb_add(&bar[XB_XSUB(b.x)], 1u);
        const unsigned gen = old / nloc;
        if (old + 1u == (gen + 1u) * nloc) {
            __builtin_amdgcn_fence(__ATOMIC_RELEASE, "agent");
            asm volatile("s_waitcnt vmcnt(0)" ::: "memory");
            const unsigned og = xb_add(&bar[XB_TOP], 1u);
            const unsigned tg = og / nx;
            if (og + 1u == (tg + 1u) * nx) xb_add(&bar[XB_TOPGEN], 1u);
            else XB_SPIN(xb_ld(&bar[XB_TOPGEN]) == tg, bar);
            __builtin_amdgcn_fence(__ATOMIC_ACQUIRE, "agent");
            xb_add(&bar[XB_XGEN(b.x)], 1u);
            asm volatile("s_waitcnt vmcnt(0)" ::: "memory");
        } else {
            XB_SPIN(xb_ld(&bar[XB_XGEN(b.x)]) == gen, bar);
            __builtin_amdgcn_fence(__ATOMIC_ACQUIRE, "agent");
            asm volatile("s_waitcnt vmcnt(0)" ::: "memory");
        }
    }
    __syncthreads();
}

struct RowId { __device__ __forceinline__ int operator()(int n) const { return n; } };
struct RowGate { int up; __device__ __forceinline__ int operator()(int f) const { return 256 * (f >> 7) + 128 * up + (f & 127); } };
template <class RM>
__device__ __forceinline__ void cvt_tile(const float* __restrict__ W, int K, int N, int k0, int n0, const float* __restrict__ gk, bf16* Wt, RM rowmap, LAS float* scr, int lane) {
    const int cl = 4 * (lane & 15), kr = lane >> 4;
    f32x4 v[16];
#pragma unroll
    for (int i = 0; i < 16; ++i) {
        const int kk = 4 * i + kr, n = n0 + cl;
        v[i] = (n + 3 < N) ? *(const f32x4*)(W + (size_t)(k0 + kk) * N + n) : (f32x4){0.f, 0.f, 0.f, 0.f};
    }
#pragma unroll
    for (int i = 0; i < 16; ++i) {
        const int kk = 4 * i + kr; const float g = gk ? gk[k0 + kk] : 1.0f;
        LAS float* s = scr + kk * 65 + cl;
        s[0] = v[i][0] * g; s[1] = v[i][1] * g; s[2] = v[i][2] * g; s[3] = v[i][3] * g;
    }
    asm volatile("s_waitcnt lgkmcnt(0)" ::: "memory");
    const int c = lane & 7;
#pragma unroll
    for (int i = 0; i < 8; ++i) {
        const int nl = 8 * i + (lane >> 3), n = n0 + nl;
        const LAS float* s = scr + (8 * c) * 65 + nl;
        u32x4 o; o.x = pk2(s[0 * 65], s[1 * 65]); o.y = pk2(s[2 * 65], s[3 * 65]); o.z = pk2(s[4 * 65], s[5 * 65]); o.w = pk2(s[6 * 65], s[7 * 65]);
        if (n < N) *(u32x4*)(Wt + (size_t)rowmap(n) * K + k0 + 8 * c) = o;
    }
    asm volatile("s_waitcnt lgkmcnt(0)" ::: "memory");
}

struct Ptrs {
    const float* in[N_IN]; float* out; unsigned char* ws;
};

__device__ __forceinline__ void prologue(const Ptrs& P, LAS unsigned char* lds, int bx, int G, int wave, int lane, int tid) {
    LAS float* scr = (LAS float*)(lds + wave * 16640);
    const int gw = bx * NWAVES + wave, NGW = G * NWAVES;
    constexpr int I_IN = 32 * 81, I_O = 32 * 32, I_G = 32 * 88, I_D = 88 * 32, I_L = I_IN + I_O + 2 * I_G + I_D;
    for (int it = gw; it < DEPTH * I_L; it += NGW) {
        const int l = it / I_L; int r = it - l * I_L;
        unsigned char* wl = P.ws + WS_W + (size_t)l * LW_SZ;
        if (r < I_IN) { const int kb = r / 81, nb = r % 81; cvt_tile(P.in[I_WIN] + (size_t)l * D * DIN, D, DIN, 64 * kb, 64 * nb, P.in[I_N1G] + l * D, (bf16*)(wl + LW_IN), RowId{}, scr, lane); continue; } r -= I_IN;
        if (r < I_O) { const int kb = r / 32, nb = r % 32; cvt_tile(P.in[I_WO] + (size_t)l * D * D, D, D, 64 * kb, 64 * nb, (const float*)nullptr, (bf16*)(wl + LW_O), RowId{}, scr, lane); continue; } r -= I_O;
        if (r < I_G) { const int kb = r / 88, nb = r % 88; cvt_tile(P.in[I_WFG] + (size_t)l * D * DFF, D, DFF, 64 * kb, 64 * nb, P.in[I_N2G] + l * D, (bf16*)(wl + LW_GU), RowGate{0}, scr, lane); continue; } r -= I_G;
        if (r < I_G) { const int kb = r / 88, nb = r % 88; cvt_tile(P.in[I_WFU] + (size_t)l * D * DFF, D, DFF, 64 * kb, 64 * nb, P.in[I_N2G] + l * D, (bf16*)(wl + LW_GU), RowGate{1}, scr, lane); continue; } r -= I_G;
        { const int kb = r / 32, nb = r % 32; cvt_tile(P.in[I_WFD] + (size_t)l * DFF * D, DFF, D, 64 * kb, 64 * nb, (const float*)nullptr, (bf16*)(wl + LW_D), RowId{}, scr, lane); }
    }
    for (int i = bx * NTHR + tid; i < DEPTH * 61440; i += G * NTHR) {
        const int l = i / 61440, j = i % 61440;
        *(u32x4*)(P.ws + WS_W + (size_t)l * LW_SZ + LW_IN + (size_t)DIN * D * 2 + (size_t)j * 16) = (u32x4){0u, 0u, 0u, 0u};
    }
    float* part2 = (float*)(P.ws + WS_PART2); float* spart2 = (float*)(P.ws + WS_SPART2); bf16* XB = (bf16*)(P.ws + WS_XB);
    for (int row = gw; row < MT; row += NGW) {
        const float* xr = (row < MP) ? P.in[I_XP] + (size_t)row * D : P.in[I_XS] + (size_t)(row - MP) * D;
        float s = 0.f;
#pragma unroll
        for (int j = 0; j < 8; ++j) {
            const f32x4 v = *(const f32x4*)(xr + 4 * lane + 256 * j);
            s += (v[0] * v[0] + v[1] * v[1]) + (v[2] * v[2] + v[3] * v[3]);
            u32x2 o; o.x = pk2(v[0], v[1]); o.y = pk2(v[2], v[3]);
            *(u32x2*)(XB + (size_t)row * D + 4 * lane + 256 * j) = o;
        }
        s = wave_sum(s);
        if (row < MP) { if (lane < 8) part2[(size_t)row * 8 + lane] = (lane == 0) ? s : 0.f; }
        else { spart2[(size_t)(row - MP) * 128 + lane] = (lane == 0) ? s : 0.f; spart2[(size_t)(row - MP) * 128 + 64 + lane] = 0.f; }
    }
}

template <int MT, int NT, int QB, class EPI>
__device__ __forceinline__ void skinny_unit(LAS unsigned char* lds, const bf16* __restrict__ A, const bf16* __restrict__ B0, const bf16* __restrict__ B1, int K, int r0, int ntile, const EPI& epi, int wave, int lane, int tid) {
    const int fr = lane & 15, fq = lane >> 4, ks = K / 8, kb = wave * ks;
    f32x4 acc[MT][NT];
#pragma unroll
    for (int a = 0; a < MT; ++a)
#pragma unroll
        for (int b = 0; b < NT; ++b) acc[a][b] = (f32x4){0.f, 0.f, 0.f, 0.f};
    const bf16* ap = A + (size_t)(r0 + fr) * K + kb + 8 * fq;
    const bf16* b0p = B0 + (size_t)fr * K + kb + 8 * fq; const bf16* b1p = B1 + (size_t)fr * K + kb + 8 * fq;
    for (int kk0 = 0; kk0 < ks; kk0 += 32 * QB) {
        bf16x8 a[QB][MT], b[QB][NT];
#pragma unroll
        for (int q = 0; q < QB; ++q) { const int kk = (kk0 + 32 * q < ks) ? kk0 + 32 * q : kk0;
#pragma unroll
            for (int m = 0; m < MT; ++m) a[q][m] = *(const bf16x8*)(ap + (size_t)(16 * m) * K + kk);
            b[q][0] = *(const bf16x8*)(b0p + kk); if (NT == 2) b[q][NT - 1] = *(const bf16x8*)(b1p + kk); }
#pragma unroll
        for (int q = 0; q < QB; ++q) if (kk0 + 32 * q < ks) {
#pragma unroll
            for (int m = 0; m < MT; ++m)
#pragma unroll
                for (int n = 0; n < NT; ++n) acc[m][n] = __builtin_amdgcn_mfma_f32_16x16x32_bf16(a[q][m], b[q][n], acc[m][n], 0, 0, 0);
        }
    }
    LAS float* red = (LAS float*)lds;
#pragma unroll
    for (int m = 0; m < MT; ++m)
#pragma unroll
        for (int nb = 0; nb < NT; ++nb)
#pragma unroll
            for (int rg = 0; rg < 4; ++rg) red[((wave * NT + nb) * (16 * MT) + m * 16 + 4 * fq + rg) * 16 + fr] = acc[m][nb][rg];
    __syncthreads();
#pragma unroll
    for (int nb = 0; nb < NT; ++nb)
#pragma unroll
        for (int hf = 0; hf < MT / 2; ++hf) {
            float v = 0.f;
#pragma unroll
            for (int w = 0; w < 8; ++w) v += red[((w * NT + nb) * (16 * MT) + hf * 32) * 16 + tid];
            if (nb < ntile) epi(r0 + (tid >> 4) + 32 * hf, hf, nb, tid & 15, v);
        }
    __syncthreads();
}
__device__ __forceinline__ float skinny_rs(const float* spart, int rbase, int tid) {
    const float* p = spart + (size_t)(rbase + (tid >> 4)) * 128 + (tid & 15) * 8;
    const f32x4 a = *(const f32x4*)p, b = *(const f32x4*)(p + 4);
    float s = ((a[0] + a[1]) + (a[2] + a[3])) + ((b[0] + b[1]) + (b[2] + b[3]));
    s += __shfl_xor(s, 1); s += __shfl_xor(s, 2); s += __shfl_xor(s, 4); s += __shfl_xor(s, 8);
    return rsqrtf(s * (1.0f / 2048.0f) + EPS);
}
struct SEpiInProj {
    float* projs; float rs0, rs1; float* sk; float* sv; float* sp; int n0;
    __device__ __forceinline__ void operator()(int row, int hf, int tile, int cl, float v0) const {
        const int col = n0 + 16 * tile + cl; const float v = v0 * (hf == 0 ? rs0 : rs1);
        projs[(size_t)row * DIN + col] = v;
        if (col >= C_KA && col < C_VA) sk[(size_t)row * 768 + (col - C_KA)] = v;
        else if (col >= C_VA && col < C_UB) sv[(size_t)row * 768 + (col - C_VA)] = v;
        else if (col >= C_UB && col < C_QC) sp[(size_t)((row >> 3) * 15 + 7 + (row & 7)) * 512 + (col - C_UB)] = v;
    }
};
struct SEpiResid {
    const float* xin; float* xout; bf16* xb; float* spart; int n0;
    __device__ __forceinline__ void operator()(int row, int, int tile, int cl, float v0) const {
        const size_t o = (size_t)row * D + n0 + 16 * tile + cl; const float v = xin[o] + v0;
        xout[o] = v; xb[o] = (bf16)f2bf(v);
        float s = v * v; s += __shfl_xor(s, 1); s += __shfl_xor(s, 2); s += __shfl_xor(s, 4); s += __shfl_xor(s, 8);
        if (cl == 0) spart[(size_t)row * 128 + (n0 >> 4) + tile] = s;
    }
};
struct SEpiGateUp {
    bf16* F; float rs0, rs1; int f0; mutable float gate0, gate1;
    __device__ __forceinline__ void operator()(int row, int hf, int tile, int cl, float v0) const {
        const float rs = hf == 0 ? rs0 : rs1;
        if (tile == 0) { if (hf == 0) gate0 = v0 * rs; else gate1 = v0 * rs; }
        else F[(size_t)(MP + row) * DFF + f0 + cl] = (bf16)f2bf(silu(hf == 0 ? gate0 : gate1) * (v0 * rs));
    }
};

__device__ __forceinline__ void s_attn_unit(const Ptrs& P, LAS unsigned char* lds, int l, int unit, int wave, int lane, int tid) {
    const int h = unit % 6, row = unit / 6, b = row >> 3, t = row & 7;
    const float* projs = (const float*)(P.ws + WS_PROJS);
    LAS float* sc = (LAS float*)lds;
    LAS float* red = sc + 416;
    LAS float* part = red + 16;
    const int qw = lane >> 4, k16 = lane & 15;
    const f32x4 qa = *(const f32x4*)(projs + (size_t)row * DIN + C_QA + h * 128 + 4 * k16) * 0.08838834764831845f;
    const f32x4 qb = *(const f32x4*)(projs + (size_t)row * DIN + C_QA + h * 128 + 64 + 4 * k16) * 0.08838834764831845f;
    const float* rowp[13];
#pragma unroll
    for (int it = 0; it < 13; ++it) {
        int s = it * 32 + wave * 4 + qw; s = s < 387 ? s : 386;
        const int p = s / 129, j = s - p * 129, dil = (p == 0) ? 1 : (p == 1 ? 4 : 16), idx = 2048 + t - dil * j;
        rowp[it] = (idx >= 2048) ? projs + (size_t)(b * 8 + idx - 2048) * DIN + C_KA + h * 128
                                 : P.in[I_CK] + ((size_t)((l * 8 + b) * 2048 + idx) * 6 + h) * 128;
    }
    {
        f32x4 ka[13], kb[13];
#pragma unroll
        for (int it = 0; it < 13; ++it) { ka[it] = *(const f32x4*)(rowp[it] + 4 * k16); kb[it] = *(const f32x4*)(rowp[it] + 64 + 4 * k16); }
#pragma unroll
        for (int it = 0; it < 13; ++it) {
            float a = (ka[it][0] * qa[0] + ka[it][1] * qa[1]) + (ka[it][2] * qa[2] + ka[it][3] * qa[3]) + (kb[it][0] * qb[0] + kb[it][1] * qb[1]) + (kb[it][2] * qb[2] + kb[it][3] * qb[3]);
            a += __shfl_xor(a, 1); a += __shfl_xor(a, 2); a += __shfl_xor(a, 4); a += __shfl_xor(a, 8);
            const int s = it * 32 + wave * 4 + qw;
            if (k16 == 0) sc[s] = (s < 387) ? a : -1e30f;
        }
    }
    __syncthreads();
    const float v = (tid < 416) ? sc[tid] : -1e30f;
    float m = wave_max(v);
    if (lane == 0) red[wave] = m;
    __syncthreads();
    m = red[0];
#pragma unroll
    for (int w = 1; w < 8; ++w) m = fmaxf(m, red[w]);
    const float e = (tid < 387) ? __expf(v - m) : 0.f;
    float sm = wave_sum(e);
    __syncthreads();
    if (tid < 416) sc[tid] = e;
    if (lane == 0) red[8 + wave] = sm;
    __syncthreads();
    float den = 0.f;
#pragma unroll
    for (int w = 0; w < 8; ++w) den += red[8 + w];
    f32x4 oa = (f32x4){0.f, 0.f, 0.f, 0.f}, ob = (f32x4){0.f, 0.f, 0.f, 0.f};
    {
        f32x4 va[13], vb[13];
#pragma unroll
        for (int it = 0; it < 13; ++it) {
            int s = it * 32 + wave * 4 + qw; s = s < 387 ? s : 386;
            const int p = s / 129, j = s - p * 129, dil = (p == 0) ? 1 : (p == 1 ? 4 : 16), idx = 2048 + t - dil * j;
            const float* vr = (idx >= 2048) ? projs + (size_t)(b * 8 + idx - 2048) * DIN + C_VA + h * 128
                                            : P.in[I_CV] + ((size_t)((l * 8 + b) * 2048 + idx) * 6 + h) * 128;
            va[it] = *(const f32x4*)(vr + 4 * k16); vb[it] = *(const f32x4*)(vr + 64 + 4 * k16);
        }
#pragma unroll
        for (int it = 0; it < 13; ++it) { const float pe = sc[it * 32 + wave * 4 + qw]; oa += va[it] * pe; ob += vb[it] * pe; }
    }
#pragma unroll
    for (int i = 0; i < 4; ++i) { oa[i] += __shfl_xor(oa[i], 16); oa[i] += __shfl_xor(oa[i], 32); ob[i] += __shfl_xor(ob[i], 16); ob[i] += __shfl_xor(ob[i], 32); }
    if (qw == 0) { *(LAS f32x4*)(part + wave * 128 + 4 * k16) = oa; *(LAS f32x4*)(part + wave * 128 + 64 + 4 * k16) = ob; }
    __syncthreads();
    if (tid < 128) {
        float o = 0.f;
#pragma unroll
        for (int w = 0; w < 8; ++w) o += part[w * 128 + tid];
        ((bf16*)(P.ws + WS_MIX))[(size_t)(MP + row) * D + M_A + h * 128 + tid] = (bf16)f2bf(o / den);
    }
    __syncthreads();
}
__device__ __forceinline__ void s_pool_unit(const Ptrs& P, LAS unsigned char* lds, int l, int row, int tid) {
    const int b = row >> 3, t = row & 7;
    const float* projs = (const float*)(P.ws + WS_PROJS);
    const float* sp = P.in[I_SPOOL] + (size_t)(l * 8 + b) * 15 * 512;
    LAS float* pl = (LAS float*)lds;
    {
        const int c = tid, g = c >> 7, w = 2 << g; float sum = 0.f, cur = 0.f;
        for (int i = 0; i < w; ++i) { const int e = 15 + t - i;
            const float uv = (e < 15) ? sp[(size_t)e * 512 + c] : projs[(size_t)(b * 8 + e - 15) * DIN + C_UB + c];
            sum += uv; if (i == 0) cur = uv; }
        pl[c] = sum / (float)w - cur;
        if (t == 0) { float* dst = P.out + O_SP + (size_t)(l * 8 + b) * 15 * 512;
            for (int i = 0; i < 7; ++i) dst[(size_t)i * 512 + c] = sp[(size_t)(8 + i) * 512 + c]; }
    }
    __syncthreads();
    {
        const int g = tid >> 7, d = tid & 127; const float* wp = P.in[I_WPOOL] + (size_t)(l * 4 + g) * 128 * 128;
        float a = 0.f;
#pragma unroll 8
        for (int c = 0; c < 128; ++c) a += pl[g * 128 + c] * wp[(size_t)c * 128 + d];
        a *= P.in[I_PSCALE][l * 512 + tid];
        ((bf16*)(P.ws + WS_MIX))[(size_t)(MP + row) * D + M_B + tid] = (bf16)f2bf(a);
    }
    __syncthreads();
}
__device__ __forceinline__ void s_gla_unit(const Ptrs& P, LAS unsigned char* lds, int l, int unit, int tid) {
    const int b = unit >> 2, h = unit & 3;
    const float* projs = (const float*)(P.ws + WS_PROJS);
    LAS float* eg = (LAS float*)lds;
    LAS float* qL = eg + 768;
    LAS float* kL = qL + 768;
    LAS float* vL = kL + 768;
    LAS float* op = vL + 1536;
    LAS float* oc = op + 384;
    LAS float* rs = oc + 1536;
    for (int i = tid; i < 768; i += NTHR) {
        const int t = i / 96, dk = i % 96; const float* pr = projs + (size_t)(b * 8 + t) * DIN;
        float z = P.in[I_BG][l * 384 + h * 96 + dk];
#pragma unroll
        for (int r = 0; r < 16; ++r) z += pr[C_GC + r] * P.in[I_WG2][(size_t)(l * 16 + r) * 384 + h * 96 + dk];
        eg[i] = __expf(logsig(z) * (1.0f / 16.0f));
        qL[i] = pr[C_QC + h * 96 + dk] * 0.10206207261596575f;
        kL[i] = pr[C_KC + h * 96 + dk];
    }
    for (int i = tid; i < 1536; i += NTHR) { const int t = i / 192, dv = i % 192; vL[i] = projs[(size_t)(b * 8 + t) * DIN + C_VC + h * 192 + dv]; }
    __syncthreads();
    const int dv = tid % 192, hf = tid / 192;
    float S[48];
    const float* s0 = P.in[I_SGLA] + (size_t)((l * 8 + b) * 4 + h) * SELEMS;
    if (tid < 384) {
#pragma unroll
        for (int i = 0; i < 48; ++i) S[i] = s0[(size_t)(48 * hf + i) * 192 + dv];
    }
    for (int t = 0; t < 8; ++t) {
        if (tid < 384) {
            float o = 0.f; const float vv = vL[t * 192 + dv];
#pragma unroll
            for (int i = 0; i < 48; ++i) { const int dk = 48 * hf + i; S[i] = eg[t * 96 + dk] * S[i] + kL[t * 96 + dk] * vv; o += qL[t * 96 + dk] * S[i]; }
            op[hf * 192 + dv] = o;
        }
        __syncthreads();
        if (tid < 192) oc[t * 192 + tid] = op[tid] + op[192 + tid];
        __syncthreads();
    }
    if (tid < 384) { float* dst = P.out + O_SG + (size_t)((l * 8 + b) * 4 + h) * SELEMS;
#pragma unroll
        for (int i = 0; i < 48; ++i) dst[(size_t)(48 * hf + i) * 192 + dv] = S[i]; }
    {
        const int w = tid >> 6, ln = tid & 63; float s = 0.f;
        for (int i = ln; i < 192; i += 64) { const float x = oc[w * 192 + i]; s += x * x; }
        s = wave_sum(s);
        if (ln == 0) rs[w] = rsqrtf(s * (1.0f / 192.0f) + EPS);
    }
    __syncthreads();
    for (int i = tid; i < 1536; i += NTHR) {
        const int t = i / 192, d2 = i % 192; const int row = b * 8 + t;
        const float r = projs[(size_t)row * DIN + C_RC + h * 192 + d2];
        const float val = oc[i] * rs[t] * P.in[I_GNG][l * 192 + d2] * silu(r);
        ((bf16*)(P.ws + WS_MIX))[(size_t)(MP + row) * D + M_C + h * 192 + d2] = (bf16)f2bf(val);
    }
    __syncthreads();
}

typedef short v4i16_t __attribute__((ext_vector_type(4)));
__device__ __forceinline__ unsigned offb(unsigned row, unsigned ch) { return 256u * row + 16u * (ch ^ (((row & 3u) << 2) | ((row >> 2) & 3u))); }
__device__ __forceinline__ void p_attn_unit(const Ptrs& P, LAS unsigned char* lds, int unit, int wave, int lane) {
    const bf16* PROJ = (const bf16*)(P.ws + WS_PROJ);
    const int cb = unit & 31, pbh = unit >> 5, p = pbh / 12, bh = pbh - 12 * p, b = bh / 6, h = bh - 6 * b;
    const int dsh = 2 * p, dil = 1 << dsh, nbk = 32 >> dsh, r = cb / nbk, n = cb - r * nbk;
    const size_t rb = (size_t)b * SEQ + r;
#pragma unroll
    for (int i8 = 0; i8 < 8; ++i8) {
        const int i = wave * 8 + i8, row = 4 * i + (lane >> 4), pc = lane & 15;
        const int ch = pc ^ (((row & 3) << 2) | ((row >> 2) & 3));
        int ci = 128 * (n - 1) + row; ci = ci < 0 ? 0 : ci;
        const bf16* src = PROJ + (rb + (size_t)dil * ci) * NINP + h * 128 + 8 * ch;
        __builtin_amdgcn_global_load_lds((const unsigned*)(src + C_KA), (LAS unsigned*)(lds + i * 1024), 16, 0, 0);
        __builtin_amdgcn_global_load_lds((const unsigned*)(src + C_VA), (LAS unsigned*)(lds + 65536 + i * 1024), 16, 0, 0);
    }
    const int g = lane >> 4, ql = lane & 15, iloc = 16 * wave + ql;
    const size_t qrow = rb + (size_t)dil * (128 * n + iloc);
    bf16x8 qf[4];
#pragma unroll
    for (int ks = 0; ks < 4; ++ks) qf[ks] = *(const bf16x8*)(PROJ + qrow * NINP + C_QA + h * 128 + 32 * ks + 8 * g);
    asm volatile("s_waitcnt vmcnt(0)" ::: "memory");
    __syncthreads();
    const int s0 = wave >> 1;
    f32x4 st[5][2];
#pragma unroll
    for (int s = 0; s < 5; ++s)
#pragma unroll
        for (int T = 0; T < 2; ++T) {
            const unsigned krow = 32 * (s0 + s) + 8 * (ql >> 2) + 4 * T + (ql & 3);
            f32x4 a = (f32x4){0.f, 0.f, 0.f, 0.f};
#pragma unroll
            for (int ks = 0; ks < 4; ++ks) { const bf16x8 kf = *(const LAS bf16x8*)(lds + offb(krow, 4 * ks + g)); a = __builtin_amdgcn_mfma_f32_16x16x32_bf16(kf, qf[ks], a, 0, 0, 0); }
            st[s][T] = a;
        }
    float mx = -1e30f;
#pragma unroll
    for (int s = 0; s < 5; ++s)
#pragma unroll
        for (int T = 0; T < 2; ++T)
#pragma unroll
            for (int e = 0; e < 4; ++e) {
                const int j = 32 * (s0 + s) + 8 * g + 4 * T + e;
                const bool valid = (j >= iloc) && (j <= iloc + 128) && (n > 0 || j >= 128);
                const float v = valid ? st[s][T][e] * 0.08838834764831845f : -1e30f;
                st[s][T][e] = v; mx = fmaxf(mx, v);
            }
    mx = fmaxf(mx, __shfl_xor(mx, 16)); mx = fmaxf(mx, __shfl_xor(mx, 32));
    float sum = 0.f;
    bf16x8 pf[5];
#pragma unroll
    for (int s = 0; s < 5; ++s) {
        float e[8];
#pragma unroll
        for (int T = 0; T < 2; ++T)
#pragma unroll
            for (int k = 0; k < 4; ++k) { const float v = st[s][T][k]; const float x = (v > -1e29f) ? __expf(v - mx) : 0.f; e[4 * T + k] = x; sum += x; }
        u32x4 w; w.x = pk2(e[0], e[1]); w.y = pk2(e[2], e[3]); w.z = pk2(e[4], e[5]); w.w = pk2(e[6], e[7]);
        pf[s] = __builtin_bit_cast(bf16x8, w);
    }
    sum += __shfl_xor(sum, 16); sum += __shfl_xor(sum, 32);
    f32x4 ot[8];
#pragma unroll
    for (int c = 0; c < 8; ++c) ot[c] = (f32x4){0.f, 0.f, 0.f, 0.f};
    const unsigned q4 = ql >> 2, p4 = lane & 3;
#pragma unroll
    for (int s = 0; s < 5; ++s)
#pragma unroll
        for (int c = 0; c < 8; ++c) {
            const unsigned a0 = 65536u + offb(32 * (s0 + s) + 8 * g + q4, 2 * c + (p4 >> 1)) + 8u * (p4 & 1);
            const unsigned a1 = 65536u + offb(32 * (s0 + s) + 8 * g + 4 + q4, 2 * c + (p4 >> 1)) + 8u * (p4 & 1);
            const v4i16_t lo = __builtin_amdgcn_ds_read_tr16_b64_v4i16((LAS v4i16_t*)(lds + a0));
            const v4i16_t hi = __builtin_amdgcn_ds_read_tr16_b64_v4i16((LAS v4i16_t*)(lds + a1));
            bf16x8 vf; vf[0] = lo[0]; vf[1] = lo[1]; vf[2] = lo[2]; vf[3] = lo[3]; vf[4] = hi[0]; vf[5] = hi[1]; vf[6] = hi[2]; vf[7] = hi[3];
            ot[c] = __builtin_amdgcn_mfma_f32_16x16x32_bf16(vf, pf[s], ot[c], 0, 0, 0);
        }
    const float inv = 1.0f / sum;
    bf16* op = (bf16*)(P.ws + WS_OP) + ((size_t)p * MP + qrow) * 768 + h * 128 + 4 * g;
#pragma unroll
    for (int c = 0; c < 8; ++c) { u32x2 w; w.x = pk2(ot[c][0] * inv, ot[c][1] * inv); w.y = pk2(ot[c][2] * inv, ot[c][3] * inv); *(u32x2*)(op + 16 * c) = w; }
    if (g == 0) ((float*)(P.ws + WS_LSE))[((size_t)p * MP + qrow) * 6 + h] = mx + __logf(sum);
    __syncthreads();
}
__device__ __forceinline__ void attn_combine(const Ptrs& P, int bx, int G, int wave, int lane) {
    const bf16* OP = (const bf16*)(P.ws + WS_OP); const float* LSE = (const float*)(P.ws + WS_LSE); bf16* MIX = (bf16*)(P.ws + WS_MIX);
    for (int tok = bx * NWAVES + wave; tok < MP; tok += G * NWAVES) {
#pragma unroll
        for (int h = 0; h < 6; ++h) {
            const float l0 = LSE[((size_t)0 * MP + tok) * 6 + h], l1 = LSE[((size_t)1 * MP + tok) * 6 + h], l2 = LSE[((size_t)2 * MP + tok) * 6 + h];
            const float m = fmaxf(l0, fmaxf(l1, l2)), e0 = __expf(l0 - m), e1 = __expf(l1 - m), e2 = __expf(l2 - m), inv = 1.0f / (e0 + e1 + e2);
            const unsigned w0 = *(const unsigned*)(OP + ((size_t)0 * MP + tok) * 768 + h * 128 + 2 * lane);
            const unsigned w1 = *(const unsigned*)(OP + ((size_t)1 * MP + tok) * 768 + h * 128 + 2 * lane);
            const unsigned w2 = *(const unsigned*)(OP + ((size_t)2 * MP + tok) * 768 + h * 128 + 2 * lane);
            const float a = (e0 * bf2f(w0 & 0xffffu) + e1 * bf2f(w1 & 0xffffu) + e2 * bf2f(w2 & 0xffffu)) * inv;
            const float c = (e0 * bf2f(w0 >> 16) + e1 * bf2f(w1 >> 16) + e2 * bf2f(w2 >> 16)) * inv;
            *(unsigned*)(MIX + (size_t)tok * D + M_A + h * 128 + 2 * lane) = pk2(a, c);
        }
    }
}
__device__ __forceinline__ void p_pool_unit(const Ptrs& P, LAS unsigned char* lds, int l, int unit, int tid) {
    const bf16* PROJ = (const bf16*)(P.ws + WS_PROJ);
    const int b = unit >> 8, t0 = (unit & 255) * 16;
    LAS float* pl = (LAS float*)lds;
    {
        const int c = tid, g = c >> 7, w = 2 << g;
        const bf16* up = PROJ + (size_t)b * SEQ * NINP + C_UB + c;
        float pre[32]; pre[0] = 0.f;
        unsigned short raw[31];
#pragma unroll
        for (int i = 0; i < 31; ++i) { const int tp = t0 - 15 + i; raw[i] = (tp >= 0) ? up[(size_t)tp * NINP] : (unsigned short)0; }
#pragma unroll
        for (int i = 0; i < 31; ++i) pre[i + 1] = pre[i] + bf2f(raw[i]);
#pragma unroll
        for (int tt = 0; tt < 16; ++tt) {
            const int t = t0 + tt; const int cnt = (t + 1 < w) ? (t + 1) : w;
            float sum = 0.f;
            sum = (g == 0) ? pre[16 + tt] - pre[14 + tt] : (g == 1) ? pre[16 + tt] - pre[12 + tt] : (g == 2) ? pre[16 + tt] - pre[8 + tt] : pre[16 + tt] - pre[tt];
            pl[c * 16 + tt] = sum / (float)cnt - bf2f(raw[15 + tt]);
        }
    }
    __syncthreads();
    {
        const int g = tid >> 7, d = tid & 127; const float* wp = P.in[I_WPOOL] + (size_t)(l * 4 + g) * 128 * 128;
        float a[16];
#pragma unroll
        for (int i = 0; i < 16; ++i) a[i] = 0.f;
#pragma unroll 8
        for (int c = 0; c < 128; ++c) {
            const float wv = wp[(size_t)c * 128 + d]; const LAS f32x4* pv = (const LAS f32x4*)(pl + (g * 128 + c) * 16);
#pragma unroll
            for (int q = 0; q < 4; ++q) { const f32x4 x = pv[q]; a[4 * q] += x[0] * wv; a[4 * q + 1] += x[1] * wv; a[4 * q + 2] += x[2] * wv; a[4 * q + 3] += x[3] * wv; }
        }
        const float sc = P.in[I_PSCALE][l * 512 + tid];
        bf16* mx = (bf16*)(P.ws + WS_MIX) + ((size_t)b * SEQ + t0) * D + M_B + tid;
#pragma unroll
        for (int i = 0; i < 16; ++i) mx[(size_t)i * D] = (bf16)f2bf(a[i] * sc);
    }
    __syncthreads();
}
__device__ __forceinline__ void gla_gate_cumsum(const Ptrs& P, int l, int b, int h, int t0, int tid, LAS float* bL, LAS float* gaL, LAS float* wgL) {
    const float* GA = (const float*)(P.ws + WS_GA) + ((size_t)b * SEQ + t0) * 16;
    for (int i = tid; i < 1024; i += NTHR) gaL[i] = GA[i];
    for (int i = tid; i < 1536; i += NTHR) { const int r = i / 96, dk = i % 96; wgL[i] = P.in[I_WG2][(size_t)(l * 16 + r) * 384 + h * 96 + dk]; }
    if (tid < 96) wgL[1536 + tid] = P.in[I_BG][l * 384 + h * 96 + tid];
    __syncthreads();
    for (int i = tid; i < 6144; i += NTHR) {
        const int j = i / 96, dk = i % 96; float z = wgL[1536 + dk];
#pragma unroll
        for (int r = 0; r < 16; ++r) z += gaL[j * 16 + r] * wgL[r * 96 + dk];
        bL[j * 97 + dk] = logsig(z) * (1.0f / 16.0f);
    }
    __syncthreads();
    const int dk = tid % 96, seg = tid / 96;
    if (tid < 384) { float run = 0.f;
        for (int jj = 0; jj < 16; ++jj) { const int idx = (16 * seg + jj) * 97 + dk; run += bL[idx]; bL[idx] = run; } }
    __syncthreads();
    float off = 0.f;
    if (tid < 384) { for (int s = 0; s < seg; ++s) off += bL[(16 * s + 15) * 97 + dk]; }
    __syncthreads();
    if (tid < 384 && seg > 0) { for (int jj = 0; jj < 16; ++jj) bL[(16 * seg + jj) * 97 + dk] += off; }
    __syncthreads();
}
__device__ __forceinline__ bf16x8 tr8(LAS unsigned char* vi, int tok0, int col, int q4, int p4) {
    const v4i16_t lo = __builtin_amdgcn_ds_read_tr16_b64_v4i16((LAS v4i16_t*)(vi + (tok0 + q4) * 400 + (col + 4 * p4) * 2));
    const v4i16_t hi = __builtin_amdgcn_ds_read_tr16_b64_v4i16((LAS v4i16_t*)(vi + (tok0 + 4 + q4) * 400 + (col + 4 * p4) * 2));
    bf16x8 r; r[0] = lo[0]; r[1] = lo[1]; r[2] = lo[2]; r[3] = lo[3]; r[4] = hi[0]; r[5] = hi[1]; r[6] = hi[2]; r[7] = hi[3]; return r;
}
__device__ __forceinline__ void gla1_unit(const Ptrs& P, LAS unsigned char* lds, int l, int unit, int tid, int wave, int lane) {
    const bf16* PROJ = (const bf16*)(P.ws + WS_PROJ);
    const int bh = unit >> 6, n = unit & 63, b = bh >> 2, h = bh & 3, t0 = n * CH;
    LAS float* bL = (LAS float*)lds; LAS float* gaL = (LAS float*)(lds + 24832); LAS float* wgL = (LAS float*)(lds + 28928);
    LAS unsigned char* KT = lds + 35456;
    LAS unsigned char* VI = lds + 49280;
    gla_gate_cumsum(P, l, b, h, t0, tid, bL, gaL, wgL);
    const bf16* pr = PROJ + ((size_t)b * SEQ + t0) * NINP;
    float* bc = (float*)(P.ws + WS_BCUM) + ((size_t)b * SEQ + t0) * 384 + h * 96;
    for (int i = tid; i < 6144; i += NTHR) { const int j = i / 96, dk = i - 96 * j; const float bb = bL[j * 97 + dk];
        bc[(size_t)j * 384 + dk] = bb;
        ((LAS bf16*)KT)[dk * 72 + j] = (bf16)f2bf(bf2f(pr[(size_t)j * NINP + C_KC + h * 96 + dk]) * __expf(bL[63 * 97 + dk] - bb)); }
    for (int i = tid; i < 1536; i += NTHR) { const int j = i / 24, ch = i - 24 * j;
        *(LAS u32x4*)(VI + j * 400 + ch * 16) = *(const u32x4*)(pr + (size_t)j * NINP + C_VC + h * 192 + 8 * ch); }
    if (tid < 96) ((float*)(P.ws + WS_DEC))[(size_t)unit * 96 + tid] = __expf(bL[63 * 97 + tid]);
    __syncthreads();
    const int g = lane >> 4, ql = lane & 15, q4 = ql >> 2, p4 = lane & 3, dkg = wave & 1, dvg = wave >> 1;
    f32x4 acc[3][3];
#pragma unroll
    for (int a = 0; a < 3; ++a)
#pragma unroll
        for (int d = 0; d < 3; ++d) acc[a][d] = (f32x4){0.f, 0.f, 0.f, 0.f};
#pragma unroll
    for (int ks = 0; ks < 2; ++ks) {
        bf16x8 af[3], bfr[3];
#pragma unroll
        for (int a = 0; a < 3; ++a) af[a] = tr8(VI, 32 * ks + 8 * g, 16 * (3 * dvg + a), q4, p4);
#pragma unroll
        for (int d = 0; d < 3; ++d) bfr[d] = *(const LAS bf16x8*)(KT + (16 * (3 * dkg + d) + ql) * 144 + (32 * ks + 8 * g) * 2);
#pragma unroll
        for (int a = 0; a < 3; ++a)
#pragma unroll
            for (int d = 0; d < 3; ++d) acc[a][d] = __builtin_amdgcn_mfma_f32_16x16x32_bf16(af[a], bfr[d], acc[a][d], 0, 0, 0);
    }
    float* sl = (float*)(P.ws + WS_SLOC) + (size_t)unit * SELEMS;
#pragma unroll
    for (int a = 0; a < 3; ++a)
#pragma unroll
        for (int d = 0; d < 3; ++d)
#pragma unroll
            for (int e = 0; e < 4; ++e) sl[(size_t)(16 * (3 * dvg + a) + 4 * g + e) * 96 + 16 * (3 * dkg + d) + ql] = acc[a][d][e];
    __syncthreads();
}
__device__ __forceinline__ void gla2_scan(const Ptrs& P, int l, int bx, int G, int tid) {
    const float* SL = (const float*)(P.ws + WS_SLOC); unsigned* ST = (unsigned*)(P.ws + WS_SST); const float* DEC = (const float*)(P.ws + WS_DEC);
    for (int e2 = bx * NTHR + tid; e2 < 8 * (SELEMS / 2); e2 += G * NTHR) {
        const int bh = e2 / (SELEMS / 2), rem = 2 * (e2 - bh * (SELEMS / 2)), dv = rem / 96, dk = rem - 96 * dv;
        float S0 = 0.f, S1 = 0.f;
#pragma unroll 8
        for (int n = 0; n < NCH; ++n) {
            const size_t idx = (size_t)(bh * NCH + n) * SELEMS + rem;
            const f32x2 sl = *(const f32x2*)(SL + idx), dc = *(const f32x2*)(DEC + (size_t)(bh * NCH + n) * 96 + dk);
            ST[idx >> 1] = pk2(S0, S1); S0 = dc[0] * S0 + sl[0]; S1 = dc[1] * S1 + sl[1];
        }
        float* o = P.out + O_PG + (size_t)(l * 8 + bh) * SELEMS;
        o[(size_t)dk * 192 + dv] = S0; o[(size_t)(dk + 1) * 192 + dv] = S1;
    }
}
__device__ __forceinline__ void gla3_unit(const Ptrs& P, LAS unsigned char* lds, int l, int unit, int tid, int wave, int lane) {
    const bf16* PROJ = (const bf16*)(P.ws + WS_PROJ);
    const int bh = unit >> 6, n = unit & 63, b = bh >> 2, h = bh & 3, t0 = n * CH;
    LAS unsigned char* QE = lds; LAS unsigned char* KE = lds + 13312; LAS unsigned char* VI = lds + 26624; LAS float* SSQ = (LAS float*)(lds + 52224);
    const int g = lane >> 4, ql = lane & 15, q4 = ql >> 2, p4 = lane & 3, it = wave & 3, hv = wave >> 2, iloc = 16 * it + ql;
    const bf16* sst = (const bf16*)(P.ws + WS_SST) + (size_t)unit * SELEMS;
    bf16x8 sf[6][3];
#pragma unroll
    for (int a = 0; a < 6; ++a)
#pragma unroll
        for (int ks = 0; ks < 3; ++ks) sf[a][ks] = *(const bf16x8*)(sst + (size_t)(16 * (6 * hv + a) + ql) * 96 + 32 * ks + 8 * g);
    const bf16* pr = PROJ + ((size_t)b * SEQ + t0) * NINP;
    const float* bc = (const float*)(P.ws + WS_BCUM) + ((size_t)b * SEQ + t0) * 384 + h * 96;
    for (int i = tid; i < 6144; i += NTHR) { const int j = i / 96, dk = i - 96 * j; const float bb = bc[(size_t)j * 384 + dk];
        const float q = bf2f(pr[(size_t)j * NINP + C_QC + h * 96 + dk]) * 0.10206207261596575f, k = bf2f(pr[(size_t)j * NINP + C_KC + h * 96 + dk]);
        ((LAS bf16*)QE)[j * 104 + dk] = (bf16)f2bf(q * __expf(bb)); ((LAS bf16*)KE)[j * 104 + dk] = (bf16)f2bf(k * __expf(-bb)); }
    for (int i = tid; i < 1536; i += NTHR) { const int j = i / 24, ch = i - 24 * j;
        *(LAS u32x4*)(VI + j * 400 + ch * 16) = *(const u32x4*)(pr + (size_t)j * NINP + C_VC + h * 192 + 8 * ch); }
    __syncthreads();
    bf16x8 qfr[3];
#pragma unroll
    for (int ks = 0; ks < 3; ++ks) qfr[ks] = *(const LAS bf16x8*)(QE + iloc * 208 + (32 * ks + 8 * g) * 2);
    const int nst = (it >> 1) + 1;
    f32x4 ot[6];
#pragma unroll
    for (int a = 0; a < 6; ++a) ot[a] = (f32x4){0.f, 0.f, 0.f, 0.f};
#pragma unroll
    for (int js = 0; js < 2; ++js) if (js < nst) {
        u32x4 w;
#pragma unroll
        for (int T = 0; T < 2; ++T) {
            const int jrow = 32 * js + 8 * q4 + 4 * T + (ql & 3);
            f32x4 a = (f32x4){0.f, 0.f, 0.f, 0.f};
#pragma unroll
            for (int ks = 0; ks < 3; ++ks) { const bf16x8 kf = *(const LAS bf16x8*)(KE + jrow * 208 + (32 * ks + 8 * g) * 2); a = __builtin_amdgcn_mfma_f32_16x16x32_bf16(kf, qfr[ks], a, 0, 0, 0); }
            float e[4];
#pragma unroll
            for (int k = 0; k < 4; ++k) { const int j = 32 * js + 8 * g + 4 * T + k; e[k] = (j <= iloc) ? a[k] : 0.f; }
            if (T == 0) { w.x = pk2(e[0], e[1]); w.y = pk2(e[2], e[3]); } else { w.z = pk2(e[0], e[1]); w.w = pk2(e[2], e[3]); }
        }
        const bf16x8 pf = __builtin_bit_cast(bf16x8, w);
#pragma unroll
        for (int a = 0; a < 6; ++a) { const bf16x8 vf = tr8(VI, 32 * js + 8 * g, 16 * (6 * hv + a), q4, p4); ot[a] = __builtin_amdgcn_mfma_f32_16x16x32_bf16(vf, pf, ot[a], 0, 0, 0); }
    }
#pragma unroll
    for (int a = 0; a < 6; ++a)
#pragma unroll
        for (int ks = 0; ks < 3; ++ks) ot[a] = __builtin_amdgcn_mfma_f32_16x16x32_bf16(sf[a][ks], qfr[ks], ot[a], 0, 0, 0);
    float ss = 0.f;
#pragma unroll
    for (int a = 0; a < 6; ++a) ss += (ot[a][0] * ot[a][0] + ot[a][1] * ot[a][1]) + (ot[a][2] * ot[a][2] + ot[a][3] * ot[a][3]);
    ss += __shfl_xor(ss, 16); ss += __shfl_xor(ss, 32);
    if (g == 0) SSQ[hv * 64 + iloc] = ss;
    __syncthreads();
    const float rstd = rsqrtf((SSQ[iloc] + SSQ[64 + iloc]) * (1.0f / 192.0f) + EPS);
    const size_t r = (size_t)b * SEQ + t0 + iloc;
    bf16* MIX = (bf16*)(P.ws + WS_MIX);
#pragma unroll
    for (int a = 0; a < 6; ++a) {
        const int dv0 = 16 * (6 * hv + a) + 4 * g;
        const u32x2 rc = *(const u32x2*)(PROJ + r * NINP + C_RC + h * 192 + dv0); const f32x4 gn = *(const f32x4*)(P.in[I_GNG] + l * 192 + dv0);
        u32x2 w;
        w.x = pk2(ot[a][0] * rstd * gn[0] * silu(bf2f(rc.x & 0xffffu)), ot[a][1] * rstd * gn[1] * silu(bf2f(rc.x >> 16)));
        w.y = pk2(ot[a][2] * rstd * gn[2] * silu(bf2f(rc.y & 0xffffu)), ot[a][3] * rstd * gn[3] * silu(bf2f(rc.y >> 16)));
        *(u32x2*)(MIX + r * D + M_C + h * 192 + dv0) = w;
    }
    __syncthreads();
}
__device__ __forceinline__ void final_norm(const Ptrs& P, int bx, int G, int wave, int lane) {
    const float* X = (const float*)(P.ws + WS_X); const float* part2 = (const float*)(P.ws + WS_PART2); const float* spart2 = (const float*)(P.ws + WS_SPART2); const float* g = P.in[I_FNG];
    for (int row = bx * NWAVES + wave; row < MT; row += G * NWAVES) {
        float ss;
        if (row < MP) ss = (lane < 8) ? part2[(size_t)row * 8 + lane] : 0.f;
        else ss = spart2[(size_t)(row - MP) * 128 + lane] + spart2[(size_t)(row - MP) * 128 + 64 + lane];
        const float rs = rsqrtf(wave_sum(ss) * (1.0f / 2048.0f) + EPS);
#pragma unroll
        for (int j = 0; j < 8; ++j) {
            const f32x4 v = *(const f32x4*)(X + (size_t)row * D + 4 * lane + 256 * j), gg = *(const f32x4*)(g + 4 * lane + 256 * j);
            *(f32x4*)(P.out + (size_t)row * D + 4 * lane + 256 * j) = v * rs * gg;
        }
    }
}

#ifndef REP_PRO
#define REP_PRO 1
#endif
#ifndef REP_GLA1
#define REP_GLA1 1
#endif
#ifndef REP_GLA2
#define REP_GLA2 1
#endif
#ifndef REP_GLA3
#define REP_GLA3 1
#endif
#ifndef REP_POOL
#define REP_POOL 1
#endif
#ifndef REP_SMIX
#define REP_SMIX 1
#endif
#ifndef REP_PATTN
#define REP_PATTN 1
#endif
#ifndef REP_COMB
#define REP_COMB 1
#endif
#ifndef REP_BAR
#define REP_BAR 1
#endif
#ifndef REP_INPROJ
#define REP_INPROJ 1
#endif
#ifndef REP_SKINNY
#define REP_SKINNY 1
#endif
#ifndef MK_PER_PHASE
#define MK_PER_PHASE 0
#endif
constexpr int NPH = 30;
struct Args { const float* in[N_IN]; float* out; unsigned char* ws; int ph_lo, ph_hi, li, pad; };

__global__ void __launch_bounds__(NTHR, 2) fwd(Args args) {
    extern __shared__ __attribute__((aligned(16))) unsigned char lds_raw[];
    LAS unsigned char* lds = (LAS unsigned char*)lds_raw;
    const int tid = threadIdx.x, lane = tid & 63, wave = __builtin_amdgcn_readfirstlane(tid >> 6);
    const int G = gridDim.x, bx = blockIdx.x;
    Ptrs P;
#pragma unroll
    for (int i = 0; i < N_IN; ++i) P.in[i] = args.in[i];
    P.out = args.out; P.ws = args.ws;
    for (int u = tid; u < (LDS_BYTES - LDSCTL_OFF) / 4; u += NTHR) ((LAS unsigned*)(lds + LDSCTL_OFF))[u] = 0u;
    __syncthreads();
    unsigned* ctl = (unsigned*)(args.ws + WS_CTL);
    XcdBarrier bar; bar.bar = ctl + CW_BAR; bar.x = 0; bar.st = nullptr;
    if (!MK_PER_PHASE) bar = xcd_barrier_post(ctl + CW_BAR, (volatile LAS unsigned*)(lds + MISC_OFF) + 8);
    const int lo = args.ph_lo, hi = args.ph_hi;
#define IN(k) (lo <= (k) && (k) < hi)
#define LAUNDER() int tid_ = tid; asm volatile("" : "+v"(tid_)); const int lane_ = tid_ & 63, wave_ = __builtin_amdgcn_readfirstlane(tid_ >> 6); (void)lane_; (void)wave_
#define SEAM(k) do { if (IN((k) + 1)) { if (!MK_PER_PHASE) { for (int rb_ = 0; rb_ < REP_BAR; ++rb_) xcd_barrier(bar); } } } while (0)

    float* part1 = (float*)(args.ws + WS_PART1); float* part2 = (float*)(args.ws + WS_PART2); float* spart1 = (float*)(args.ws + WS_SPART1); float* spart2 = (float*)(args.ws + WS_SPART2);
    pg8::PG8_LAS_T xch = (pg8::PG8_LAS_T)(lds + XCH_OFF);
    bf16* XB = (bf16*)(args.ws + WS_XB); bf16* MIXB = (bf16*)(args.ws + WS_MIX); bf16* PROJ = (bf16*)(args.ws + WS_PROJ); bf16* FB = (bf16*)(args.ws + WS_F);
    float* X = (float*)(args.ws + WS_X); float* projs = (float*)(args.ws + WS_PROJS);

    if (IN(0)) { for (int rep = 0; rep < REP_PRO; ++rep) { LAUNDER(); prologue(P, lds, bx, G, wave_, lane_, tid_); __syncthreads(); } SEAM(0); }

    for (int l = 0; l < DEPTH; ++l) {
        const int pb = 1 + 7 * l;
        unsigned char* wl = args.ws + WS_W + (size_t)l * LW_SZ;
        const bf16* Win = (const bf16*)(wl + LW_IN); const bf16* Wo = (const bf16*)(wl + LW_O); const bf16* Wgu = (const bf16*)(wl + LW_GU); const bf16* Wd = (const bf16*)(wl + LW_D);
        const float* xin_p = (l == 0) ? P.in[I_XP] : X; const float* xin_s = (l == 0) ? P.in[I_XS] : X + (size_t)MP * D;

        if (IN(pb + 0)) {
            LAUNDER();
            for (int rep = 0; rep < REP_INPROJ; ++rep) {
                pg8::Gemm g{XB, Win, MP, NINP, D}; pg8::StaticOrder S; S.init(MP, NINP, G, bx);
                pg8::EpiInProj E{PROJ, part2, (float*)(args.ws + WS_GA), P.out + O_PK + (size_t)l * 3145728, P.out + O_PV + (size_t)l * 3145728, P.out + O_PP + (size_t)l * 15360};
                pg8::gemm_phase<pg8::EpiInProj, pg8::StaticOrder, true, true>(lds, g, S, E);
            }
            const int sh1 = (672 % G) ? (672 % G) : 0, ns1 = G - sh1;
            for (int rep = 0; rep < REP_SKINNY; ++rep) for (int u = bx - sh1; u >= 0 && u < 161; u += ns1) {
                const int t0 = 2 * u, t1 = (2 * u + 1 < 321) ? 2 * u + 1 : 320;
                SEpiInProj E{projs, skinny_rs(spart2, 0, tid_), skinny_rs(spart2, 32, tid_), P.out + O_SK + (size_t)l * 49152, P.out + O_SV + (size_t)l * 49152, P.out + O_SP + (size_t)l * 61440, 16 * t0};
                skinny_unit<4, 2, 4>(lds, XB + (size_t)MP * D, Win + (size_t)16 * t0 * D, Win + (size_t)16 * t1 * D, D, 0, (2 * u + 1 < 321) ? 2 : 1, E, wave_, lane_, tid_);
            }
            SEAM(pb + 0);
        }
        if (IN(pb + 1)) {
            for (int rep = 0; rep < REP_SMIX; ++rep) { LAUNDER(); for (int u = bx; u < 384; u += G) s_attn_unit(P, lds, l, u, wave_, lane_, tid_); }
            { LAUNDER(); for (int u = bx; u < 64; u += G) s_pool_unit(P, lds, l, u, tid_); }
            { LAUNDER(); for (int u = bx; u < 32; u += G) s_gla_unit(P, lds, l, u, tid_); }
            for (int rep = 0; rep < REP_GLA1; ++rep) { LAUNDER(); for (int u = bx; u < 512; u += G) gla1_unit(P, lds, l, u, tid_, wave_, lane_); }
            for (int rep = 0; rep < REP_POOL; ++rep) { LAUNDER(); for (int u = bx; u < 512; u += G) p_pool_unit(P, lds, l, u, tid_); }
            for (int rep = 0; rep < REP_PATTN; ++rep) { LAUNDER(); for (int u = bx; u < 1152; u += G) p_attn_unit(P, lds, u, wave_, lane_); }
            SEAM(pb + 1);
        }
        if (IN(pb + 2)) { for (int rep = 0; rep < REP_GLA2; ++rep) { LAUNDER(); gla2_scan(P, l, bx, G, tid_); } SEAM(pb + 2); }
        if (IN(pb + 3)) { for (int rep = 0; rep < REP_GLA3; ++rep) { LAUNDER(); for (int u = bx; u < 512; u += G) gla3_unit(P, lds, l, u, tid_, wave_, lane_); } for (int rep = 0; rep < REP_COMB; ++rep) { LAUNDER(); attn_combine(P, bx, G, wave_, lane_); } SEAM(pb + 3); }
        if (IN(pb + 4)) {
            LAUNDER();
            {
                pg8::Gemm g{MIXB, Wo, MP, D, D}; pg8::StaticOrder S; S.init(MP, D, G, bx);
                pg8::EpiResid E{xin_p, X, XB, part1, xch};
                pg8::gemm_phase<pg8::EpiResid, pg8::StaticOrder, true, true>(lds, g, S, E);
            }
            for (int u = G - 1 - bx; u < 256; u += G) {
                const int rh = u & 1, ct = u >> 1;
                SEpiResid E{xin_s, X + (size_t)MP * D, XB + (size_t)MP * D, spart1, 16 * ct};
                skinny_unit<2, 1, 8>(lds, MIXB + (size_t)MP * D, Wo + (size_t)16 * ct * D, Wo, D, 32 * rh, 1, E, wave_, lane_, tid_);
            }
            SEAM(pb + 4);
        }
        if (IN(pb + 5)) {
            LAUNDER();
            {
                pg8::Gemm g{XB, Wgu, MP, NGU, D}; pg8::StaticOrder S; S.init(MP, NGU, G, bx);
                pg8::EpiGateUp E{FB, part1};
                pg8::gemm_phase<pg8::EpiGateUp, pg8::StaticOrder, true, true>(lds, g, S, E);
            }
            const int sh2 = (1408 % G) ? (1408 % G) : 0, ns2 = G - sh2;
            for (int rep = 0; rep < REP_SKINNY; ++rep) for (int u = bx - sh2; u >= 0 && u < 352; u += ns2) {
                const int f0 = 16 * u; const size_t gr = (size_t)(256 * (f0 >> 7) + (f0 & 127));
                SEpiGateUp E{FB, skinny_rs(spart1, 0, tid_), skinny_rs(spart1, 32, tid_), f0, 0.f, 0.f};
                skinny_unit<4, 2, 4>(lds, XB + (size_t)MP * D, Wgu + gr * D, Wgu + (gr + 128) * D, D, 0, 2, E, wave_, lane_, tid_);
            }
            SEAM(pb + 5);
        }
        if (IN(pb + 6)) {
            LAUNDER();
            {
                pg8::Gemm g{FB, Wd, MP, D, DFF}; pg8::StaticOrder S; S.init(MP, D, G, bx);
                pg8::EpiResid E{X, X, XB, part2, xch};
                pg8::gemm_phase<pg8::EpiResid, pg8::StaticOrder, true, true>(lds, g, S, E);
            }
            for (int u = G - 1 - bx; u < 256; u += G) {
                const int rh = u & 1, ct = u >> 1;
                SEpiResid E{X + (size_t)MP * D, X + (size_t)MP * D, XB + (size_t)MP * D, spart2, 16 * ct};
                skinny_unit<2, 1, 8>(lds, FB + (size_t)MP * DFF, Wd + (size_t)16 * ct * DFF, Wd, DFF, 32 * rh, 1, E, wave_, lane_, tid_);
            }
            SEAM(pb + 6);
        }
    }
    if (IN(29)) { LAUNDER(); final_norm(P, bx, G, wave_, lane_); }
#undef IN
#undef SEAM
}

extern "C" void kernel_launch(void* const* d_in, const int* in_sizes, int n_in, void* d_out, int out_size, void* d_ws, size_t ws_size, hipStream_t stream) {
    static int grid = 0;
    if (grid == 0) {
        if (n_in != N_IN || (size_t)out_size != O_END || ws_size < WS_END) { fprintf(stderr, "kernel_launch: unexpected sizes n_in %d out %d ws %zu\n", n_in, out_size, ws_size); grid = -1; return; }
        int dev = 0, cus = 0, per_cu = 0;
        if (hipGetDevice(&dev) != hipSuccess || hipDeviceGetAttribute(&cus, hipDeviceAttributeMultiprocessorCount, dev) != hipSuccess) { grid = -1; return; }
        if (hipFuncSetAttribute((const void*)fwd, hipFuncAttributeMaxDynamicSharedMemorySize, LDS_BYTES) != hipSuccess) { fprintf(stderr, "kernel_launch: hipFuncSetAttribute failed\n"); grid = -1; return; }
        if (hipOccupancyMaxActiveBlocksPerMultiprocessor(&per_cu, (const void*)fwd, NTHR, LDS_BYTES) != hipSuccess || per_cu < 1) { fprintf(stderr, "kernel_launch: occupancy query says %d\n", per_cu); }
        (void)hipGetLastError();
        grid = cus;
    }
    if (grid < 0) return;
    (void)hipMemsetAsync((char*)d_ws + WS_CTL, 0, CTL_ZERO_BYTES, stream);
    Args a{};
    for (int i = 0; i < N_IN; ++i) a.in[i] = (const float*)d_in[i];
    a.out = (float*)d_out; a.ws = (unsigned char*)d_ws; a.li = 0; a.pad = 0;
#if MK_PER_PHASE
    for (int p = 0; p < NPH; ++p) { a.ph_lo = p; a.ph_hi = p + 1; hipLaunchKernelGGL(fwd, dim3(grid), dim3(NTHR), LDS_BYTES, stream, a); }
#else
    a.ph_lo = 0; a.ph_hi = NPH;
    hipLaunchKernelGGL(fwd, dim3(grid), dim3(NTHR), LDS_BYTES, stream, a);
#endif
    const hipError_t le = hipPeekAtLastError();
    if (le != hipSuccess) fprintf(stderr, "kernel_launch: launch failed: %s\n", hipGetErrorName(le));
}
```

```cpp
#include <hip/hip_runtime.h>
#include <cstdio>
#include <cstdint>
namespace pg8 {
#define PG8_LAS __attribute__((address_space(3)))
typedef unsigned short bf16_t;
typedef PG8_LAS float* PG8_LAS_T;
typedef short bf16x8 __attribute__((ext_vector_type(8)));
typedef float f32x4 __attribute__((ext_vector_type(4)));
typedef unsigned u32x4 __attribute__((ext_vector_type(4)));
constexpr int BM = 256, BK = 64, HALF = 128, HTB = HALF * BK * 2  , STAGE_BYTES = 8 * HTB, NXCD = 8, WGM = 8;

__host__ __device__ __forceinline__ int lds_byte(int r, int c) { const int st = (r >> 4) * 2 + (c >> 5), rr = r & 15, cc = c & 31, ob = rr * 64 + cc * 2; return st * 1024 + (ob ^ (((ob >> 9) & 1) << 5)); }
__host__ __device__ __forceinline__ void stage_rc(int b, int& R, int& C) { const int st = b / 1024, sb = b % 1024, swz = sb ^ (((sb >> 9) & 1) << 5); R = (st >> 1) * 16 + swz / 64; C = (st & 1) * 32 + (swz % 64) / 2; }
__host__ __device__ __forceinline__ int perm32(int rho) { const int n = rho >> 4, i = rho & 15; return 8 * (i >> 2) + 4 * n + (i & 3); }

struct Unit { int pm, pn; };
struct Gemm { const bf16_t* A; const bf16_t* Bt; int M, N, K; };

struct StaticOrder {
    int nM, nN, nwg, G, c;
    __host__ __device__ void init(int M, int N, int G_, int c_) { nM = M / BM; nN = N / BM; nwg = nM * nN; G = G_; c = c_; }
    __host__ __device__ bool next(int i, Unit& u) const {
        const long L = (long)i * G + c; if (L >= nwg) return false;
        int wgid = (int)L; { const int q = nwg / NXCD, r = nwg % NXCD, xcd = wgid % NXCD, off = wgid / NXCD; wgid = (xcd < r ? xcd * (q + 1) : r * (q + 1) + (xcd - r) * q) + off; }
        const int nig = WGM * nN, gid = wgid / nig, fm = gid * WGM, gsz = (nM - fm) < WGM ? (nM - fm) : WGM;
        u.pm = fm + ((wgid % nig) % gsz); u.pn = (wgid % nig) / gsz; return true;
    }
    __device__ __forceinline__ void a_ready(const Unit&) const {}
    __device__ __forceinline__ void done(const Unit&) const {}
};


__device__ __forceinline__ unsigned cvt_pk_bf16(float lo, float hi) { unsigned r; asm volatile("v_cvt_pk_bf16_f32 %0, %1, %2" : "=v"(r) : "v"(lo), "v"(hi)); return r; }
__device__ __forceinline__ float silu_f(float x) { return x * __builtin_amdgcn_rcpf(1.0f + __expf(-x)); }

struct EpiInProj {
    static constexpr bool PERM = true, AFTER_DRAIN = false;
    bf16_t* P; const float* part; float* ga; float* pk; float* pv; float* pp;
    __device__ __forceinline__ void operator()(const f32x4 (&acc)[2][2][4][2], const Unit& u, int wr, int wc, int fr, int fq) const {
        const int row0 = u.pm * BM + wr * 64 + fr, col0 = u.pn * BM + wc * 32 + 8 * fq;
        const int tp = (u.pm & 15) * 256;
        const bool kv_out = (u.pn >= 3 && u.pn < 9) && (tp >= 2048);
        const bool u_out = (u.pn == 9 || u.pn == 10) && (tp == 3840);
        const bool g_out = (u.pn == 20) && (wc == 0) && (fq < 2);
#pragma unroll
        for (int ai = 0; ai < 2; ++ai)
#pragma unroll
            for (int m = 0; m < 4; ++m) {
                const int r = row0 + ai * HALF + m * 16;
                const f32x4 q0 = *(const f32x4*)(part + (size_t)r * 8), q1 = *(const f32x4*)(part + (size_t)r * 8 + 4);
                const float rs = rsqrtf((((q0[0] + q0[1]) + (q0[2] + q0[3])) + ((q1[0] + q1[1]) + (q1[2] + q1[3]))) * (1.0f / 2048.0f) + 1e-6f);
                bf16_t* rowp = P + (size_t)r * 5376 + col0;
                const int b = r >> 12, t = r & 4095;
#pragma unroll
                for (int bj = 0; bj < 2; ++bj) {
                    const f32x4 v0 = acc[ai][bj][m][0] * rs, v1 = acc[ai][bj][m][1] * rs;
                    u32x4 w; w.x = cvt_pk_bf16(v0[0], v0[1]); w.y = cvt_pk_bf16(v0[2], v0[3]); w.z = cvt_pk_bf16(v1[0], v1[1]); w.w = cvt_pk_bf16(v1[2], v1[3]);
                    *(u32x4*)(rowp + bj * HALF) = w;
                    const int c = col0 + bj * HALF;
                    if (kv_out) {
                        float* dst = (u.pn < 6) ? (pk + ((size_t)(b * 2048 + (t - 2048)) * 768 + (c - 768))) : (pv + ((size_t)(b * 2048 + (t - 2048)) * 768 + (c - 1536)));
                        *(f32x4*)dst = v0; *(f32x4*)(dst + 4) = v1;
                    }
                    if (u_out && t >= 4081) {
                        float* dst = pp + ((size_t)(b * 15 + (t - 4081)) * 512 + (c - 2304));
                        *(f32x4*)dst = v0; *(f32x4*)(dst + 4) = v1;
                    }
                    if (g_out && bj == 0) {
                        float* dst = ga + (size_t)r * 16 + 8 * fq;
                        *(f32x4*)dst = v0; *(f32x4*)(dst + 4) = v1;
                    }
                }
            }
    }
};
struct EpiResid {
    static constexpr bool PERM = true, AFTER_DRAIN = false;
    const float* xin; float* xout; bf16_t* xb; float* part; PG8_LAS float* xch;
    __device__ __forceinline__ void operator()(const f32x4 (&acc)[2][2][4][2], const Unit& u, int wr, int wc, int fr, int fq) const {
        const int row0 = u.pm * BM + wr * 64 + fr, col0 = u.pn * BM + wc * 32 + 8 * fq;
#pragma unroll
        for (int ai = 0; ai < 2; ++ai)
#pragma unroll
            for (int m = 0; m < 4; ++m) {
                const int r = row0 + ai * HALF + m * 16;
                const size_t off = (size_t)r * 2048 + col0;
                float s = 0.f;
#pragma unroll
                for (int bj = 0; bj < 2; ++bj) {
                    const f32x4 a0 = *(const f32x4*)(xin + off + bj * HALF), a1 = *(const f32x4*)(xin + off + bj * HALF + 4);
                    const f32x4 v0 = acc[ai][bj][m][0] + a0, v1 = acc[ai][bj][m][1] + a1;
                    *(f32x4*)(xout + off + bj * HALF) = v0; *(f32x4*)(xout + off + bj * HALF + 4) = v1;
                    u32x4 w; w.x = cvt_pk_bf16(v0[0], v0[1]); w.y = cvt_pk_bf16(v0[2], v0[3]); w.z = cvt_pk_bf16(v1[0], v1[1]); w.w = cvt_pk_bf16(v1[2], v1[3]);
                    *(u32x4*)(xb + off + bj * HALF) = w;
                    s += (v0[0] * v0[0] + v0[1] * v0[1]) + (v0[2] * v0[2] + v0[3] * v0[3]) + (v1[0] * v1[0] + v1[1] * v1[1]) + (v1[2] * v1[2] + v1[3] * v1[3]);
                }
                s += __shfl_xor(s, 16); s += __shfl_xor(s, 32);
                if (fq == 0) xch[(ai * HALF + wr * 64 + m * 16 + fr) * 4 + wc] = s;
                asm volatile("" ::: "memory");
            }
        asm volatile("s_waitcnt lgkmcnt(0)" ::: "memory"); __builtin_amdgcn_s_barrier(); asm volatile("" ::: "memory");
        if (wr == 0) { const int row = wc * 64 + fq * 16 + fr; const f32x4 q = *(const PG8_LAS f32x4*)(xch + row * 4);
            part[(size_t)(u.pm * BM + row) * 8 + u.pn] = (q[0] + q[1]) + (q[2] + q[3]); }
    }
};
struct EpiGateUp {
    static constexpr bool PERM = true, AFTER_DRAIN = false;
    bf16_t* F; const float* part;
    __device__ __forceinline__ void operator()(const f32x4 (&acc)[2][2][4][2], const Unit& u, int wr, int wc, int fr, int fq) const {
        const int row0 = u.pm * BM + wr * 64 + fr, col0 = u.pn * HALF + wc * 32 + 8 * fq;
#pragma unroll
        for (int ai = 0; ai < 2; ++ai)
#pragma unroll
            for (int m = 0; m < 4; ++m) {
                const int r = row0 + ai * HALF + m * 16;
                const f32x4 q0 = *(const f32x4*)(part + (size_t)r * 8), q1 = *(const f32x4*)(part + (size_t)r * 8 + 4);
                const float rs = rsqrtf((((q0[0] + q0[1]) + (q0[2] + q0[3])) + ((q1[0] + q1[1]) + (q1[2] + q1[3]))) * (1.0f / 2048.0f) + 1e-6f);
                const f32x4 g0 = acc[ai][0][m][0] * rs, g1 = acc[ai][0][m][1] * rs, u0 = acc[ai][1][m][0] * rs, u1 = acc[ai][1][m][1] * rs;
                u32x4 w;
                w.x = cvt_pk_bf16(silu_f(g0[0]) * u0[0], silu_f(g0[1]) * u0[1]); w.y = cvt_pk_bf16(silu_f(g0[2]) * u0[2], silu_f(g0[3]) * u0[3]);
                w.z = cvt_pk_bf16(silu_f(g1[0]) * u1[0], silu_f(g1[1]) * u1[1]); w.w = cvt_pk_bf16(silu_f(g1[2]) * u1[2], silu_f(g1[3]) * u1[3]);
                *(u32x4*)(F + (size_t)r * 5632 + col0) = w;
            }
    }
};

template <class Epi, class Sched, bool ALIGN_EPI = false, bool SP2 = false>
__device__ __forceinline__ void gemm_phase(PG8_LAS unsigned char* lds, const Gemm g, const Sched& S, const Epi& E) {
    int tid = threadIdx.x; asm volatile("" : "+v"(tid)); const int wid = __builtin_amdgcn_readfirstlane(tid >> 6), lane = tid & 63, wr = wid >> 2, wc = wid & 3, fr = lane & 15, fq = lane >> 4;
    const int K = g.K, nt = K / BK;
    unsigned voffA[2], voffB[2];
#pragma unroll
    for (int i = 0; i < 2; ++i) { int R, C; stage_rc(tid * 16 + i * 8192, R, C); const int Rb = Epi::PERM ? ((R & ~31) + perm32(R & 31)) : R;
        voffA[i] = (unsigned)(R * K + C) * 2u; voffB[i] = (unsigned)(Rb * K + C) * 2u; }
    const size_t kstep = (size_t)(BK * 2);
    const size_t hstep = (size_t)HALF * K * 2;
    const size_t tstep = 2 * hstep;
    const unsigned ldsw = (unsigned)wid * 1024u;
    const int aoff = lds_byte(wr * 64 + fr, fq * 8), boff = lds_byte(wc * 32 + fr, fq * 8);
#define PG8_SA(b, h) (((b) * 2 + (h)) * HTB)
#define PG8_SB(b, h) ((4 + (b) * 2 + (h)) * HTB)
#define PG8_STAGE(bufoff, gbase, voff) do { _Pragma("unroll") for (int _i = 0; _i < 2; ++_i) \
        __builtin_amdgcn_global_load_lds((const unsigned*)((const char*)(gbase) + (voff)[_i]), (PG8_LAS unsigned*)(lds + (bufoff) + ldsw + _i * 8192), 16, 0, 0); } while (0)
#define PG8_LDA(dst, b, h) do { _Pragma("unroll") for (int m = 0; m < 4; ++m) _Pragma("unroll") for (int k = 0; k < 2; ++k) dst[m][k] = *(const PG8_LAS bf16x8*)(lds + PG8_SA(b, h) + aoff + m * 2048 + k * 1024); } while (0)
#define PG8_LDB(dst, b, h) do { _Pragma("unroll") for (int n = 0; n < 2; ++n) _Pragma("unroll") for (int k = 0; k < 2; ++k) dst[n][k] = *(const PG8_LAS bf16x8*)(lds + PG8_SB(b, h) + boff + n * 2048 + k * 1024); } while (0)
#define PG8_MMA(ai, bj, At, Bt) do { __builtin_amdgcn_s_setprio(1); _Pragma("unroll") for (int m = 0; m < 4; ++m) _Pragma("unroll") for (int n = 0; n < 2; ++n) _Pragma("unroll") for (int k = 0; k < 2; ++k) \
        acc[ai][bj][m][n] = __builtin_amdgcn_mfma_f32_16x16x32_bf16(Bt[n][k], At[m][k], acc[ai][bj][m][n], 0, 0, 0); __builtin_amdgcn_s_setprio(0); } while (0)
#define PG8_WAIT_V(n) asm volatile("s_waitcnt vmcnt(" #n ")" ::: "memory")
#define PG8_WAIT_L(n) asm volatile("s_waitcnt lgkmcnt(" #n ")" ::: "memory")
#define PG8_BAR __builtin_amdgcn_s_barrier()
#define PG8_SCHED __builtin_amdgcn_sched_barrier(0)
    Unit cur, nxt; int ui = 0;
    if (!S.next(0, cur)) return;
    f32x4 acc[2][2][4][2];
#pragma unroll
    for (int a = 0; a < 2; ++a)
#pragma unroll
        for (int b = 0; b < 2; ++b)
#pragma unroll
            for (int m = 0; m < 4; ++m)
#pragma unroll
                for (int n = 0; n < 2; ++n) acc[a][b][m][n] = (f32x4){0.f, 0.f, 0.f, 0.f};
    bf16x8 At[4][2], B0[2][2], B1[2][2];
    const char* cA = (const char*)g.A + (size_t)cur.pm * tstep; const char* cB = (const char*)g.Bt + (size_t)cur.pn * tstep;
    S.a_ready(cur);
    if constexpr (SP2) {
        PG8_STAGE(PG8_SB(0, 0), cB, voffB); PG8_STAGE(PG8_SB(0, 1), cB + hstep, voffB); PG8_STAGE(PG8_SA(0, 0), cA, voffA); PG8_STAGE(PG8_SA(0, 1), cA + hstep, voffA);
        if (wr == 1) PG8_BAR;
        PG8_WAIT_V(2); PG8_BAR;
        PG8_STAGE(PG8_SB(1, 0), cB + kstep, voffB); PG8_STAGE(PG8_SA(1, 0), cA + kstep, voffA); PG8_STAGE(PG8_SB(1, 1), cB + hstep + kstep, voffB);
        PG8_WAIT_V(6); PG8_BAR;
    } else {
        PG8_STAGE(PG8_SB(0, 0), cB, voffB); PG8_STAGE(PG8_SA(0, 0), cA, voffA); PG8_STAGE(PG8_SB(0, 1), cB + hstep, voffB); PG8_STAGE(PG8_SA(0, 1), cA + hstep, voffA);
        if (wr == 1) PG8_BAR;
        PG8_WAIT_V(4); PG8_BAR;
        PG8_STAGE(PG8_SB(1, 0), cB + kstep, voffB); PG8_STAGE(PG8_SA(1, 0), cA + kstep, voffA); PG8_STAGE(PG8_SB(1, 1), cB + hstep + kstep, voffB);
        PG8_WAIT_V(6); PG8_BAR;
    }
    for (;;) {
        const bool has_next = S.next(ui + 1, nxt);
        const char* nA = has_next ? (const char*)g.A + (size_t)nxt.pm * tstep : cA; const char* nB = has_next ? (const char*)g.Bt + (size_t)nxt.pn * tstep : cB;
        for (int t = 0; t < nt; t += 2) {
            const bool last = (t == nt - 2);
            const char* a1 = cA + (size_t)(t + 1) * kstep;
            const char* a2 = last ? nA : cA + (size_t)(t + 2) * kstep; const char* b2 = last ? nB : cB + (size_t)(t + 2) * kstep;
            const char* a3 = a2 + kstep; const char* b3 = b2 + kstep;
            if (last && has_next) S.a_ready(nxt);
            if constexpr (SP2) {
            PG8_LDB(B0, 0, 0); PG8_LDB(B1, 0, 1); PG8_SCHED; PG8_LDA(At, 0, 0); PG8_STAGE(PG8_SA(1, 1), a1 + hstep, voffA);
            PG8_WAIT_V(8); PG8_WAIT_L(0); PG8_BAR; PG8_MMA(0, 0, At, B0); PG8_MMA(0, 1, At, B1); PG8_BAR; PG8_SCHED;
            PG8_LDA(At, 0, 1); PG8_STAGE(PG8_SB(0, 0), b2, voffB); PG8_STAGE(PG8_SB(0, 1), b2 + hstep, voffB); PG8_STAGE(PG8_SA(0, 0), a2, voffA);
            PG8_WAIT_V(8); PG8_WAIT_L(0); PG8_BAR; PG8_MMA(1, 0, At, B0); PG8_MMA(1, 1, At, B1); PG8_BAR; PG8_SCHED;
            PG8_LDB(B0, 1, 0); PG8_LDB(B1, 1, 1); PG8_SCHED; PG8_LDA(At, 1, 0); PG8_STAGE(PG8_SA(0, 1), a2 + hstep, voffA);
            PG8_WAIT_V(8); PG8_WAIT_L(0); PG8_BAR; PG8_MMA(0, 0, At, B0); PG8_MMA(0, 1, At, B1); PG8_BAR; PG8_SCHED;
            PG8_LDA(At, 1, 1); PG8_STAGE(PG8_SB(1, 0), b3, voffB); PG8_STAGE(PG8_SB(1, 1), b3 + hstep, voffB); PG8_STAGE(PG8_SA(1, 0), a3, voffA);
            PG8_WAIT_V(8); PG8_WAIT_L(0); PG8_BAR; PG8_MMA(1, 0, At, B0); PG8_MMA(1, 1, At, B1); PG8_BAR; PG8_SCHED;
            } else {
            PG8_LDB(B0, 0, 0); PG8_SCHED; PG8_LDA(At, 0, 0); PG8_STAGE(PG8_SA(1, 1), a1 + hstep, voffA);
            PG8_WAIT_L(8); PG8_BAR; PG8_WAIT_L(0); PG8_MMA(0, 0, At, B0); PG8_BAR; PG8_SCHED;
            PG8_LDB(B1, 0, 1); PG8_STAGE(PG8_SB(0, 0), b2, voffB);
            PG8_BAR; PG8_WAIT_L(0); PG8_MMA(0, 1, At, B1); PG8_BAR;
            PG8_LDA(At, 0, 1); PG8_STAGE(PG8_SA(0, 0), a2, voffA);
            PG8_BAR; PG8_WAIT_L(0); PG8_MMA(1, 0, At, B0); PG8_BAR; PG8_SCHED;
            PG8_STAGE(PG8_SB(0, 1), b2 + hstep, voffB);
            PG8_WAIT_V(6); PG8_BAR; PG8_MMA(1, 1, At, B1); PG8_BAR;
            PG8_LDB(B0, 1, 0); PG8_SCHED; PG8_LDA(At, 1, 0); PG8_STAGE(PG8_SA(0, 1), a2 + hstep, voffA);
            PG8_WAIT_L(8); PG8_BAR; PG8_WAIT_L(0); PG8_MMA(0, 0, At, B0); PG8_BAR; PG8_SCHED;
            PG8_LDB(B1, 1, 1); PG8_STAGE(PG8_SB(1, 0), b3, voffB);
            PG8_BAR; PG8_WAIT_L(0); PG8_MMA(0, 1, At, B1); PG8_BAR;
            PG8_LDA(At, 1, 1); PG8_STAGE(PG8_SA(1, 0), a3, voffA);
            PG8_BAR; PG8_WAIT_L(0); PG8_MMA(1, 0, At, B0); PG8_BAR; PG8_SCHED;
            PG8_STAGE(PG8_SB(1, 1), b3 + hstep, voffB);
            PG8_WAIT_V(6); PG8_BAR; PG8_MMA(1, 1, At, B1); PG8_BAR;
            }
        }
        if constexpr (ALIGN_EPI) { if (wr == 0) PG8_BAR; }
        if constexpr (!Epi::AFTER_DRAIN) { E(acc, cur, wr, wc, fr, fq); S.done(cur); }
        if (!has_next) break;
#pragma unroll
        for (int a = 0; a < 2; ++a)
#pragma unroll
            for (int b = 0; b < 2; ++b)
#pragma unroll
                for (int m = 0; m < 4; ++m)
#pragma unroll
                    for (int n = 0; n < 2; ++n) acc[a][b][m][n] = (f32x4){0.f, 0.f, 0.f, 0.f};
        cur = nxt; cA = nA; cB = nB; ++ui;
        if constexpr (ALIGN_EPI) { if (wr == 1) PG8_BAR; }
    }
    PG8_WAIT_V(0);
    if constexpr (!ALIGN_EPI) { if (wr == 0) PG8_BAR; }
    PG8_BAR;
    if constexpr (Epi::AFTER_DRAIN) { E.fused(acc, cur, wr, wc, fr, fq, lds, wid, lane); S.done(cur); }
#undef PG8_SA
#undef PG8_SB
#undef PG8_STAGE
#undef PG8_LDA
#undef PG8_LDB
#undef PG8_MMA
#undef PG8_WAIT_V
#undef PG8_WAIT_L
#undef PG8_BAR
#undef PG8_SCHED
}
}

#define GAS __attribute__((address_space(1)))
#define LAS __attribute__((address_space(3)))
typedef unsigned short bf16;
typedef float f32x4 __attribute__((ext_vector_type(4)));
typedef float f32x2 __attribute__((ext_vector_type(2)));
typedef short bf16x8 __attribute__((ext_vector_type(8)));
typedef unsigned u32x4 __attribute__((ext_vector_type(4)));
typedef unsigned u32x2 __attribute__((ext_vector_type(2)));
typedef GAS unsigned gu32;

constexpr int NWAVES = 8, NTHR = 512;
constexpr int D = 2048, SEQ = 4096, MP = 8192, MS = 64, MT = MP + MS, DEPTH = 4;
constexpr int DIN = 5136, NINP = 5376, DFF = 5632, NGU = 2 * DFF;
constexpr int C_QA = 0, C_KA = 768, C_VA = 1536, C_UB = 2304, C_QC = 2816, C_KC = 3200, C_VC = 3584, C_RC = 4352, C_GC = 5120;
constexpr int M_A = 0, M_B = 768, M_C = 1280;
constexpr float EPS = 1e-6f;
constexpr int NCH = 64, CH = 64;
constexpr int SELEMS = 96 * 192;

enum { I_XP = 0, I_XS, I_CK, I_CV, I_SPOOL, I_SGLA, I_N1G, I_WIN, I_WG2, I_BG, I_WPOOL, I_PSCALE, I_GNG, I_WO, I_N2G, I_WFG, I_WFU, I_WFD, I_FNG, N_IN };
constexpr size_t O_YP = 0, O_YS = 16777216, O_PK = 16908288, O_PV = 29491200, O_PP = 42074112, O_PG = 42135552, O_SK = 42725376, O_SV = 42921984, O_SP = 43118592, O_SG = 43364352, O_END = 45723648;
constexpr size_t MiB = 1u << 20;
constexpr size_t WS_CTL = 0, CTL_ZERO_BYTES = 1 * MiB;
constexpr size_t WS_PART1 = 1 * MiB, WS_PART2 = 1 * MiB + 262144, WS_SPART1 = 1 * MiB + 524288, WS_SPART2 = 1 * MiB + 589824;
constexpr size_t WS_GA = 2 * MiB, WS_DEC = 3 * MiB, WS_PROJS = 4 * MiB, WS_WPT = 6 * MiB;
constexpr size_t WS_W = 8 * MiB;
constexpr size_t LW_IN = 0, LW_O = (size_t)NINP * D * 2, LW_GU = LW_O + (size_t)D * D * 2, LW_D = LW_GU + (size_t)NGU * D * 2, LW_SZ = LW_D + (size_t)D * DFF * 2;
static_assert(LW_SZ == 99614720, "layer weight bytes");
constexpr size_t WS_X = 388 * MiB, WS_XB = 453 * MiB, WS_MIX = 486 * MiB, WS_PROJ = 519 * MiB, WS_F = 603 * MiB, WS_SLOC = 692 * MiB, WS_SST = 728 * MiB, WS_BCUM = 764 * MiB, WS_END = 780 * MiB;
static_assert(WS_W + 4 * LW_SZ <= WS_X && WS_X + (size_t)MT * D * 4 <= WS_XB && WS_XB + (size_t)MT * D * 2 <= WS_MIX && WS_MIX + (size_t)MT * D * 2 <= WS_PROJ, "ws map 1");
static_assert(WS_PROJ + (size_t)MP * NINP * 2 <= WS_F && WS_F + (size_t)MT * DFF * 2 <= WS_SLOC && WS_SLOC + (size_t)512 * SELEMS * 4 <= WS_SST && WS_SST + (size_t)512 * SELEMS * 4 <= WS_BCUM && WS_BCUM + (size_t)MP * 384 * 4 <= WS_END, "ws map 2");
constexpr size_t WS_OP = WS_F, WS_LSE = WS_F + 40 * MiB;
static_assert((size_t)3 * MP * 768 * 2 <= 40 * MiB && WS_LSE + (size_t)3 * MP * 6 * 4 <= WS_SLOC, "attention partials fit");
constexpr int CW_BAR = 4096;
constexpr int RING_BYTES = 131072, XCH_OFF = RING_BYTES, SCRATCH_BYTES = 139264, LDSCTL_OFF = SCRATCH_BYTES, MISC_OFF = LDSCTL_OFF + 320, LDS_BYTES = 147456;

#define RLX_AGENT __ATOMIC_RELAXED, __HIP_MEMORY_SCOPE_AGENT
__device__ __forceinline__ float bf2f(unsigned b) { return __uint_as_float(b << 16); }
__device__ __forceinline__ unsigned f2bf(float f) { unsigned u = __float_as_uint(f); return (u + 0x7fffu + ((u >> 16) & 1u)) >> 16; }
__device__ __forceinline__ unsigned pk2(float lo, float hi) { return f2bf(lo) | (f2bf(hi) << 16); }
__device__ __forceinline__ float wave_sum(float v) {
#pragma unroll
    for (int o = 1; o < 64; o <<= 1) v += __shfl_xor(v, o);
    return v;
}
__device__ __forceinline__ float wave_max(float v) {
#pragma unroll
    for (int o = 1; o < 64; o <<= 1) v = fmaxf(v, __shfl_xor(v, o));
    return v;
}
__device__ __forceinline__ float logsig(float z) { return fminf(z, 0.f) - log1pf(__expf(-fabsf(z))); }
__device__ __forceinline__ float silu(float x) { return x / (1.0f + __expf(-x)); }

#define XB_TMO      128
#define XB_XCNT(j)  (256  + 64 * (j))
#define XB_XSUB(j)  (1280 + 64 * (j))
#define XB_XGEN(j)  (2304 + 64 * (j))
#define XB_TOP      3328
#define XB_TOPGEN   3392
#define XCD_BAR_WORDS 3456
#define XB_SPIN_CAP (1u << 18)

__device__ __forceinline__ unsigned xb_ld(unsigned* p)              { return __hip_atomic_load(p, __ATOMIC_RELAXED, __HIP_MEMORY_SCOPE_AGENT); }
__device__ __forceinline__ unsigned xb_add(unsigned* p, unsigned v) { return __hip_atomic_fetch_add(p, v, __ATOMIC_RELAXED, __HIP_MEMORY_SCOPE_AGENT); }
__device__ __forceinline__ unsigned xb_xcc_id() { return (unsigned)__builtin_amdgcn_s_getreg((3 << 11) | 20) & 0xFu; }
#define XB_SPIN(cond, bar) do { unsigned _sp = 0; while (cond) { __builtin_amdgcn_s_sleep(1); \
    if ((++_sp & 255u) == 0u) { if (xb_ld(&(bar)[XB_TMO])) break; if (_sp > XB_SPIN_CAP) { atomicAdd(&(bar)[XB_TMO], 1u); break; } } } } while (0)

struct XcdBarrier {
    unsigned* bar; unsigned x;
    volatile LAS unsigned* st;
};

__device__ __forceinline__ XcdBarrier xcd_barrier_post(unsigned* bar, volatile LAS unsigned* st) {
    XcdBarrier b; b.bar = bar; b.x = xb_xcc_id(); b.st = st;
    if (threadIdx.x == 0) (void)xb_add(&bar[XB_XCNT(b.x)], 1u);
    return b;
}
__device__ __forceinline__ void xcd_barrier_complete(unsigned* bar, unsigned x, unsigned& nloc, unsigned& nx) {
    const unsigned G = gridDim.x * gridDim.y * gridDim.z;
    unsigned sum, cnt, mine, sp = 0u;
    for (;;) {
        sum = 0u; cnt = 0u; mine = 0u;
#pragma unroll
        for (unsigned j = 0; j < 16; ++j) { const unsigned c = xb_ld(&bar[XB_XCNT(j)]); sum += c; cnt += (c > 0u) ? 1u : 0u; mine = (j == x) ? c : mine; }
        if (sum == G) break;
        __builtin_amdgcn_s_sleep(1);
        if ((++sp & 255u) == 0u) { if (xb_ld(&bar[XB_TMO])) break; if (sp > XB_SPIN_CAP) { atomicAdd(&bar[XB_TMO], 1u); break; } }
    }
    nloc = mine > 0u ? mine : 1u; nx = cnt > 0u ? cnt : 1u;
}

__device__ __forceinline__ void xcd_barrier(const XcdBarrier& b) {
    asm volatile("s_waitcnt vmcnt(0)" ::: "memory");
    __syncthreads();
    if (threadIdx.x == 0) {
        unsigned* bar = b.bar;
        __builtin_amdgcn_s_waitcnt(0);
        unsigned nloc = b.st[0], nx = b.st[1];
        if (nloc == 0u) { xcd_barrier_complete(bar, b.x, nloc, nx); b.st[0] = nloc; b.st[1] = nx; }
        const unsigned old = xb_add(&bar[XB_XSUB(b.x)], 1u);
        const unsigned gen = old / nloc;
        if (old + 1u == (gen + 1u) * nloc) {
            __builtin_amdgcn_fence(__ATOMIC_RELEASE, "agent");
            asm volatile("s_waitcnt vmcnt(0)" ::: "memory");
            const unsigned og = xb_add(&bar[XB_TOP], 1u);
            const unsigned tg = og / nx;
            if (og + 1u == (tg + 1u) * nx) xb_add(&bar[XB_TOPGEN], 1u);
            else XB_SPIN(xb_ld(&bar[XB_TOPGEN]) == tg, bar);
            __builtin_amdgcn_fence(__ATOMIC_ACQUIRE, "agent");
            xb_add(&bar[XB_XGEN(b.x)], 1u);
            asm volatile("s_waitcnt vmcnt(0)" ::: "memory");
        } else {
            XB_SPIN(xb_ld(&bar[XB_XGEN(b.x)]) == gen, bar);
            __builtin_amdgcn_fence(__ATOMIC_ACQUIRE, "agent");
            asm volatile("s_waitcnt vmcnt(0)" ::: "memory");
        }
    }
    __syncthreads();
}

struct RowId { __device__ __forceinline__ int operator()(int n) const { return n; } };
struct RowGate { int up; __device__ __forceinline__ int operator()(int f) const { return 256 * (f >> 7) + 128 * up + (f & 127); } };
template <class RM>
__device__ __forceinline__ void cvt_tile(const float* __restrict__ W, int K, int N, int k0, int n0, const float* __restrict__ gk, bf16* Wt, RM rowmap, LAS float* scr, int lane) {
    const int cl = 4 * (lane & 15), kr = lane >> 4;
    f32x4 v[16];
#pragma unroll
    for (int i = 0; i < 16; ++i) {
        const int kk = 4 * i + kr, n = n0 + cl;
        v[i] = (n + 3 < N) ? *(const f32x4*)(W + (size_t)(k0 + kk) * N + n) : (f32x4){0.f, 0.f, 0.f, 0.f};
    }
#pragma unroll
    for (int i = 0; i < 16; ++i) {
        const int kk = 4 * i + kr; const float g = gk ? gk[k0 + kk] : 1.0f;
        LAS float* s = scr + kk * 65 + cl;
        s[0] = v[i][0] * g; s[1] = v[i][1] * g; s[2] = v[i][2] * g; s[3] = v[i][3] * g;
    }
    asm volatile("s_waitcnt lgkmcnt(0)" ::: "memory");
    const int c = lane & 7;
#pragma unroll
    for (int i = 0; i < 8; ++i) {
        const int nl = 8 * i + (lane >> 3), n = n0 + nl;
        const LAS float* s = scr + (8 * c) * 65 + nl;
        u32x4 o; o.x = pk2(s[0 * 65], s[1 * 65]); o.y = pk2(s[2 * 65], s[3 * 65]); o.z = pk2(s[4 * 65], s[5 * 65]); o.w = pk2(s[6 * 65], s[7 * 65]);
        if (n < N) *(u32x4*)(Wt + (size_t)rowmap(n) * K + k0 + 8 * c) = o;
    }
    asm volatile("s_waitcnt lgkmcnt(0)" ::: "memory");
}

struct Ptrs {
    const float* in[N_IN]; float* out; unsigned char* ws;
};

__device__ __forceinline__ void prologue(const Ptrs& P, LAS unsigned char* lds, int bx, int G, int wave, int lane, int tid) {
    LAS float* scr = (LAS float*)(lds + wave * 16640);
    const int gw = bx * NWAVES + wave, NGW = G * NWAVES;
    constexpr int I_IN = 32 * 81, I_O = 32 * 32, I_G = 32 * 88, I_D = 88 * 32, I_L = I_IN + I_O + 2 * I_G + I_D;
    for (int it = gw; it < DEPTH * I_L; it += NGW) {
        const int l = it / I_L; int r = it - l * I_L;
        unsigned char* wl = P.ws + WS_W + (size_t)l * LW_SZ;
        if (r < I_IN) { const int kb = r / 81, nb = r % 81; cvt_tile(P.in[I_WIN] + (size_t)l * D * DIN, D, DIN, 64 * kb, 64 * nb, P.in[I_N1G] + l * D, (bf16*)(wl + LW_IN), RowId{}, scr, lane); continue; } r -= I_IN;
        if (r < I_O) { const int kb = r / 32, nb = r % 32; cvt_tile(P.in[I_WO] + (size_t)l * D * D, D, D, 64 * kb, 64 * nb, (const float*)nullptr, (bf16*)(wl + LW_O), RowId{}, scr, lane); continue; } r -= I_O;
        if (r < I_G) { const int kb = r / 88, nb = r % 88; cvt_tile(P.in[I_WFG] + (size_t)l * D * DFF, D, DFF, 64 * kb, 64 * nb, P.in[I_N2G] + l * D, (bf16*)(wl + LW_GU), RowGate{0}, scr, lane); continue; } r -= I_G;
        if (r < I_G) { const int kb = r / 88, nb = r % 88; cvt_tile(P.in[I_WFU] + (size_t)l * D * DFF, D, DFF, 64 * kb, 64 * nb, P.in[I_N2G] + l * D, (bf16*)(wl + LW_GU), RowGate{1}, scr, lane); continue; } r -= I_G;
        { const int kb = r / 32, nb = r % 32; cvt_tile(P.in[I_WFD] + (size_t)l * DFF * D, DFF, D, 64 * kb, 64 * nb, (const float*)nullptr, (bf16*)(wl + LW_D), RowId{}, scr, lane); }
    }
    for (int i = bx * NTHR + tid; i < DEPTH * 61440; i += G * NTHR) {
        const int l = i / 61440, j = i % 61440;
        *(u32x4*)(P.ws + WS_W + (size_t)l * LW_SZ + LW_IN + (size_t)DIN * D * 2 + (size_t)j * 16) = (u32x4){0u, 0u, 0u, 0u};
    }
    for (int i = bx * NTHR + tid; i < DEPTH * 4 * 128 * 128; i += G * NTHR) {
        const int c = i & 127, d = (i >> 7) & 127, lg = i >> 14;
        ((bf16*)(P.ws + WS_WPT))[i] = (bf16)f2bf(P.in[I_WPOOL][((size_t)lg * 128 + c) * 128 + d] * P.in[I_PSCALE][lg * 128 + d]);
    }
    float* part2 = (float*)(P.ws + WS_PART2); float* spart2 = (float*)(P.ws + WS_SPART2); bf16* XB = (bf16*)(P.ws + WS_XB);
    for (int row = gw; row < MT; row += NGW) {
        const float* xr = (row < MP) ? P.in[I_XP] + (size_t)row * D : P.in[I_XS] + (size_t)(row - MP) * D;
        float s = 0.f;
#pragma unroll
        for (int j = 0; j < 8; ++j) {
            const f32x4 v = *(const f32x4*)(xr + 4 * lane + 256 * j);
            s += (v[0] * v[0] + v[1] * v[1]) + (v[2] * v[2] + v[3] * v[3]);
            u32x2 o; o.x = pk2(v[0], v[1]); o.y = pk2(v[2], v[3]);
            *(u32x2*)(XB + (size_t)row * D + 4 * lane + 256 * j) = o;
        }
        s = wave_sum(s);
        if (row < MP) { if (lane < 8) part2[(size_t)row * 8 + lane] = (lane == 0) ? s : 0.f; }
        else { spart2[(size_t)(row - MP) * 128 + lane] = (lane == 0) ? s : 0.f; spart2[(size_t)(row - MP) * 128 + 64 + lane] = 0.f; }
    }
}

template <int MT, int NT, int QB, class EPI>
__device__ __forceinline__ void skinny_unit(LAS unsigned char* lds, const bf16* __restrict__ A, const bf16* __restrict__ B0, const bf16* __restrict__ B1, int K, int r0, int ntile, const EPI& epi, int wave, int lane, int tid) {
    const int fr = lane & 15, fq = lane >> 4, ks = K / 8, kb = wave * ks;
    f32x4 acc[MT][NT];
#pragma unroll
    for (int a = 0; a < MT; ++a)
#pragma unroll
        for (int b = 0; b < NT; ++b) acc[a][b] = (f32x4){0.f, 0.f, 0.f, 0.f};
    const bf16* ap = A + (size_t)(r0 + fr) * K + kb + 8 * fq;
    const bf16* b0p = B0 + (size_t)fr * K + kb + 8 * fq; const bf16* b1p = B1 + (size_t)fr * K + kb + 8 * fq;
    for (int kk0 = 0; kk0 < ks; kk0 += 32 * QB) {
        bf16x8 a[QB][MT], b[QB][NT];
#pragma unroll
        for (int q = 0; q < QB; ++q) { const int kk = (kk0 + 32 * q < ks) ? kk0 + 32 * q : kk0;
#pragma unroll
            for (int m = 0; m < MT; ++m) a[q][m] = *(const bf16x8*)(ap + (size_t)(16 * m) * K + kk);
            b[q][0] = *(const bf16x8*)(b0p + kk); if (NT == 2) b[q][NT - 1] = *(const bf16x8*)(b1p + kk); }
#pragma unroll
        for (int q = 0; q < QB; ++q) if (kk0 + 32 * q < ks) {
#pragma unroll
            for (int m = 0; m < MT; ++m)
#pragma unroll
                for (int n = 0; n < NT; ++n) acc[m][n] = __builtin_amdgcn_mfma_f32_16x16x32_bf16(a[q][m], b[q][n], acc[m][n], 0, 0, 0);
        }
    }
    LAS float* red = (LAS float*)lds;
#pragma unroll
    for (int m = 0; m < MT; ++m)
#pragma unroll
        for (int nb = 0; nb < NT; ++nb)
#pragma unroll
            for (int rg = 0; rg < 4; ++rg) red[((wave * NT + nb) * (16 * MT) + m * 16 + 4 * fq + rg) * 16 + fr] = acc[m][nb][rg];
    __syncthreads();
#pragma unroll
    for (int nb = 0; nb < NT; ++nb)
#pragma unroll
        for (int hf = 0; hf < MT / 2; ++hf) {
            float v = 0.f;
#pragma unroll
            for (int w = 0; w < 8; ++w) v += red[((w * NT + nb) * (16 * MT) + hf * 32) * 16 + tid];
            if (nb < ntile) epi(r0 + (tid >> 4) + 32 * hf, hf, nb, tid & 15, v);
        }
    __syncthreads();
}
__device__ __forceinline__ float skinny_rs(const float* spart, int rbase, int tid) {
    const float* p = spart + (size_t)(rbase + (tid >> 4)) * 128 + (tid & 15) * 8;
    const f32x4 a = *(const f32x4*)p, b = *(const f32x4*)(p + 4);
    float s = ((a[0] + a[1]) + (a[2] + a[3])) + ((b[0] + b[1]) + (b[2] + b[3]));
    s += __shfl_xor(s, 1); s += __shfl_xor(s, 2); s += __shfl_xor(s, 4); s += __shfl_xor(s, 8);
    return rsqrtf(s * (1.0f / 2048.0f) + EPS);
}
struct SEpiInProj {
    float* projs; float rs0, rs1; float* sk; float* sv; float* sp; int n0;
    __device__ __forceinline__ void operator()(int row, int hf, int tile, int cl, float v0) const {
        const int col = n0 + 16 * tile + cl; const float v = v0 * (hf == 0 ? rs0 : rs1);
        projs[(size_t)row * DIN + col] = v;
        if (col >= C_KA && col < C_VA) sk[(size_t)row * 768 + (col - C_KA)] = v;
        else if (col >= C_VA && col < C_UB) sv[(size_t)row * 768 + (col - C_VA)] = v;
        else if (col >= C_UB && col < C_QC) sp[(size_t)((row >> 3) * 15 + 7 + (row & 7)) * 512 + (col - C_UB)] = v;
    }
};
struct SEpiResid {
    const float* xin; float* xout; bf16* xb; float* spart; int n0;
    __device__ __forceinline__ void operator()(int row, int, int tile, int cl, float v0) const {
        const size_t o = (size_t)row * D + n0 + 16 * tile + cl; const float v = xin[o] + v0;
        xout[o] = v; xb[o] = (bf16)f2bf(v);
        float s = v * v; s += __shfl_xor(s, 1); s += __shfl_xor(s, 2); s += __shfl_xor(s, 4); s += __shfl_xor(s, 8);
        if (cl == 0) spart[(size_t)row * 128 + (n0 >> 4) + tile] = s;
    }
};
struct SEpiGateUp {
    bf16* F; float rs0, rs1; int f0; mutable float gate0, gate1;
    __device__ __forceinline__ void operator()(int row, int hf, int tile, int cl, float v0) const {
        const float rs = hf == 0 ? rs0 : rs1;
        if (tile == 0) { if (hf == 0) gate0 = v0 * rs; else gate1 = v0 * rs; }
        else F[(size_t)(MP + row) * DFF + f0 + cl] = (bf16)f2bf(silu(hf == 0 ? gate0 : gate1) * (v0 * rs));
    }
};

__device__ __forceinline__ void s_attn_unit(const Ptrs& P, LAS unsigned char* lds, int l, int unit, int wave, int lane, int tid) {
    const int h = unit % 6, row = unit / 6, b = row >> 3, t = row & 7;
    const float* projs = (const float*)(P.ws + WS_PROJS);
    LAS float* sc = (LAS float*)lds;
    LAS float* red = sc + 416;
    LAS float* part = red + 16;
    const int qw = lane >> 4, k16 = lane & 15;
    const f32x4 qa = *(const f32x4*)(projs + (size_t)row * DIN + C_QA + h * 128 + 4 * k16) * 0.08838834764831845f;
    const f32x4 qb = *(const f32x4*)(projs + (size_t)row * DIN + C_QA + h * 128 + 64 + 4 * k16) * 0.08838834764831845f;
    const float* rowp[13];
#pragma unroll
    for (int it = 0; it < 13; ++it) {
        int s = it * 32 + wave * 4 + qw; s = s < 387 ? s : 386;
        const int p = s / 129, j = s - p * 129, dil = (p == 0) ? 1 : (p == 1 ? 4 : 16), idx = 2048 + t - dil * j;
        rowp[it] = (idx >= 2048) ? projs + (size_t)(b * 8 + idx - 2048) * DIN + C_KA + h * 128
                                 : P.in[I_CK] + ((size_t)((l * 8 + b) * 2048 + idx) * 6 + h) * 128;
    }
    {
        f32x4 ka[13], kb[13];
#pragma unroll
        for (int it = 0; it < 13; ++it) { ka[it] = *(const f32x4*)(rowp[it] + 4 * k16); kb[it] = *(const f32x4*)(rowp[it] + 64 + 4 * k16); }
#pragma unroll
        for (int it = 0; it < 13; ++it) {
            float a = (ka[it][0] * qa[0] + ka[it][1] * qa[1]) + (ka[it][2] * qa[2] + ka[it][3] * qa[3]) + (kb[it][0] * qb[0] + kb[it][1] * qb[1]) + (kb[it][2] * qb[2] + kb[it][3] * qb[3]);
            a += __shfl_xor(a, 1); a += __shfl_xor(a, 2); a += __shfl_xor(a, 4); a += __shfl_xor(a, 8);
            const int s = it * 32 + wave * 4 + qw;
            if (k16 == 0) sc[s] = (s < 387) ? a : -1e30f;
        }
    }
    __syncthreads();
    const float v = (tid < 416) ? sc[tid] : -1e30f;
    float m = wave_max(v);
    if (lane == 0) red[wave] = m;
    __syncthreads();
    m = red[0];
#pragma unroll
    for (int w = 1; w < 8; ++w) m = fmaxf(m, red[w]);
    const float e = (tid < 387) ? __expf(v - m) : 0.f;
    float sm = wave_sum(e);
    __syncthreads();
    if (tid < 416) sc[tid] = e;
    if (lane == 0) red[8 + wave] = sm;
    __syncthreads();
    float den = 0.f;
#pragma unroll
    for (int w = 0; w < 8; ++w) den += red[8 + w];
    f32x4 oa = (f32x4){0.f, 0.f, 0.f, 0.f}, ob = (f32x4){0.f, 0.f, 0.f, 0.f};
    {
        f32x4 va[13], vb[13];
#pragma unroll
        for (int it = 0; it < 13; ++it) {
            int s = it * 32 + wave * 4 + qw; s = s < 387 ? s : 386;
            const int p = s / 129, j = s - p * 129, dil = (p == 0) ? 1 : (p == 1 ? 4 : 16), idx = 2048 + t - dil * j;
            const float* vr = (idx >= 2048) ? projs + (size_t)(b * 8 + idx - 2048) * DIN + C_VA + h * 128
                                            : P.in[I_CV] + ((size_t)((l * 8 + b) * 2048 + idx) * 6 + h) * 128;
            va[it] = *(const f32x4*)(vr + 4 * k16); vb[it] = *(const f32x4*)(vr + 64 + 4 * k16);
        }
#pragma unroll
        for (int it = 0; it < 13; ++it) { const float pe = sc[it * 32 + wave * 4 + qw]; oa += va[it] * pe; ob += vb[it] * pe; }
    }
#pragma unroll
    for (int i = 0; i < 4; ++i) { oa[i] += __shfl_xor(oa[i], 16); oa[i] += __shfl_xor(oa[i], 32); ob[i] += __shfl_xor(ob[i], 16); ob[i] += __shfl_xor(ob[i], 32); }
    if (qw == 0) { *(LAS f32x4*)(part + wave * 128 + 4 * k16) = oa; *(LAS f32x4*)(part + wave * 128 + 64 + 4 * k16) = ob; }
    __syncthreads();
    if (tid < 128) {
        float o = 0.f;
#pragma unroll
        for (int w = 0; w < 8; ++w) o += part[w * 128 + tid];
        ((bf16*)(P.ws + WS_MIX))[(size_t)(MP + row) * D + M_A + h * 128 + tid] = (bf16)f2bf(o / den);
    }
    __syncthreads();
}
__device__ __forceinline__ void s_pool_unit(const Ptrs& P, LAS unsigned char* lds, int l, int row, int tid) {
    const int b = row >> 3, t = row & 7;
    const float* projs = (const float*)(P.ws + WS_PROJS);
    const float* sp = P.in[I_SPOOL] + (size_t)(l * 8 + b) * 15 * 512;
    LAS float* pl = (LAS float*)lds;
    {
        const int c = tid, g = c >> 7, w = 2 << g; float sum = 0.f, cur = 0.f;
        for (int i = 0; i < w; ++i) { const int e = 15 + t - i;
            const float uv = (e < 15) ? sp[(size_t)e * 512 + c] : projs[(size_t)(b * 8 + e - 15) * DIN + C_UB + c];
            sum += uv; if (i == 0) cur = uv; }
        pl[c] = sum / (float)w - cur;
        if (t == 0) { float* dst = P.out + O_SP + (size_t)(l * 8 + b) * 15 * 512;
            for (int i = 0; i < 7; ++i) dst[(size_t)i * 512 + c] = sp[(size_t)(8 + i) * 512 + c]; }
    }
    __syncthreads();
    {
        const int g = tid >> 7, d = tid & 127; const float* wp = P.in[I_WPOOL] + (size_t)(l * 4 + g) * 128 * 128;
        float a = 0.f;
#pragma unroll 8
        for (int c = 0; c < 128; ++c) a += pl[g * 128 + c] * wp[(size_t)c * 128 + d];
        a *= P.in[I_PSCALE][l * 512 + tid];
        ((bf16*)(P.ws + WS_MIX))[(size_t)(MP + row) * D + M_B + tid] = (bf16)f2bf(a);
    }
    __syncthreads();
}
__device__ __forceinline__ void s_gla_unit(const Ptrs& P, LAS unsigned char* lds, int l, int unit, int tid) {
    const int b = unit >> 2, h = unit & 3;
    const float* projs = (const float*)(P.ws + WS_PROJS);
    LAS float* eg = (LAS float*)lds;
    LAS float* qL = eg + 768;
    LAS float* kL = qL + 768;
    LAS float* vL = kL + 768;
    LAS float* op = vL + 1536;
    LAS float* oc = op + 384;
    LAS float* rs = oc + 1536;
    for (int i = tid; i < 768; i += NTHR) {
        const int t = i / 96, dk = i % 96; const float* pr = projs + (size_t)(b * 8 + t) * DIN;
        float z = P.in[I_BG][l * 384 + h * 96 + dk];
#pragma unroll
        for (int r = 0; r < 16; ++r) z += pr[C_GC + r] * P.in[I_WG2][(size_t)(l * 16 + r) * 384 + h * 96 + dk];
        eg[i] = __expf(logsig(z) * (1.0f / 16.0f));
        qL[i] = pr[C_QC + h * 96 + dk] * 0.10206207261596575f;
        kL[i] = pr[C_KC + h * 96 + dk];
    }
    for (int i = tid; i < 1536; i += NTHR) { const int t = i / 192, dv = i % 192; vL[i] = projs[(size_t)(b * 8 + t) * DIN + C_VC + h * 192 + dv]; }
    __syncthreads();
    const int dv = tid % 192, hf = tid / 192;
    float S[48];
    const float* s0 = P.in[I_SGLA] + (size_t)((l * 8 + b) * 4 + h) * SELEMS;
    if (tid < 384) {
#pragma unroll
        for (int i = 0; i < 48; ++i) S[i] = s0[(size_t)(48 * hf + i) * 192 + dv];
    }
    for (int t = 0; t < 8; ++t) {
        if (tid < 384) {
            float o = 0.f; const float vv = vL[t * 192 + dv];
#pragma unroll
            for (int i = 0; i < 48; ++i) { const int dk = 48 * hf + i; S[i] = eg[t * 96 + dk] * S[i] + kL[t * 96 + dk] * vv; o += qL[t * 96 + dk] * S[i]; }
            op[hf * 192 + dv] = o;
        }
        __syncthreads();
        if (tid < 192) oc[t * 192 + tid] = op[tid] + op[192 + tid];
        __syncthreads();
    }
    if (tid < 384) { float* dst = P.out + O_SG + (size_t)((l * 8 + b) * 4 + h) * SELEMS;
#pragma unroll
        for (int i = 0; i < 48; ++i) dst[(size_t)(48 * hf + i) * 192 + dv] = S[i]; }
    {
        const int w = tid >> 6, ln = tid & 63; float s = 0.f;
        for (int i = ln; i < 192; i += 64) { const float x = oc[w * 192 + i]; s += x * x; }
        s = wave_sum(s);
        if (ln == 0) rs[w] = rsqrtf(s * (1.0f / 192.0f) + EPS);
    }
    __syncthreads();
    for (int i = tid; i < 1536; i += NTHR) {
        const int t = i / 192, d2 = i % 192; const int row = b * 8 + t;
        const float r = projs[(size_t)row * DIN + C_RC + h * 192 + d2];
        const float val = oc[i] * rs[t] * P.in[I_GNG][l * 192 + d2] * silu(r);
        ((bf16*)(P.ws + WS_MIX))[(size_t)(MP + row) * D + M_C + h * 192 + d2] = (bf16)f2bf(val);
    }
    __syncthreads();
}

typedef short v4i16_t __attribute__((ext_vector_type(4)));
__device__ __forceinline__ unsigned offb(unsigned row, unsigned ch) { return 256u * row + 16u * (ch ^ (((row & 3u) << 2) | ((row >> 2) & 3u))); }
__device__ __forceinline__ void p_attn_unit(const Ptrs& P, LAS unsigned char* lds, int unit, int wave, int lane) {
    const bf16* PROJ = (const bf16*)(P.ws + WS_PROJ);
    const int cb = unit & 31, pbh = unit >> 5, p = pbh / 12, bh = pbh - 12 * p, b = bh / 6, h = bh - 6 * b;
    const int dsh = 2 * p, dil = 1 << dsh, nbk = 32 >> dsh, r = cb / nbk, n = cb - r * nbk;
    const size_t rb = (size_t)b * SEQ + r;
#pragma unroll
    for (int i8 = 0; i8 < 8; ++i8) {
        const int i = wave * 8 + i8, row = 4 * i + (lane >> 4), pc = lane & 15;
        const int ch = pc ^ (((row & 3) << 2) | ((row >> 2) & 3));
        int ci = 128 * (n - 1) + row; ci = ci < 0 ? 0 : ci;
        const bf16* src = PROJ + (rb + (size_t)dil * ci) * NINP + h * 128 + 8 * ch;
        __builtin_amdgcn_global_load_lds((const unsigned*)(src + C_KA), (LAS unsigned*)(lds + i * 1024), 16, 0, 0);
        __builtin_amdgcn_global_load_lds((const unsigned*)(src + C_VA), (LAS unsigned*)(lds + 65536 + i * 1024), 16, 0, 0);
    }
    const int g = lane >> 4, ql = lane & 15, iloc = 16 * wave + ql;
    const size_t qrow = rb + (size_t)dil * (128 * n + iloc);
    bf16x8 qf[4];
#pragma unroll
    for (int ks = 0; ks < 4; ++ks) qf[ks] = *(const bf16x8*)(PROJ + qrow * NINP + C_QA + h * 128 + 32 * ks + 8 * g);
    asm volatile("s_waitcnt vmcnt(0)" ::: "memory");
    __syncthreads();
    const int s0 = wave >> 1;
    const unsigned q4 = ql >> 2, p4 = lane & 3;
    LAS unsigned char* kbase[2][4]; LAS unsigned char* vbase[8][2];
#pragma unroll
    for (int T = 0; T < 2; ++T)
#pragma unroll
        for (int ks = 0; ks < 4; ++ks) kbase[T][ks] = lds + offb(32 * s0 + 8 * (ql >> 2) + 4 * T + (ql & 3), 4 * ks + g);
#pragma unroll
    for (int c = 0; c < 8; ++c)
#pragma unroll
        for (int t = 0; t < 2; ++t) vbase[c][t] = lds + 65536u + offb(32 * s0 + 8 * g + 4 * t + q4, 2 * c + (p4 >> 1)) + 8u * (p4 & 1);
    f32x4 st[5][2];
#pragma unroll
    for (int s = 0; s < 5; ++s) {
        bf16x8 kf[2][4];
#pragma unroll
        for (int T = 0; T < 2; ++T)
#pragma unroll
            for (int ks = 0; ks < 4; ++ks) kf[T][ks] = *(const LAS bf16x8*)(kbase[T][ks] + 8192 * s);
        __builtin_amdgcn_sched_barrier(0);
#pragma unroll
        for (int T = 0; T < 2; ++T) {
            f32x4 a = (f32x4){0.f, 0.f, 0.f, 0.f};
#pragma unroll
            for (int ks = 0; ks < 4; ++ks) a = __builtin_amdgcn_mfma_f32_16x16x32_bf16(kf[T][ks], qf[ks], a, 0, 0, 0);
            st[s][T] = a;
        }
    }
    const float NINF = -__builtin_inff();
#pragma unroll
    for (int T = 0; T < 2; ++T)
#pragma unroll
        for (int e = 0; e < 4; ++e) {
            const int j0 = 32 * s0 + 8 * g + 4 * T + e, j4 = j0 + 128;
            st[0][T][e] = (j0 >= iloc) ? st[0][T][e] : NINF;
            st[4][T][e] = (j4 <= iloc + 128) ? st[4][T][e] : NINF;
        }
    if (n == 0) {
#pragma unroll
        for (int s = 0; s < 5; ++s)
#pragma unroll
            for (int T = 0; T < 2; ++T)
#pragma unroll
                for (int e = 0; e < 4; ++e) { const int j = 32 * (s0 + s) + 8 * g + 4 * T + e; st[s][T][e] = (j >= 128) ? st[s][T][e] : NINF; }
    }
    float mx = NINF;
#pragma unroll
    for (int s = 0; s < 5; ++s)
#pragma unroll
        for (int T = 0; T < 2; ++T) mx = fmaxf(fmaxf(mx, fmaxf(st[s][T][0], st[s][T][1])), fmaxf(st[s][T][2], st[s][T][3]));
    mx = fmaxf(mx, __shfl_xor(mx, 16)); mx = fmaxf(mx, __shfl_xor(mx, 32));
    const float SC2 = 0.08838834764831845f * 1.4426950408889634f, m2 = mx * SC2;
    float sum = 0.f;
    bf16x8 pf[5];
#pragma unroll
    for (int s = 0; s < 5; ++s) {
        float e[8];
#pragma unroll
        for (int T = 0; T < 2; ++T)
#pragma unroll
            for (int k = 0; k < 4; ++k) { const float x = __builtin_amdgcn_exp2f(__builtin_fmaf(st[s][T][k], SC2, -m2)); e[4 * T + k] = x; sum += x; }
        u32x4 w; w.x = pk2(e[0], e[1]); w.y = pk2(e[2], e[3]); w.z = pk2(e[4], e[5]); w.w = pk2(e[6], e[7]);
        pf[s] = __builtin_bit_cast(bf16x8, w);
    }
    sum += __shfl_xor(sum, 16); sum += __shfl_xor(sum, 32);
    f32x4 ot[8];
#pragma unroll
    for (int c = 0; c < 8; ++c) ot[c] = (f32x4){0.f, 0.f, 0.f, 0.f};
#pragma unroll
    for (int s = 0; s < 5; ++s) {
        v4i16_t lo[8], hi[8];
#pragma unroll
        for (int c = 0; c < 8; ++c) {
            lo[c] = __builtin_amdgcn_ds_read_tr16_b64_v4i16((LAS v4i16_t*)(vbase[c][0] + 8192 * s));
            hi[c] = __builtin_amdgcn_ds_read_tr16_b64_v4i16((LAS v4i16_t*)(vbase[c][1] + 8192 * s));
        }
        __builtin_amdgcn_sched_barrier(0);
#pragma unroll
        for (int c = 0; c < 8; ++c) {
            bf16x8 vf; vf[0] = lo[c][0]; vf[1] = lo[c][1]; vf[2] = lo[c][2]; vf[3] = lo[c][3]; vf[4] = hi[c][0]; vf[5] = hi[c][1]; vf[6] = hi[c][2]; vf[7] = hi[c][3];
            ot[c] = __builtin_amdgcn_mfma_f32_16x16x32_bf16(vf, pf[s], ot[c], 0, 0, 0);
        }
    }
    const float inv = 1.0f / sum;
    bf16* op = (bf16*)(P.ws + WS_OP) + ((size_t)p * MP + qrow) * 768 + h * 128 + 4 * g;
#pragma unroll
    for (int c = 0; c < 8; ++c) { u32x2 w; w.x = pk2(ot[c][0] * inv, ot[c][1] * inv); w.y = pk2(ot[c][2] * inv, ot[c][3] * inv); *(u32x2*)(op + 16 * c) = w; }
    if (g == 0) ((float*)(P.ws + WS_LSE))[((size_t)p * MP + qrow) * 6 + h] = mx * 0.08838834764831845f + __logf(sum);
    __syncthreads();
}
__device__ __forceinline__ void attn_combine(const Ptrs& P, int bx, int G, int wave, int lane) {
    const bf16* OP = (const bf16*)(P.ws + WS_OP); const float* LSE = (const float*)(P.ws + WS_LSE); bf16* MIX = (bf16*)(P.ws + WS_MIX);
    for (int tok = bx * NWAVES + wave; tok < MP; tok += G * NWAVES) {
#pragma unroll
        for (int h = 0; h < 6; ++h) {
            const float l0 = LSE[((size_t)0 * MP + tok) * 6 + h], l1 = LSE[((size_t)1 * MP + tok) * 6 + h], l2 = LSE[((size_t)2 * MP + tok) * 6 + h];
            const float m = fmaxf(l0, fmaxf(l1, l2)), e0 = __expf(l0 - m), e1 = __expf(l1 - m), e2 = __expf(l2 - m), inv = 1.0f / (e0 + e1 + e2);
            const unsigned w0 = *(const unsigned*)(OP + ((size_t)0 * MP + tok) * 768 + h * 128 + 2 * lane);
            const unsigned w1 = *(const unsigned*)(OP + ((size_t)1 * MP + tok) * 768 + h * 128 + 2 * lane);
            const unsigned w2 = *(const unsigned*)(OP + ((size_t)2 * MP + tok) * 768 + h * 128 + 2 * lane);
            const float a = (e0 * bf2f(w0 & 0xffffu) + e1 * bf2f(w1 & 0xffffu) + e2 * bf2f(w2 & 0xffffu)) * inv;
            const float c = (e0 * bf2f(w0 >> 16) + e1 * bf2f(w1 >> 16) + e2 * bf2f(w2 >> 16)) * inv;
            *(unsigned*)(MIX + (size_t)tok * D + M_A + h * 128 + 2 * lane) = pk2(a, c);
        }
    }
}
__device__ __forceinline__ void p_pool_wunit(const Ptrs& P, LAS unsigned char* lds, int l, int unit, int wave, int lane) {
    const bf16* PROJ = (const bf16*)(P.ws + WS_PROJ);
    const int grp = unit & 3, tb = unit >> 2, b = tb >> 8, t0 = (tb & 255) * 16;
    const int g = lane >> 4, ql = lane & 15, w = 2 << grp;
    LAS unsigned char* pl = lds + wave * 4352;
    const bf16* wpt = (const bf16*)(P.ws + WS_WPT) + (size_t)(l * 4 + grp) * 128 * 128;
    {
        const bf16* up = PROJ + (size_t)b * SEQ * NINP + C_UB + grp * 128 + 2 * lane;
        unsigned raw[31];
#pragma unroll
        for (int i = 0; i < 31; ++i) { const int tp = t0 - 15 + i; raw[i] = (tp >= 0) ? *(const unsigned*)(up + (size_t)tp * NINP) : 0u; }
        float p0[32], p1[32]; p0[0] = 0.f; p1[0] = 0.f;
#pragma unroll
        for (int i = 0; i < 31; ++i) { p0[i + 1] = p0[i] + bf2f(raw[i] & 0xffffu); p1[i + 1] = p1[i] + bf2f(raw[i] >> 16); }
#pragma unroll
        for (int tt = 0; tt < 16; ++tt) {
            const int t = t0 + tt; const float inv = 1.0f / (float)((t + 1 < w) ? (t + 1) : w);
            const int lo = (grp == 0) ? 14 + tt : (grp == 1) ? 12 + tt : (grp == 2) ? 8 + tt : tt;
            float s0, s1;
            if (grp == 0) { s0 = p0[16 + tt] - p0[14 + tt]; s1 = p1[16 + tt] - p1[14 + tt]; }
            else if (grp == 1) { s0 = p0[16 + tt] - p0[12 + tt]; s1 = p1[16 + tt] - p1[12 + tt]; }
            else if (grp == 2) { s0 = p0[16 + tt] - p0[8 + tt]; s1 = p1[16 + tt] - p1[8 + tt]; }
            else { s0 = p0[16 + tt] - p0[tt]; s1 = p1[16 + tt] - p1[tt]; }
            (void)lo;
            *(LAS unsigned*)(pl + tt * 272 + 4 * lane) = pk2(s0 * inv - bf2f(raw[15 + tt] & 0xffffu), s1 * inv - bf2f(raw[15 + tt] >> 16));
        }
    }
    asm volatile("s_waitcnt lgkmcnt(0)" ::: "memory");
    bf16x8 bfr[4];
#pragma unroll
    for (int ks = 0; ks < 4; ++ks) bfr[ks] = *(const LAS bf16x8*)(pl + ql * 272 + (32 * ks + 8 * g) * 2);
    bf16* mx = (bf16*)(P.ws + WS_MIX) + ((size_t)b * SEQ + t0 + ql) * D + M_B + grp * 128 + 4 * g;
#pragma unroll
    for (int hf = 0; hf < 2; ++hf) {
        bf16x8 af[4][4];
#pragma unroll
        for (int nt = 0; nt < 4; ++nt)
#pragma unroll
            for (int ks = 0; ks < 4; ++ks) af[nt][ks] = *(const bf16x8*)(wpt + (size_t)(16 * (4 * hf + nt) + ql) * 128 + 32 * ks + 8 * g);
#pragma unroll
        for (int nt = 0; nt < 4; ++nt) {
            f32x4 acc = (f32x4){0.f, 0.f, 0.f, 0.f};
#pragma unroll
            for (int ks = 0; ks < 4; ++ks) acc = __builtin_amdgcn_mfma_f32_16x16x32_bf16(af[nt][ks], bfr[ks], acc, 0, 0, 0);
            u32x2 o; o.x = pk2(acc[0], acc[1]); o.y = pk2(acc[2], acc[3]); *(u32x2*)(mx + 16 * (4 * hf + nt)) = o;
        }
    }
    asm volatile("s_waitcnt lgkmcnt(0)" ::: "memory");
}
__device__ __forceinline__ float logsig_fast(float z) { return fminf(z, 0.f) - __logf(1.0f + __expf(-fabsf(z))); }
__device__ __forceinline__ void gla_gate_cumsum(const Ptrs& P, int l, int b, int h, int t0, int tid, LAS float* bL, LAS float* gaL, LAS float* tot) {
    const float* GA = (const float*)(P.ws + WS_GA) + ((size_t)b * SEQ + t0) * 16;
    for (int i = tid; i < 256; i += NTHR) *(LAS f32x4*)(gaL + 4 * i) = *(const f32x4*)(GA + 4 * i);
    const int dk = tid % 96, seg = tid / 96;
    float wg[16], bg = 0.f;
    if (tid < 384) {
#pragma unroll
        for (int r = 0; r < 16; ++r) wg[r] = P.in[I_WG2][(size_t)(l * 16 + r) * 384 + h * 96 + dk];
        bg = P.in[I_BG][l * 384 + h * 96 + dk];
    }
    __syncthreads();
    float run[16];
    if (tid < 384) {
        float acc = 0.f;
#pragma unroll
        for (int jj = 0; jj < 16; ++jj) {
            const LAS f32x4* gp = (const LAS f32x4*)(gaL + (16 * seg + jj) * 16);
            const f32x4 a0 = gp[0], a1 = gp[1], a2 = gp[2], a3 = gp[3];
            float z = bg;
            z += (a0[0] * wg[0] + a0[1] * wg[1]) + (a0[2] * wg[2] + a0[3] * wg[3]);
            z += (a1[0] * wg[4] + a1[1] * wg[5]) + (a1[2] * wg[6] + a1[3] * wg[7]);
            z += (a2[0] * wg[8] + a2[1] * wg[9]) + (a2[2] * wg[10] + a2[3] * wg[11]);
            z += (a3[0] * wg[12] + a3[1] * wg[13]) + (a3[2] * wg[14] + a3[3] * wg[15]);
            acc += logsig_fast(z) * (1.0f / 16.0f); run[jj] = acc;
        }
        tot[seg * 96 + dk] = acc;
    }
    __syncthreads();
    if (tid < 384) {
        float off = 0.f;
#pragma unroll
        for (int s = 0; s < 3; ++s) if (s < seg) off += tot[s * 96 + dk];
#pragma unroll
        for (int jj = 0; jj < 16; ++jj) bL[(16 * seg + jj) * 97 + dk] = run[jj] + off;
    }
    __syncthreads();
}
__device__ __forceinline__ bf16x8 tr8(LAS unsigned char* vi, int tok0, int col, int q4, int p4) {
    const v4i16_t lo = __builtin_amdgcn_ds_read_tr16_b64_v4i16((LAS v4i16_t*)(vi + (tok0 + q4) * 400 + (col + 4 * p4) * 2));
    const v4i16_t hi = __builtin_amdgcn_ds_read_tr16_b64_v4i16((LAS v4i16_t*)(vi + (tok0 + 4 + q4) * 400 + (col + 4 * p4) * 2));
    bf16x8 r; r[0] = lo[0]; r[1] = lo[1]; r[2] = lo[2]; r[3] = lo[3]; r[4] = hi[0]; r[5] = hi[1]; r[6] = hi[2]; r[7] = hi[3]; return r;
}
__device__ __forceinline__ void gla1_unit(const Ptrs& P, LAS unsigned char* lds, int l, int unit, int tid, int wave, int lane) {
    const bf16* PROJ = (const bf16*)(P.ws + WS_PROJ);
    const int bh = unit >> 6, n = unit & 63, b = bh >> 2, h = bh & 3, t0 = n * CH;
    LAS float* bL = (LAS float*)lds; LAS float* gaL = (LAS float*)(lds + 24832); LAS float* wgL = (LAS float*)(lds + 28928);
    LAS unsigned char* KT = lds + 35456;
    LAS unsigned char* VI = lds + 49280;
    gla_gate_cumsum(P, l, b, h, t0, tid, bL, gaL, wgL);
    const bf16* pr = PROJ + ((size_t)b * SEQ + t0) * NINP;
    float* bc = (float*)(P.ws + WS_BCUM) + ((size_t)b * SEQ + t0) * 384 + h * 96;
    for (int i = tid; i < 6144; i += NTHR) { const int j = i / 96, dk = i - 96 * j; const float bb = bL[j * 97 + dk];
        bc[(size_t)j * 384 + dk] = bb;
        ((LAS bf16*)KT)[dk * 72 + j] = (bf16)f2bf(bf2f(pr[(size_t)j * NINP + C_KC + h * 96 + dk]) * __expf(bL[63 * 97 + dk] - bb)); }
    for (int i = tid; i < 1536; i += NTHR) { const int j = i / 24, ch = i - 24 * j;
        *(LAS u32x4*)(VI + j * 400 + ch * 16) = *(const u32x4*)(pr + (size_t)j * NINP + C_VC + h * 192 + 8 * ch); }
    if (tid < 96) ((float*)(P.ws + WS_DEC))[(size_t)unit * 96 + tid] = __expf(bL[63 * 97 + tid]);
    __syncthreads();
    const int g = lane >> 4, ql = lane & 15, q4 = ql >> 2, p4 = lane & 3, dkg = wave & 1, dvg = wave >> 1;
    f32x4 acc[3][3];
#pragma unroll
    for (int a = 0; a < 3; ++a)
#pragma unroll
        for (int d = 0; d < 3; ++d) acc[a][d] = (f32x4){0.f, 0.f, 0.f, 0.f};
#pragma unroll
    for (int ks = 0; ks < 2; ++ks) {
        bf16x8 af[3], bfr[3];
#pragma unroll
        for (int a = 0; a < 3; ++a) af[a] = tr8(VI, 32 * ks + 8 * g, 16 * (3 * dvg + a), q4, p4);
#pragma unroll
        for (int d = 0; d < 3; ++d) bfr[d] = *(const LAS bf16x8*)(KT + (16 * (3 * dkg + d) + ql) * 144 + (32 * ks + 8 * g) * 2);
#pragma unroll
        for (int a = 0; a < 3; ++a)
#pragma unroll
            for (int d = 0; d < 3; ++d) acc[a][d] = __builtin_amdgcn_mfma_f32_16x16x32_bf16(af[a], bfr[d], acc[a][d], 0, 0, 0);
    }
    float* sl = (float*)(P.ws + WS_SLOC) + (size_t)unit * SELEMS;
#pragma unroll
    for (int a = 0; a < 3; ++a)
#pragma unroll
        for (int d = 0; d < 3; ++d)
#pragma unroll
            for (int e = 0; e < 4; ++e) sl[(size_t)(16 * (3 * dvg + a) + 4 * g + e) * 96 + 16 * (3 * dkg + d) + ql] = acc[a][d][e];
    __syncthreads();
}
__device__ __forceinline__ void gla2_scan(const Ptrs& P, int l, int bx, int G, int tid) {
    const float* SL = (const float*)(P.ws + WS_SLOC); unsigned* ST = (unsigned*)(P.ws + WS_SST); const float* DEC = (const float*)(P.ws + WS_DEC);
    for (int e2 = bx * NTHR + tid; e2 < 8 * (SELEMS / 2); e2 += G * NTHR) {
        const int bh = e2 / (SELEMS / 2), rem = 2 * (e2 - bh * (SELEMS / 2)), dv = rem / 96, dk = rem - 96 * dv;
        float S0 = 0.f, S1 = 0.f;
#pragma unroll 16
        for (int n = 0; n < NCH; ++n) {
            const size_t idx = (size_t)(bh * NCH + n) * SELEMS + rem;
            const f32x2 sl = *(const f32x2*)(SL + idx), dc = *(const f32x2*)(DEC + (size_t)(bh * NCH + n) * 96 + dk);
            ST[idx >> 1] = pk2(S0, S1); S0 = dc[0] * S0 + sl[0]; S1 = dc[1] * S1 + sl[1];
        }
        float* o = P.out + O_PG + (size_t)(l * 8 + bh) * SELEMS;
        o[(size_t)dk * 192 + dv] = S0; o[(size_t)(dk + 1) * 192 + dv] = S1;
    }
}
__device__ __forceinline__ void gla3_unit(const Ptrs& P, LAS unsigned char* lds, int l, int unit, int tid, int wave, int lane) {
    const bf16* PROJ = (const bf16*)(P.ws + WS_PROJ);
    const int bh = unit >> 6, n = unit & 63, b = bh >> 2, h = bh & 3, t0 = n * CH;
    LAS unsigned char* QE = lds; LAS unsigned char* KE = lds + 13312; LAS unsigned char* VI = lds + 26624; LAS float* SSQ = (LAS float*)(lds + 52224);
    const int g = lane >> 4, ql = lane & 15, q4 = ql >> 2, p4 = lane & 3, it = wave & 3, hv = wave >> 2, iloc = 16 * it + ql;
    const bf16* sst = (const bf16*)(P.ws + WS_SST) + (size_t)unit * SELEMS;
    bf16x8 sf[6][3];
#pragma unroll
    for (int a = 0; a < 6; ++a)
#pragma unroll
        for (int ks = 0; ks < 3; ++ks) sf[a][ks] = *(const bf16x8*)(sst + (size_t)(16 * (6 * hv + a) + ql) * 96 + 32 * ks + 8 * g);
    const bf16* pr = PROJ + ((size_t)b * SEQ + t0) * NINP;
    const float* bc = (const float*)(P.ws + WS_BCUM) + ((size_t)b * SEQ + t0) * 384 + h * 96;
    for (int i = tid; i < 6144; i += NTHR) { const int j = i / 96, dk = i - 96 * j; const float bb = bc[(size_t)j * 384 + dk];
        const float q = bf2f(pr[(size_t)j * NINP + C_QC + h * 96 + dk]) * 0.10206207261596575f, k = bf2f(pr[(size_t)j * NINP + C_KC + h * 96 + dk]);
        ((LAS bf16*)QE)[j * 104 + dk] = (bf16)f2bf(q * __expf(bb)); ((LAS bf16*)KE)[j * 104 + dk] = (bf16)f2bf(k * __expf(-bb)); }
    for (int i = tid; i < 1536; i += NTHR) { const int j = i / 24, ch = i - 24 * j;
        *(LAS u32x4*)(VI + j * 400 + ch * 16) = *(const u32x4*)(pr + (size_t)j * NINP + C_VC + h * 192 + 8 * ch); }
    __syncthreads();
    bf16x8 qfr[3];
#pragma unroll
    for (int ks = 0; ks < 3; ++ks) qfr[ks] = *(const LAS bf16x8*)(QE + iloc * 208 + (32 * ks + 8 * g) * 2);
    const int nst = (it >> 1) + 1;
    f32x4 ot[6];
#pragma unroll
    for (int a = 0; a < 6; ++a) ot[a] = (f32x4){0.f, 0.f, 0.f, 0.f};
#pragma unroll
    for (int js = 0; js < 2; ++js) if (js < nst) {
        u32x4 w;
#pragma unroll
        for (int T = 0; T < 2; ++T) {
            const int jrow = 32 * js + 8 * q4 + 4 * T + (ql & 3);
            f32x4 a = (f32x4){0.f, 0.f, 0.f, 0.f};
            bf16x8 kf[3];
#pragma unroll
            for (int ks = 0; ks < 3; ++ks) kf[ks] = *(const LAS bf16x8*)(KE + jrow * 208 + (32 * ks + 8 * g) * 2);
#pragma unroll
            for (int ks = 0; ks < 3; ++ks) a = __builtin_amdgcn_mfma_f32_16x16x32_bf16(kf[ks], qfr[ks], a, 0, 0, 0);
            float e[4];
#pragma unroll
            for (int k = 0; k < 4; ++k) { const int j = 32 * js + 8 * g + 4 * T + k; e[k] = (j <= iloc) ? a[k] : 0.f; }
            if (T == 0) { w.x = pk2(e[0], e[1]); w.y = pk2(e[2], e[3]); } else { w.z = pk2(e[0], e[1]); w.w = pk2(e[2], e[3]); }
        }
        const bf16x8 pf = __builtin_bit_cast(bf16x8, w);
        bf16x8 vf[6];
#pragma unroll
        for (int a = 0; a < 6; ++a) vf[a] = tr8(VI, 32 * js + 8 * g, 16 * (6 * hv + a), q4, p4);
        __builtin_amdgcn_sched_barrier(0);
#pragma unroll
        for (int a = 0; a < 6; ++a) ot[a] = __builtin_amdgcn_mfma_f32_16x16x32_bf16(vf[a], pf, ot[a], 0, 0, 0);
    }
#pragma unroll
    for (int a = 0; a < 6; ++a)
#pragma unroll
        for (int ks = 0; ks < 3; ++ks) ot[a] = __builtin_amdgcn_mfma_f32_16x16x32_bf16(sf[a][ks], qfr[ks], ot[a], 0, 0, 0);
    float ss = 0.f;
#pragma unroll
    for (int a = 0; a < 6; ++a) ss += (ot[a][0] * ot[a][0] + ot[a][1] * ot[a][1]) + (ot[a][2] * ot[a][2] + ot[a][3] * ot[a][3]);
    ss += __shfl_xor(ss, 16); ss += __shfl_xor(ss, 32);
    if (g == 0) SSQ[hv * 64 + iloc] = ss;
    __syncthreads();
    const float rstd = rsqrtf((SSQ[iloc] + SSQ[64 + iloc]) * (1.0f / 192.0f) + EPS);
    const size_t r = (size_t)b * SEQ + t0 + iloc;
    bf16* MIX = (bf16*)(P.ws + WS_MIX);
#pragma unroll
    for (int a = 0; a < 6; ++a) {
        const int dv0 = 16 * (6 * hv + a) + 4 * g;
        const u32x2 rc = *(const u32x2*)(PROJ + r * NINP + C_RC + h * 192 + dv0); const f32x4 gn = *(const f32x4*)(P.in[I_GNG] + l * 192 + dv0);
        u32x2 w;
        w.x = pk2(ot[a][0] * rstd * gn[0] * silu(bf2f(rc.x & 0xffffu)), ot[a][1] * rstd * gn[1] * silu(bf2f(rc.x >> 16)));
        w.y = pk2(ot[a][2] * rstd * gn[2] * silu(bf2f(rc.y & 0xffffu)), ot[a][3] * rstd * gn[3] * silu(bf2f(rc.y >> 16)));
        *(u32x2*)(MIX + r * D + M_C + h * 192 + dv0) = w;
    }
    __syncthreads();
}
__device__ __forceinline__ void final_norm(const Ptrs& P, int bx, int G, int wave, int lane) {
    const float* X = (const float*)(P.ws + WS_X); const float* part2 = (const float*)(P.ws + WS_PART2); const float* spart2 = (const float*)(P.ws + WS_SPART2); const float* g = P.in[I_FNG];
    for (int row = bx * NWAVES + wave; row < MT; row += G * NWAVES) {
        float ss;
        if (row < MP) ss = (lane < 8) ? part2[(size_t)row * 8 + lane] : 0.f;
        else ss = spart2[(size_t)(row - MP) * 128 + lane] + spart2[(size_t)(row - MP) * 128 + 64 + lane];
        const float rs = rsqrtf(wave_sum(ss) * (1.0f / 2048.0f) + EPS);
#pragma unroll
        for (int j = 0; j < 8; ++j) {
            const f32x4 v = *(const f32x4*)(X + (size_t)row * D + 4 * lane + 256 * j), gg = *(const f32x4*)(g + 4 * lane + 256 * j);
            *(f32x4*)(P.out + (size_t)row * D + 4 * lane + 256 * j) = v * rs * gg;
        }
    }
}

#ifndef REP_PRO
#define REP_PRO 1
#endif
#ifndef REP_GLA1
#define REP_GLA1 1
#endif
#ifndef REP_GLA2
#define REP_GLA2 1
#endif
#ifndef REP_GLA3
#define REP_GLA3 1
#endif
#ifndef REP_POOL
#define REP_POOL 1
#endif
#ifndef REP_SMIX
#define REP_SMIX 1
#endif
#ifndef REP_PATTN
#define REP_PATTN 1
#endif
#ifndef REP_COMB
#define REP_COMB 1
#endif
#ifndef REP_BAR
#define REP_BAR 1
#endif
#ifndef REP_INPROJ
#define REP_INPROJ 1
#endif
#ifndef REP_GU
#define REP_GU 1
#endif
#ifndef REP_SKINNY
#define REP_SKINNY 1
#endif
#ifndef MK_PER_PHASE
#define MK_PER_PHASE 0
#endif
constexpr int NPH = 30;
struct Args { const float* in[N_IN]; float* out; unsigned char* ws; int ph_lo, ph_hi, li, pad; };

__global__ void __launch_bounds__(NTHR, 2) fwd(Args args) {
    extern __shared__ __attribute__((aligned(16))) unsigned char lds_raw[];
    LAS unsigned char* lds = (LAS unsigned char*)lds_raw;
    const int tid = threadIdx.x, lane = tid & 63, wave = __builtin_amdgcn_readfirstlane(tid >> 6);
    const int G = gridDim.x, bx = blockIdx.x;
    Ptrs P;
#pragma unroll
    for (int i = 0; i < N_IN; ++i) P.in[i] = args.in[i];
    P.out = args.out; P.ws = args.ws;
    for (int u = tid; u < (LDS_BYTES - LDSCTL_OFF) / 4; u += NTHR) ((LAS unsigned*)(lds + LDSCTL_OFF))[u] = 0u;
    __syncthreads();
    unsigned* ctl = (unsigned*)(args.ws + WS_CTL);
    XcdBarrier bar; bar.bar = ctl + CW_BAR; bar.x = 0; bar.st = nullptr;
    if (!MK_PER_PHASE) bar = xcd_barrier_post(ctl + CW_BAR, (volatile LAS unsigned*)(lds + MISC_OFF) + 8);
    const int lo = args.ph_lo, hi = args.ph_hi;
#define IN(k) (lo <= (k) && (k) < hi)
#define LAUNDER() int tid_ = tid; asm volatile("" : "+v"(tid_)); const int lane_ = tid_ & 63, wave_ = __builtin_amdgcn_readfirstlane(tid_ >> 6); (void)lane_; (void)wave_
#define SEAM(k) do { if (IN((k) + 1)) { if (!MK_PER_PHASE) { for (int rb_ = 0; rb_ < REP_BAR; ++rb_) xcd_barrier(bar); } } } while (0)

    float* part1 = (float*)(args.ws + WS_PART1); float* part2 = (float*)(args.ws + WS_PART2); float* spart1 = (float*)(args.ws + WS_SPART1); float* spart2 = (float*)(args.ws + WS_SPART2);
    pg8::PG8_LAS_T xch = (pg8::PG8_LAS_T)(lds + XCH_OFF);
    bf16* XB = (bf16*)(args.ws + WS_XB); bf16* MIXB = (bf16*)(args.ws + WS_MIX); bf16* PROJ = (bf16*)(args.ws + WS_PROJ); bf16* FB = (bf16*)(args.ws + WS_F);
    float* X = (float*)(args.ws + WS_X); float* projs = (float*)(args.ws + WS_PROJS);

    if (IN(0)) { for (int rep = 0; rep < REP_PRO; ++rep) { LAUNDER(); prologue(P, lds, bx, G, wave_, lane_, tid_); __syncthreads(); } SEAM(0); }

    for (int l = 0; l < DEPTH; ++l) {
        const int pb = 1 + 7 * l;
        unsigned char* wl = args.ws + WS_W + (size_t)l * LW_SZ;
        const bf16* Win = (const bf16*)(wl + LW_IN); const bf16* Wo = (const bf16*)(wl + LW_O); const bf16* Wgu = (const bf16*)(wl + LW_GU); const bf16* Wd = (const bf16*)(wl + LW_D);
        const float* xin_p = (l == 0) ? P.in[I_XP] : X; const float* xin_s = (l == 0) ? P.in[I_XS] : X + (size_t)MP * D;

        if (IN(pb + 0)) {
            LAUNDER();
            for (int rep = 0; rep < REP_INPROJ; ++rep) {
                pg8::Gemm g{XB, Win, MP, NINP, D}; pg8::StaticOrder S; S.init(MP, NINP, G, bx);
                pg8::EpiInProj E{PROJ, part2, (float*)(args.ws + WS_GA), P.out + O_PK + (size_t)l * 3145728, P.out + O_PV + (size_t)l * 3145728, P.out + O_PP + (size_t)l * 15360};
                pg8::gemm_phase<pg8::EpiInProj, pg8::StaticOrder, true, true>(lds, g, S, E);
            }
            const int sh1 = (672 % G) ? (672 % G) : 0, ns1 = G - sh1;
            for (int rep = 0; rep < REP_SKINNY; ++rep) for (int u = bx - sh1; u >= 0 && u < 161; u += ns1) {
                const int t0 = 2 * u, t1 = (2 * u + 1 < 321) ? 2 * u + 1 : 320;
                SEpiInProj E{projs, skinny_rs(spart2, 0, tid_), skinny_rs(spart2, 32, tid_), P.out + O_SK + (size_t)l * 49152, P.out + O_SV + (size_t)l * 49152, P.out + O_SP + (size_t)l * 61440, 16 * t0};
                skinny_unit<4, 2, 4>(lds, XB + (size_t)MP * D, Win + (size_t)16 * t0 * D, Win + (size_t)16 * t1 * D, D, 0, (2 * u + 1 < 321) ? 2 : 1, E, wave_, lane_, tid_);
            }
            SEAM(pb + 0);
        }
        if (IN(pb + 1)) {
            for (int rep = 0; rep < REP_SMIX; ++rep) { LAUNDER(); for (int u = bx; u < 384; u += G) s_attn_unit(P, lds, l, u, wave_, lane_, tid_); }
            { LAUNDER(); for (int u = (bx + G - 192 % G) % G; u < 64; u += G) s_pool_unit(P, lds, l, u, tid_); }
            { LAUNDER(); for (int u = (bx + G - 160 % G) % G; u < 32; u += G) s_gla_unit(P, lds, l, u, tid_); }
            for (int rep = 0; rep < REP_GLA1; ++rep) { LAUNDER(); for (int u = bx; u < 512; u += G) gla1_unit(P, lds, l, u, tid_, wave_, lane_); }
            for (int rep = 0; rep < REP_POOL; ++rep) { LAUNDER(); for (int u = bx * NWAVES + wave_; u < 2048; u += G * NWAVES) p_pool_wunit(P, lds, l, u, wave_, lane_); __syncthreads(); }
            for (int rep = 0; rep < REP_PATTN; ++rep) { LAUNDER(); for (int u = (bx + G - 128 % G) % G; u < 1152; u += G) p_attn_unit(P, lds, u, wave_, lane_); }
            SEAM(pb + 1);
        }
        if (IN(pb + 2)) { for (int rep = 0; rep < REP_GLA2; ++rep) { LAUNDER(); gla2_scan(P, l, bx, G, tid_); } SEAM(pb + 2); }
        if (IN(pb + 3)) { for (int rep = 0; rep < REP_GLA3; ++rep) { LAUNDER(); for (int u = bx; u < 512; u += G) gla3_unit(P, lds, l, u, tid_, wave_, lane_); } for (int rep = 0; rep < REP_COMB; ++rep) { LAUNDER(); attn_combine(P, bx, G, wave_, lane_); } SEAM(pb + 3); }
        if (IN(pb + 4)) {
            LAUNDER();
            {
                pg8::Gemm g{MIXB, Wo, MP, D, D}; pg8::StaticOrder S; S.init(MP, D, G, bx);
                pg8::EpiResid E{xin_p, X, XB, part1, xch};
                pg8::gemm_phase<pg8::EpiResid, pg8::StaticOrder, true, true>(lds, g, S, E);
            }
            for (int u = G - 1 - bx; u < 256; u += G) {
                const int rh = u & 1, ct = u >> 1;
                SEpiResid E{xin_s, X + (size_t)MP * D, XB + (size_t)MP * D, spart1, 16 * ct};
                skinny_unit<2, 1, 8>(lds, MIXB + (size_t)MP * D, Wo + (size_t)16 * ct * D, Wo, D, 32 * rh, 1, E, wave_, lane_, tid_);
            }
            SEAM(pb + 4);
        }
        if (IN(pb + 5)) {
            LAUNDER();
            for (int rep = 0; rep < REP_GU; ++rep) {
                pg8::Gemm g{XB, Wgu, MP, NGU, D}; pg8::StaticOrder S; S.init(MP, NGU, G, bx);
                pg8::EpiGateUp E{FB, part1};
                pg8::gemm_phase<pg8::EpiGateUp, pg8::StaticOrder, true, true>(lds, g, S, E);
            }
            const int sh2 = (1408 % G) ? (1408 % G) : 0, ns2 = G - sh2;
            for (int rep = 0; rep < REP_SKINNY; ++rep) for (int u = bx - sh2; u >= 0 && u < 352; u += ns2) {
                const int f0 = 16 * u; const size_t gr = (size_t)(256 * (f0 >> 7) + (f0 & 127));
                SEpiGateUp E{FB, skinny_rs(spart1, 0, tid_), skinny_rs(spart1, 32, tid_), f0, 0.f, 0.f};
                skinny_unit<4, 2, 4>(lds, XB + (size_t)MP * D, Wgu + gr * D, Wgu + (gr + 128) * D, D, 0, 2, E, wave_, lane_, tid_);
            }
            SEAM(pb + 5);
        }
        if (IN(pb + 6)) {
            LAUNDER();
            {
                pg8::Gemm g{FB, Wd, MP, D, DFF}; pg8::StaticOrder S; S.init(MP, D, G, bx);
                pg8::EpiResid E{X, X, XB, part2, xch};
                pg8::gemm_phase<pg8::EpiResid, pg8::StaticOrder, true, true>(lds, g, S, E);
            }
            for (int u = G - 1 - bx; u < 256; u += G) {
                const int rh = u & 1, ct = u >> 1;
                SEpiResid E{X + (size_t)MP * D, X + (size_t)MP * D, XB + (size_t)MP * D, spart2, 16 * ct};
                skinny_unit<2, 1, 8>(lds, FB + (size_t)MP * DFF, Wd + (size_t)16 * ct * DFF, Wd, DFF, 32 * rh, 1, E, wave_, lane_, tid_);
            }
            SEAM(pb + 6);
        }
    }
    if (IN(29)) { LAUNDER(); final_norm(P, bx, G, wave_, lane_); }
#undef IN
#undef SEAM
}

extern "C" void kernel_launch(void* const* d_in, const int* in_sizes, int n_in, void* d_out, int out_size, void* d_ws, size_t ws_size, hipStream_t stream) {
    static int grid = 0;
    if (grid == 0) {
        if (n_in != N_IN || (size_t)out_size != O_END || ws_size < WS_END) { fprintf(stderr, "kernel_launch: unexpected sizes n_in %d out %d ws %zu\n", n_in, out_size, ws_size); grid = -1; return; }
        int dev = 0, cus = 0, per_cu = 0;
        if (hipGetDevice(&dev) != hipSuccess || hipDeviceGetAttribute(&cus, hipDeviceAttributeMultiprocessorCount, dev) != hipSuccess) { grid = -1; return; }
        if (hipFuncSetAttribute((const void*)fwd, hipFuncAttributeMaxDynamicSharedMemorySize, LDS_BYTES) != hipSuccess) { fprintf(stderr, "kernel_launch: hipFuncSetAttribute failed\n"); grid = -1; return; }
        if (hipOccupancyMaxActiveBlocksPerMultiprocessor(&per_cu, (const void*)fwd, NTHR, LDS_BYTES) != hipSuccess || per_cu < 1) { fprintf(stderr, "kernel_launch: occupancy query says %d\n", per_cu); }
        (void)hipGetLastError();
        grid = cus;
    }
    if (grid < 0) return;
    (void)hipMemsetAsync((char*)d_ws + WS_CTL, 0, CTL_ZERO_BYTES, stream);
    Args a{};
    for (int i = 0; i < N_IN; ++i) a.in[i] = (const float*)d_in[i];
    a.out = (float*)d_out; a.ws = (unsigned char*)d_ws; a.li = 0; a.pad = 0;
#if MK_PER_PHASE
    for (int p = 0; p < NPH; ++p) { a.ph_lo = p; a.ph_hi = p + 1; hipLaunchKernelGGL(fwd, dim3(grid), dim3(NTHR), LDS_BYTES, stream, a); }
#else
    a.ph_lo = 0; a.ph_hi = NPH;
    hipLaunchKernelGGL(fwd, dim3(grid), dim3(NTHR), LDS_BYTES, stream, a);
#endif
    const hipError_t le = hipPeekAtLastError();
    if (le != hipSuccess) fprintf(stderr, "kernel_launch: launch failed: %s\n", hipGetErrorName(le));
}
```

```cpp
#include <hip/hip_runtime.h>
#include <cstdio>
#include <cstdint>
namespace pg8 {
#define PG8_LAS __attribute__((address_space(3)))
typedef unsigned short bf16_t;
typedef PG8_LAS float* PG8_LAS_T;
typedef short bf16x8 __attribute__((ext_vector_type(8)));
typedef float f32x4 __attribute__((ext_vector_type(4)));
typedef unsigned u32x4 __attribute__((ext_vector_type(4)));
constexpr int BM = 256, BK = 64, HALF = 128, HTB = HALF * BK * 2  , STAGE_BYTES = 8 * HTB, NXCD = 8, WGM = 8;

__host__ __device__ __forceinline__ int lds_byte(int r, int c) { const int st = (r >> 4) * 2 + (c >> 5), rr = r & 15, cc = c & 31, ob = rr * 64 + cc * 2; return st * 1024 + (ob ^ (((ob >> 9) & 1) << 5)); }
__host__ __device__ __forceinline__ void stage_rc(int b, int& R, int& C) { const int st = b / 1024, sb = b % 1024, swz = sb ^ (((sb >> 9) & 1) << 5); R = (st >> 1) * 16 + swz / 64; C = (st & 1) * 32 + (swz % 64) / 2; }
__host__ __device__ __forceinline__ int perm32(int rho) { const int n = rho >> 4, i = rho & 15; return 8 * (i >> 2) + 4 * n + (i & 3); }

struct Unit { int pm, pn; };
struct Gemm { const bf16_t* A; const bf16_t* Bt; int M, N, K; };

struct StaticOrder {
    int nM, nN, nwg, G, c;
    __host__ __device__ void init(int M, int N, int G_, int c_) { nM = M / BM; nN = N / BM; nwg = nM * nN; G = G_; c = c_; }
    __host__ __device__ bool next(int i, Unit& u) const {
        const long L = (long)i * G + c; if (L >= nwg) return false;
        int wgid = (int)L; { const int q = nwg / NXCD, r = nwg % NXCD, xcd = wgid % NXCD, off = wgid / NXCD; wgid = (xcd < r ? xcd * (q + 1) : r * (q + 1) + (xcd - r) * q) + off; }
        const int nig = WGM * nN, gid = wgid / nig, fm = gid * WGM, gsz = (nM - fm) < WGM ? (nM - fm) : WGM;
        u.pm = fm + ((wgid % nig) % gsz); u.pn = (wgid % nig) / gsz; return true;
    }
    __device__ __forceinline__ void a_ready(const Unit&) const {}
    __device__ __forceinline__ void done(const Unit&) const {}
};


__device__ __forceinline__ unsigned cvt_pk_bf16(float lo, float hi) { unsigned r; asm volatile("v_cvt_pk_bf16_f32 %0, %1, %2" : "=v"(r) : "v"(lo), "v"(hi)); return r; }
__device__ __forceinline__ float silu_f(float x) { return x * __builtin_amdgcn_rcpf(1.0f + __expf(-x)); }

struct EpiInProj {
    static constexpr bool PERM = true, AFTER_DRAIN = false;
    bf16_t* P; const float* part; float* ga; float* pk; float* pv; float* pp;
    __device__ __forceinline__ void operator()(const f32x4 (&acc)[2][2][4][2], const Unit& u, int wr, int wc, int fr, int fq) const {
        const int row0 = u.pm * BM + wr * 64 + fr, col0 = u.pn * BM + wc * 32 + 8 * fq;
        const int tp = (u.pm & 15) * 256;
        const bool kv_out = (u.pn >= 3 && u.pn < 9) && (tp >= 2048);
        const bool u_out = (u.pn == 9 || u.pn == 10) && (tp == 3840);
        const bool g_out = (u.pn == 20) && (wc == 0) && (fq < 2);
#pragma unroll
        for (int ai = 0; ai < 2; ++ai)
#pragma unroll
            for (int m = 0; m < 4; ++m) {
                const int r = row0 + ai * HALF + m * 16;
                const f32x4 q0 = *(const f32x4*)(part + (size_t)r * 8), q1 = *(const f32x4*)(part + (size_t)r * 8 + 4);
                const float rs = rsqrtf((((q0[0] + q0[1]) + (q0[2] + q0[3])) + ((q1[0] + q1[1]) + (q1[2] + q1[3]))) * (1.0f / 2048.0f) + 1e-6f);
                bf16_t* rowp = P + (size_t)r * 5376 + col0;
                const int b = r >> 12, t = r & 4095;
#pragma unroll
                for (int bj = 0; bj < 2; ++bj) {
                    const f32x4 v0 = acc[ai][bj][m][0] * rs, v1 = acc[ai][bj][m][1] * rs;
                    u32x4 w; w.x = cvt_pk_bf16(v0[0], v0[1]); w.y = cvt_pk_bf16(v0[2], v0[3]); w.z = cvt_pk_bf16(v1[0], v1[1]); w.w = cvt_pk_bf16(v1[2], v1[3]);
                    *(u32x4*)(rowp + bj * HALF) = w;
                    const int c = col0 + bj * HALF;
                    if (kv_out) {
                        float* dst = (u.pn < 6) ? (pk + ((size_t)(b * 2048 + (t - 2048)) * 768 + (c - 768))) : (pv + ((size_t)(b * 2048 + (t - 2048)) * 768 + (c - 1536)));
                        *(f32x4*)dst = v0; *(f32x4*)(dst + 4) = v1;
                    }
                    if (u_out && t >= 4081) {
                        float* dst = pp + ((size_t)(b * 15 + (t - 4081)) * 512 + (c - 2304));
                        *(f32x4*)dst = v0; *(f32x4*)(dst + 4) = v1;
                    }
                    if (g_out && bj == 0) {
                        float* dst = ga + (size_t)r * 16 + 8 * fq;
                        *(f32x4*)dst = v0; *(f32x4*)(dst + 4) = v1;
                    }
                }
            }
    }
};
struct EpiResid {
    static constexpr bool PERM = true, AFTER_DRAIN = false;
    const float* xin; float* xout; bf16_t* xb; float* part; PG8_LAS float* xch;
    __device__ __forceinline__ void operator()(const f32x4 (&acc)[2][2][4][2], const Unit& u, int wr, int wc, int fr, int fq) const {
        const int row0 = u.pm * BM + wr * 64 + fr, col0 = u.pn * BM + wc * 32 + 8 * fq;
#pragma unroll
        for (int ai = 0; ai < 2; ++ai) {
            f32x4 res[4][2][2];
#pragma unroll
            for (int m = 0; m < 4; ++m) { const size_t off = (size_t)(row0 + ai * HALF + m * 16) * 2048 + col0;
#pragma unroll
                for (int bj = 0; bj < 2; ++bj) { res[m][bj][0] = *(const f32x4*)(xin + off + bj * HALF); res[m][bj][1] = *(const f32x4*)(xin + off + bj * HALF + 4); } }
#pragma unroll
            for (int m = 0; m < 4; ++m) {
                const int r = row0 + ai * HALF + m * 16;
                const size_t off = (size_t)r * 2048 + col0;
                float s = 0.f;
#pragma unroll
                for (int bj = 0; bj < 2; ++bj) {
                    const f32x4 v0 = acc[ai][bj][m][0] + res[m][bj][0], v1 = acc[ai][bj][m][1] + res[m][bj][1];
                    *(f32x4*)(xout + off + bj * HALF) = v0; *(f32x4*)(xout + off + bj * HALF + 4) = v1;
                    u32x4 w; w.x = cvt_pk_bf16(v0[0], v0[1]); w.y = cvt_pk_bf16(v0[2], v0[3]); w.z = cvt_pk_bf16(v1[0], v1[1]); w.w = cvt_pk_bf16(v1[2], v1[3]);
                    *(u32x4*)(xb + off + bj * HALF) = w;
                    s += (v0[0] * v0[0] + v0[1] * v0[1]) + (v0[2] * v0[2] + v0[3] * v0[3]) + (v1[0] * v1[0] + v1[1] * v1[1]) + (v1[2] * v1[2] + v1[3] * v1[3]);
                }
                s += __shfl_xor(s, 16); s += __shfl_xor(s, 32);
                if (fq == 0) xch[(ai * HALF + wr * 64 + m * 16 + fr) * 4 + wc] = s;
            }
            asm volatile("" ::: "memory");
        }
        asm volatile("s_waitcnt lgkmcnt(0)" ::: "memory"); __builtin_amdgcn_s_barrier(); asm volatile("" ::: "memory");
        if (wr == 0) { const int row = wc * 64 + fq * 16 + fr; const f32x4 q = *(const PG8_LAS f32x4*)(xch + row * 4);
            part[(size_t)(u.pm * BM + row) * 8 + u.pn] = (q[0] + q[1]) + (q[2] + q[3]); }
    }
};
struct EpiGateUp {
    static constexpr bool PERM = true, AFTER_DRAIN = false;
    bf16_t* F; const float* part;
    __device__ __forceinline__ void operator()(const f32x4 (&acc)[2][2][4][2], const Unit& u, int wr, int wc, int fr, int fq) const {
        const int row0 = u.pm * BM + wr * 64 + fr, col0 = u.pn * HALF + wc * 32 + 8 * fq;
#pragma unroll
        for (int ai = 0; ai < 2; ++ai)
#pragma unroll
            for (int m = 0; m < 4; ++m) {
                const int r = row0 + ai * HALF + m * 16;
                const f32x4 q0 = *(const f32x4*)(part + (size_t)r * 8), q1 = *(const f32x4*)(part + (size_t)r * 8 + 4);
                const float rs = rsqrtf((((q0[0] + q0[1]) + (q0[2] + q0[3])) + ((q1[0] + q1[1]) + (q1[2] + q1[3]))) * (1.0f / 2048.0f) + 1e-6f);
                const f32x4 g0 = acc[ai][0][m][0] * rs, g1 = acc[ai][0][m][1] * rs, u0 = acc[ai][1][m][0] * rs, u1 = acc[ai][1][m][1] * rs;
                u32x4 w;
                w.x = cvt_pk_bf16(silu_f(g0[0]) * u0[0], silu_f(g0[1]) * u0[1]); w.y = cvt_pk_bf16(silu_f(g0[2]) * u0[2], silu_f(g0[3]) * u0[3]);
                w.z = cvt_pk_bf16(silu_f(g1[0]) * u1[0], silu_f(g1[1]) * u1[1]); w.w = cvt_pk_bf16(silu_f(g1[2]) * u1[2], silu_f(g1[3]) * u1[3]);
                *(u32x4*)(F + (size_t)r * 5632 + col0) = w;
            }
    }
};

template <class Epi, class Sched, bool ALIGN_EPI = false, bool SP2 = false>
__device__ __forceinline__ void gemm_phase(PG8_LAS unsigned char* lds, const Gemm g, const Sched& S, const Epi& E) {
    int tid = threadIdx.x; asm volatile("" : "+v"(tid)); const int wid = __builtin_amdgcn_readfirstlane(tid >> 6), lane = tid & 63, wr = wid >> 2, wc = wid & 3, fr = lane & 15, fq = lane >> 4;
    const int K = g.K, nt = K / BK;
    unsigned voffA[2], voffB[2];
#pragma unroll
    for (int i = 0; i < 2; ++i) { int R, C; stage_rc(tid * 16 + i * 8192, R, C); const int Rb = Epi::PERM ? ((R & ~31) + perm32(R & 31)) : R;
        voffA[i] = (unsigned)(R * K + C) * 2u; voffB[i] = (unsigned)(Rb * K + C) * 2u; }
    const size_t kstep = (size_t)(BK * 2);
    const size_t hstep = (size_t)HALF * K * 2;
    const size_t tstep = 2 * hstep;
    const unsigned ldsw = (unsigned)wid * 1024u;
    const int aoff = lds_byte(wr * 64 + fr, fq * 8), boff = lds_byte(wc * 32 + fr, fq * 8);
#define PG8_SA(b, h) (((b) * 2 + (h)) * HTB)
#define PG8_SB(b, h) ((4 + (b) * 2 + (h)) * HTB)
#define PG8_STAGE(bufoff, gbase, voff) do { _Pragma("unroll") for (int _i = 0; _i < 2; ++_i) \
        __builtin_amdgcn_global_load_lds((const unsigned*)((const char*)(gbase) + (voff)[_i]), (PG8_LAS unsigned*)(lds + (bufoff) + ldsw + _i * 8192), 16, 0, 0); } while (0)
#define PG8_LDA(dst, b, h) do { _Pragma("unroll") for (int m = 0; m < 4; ++m) _Pragma("unroll") for (int k = 0; k < 2; ++k) dst[m][k] = *(const PG8_LAS bf16x8*)(lds + PG8_SA(b, h) + aoff + m * 2048 + k * 1024); } while (0)
#define PG8_LDB(dst, b, h) do { _Pragma("unroll") for (int n = 0; n < 2; ++n) _Pragma("unroll") for (int k = 0; k < 2; ++k) dst[n][k] = *(const PG8_LAS bf16x8*)(lds + PG8_SB(b, h) + boff + n * 2048 + k * 1024); } while (0)
#define PG8_MMA(ai, bj, At, Bt) do { __builtin_amdgcn_s_setprio(1); _Pragma("unroll") for (int m = 0; m < 4; ++m) _Pragma("unroll") for (int n = 0; n < 2; ++n) _Pragma("unroll") for (int k = 0; k < 2; ++k) \
        acc[ai][bj][m][n] = __builtin_amdgcn_mfma_f32_16x16x32_bf16(Bt[n][k], At[m][k], acc[ai][bj][m][n], 0, 0, 0); __builtin_amdgcn_s_setprio(0); } while (0)
#define PG8_WAIT_V(n) asm volatile("s_waitcnt vmcnt(" #n ")" ::: "memory")
#define PG8_WAIT_L(n) asm volatile("s_waitcnt lgkmcnt(" #n ")" ::: "memory")
#define PG8_BAR __builtin_amdgcn_s_barrier()
#define PG8_SCHED __builtin_amdgcn_sched_barrier(0)
    Unit cur, nxt; int ui = 0;
    if (!S.next(0, cur)) return;
    f32x4 acc[2][2][4][2];
#pragma unroll
    for (int a = 0; a < 2; ++a)
#pragma unroll
        for (int b = 0; b < 2; ++b)
#pragma unroll
            for (int m = 0; m < 4; ++m)
#pragma unroll
                for (int n = 0; n < 2; ++n) acc[a][b][m][n] = (f32x4){0.f, 0.f, 0.f, 0.f};
    bf16x8 At[4][2], B0[2][2], B1[2][2];
    const char* cA = (const char*)g.A + (size_t)cur.pm * tstep; const char* cB = (const char*)g.Bt + (size_t)cur.pn * tstep;
    S.a_ready(cur);
    if constexpr (SP2) {
        PG8_STAGE(PG8_SB(0, 0), cB, voffB); PG8_STAGE(PG8_SB(0, 1), cB + hstep, voffB); PG8_STAGE(PG8_SA(0, 0), cA, voffA); PG8_STAGE(PG8_SA(0, 1), cA + hstep, voffA);
        if (wr == 1) PG8_BAR;
        PG8_WAIT_V(2); PG8_BAR;
        PG8_STAGE(PG8_SB(1, 0), cB + kstep, voffB); PG8_STAGE(PG8_SA(1, 0), cA + kstep, voffA); PG8_STAGE(PG8_SB(1, 1), cB + hstep + kstep, voffB);
        PG8_WAIT_V(6); PG8_BAR;
    } else {
        PG8_STAGE(PG8_SB(0, 0), cB, voffB); PG8_STAGE(PG8_SA(0, 0), cA, voffA); PG8_STAGE(PG8_SB(0, 1), cB + hstep, voffB); PG8_STAGE(PG8_SA(0, 1), cA + hstep, voffA);
        if (wr == 1) PG8_BAR;
        PG8_WAIT_V(4); PG8_BAR;
        PG8_STAGE(PG8_SB(1, 0), cB + kstep, voffB); PG8_STAGE(PG8_SA(1, 0), cA + kstep, voffA); PG8_STAGE(PG8_SB(1, 1), cB + hstep + kstep, voffB);
        PG8_WAIT_V(6); PG8_BAR;
    }
    for (;;) {
        const bool has_next = S.next(ui + 1, nxt);
        const char* nA = has_next ? (const char*)g.A + (size_t)nxt.pm * tstep : cA; const char* nB = has_next ? (const char*)g.Bt + (size_t)nxt.pn * tstep : cB;
        for (int t = 0; t < nt; t += 2) {
            const bool last = (t == nt - 2);
            const char* a1 = cA + (size_t)(t + 1) * kstep;
            const char* a2 = last ? nA : cA + (size_t)(t + 2) * kstep; const char* b2 = last ? nB : cB + (size_t)(t + 2) * kstep;
            const char* a3 = a2 + kstep; const char* b3 = b2 + kstep;
            if (last && has_next) S.a_ready(nxt);
            if constexpr (SP2) {
            PG8_LDB(B0, 0, 0); PG8_LDB(B1, 0, 1); PG8_SCHED; PG8_LDA(At, 0, 0); PG8_STAGE(PG8_SA(1, 1), a1 + hstep, voffA);
            PG8_WAIT_V(8); PG8_WAIT_L(0); PG8_BAR; PG8_MMA(0, 0, At, B0); PG8_MMA(0, 1, At, B1); PG8_BAR; PG8_SCHED;
            PG8_LDA(At, 0, 1); PG8_STAGE(PG8_SB(0, 0), b2, voffB); PG8_STAGE(PG8_SB(0, 1), b2 + hstep, voffB); PG8_STAGE(PG8_SA(0, 0), a2, voffA);
            PG8_WAIT_V(8); PG8_WAIT_L(0); PG8_BAR; PG8_MMA(1, 0, At, B0); PG8_MMA(1, 1, At, B1); PG8_BAR; PG8_SCHED;
            PG8_LDB(B0, 1, 0); PG8_LDB(B1, 1, 1); PG8_SCHED; PG8_LDA(At, 1, 0); PG8_STAGE(PG8_SA(0, 1), a2 + hstep, voffA);
            PG8_WAIT_V(8); PG8_WAIT_L(0); PG8_BAR; PG8_MMA(0, 0, At, B0); PG8_MMA(0, 1, At, B1); PG8_BAR; PG8_SCHED;
            PG8_LDA(At, 1, 1); PG8_STAGE(PG8_SB(1, 0), b3, voffB); PG8_STAGE(PG8_SB(1, 1), b3 + hstep, voffB); PG8_STAGE(PG8_SA(1, 0), a3, voffA);
            PG8_WAIT_V(8); PG8_WAIT_L(0); PG8_BAR; PG8_MMA(1, 0, At, B0); PG8_MMA(1, 1, At, B1); PG8_BAR; PG8_SCHED;
            } else {
            PG8_LDB(B0, 0, 0); PG8_SCHED; PG8_LDA(At, 0, 0); PG8_STAGE(PG8_SA(1, 1), a1 + hstep, voffA);
            PG8_WAIT_L(8); PG8_BAR; PG8_WAIT_L(0); PG8_MMA(0, 0, At, B0); PG8_BAR; PG8_SCHED;
            PG8_LDB(B1, 0, 1); PG8_STAGE(PG8_SB(0, 0), b2, voffB);
            PG8_BAR; PG8_WAIT_L(0); PG8_MMA(0, 1, At, B1); PG8_BAR;
            PG8_LDA(At, 0, 1); PG8_STAGE(PG8_SA(0, 0), a2, voffA);
            PG8_BAR; PG8_WAIT_L(0); PG8_MMA(1, 0, At, B0); PG8_BAR; PG8_SCHED;
            PG8_STAGE(PG8_SB(0, 1), b2 + hstep, voffB);
            PG8_WAIT_V(6); PG8_BAR; PG8_MMA(1, 1, At, B1); PG8_BAR;
            PG8_LDB(B0, 1, 0); PG8_SCHED; PG8_LDA(At, 1, 0); PG8_STAGE(PG8_SA(0, 1), a2 + hstep, voffA);
            PG8_WAIT_L(8); PG8_BAR; PG8_WAIT_L(0); PG8_MMA(0, 0, At, B0); PG8_BAR; PG8_SCHED;
            PG8_LDB(B1, 1, 1); PG8_STAGE(PG8_SB(1, 0), b3, voffB);
            PG8_BAR; PG8_WAIT_L(0); PG8_MMA(0, 1, At, B1); PG8_BAR;
            PG8_LDA(At, 1, 1); PG8_STAGE(PG8_SA(1, 0), a3, voffA);
            PG8_BAR; PG8_WAIT_L(0); PG8_MMA(1, 0, At, B0); PG8_BAR; PG8_SCHED;
            PG8_STAGE(PG8_SB(1, 1), b3 + hstep, voffB);
            PG8_WAIT_V(6); PG8_BAR; PG8_MMA(1, 1, At, B1); PG8_BAR;
            }
        }
        if constexpr (ALIGN_EPI) { if (wr == 0) PG8_BAR; }
        if constexpr (!Epi::AFTER_DRAIN) { E(acc, cur, wr, wc, fr, fq); S.done(cur); }
        if (!has_next) break;
#pragma unroll
        for (int a = 0; a < 2; ++a)
#pragma unroll
            for (int b = 0; b < 2; ++b)
#pragma unroll
                for (int m = 0; m < 4; ++m)
#pragma unroll
                    for (int n = 0; n < 2; ++n) acc[a][b][m][n] = (f32x4){0.f, 0.f, 0.f, 0.f};
        cur = nxt; cA = nA; cB = nB; ++ui;
        if constexpr (ALIGN_EPI) { if (wr == 1) PG8_BAR; }
    }
    PG8_WAIT_V(0);
    if constexpr (!ALIGN_EPI) { if (wr == 0) PG8_BAR; }
    PG8_BAR;
    if constexpr (Epi::AFTER_DRAIN) { E.fused(acc, cur, wr, wc, fr, fq, lds, wid, lane); S.done(cur); }
#undef PG8_SA
#undef PG8_SB
#undef PG8_STAGE
#undef PG8_LDA
#undef PG8_LDB
#undef PG8_MMA
#undef PG8_WAIT_V
#undef PG8_WAIT_L
#undef PG8_BAR
#undef PG8_SCHED
}
}

#define GAS __attribute__((address_space(1)))
#define LAS __attribute__((address_space(3)))
typedef unsigned short bf16;
typedef float f32x4 __attribute__((ext_vector_type(4)));
typedef float f32x2 __attribute__((ext_vector_type(2)));
typedef short bf16x8 __attribute__((ext_vector_type(8)));
typedef unsigned u32x4 __attribute__((ext_vector_type(4)));
typedef unsigned u32x2 __attribute__((ext_vector_type(2)));
typedef GAS unsigned gu32;

constexpr int NWAVES = 8, NTHR = 512;
constexpr int D = 2048, SEQ = 4096, MP = 8192, MS = 64, MT = MP + MS, DEPTH = 4;
constexpr int DIN = 5136, NINP = 5376, DFF = 5632, NGU = 2 * DFF;
constexpr int C_QA = 0, C_KA = 768, C_VA = 1536, C_UB = 2304, C_QC = 2816, C_KC = 3200, C_VC = 3584, C_RC = 4352, C_GC = 5120;
constexpr int M_A = 0, M_B = 768, M_C = 1280;
constexpr float EPS = 1e-6f;
constexpr int NCH = 64, CH = 64;
constexpr int SELEMS = 96 * 192;

enum { I_XP = 0, I_XS, I_CK, I_CV, I_SPOOL, I_SGLA, I_N1G, I_WIN, I_WG2, I_BG, I_WPOOL, I_PSCALE, I_GNG, I_WO, I_N2G, I_WFG, I_WFU, I_WFD, I_FNG, N_IN };
constexpr size_t O_YP = 0, O_YS = 16777216, O_PK = 16908288, O_PV = 29491200, O_PP = 42074112, O_PG = 42135552, O_SK = 42725376, O_SV = 42921984, O_SP = 43118592, O_SG = 43364352, O_END = 45723648;
constexpr size_t MiB = 1u << 20;
constexpr size_t WS_CTL = 0, CTL_ZERO_BYTES = 1 * MiB;
constexpr size_t WS_PART1 = 1 * MiB, WS_PART2 = 1 * MiB + 262144, WS_SPART1 = 1 * MiB + 524288, WS_SPART2 = 1 * MiB + 589824;
constexpr size_t WS_GA = 2 * MiB, WS_DEC = 3 * MiB, WS_PROJS = 4 * MiB, WS_WPT = 6 * MiB;
constexpr size_t WS_W = 8 * MiB;
constexpr size_t LW_IN = 0, LW_O = (size_t)NINP * D * 2, LW_GU = LW_O + (size_t)D * D * 2, LW_D = LW_GU + (size_t)NGU * D * 2, LW_SZ = LW_D + (size_t)D * DFF * 2;
static_assert(LW_SZ == 99614720, "layer weight bytes");
constexpr size_t WS_X = 388 * MiB, WS_XB = 453 * MiB, WS_MIX = 486 * MiB, WS_PROJ = 519 * MiB, WS_F = 603 * MiB, WS_SLOC = 692 * MiB, WS_SST = 728 * MiB, WS_BCUM = 764 * MiB, WS_END = 780 * MiB;
static_assert(WS_W + 4 * LW_SZ <= WS_X && WS_X + (size_t)MT * D * 4 <= WS_XB && WS_XB + (size_t)MT * D * 2 <= WS_MIX && WS_MIX + (size_t)MT * D * 2 <= WS_PROJ, "ws map 1");
static_assert(WS_PROJ + (size_t)MP * NINP * 2 <= WS_F && WS_F + (size_t)MT * DFF * 2 <= WS_SLOC && WS_SLOC + (size_t)512 * SELEMS * 4 <= WS_SST && WS_SST + (size_t)512 * SELEMS * 4 <= WS_BCUM && WS_BCUM + (size_t)MP * 384 * 4 <= WS_END, "ws map 2");
constexpr size_t WS_OP = WS_F, WS_LSE = WS_F + 40 * MiB;
static_assert((size_t)3 * MP * 768 * 2 <= 40 * MiB && WS_LSE + (size_t)3 * MP * 6 * 4 <= WS_SLOC, "attention partials fit");
constexpr int CW_BAR = 4096;
constexpr int RING_BYTES = 131072, XCH_OFF = RING_BYTES, SCRATCH_BYTES = 139264, LDSCTL_OFF = SCRATCH_BYTES, MISC_OFF = LDSCTL_OFF + 320, LDS_BYTES = 147456;

#define RLX_AGENT __ATOMIC_RELAXED, __HIP_MEMORY_SCOPE_AGENT
__device__ __forceinline__ float bf2f(unsigned b) { return __uint_as_float(b << 16); }
typedef __bf16 hwbf16x2 __attribute__((ext_vector_type(2)));
__device__ __forceinline__ unsigned pk2(float lo, float hi) { const f32x2 v = {lo, hi}; const hwbf16x2 b = __builtin_convertvector(v, hwbf16x2); return __builtin_bit_cast(unsigned, b); }
__device__ __forceinline__ unsigned f2bf(float f) { return pk2(f, 0.f) & 0xffffu; }
__device__ __forceinline__ float wave_sum(float v) {
#pragma unroll
    for (int o = 1; o < 64; o <<= 1) v += __shfl_xor(v, o);
    return v;
}
__device__ __forceinline__ float wave_max(float v) {
#pragma unroll
    for (int o = 1; o < 64; o <<= 1) v = fmaxf(v, __shfl_xor(v, o));
    return v;
}
__device__ __forceinline__ float logsig(float z) { return fminf(z, 0.f) - log1pf(__expf(-fabsf(z))); }
__device__ __forceinline__ float silu(float x) { return x / (1.0f + __expf(-x)); }

#define XB_TMO      128
#define XB_XCNT(j)  (256  + 64 * (j))
#define XB_XSUB(j)  (1280 + 64 * (j))
#define XB_XGEN(j)  (2304 + 64 * (j))
#define XB_TOP      3328
#define XB_TOPGEN   3392
#define XCD_BAR_WORDS 3456
#define XB_SPIN_CAP (1u << 18)

__device__ __forceinline__ unsigned xb_ld(unsigned* p)              { return __hip_atomic_load(p, __ATOMIC_RELAXED, __HIP_MEMORY_SCOPE_AGENT); }
__device__ __forceinline__ unsigned xb_add(unsigned* p, unsigned v) { return __hip_atomic_fetch_add(p, v, __ATOMIC_RELAXED, __HIP_MEMORY_SCOPE_AGENT); }
__device__ __forceinline__ unsigned xb_xcc_id() { return (unsigned)__builtin_amdgcn_s_getreg((3 << 11) | 20) & 0xFu; }
#define XB_SPIN(cond, bar) do { unsigned _sp = 0; while (cond) { __builtin_amdgcn_s_sleep(1); \
    if ((++_sp & 255u) == 0u) { if (xb_ld(&(bar)[XB_TMO])) break; if (_sp > XB_SPIN_CAP) { atomicAdd(&(bar)[XB_TMO], 1u); break; } } } } while (0)

struct XcdBarrier {
    unsigned* bar; unsigned x;
    volatile LAS unsigned* st;
};

__device__ __forceinline__ XcdBarrier xcd_barrier_post(unsigned* bar, volatile LAS unsigned* st) {
    XcdBarrier b; b.bar = bar; b.x = xb_xcc_id(); b.st = st;
    if (threadIdx.x == 0) (void)xb_add(&bar[XB_XCNT(b.x)], 1u);
    return b;
}
__device__ __forceinline__ void xcd_barrier_complete(unsigned* bar, unsigned x, unsigned& nloc, unsigned& nx) {
    const unsigned G = gridDim.x * gridDim.y * gridDim.z;
    unsigned sum, cnt, mine, sp = 0u;
    for (;;) {
        sum = 0u; cnt = 0u; mine = 0u;
#pragma unroll
        for (unsigned j = 0; j < 16; ++j) { const unsigned c = xb_ld(&bar[XB_XCNT(j)]); sum += c; cnt += (c > 0u) ? 1u : 0u; mine = (j == x) ? c : mine; }
        if (sum == G) break;
        __builtin_amdgcn_s_sleep(1);
        if ((++sp & 255u) == 0u) { if (xb_ld(&bar[XB_TMO])) break; if (sp > XB_SPIN_CAP) { atomicAdd(&bar[XB_TMO], 1u); break; } }
    }
    nloc = mine > 0u ? mine : 1u; nx = cnt > 0u ? cnt : 1u;
}

__device__ __forceinline__ void xcd_barrier(const XcdBarrier& b) {
    asm volatile("s_waitcnt vmcnt(0)" ::: "memory");
    __syncthreads();
    if (threadIdx.x == 0) {
        unsigned* bar = b.bar;
        __builtin_amdgcn_s_waitcnt(0);
        unsigned nloc = b.st[0], nx = b.st[1];
        if (nloc == 0u) { xcd_barrier_complete(bar, b.x, nloc, nx); b.st[0] = nloc; b.st[1] = nx; }
        const unsigned old = xb_add(&bar[XB_XSUB(b.x)], 1u);
        const unsigned gen = old / nloc;
        if (old + 1u == (gen + 1u) * nloc) {
            __builtin_amdgcn_fence(__ATOMIC_RELEASE, "agent");
            asm volatile("s_waitcnt vmcnt(0)" ::: "memory");
            const unsigned og = xb_add(&bar[XB_TOP], 1u);
            const unsigned tg = og / nx;
            if (og + 1u == (tg + 1u) * nx) xb_add(&bar[XB_TOPGEN], 1u);
            else XB_SPIN(xb_ld(&bar[XB_TOPGEN]) == tg, bar);
            __builtin_amdgcn_fence(__ATOMIC_ACQUIRE, "agent");
            xb_add(&bar[XB_XGEN(b.x)], 1u);
            asm volatile("s_waitcnt vmcnt(0)" ::: "memory");
        } else {
            XB_SPIN(xb_ld(&bar[XB_XGEN(b.x)]) == gen, bar);
            __builtin_amdgcn_fence(__ATOMIC_ACQUIRE, "agent");
            asm volatile("s_waitcnt vmcnt(0)" ::: "memory");
        }
    }
    __syncthreads();
}

struct RowId { __device__ __forceinline__ int operator()(int n) const { return n; } };
struct RowGate { int up; __device__ __forceinline__ int operator()(int f) const { return 256 * (f >> 7) + 128 * up + (f & 127); } };
template <class RM>
__device__ __forceinline__ void cvt_tile(const float* __restrict__ W, int K, int N, int k0, int n0, const float* __restrict__ gk, bf16* Wt, RM rowmap, LAS float* scr, int lane) {
    const int cl = 4 * (lane & 15), kr = lane >> 4;
    f32x4 v[16];
#pragma unroll
    for (int i = 0; i < 16; ++i) {
        const int kk = 4 * i + kr, n = n0 + cl;
        v[i] = (n + 3 < N) ? *(const f32x4*)(W + (size_t)(k0 + kk) * N + n) : (f32x4){0.f, 0.f, 0.f, 0.f};
    }
#pragma unroll
    for (int i = 0; i < 16; ++i) {
        const int kk = 4 * i + kr; const float g = gk ? gk[k0 + kk] : 1.0f;
        LAS float* s = scr + kk * 65 + cl;
        s[0] = v[i][0] * g; s[1] = v[i][1] * g; s[2] = v[i][2] * g; s[3] = v[i][3] * g;
    }
    asm volatile("s_waitcnt lgkmcnt(0)" ::: "memory");
    const int c = lane & 7;
#pragma unroll
    for (int i = 0; i < 8; ++i) {
        const int nl = 8 * i + (lane >> 3), n = n0 + nl;
        const LAS float* s = scr + (8 * c) * 65 + nl;
        u32x4 o; o.x = pk2(s[0 * 65], s[1 * 65]); o.y = pk2(s[2 * 65], s[3 * 65]); o.z = pk2(s[4 * 65], s[5 * 65]); o.w = pk2(s[6 * 65], s[7 * 65]);
        if (n < N) *(u32x4*)(Wt + (size_t)rowmap(n) * K + k0 + 8 * c) = o;
    }
    asm volatile("s_waitcnt lgkmcnt(0)" ::: "memory");
}

struct Ptrs {
    const float* in[N_IN]; float* out; unsigned char* ws;
};

__device__ __forceinline__ void prologue(const Ptrs& P, LAS unsigned char* lds, int bx, int G, int wave, int lane, int tid) {
    LAS float* scr = (LAS float*)(lds + wave * 16640);
    const int gw = bx * NWAVES + wave, NGW = G * NWAVES;
    constexpr int I_IN = 32 * 81, I_O = 32 * 32, I_G = 32 * 88, I_D = 88 * 32, I_L = I_IN + I_O + 2 * I_G + I_D;
    for (int it = gw; it < DEPTH * I_L; it += NGW) {
        const int l = it / I_L; int r = it - l * I_L;
        unsigned char* wl = P.ws + WS_W + (size_t)l * LW_SZ;
        if (r < I_IN) { const int kb = r / 81, nb = r % 81; cvt_tile(P.in[I_WIN] + (size_t)l * D * DIN, D, DIN, 64 * kb, 64 * nb, P.in[I_N1G] + l * D, (bf16*)(wl + LW_IN), RowId{}, scr, lane); continue; } r -= I_IN;
        if (r < I_O) { const int kb = r / 32, nb = r % 32; cvt_tile(P.in[I_WO] + (size_t)l * D * D, D, D, 64 * kb, 64 * nb, (const float*)nullptr, (bf16*)(wl + LW_O), RowId{}, scr, lane); continue; } r -= I_O;
        if (r < I_G) { const int kb = r / 88, nb = r % 88; cvt_tile(P.in[I_WFG] + (size_t)l * D * DFF, D, DFF, 64 * kb, 64 * nb, P.in[I_N2G] + l * D, (bf16*)(wl + LW_GU), RowGate{0}, scr, lane); continue; } r -= I_G;
        if (r < I_G) { const int kb = r / 88, nb = r % 88; cvt_tile(P.in[I_WFU] + (size_t)l * D * DFF, D, DFF, 64 * kb, 64 * nb, P.in[I_N2G] + l * D, (bf16*)(wl + LW_GU), RowGate{1}, scr, lane); continue; } r -= I_G;
        { const int kb = r / 32, nb = r % 32; cvt_tile(P.in[I_WFD] + (size_t)l * DFF * D, DFF, D, 64 * kb, 64 * nb, (const float*)nullptr, (bf16*)(wl + LW_D), RowId{}, scr, lane); }
    }
    for (int i = bx * NTHR + tid; i < DEPTH * 61440; i += G * NTHR) {
        const int l = i / 61440, j = i % 61440;
        *(u32x4*)(P.ws + WS_W + (size_t)l * LW_SZ + LW_IN + (size_t)DIN * D * 2 + (size_t)j * 16) = (u32x4){0u, 0u, 0u, 0u};
    }
    for (int i = bx * NTHR + tid; i < DEPTH * 4 * 128 * 128; i += G * NTHR) {
        const int c = i & 127, d = (i >> 7) & 127, lg = i >> 14;
        ((bf16*)(P.ws + WS_WPT))[i] = (bf16)f2bf(P.in[I_WPOOL][((size_t)lg * 128 + c) * 128 + d] * P.in[I_PSCALE][lg * 128 + d]);
    }
    float* part2 = (float*)(P.ws + WS_PART2); float* spart2 = (float*)(P.ws + WS_SPART2); bf16* XB = (bf16*)(P.ws + WS_XB);
    for (int row = gw; row < MT; row += NGW) {
        const float* xr = (row < MP) ? P.in[I_XP] + (size_t)row * D : P.in[I_XS] + (size_t)(row - MP) * D;
        float s = 0.f;
#pragma unroll
        for (int j = 0; j < 8; ++j) {
            const f32x4 v = *(const f32x4*)(xr + 4 * lane + 256 * j);
            s += (v[0] * v[0] + v[1] * v[1]) + (v[2] * v[2] + v[3] * v[3]);
            u32x2 o; o.x = pk2(v[0], v[1]); o.y = pk2(v[2], v[3]);
            *(u32x2*)(XB + (size_t)row * D + 4 * lane + 256 * j) = o;
        }
        s = wave_sum(s);
        if (row < MP) { if (lane < 8) part2[(size_t)row * 8 + lane] = (lane == 0) ? s : 0.f; }
        else { spart2[(size_t)(row - MP) * 128 + lane] = (lane == 0) ? s : 0.f; spart2[(size_t)(row - MP) * 128 + 64 + lane] = 0.f; }
    }
}

template <int MT, int NT, int QB, class EPI>
__device__ __forceinline__ void skinny_unit(LAS unsigned char* lds, const bf16* __restrict__ A, const bf16* __restrict__ B0, const bf16* __restrict__ B1, int K, int r0, int ntile, const EPI& epi, int wave, int lane, int tid) {
    const int fr = lane & 15, fq = lane >> 4, ks = K / 8, kb = wave * ks;
    f32x4 acc[MT][NT];
#pragma unroll
    for (int a = 0; a < MT; ++a)
#pragma unroll
        for (int b = 0; b < NT; ++b) acc[a][b] = (f32x4){0.f, 0.f, 0.f, 0.f};
    const bf16* ap = A + (size_t)(r0 + fr) * K + kb + 8 * fq;
    const bf16* b0p = B0 + (size_t)fr * K + kb + 8 * fq; const bf16* b1p = B1 + (size_t)fr * K + kb + 8 * fq;
    for (int kk0 = 0; kk0 < ks; kk0 += 32 * QB) {
        bf16x8 a[QB][MT], b[QB][NT];
#pragma unroll
        for (int q = 0; q < QB; ++q) { const int kk = (kk0 + 32 * q < ks) ? kk0 + 32 * q : kk0;
#pragma unroll
            for (int m = 0; m < MT; ++m) a[q][m] = *(const bf16x8*)(ap + (size_t)(16 * m) * K + kk);
            b[q][0] = *(const bf16x8*)(b0p + kk); if (NT == 2) b[q][NT - 1] = *(const bf16x8*)(b1p + kk); }
#pragma unroll
        for (int q = 0; q < QB; ++q) if (kk0 + 32 * q < ks) {
#pragma unroll
            for (int m = 0; m < MT; ++m)
#pragma unroll
                for (int n = 0; n < NT; ++n) acc[m][n] = __builtin_amdgcn_mfma_f32_16x16x32_bf16(a[q][m], b[q][n], acc[m][n], 0, 0, 0);
        }
    }
    LAS float* red = (LAS float*)lds;
#pragma unroll
    for (int m = 0; m < MT; ++m)
#pragma unroll
        for (int nb = 0; nb < NT; ++nb)
#pragma unroll
            for (int rg = 0; rg < 4; ++rg) red[((wave * NT + nb) * (16 * MT) + m * 16 + 4 * fq + rg) * 16 + fr] = acc[m][nb][rg];
    __syncthreads();
#pragma unroll
    for (int nb = 0; nb < NT; ++nb)
#pragma unroll
        for (int hf = 0; hf < MT / 2; ++hf) {
            float v = 0.f;
#pragma unroll
            for (int w = 0; w < 8; ++w) v += red[((w * NT + nb) * (16 * MT) + hf * 32) * 16 + tid];
            if (nb < ntile) epi(r0 + (tid >> 4) + 32 * hf, hf, nb, tid & 15, v);
        }
    __syncthreads();
}
__device__ __forceinline__ float skinny_rs(const float* spart, int rbase, int tid) {
    const float* p = spart + (size_t)(rbase + (tid >> 4)) * 128 + (tid & 15) * 8;
    const f32x4 a = *(const f32x4*)p, b = *(const f32x4*)(p + 4);
    float s = ((a[0] + a[1]) + (a[2] + a[3])) + ((b[0] + b[1]) + (b[2] + b[3]));
    s += __shfl_xor(s, 1); s += __shfl_xor(s, 2); s += __shfl_xor(s, 4); s += __shfl_xor(s, 8);
    return rsqrtf(s * (1.0f / 2048.0f) + EPS);
}
struct SEpiInProj {
    float* projs; float rs0, rs1; float* sk; float* sv; float* sp; int n0;
    __device__ __forceinline__ void operator()(int row, int hf, int tile, int cl, float v0) const {
        const int col = n0 + 16 * tile + cl; const float v = v0 * (hf == 0 ? rs0 : rs1);
        projs[(size_t)row * DIN + col] = v;
        if (col >= C_KA && col < C_VA) sk[(size_t)row * 768 + (col - C_KA)] = v;
        else if (col >= C_VA && col < C_UB) sv[(size_t)row * 768 + (col - C_VA)] = v;
        else if (col >= C_UB && col < C_QC) sp[(size_t)((row >> 3) * 15 + 7 + (row & 7)) * 512 + (col - C_UB)] = v;
    }
};
struct SEpiResid {
    const float* xin; float* xout; bf16* xb; float* spart; int n0;
    __device__ __forceinline__ void operator()(int row, int, int tile, int cl, float v0) const {
        const size_t o = (size_t)row * D + n0 + 16 * tile + cl; const float v = xin[o] + v0;
        xout[o] = v; xb[o] = (bf16)f2bf(v);
        float s = v * v; s += __shfl_xor(s, 1); s += __shfl_xor(s, 2); s += __shfl_xor(s, 4); s += __shfl_xor(s, 8);
        if (cl == 0) spart[(size_t)row * 128 + (n0 >> 4) + tile] = s;
    }
};
struct SEpiGateUp {
    bf16* F; float rs0, rs1; int f0; mutable float gate0, gate1;
    __device__ __forceinline__ void operator()(int row, int hf, int tile, int cl, float v0) const {
        const float rs = hf == 0 ? rs0 : rs1;
        if (tile == 0) { if (hf == 0) gate0 = v0 * rs; else gate1 = v0 * rs; }
        else F[(size_t)(MP + row) * DFF + f0 + cl] = (bf16)f2bf(silu(hf == 0 ? gate0 : gate1) * (v0 * rs));
    }
};

__device__ __forceinline__ void s_attn_unit(const Ptrs& P, LAS unsigned char* lds, int l, int unit, int wave, int lane, int tid) {
    const int h = unit % 6, row = unit / 6, b = row >> 3, t = row & 7;
    const float* projs = (const float*)(P.ws + WS_PROJS);
    LAS float* sc = (LAS float*)lds;
    LAS float* red = sc + 416;
    LAS float* part = red + 16;
    const int qw = lane >> 4, k16 = lane & 15;
    const f32x4 qa = *(const f32x4*)(projs + (size_t)row * DIN + C_QA + h * 128 + 4 * k16) * 0.08838834764831845f;
    const f32x4 qb = *(const f32x4*)(projs + (size_t)row * DIN + C_QA + h * 128 + 64 + 4 * k16) * 0.08838834764831845f;
    const float* rowp[13];
#pragma unroll
    for (int it = 0; it < 13; ++it) {
        int s = it * 32 + wave * 4 + qw; s = s < 387 ? s : 386;
        const int p = s / 129, j = s - p * 129, dil = (p == 0) ? 1 : (p == 1 ? 4 : 16), idx = 2048 + t - dil * j;
        rowp[it] = (idx >= 2048) ? projs + (size_t)(b * 8 + idx - 2048) * DIN + C_KA + h * 128
                                 : P.in[I_CK] + ((size_t)((l * 8 + b) * 2048 + idx) * 6 + h) * 128;
    }
    {
        f32x4 ka[13], kb[13];
#pragma unroll
        for (int it = 0; it < 13; ++it) { ka[it] = *(const f32x4*)(rowp[it] + 4 * k16); kb[it] = *(const f32x4*)(rowp[it] + 64 + 4 * k16); }
#pragma unroll
        for (int it = 0; it < 13; ++it) {
            float a = (ka[it][0] * qa[0] + ka[it][1] * qa[1]) + (ka[it][2] * qa[2] + ka[it][3] * qa[3]) + (kb[it][0] * qb[0] + kb[it][1] * qb[1]) + (kb[it][2] * qb[2] + kb[it][3] * qb[3]);
            a += __shfl_xor(a, 1); a += __shfl_xor(a, 2); a += __shfl_xor(a, 4); a += __shfl_xor(a, 8);
            const int s = it * 32 + wave * 4 + qw;
            if (k16 == 0) sc[s] = (s < 387) ? a : -1e30f;
        }
    }
    __syncthreads();
    const float v = (tid < 416) ? sc[tid] : -1e30f;
    float m = wave_max(v);
    if (lane == 0) red[wave] = m;
    __syncthreads();
    m = red[0];
#pragma unroll
    for (int w = 1; w < 8; ++w) m = fmaxf(m, red[w]);
    const float e = (tid < 387) ? __expf(v - m) : 0.f;
    float sm = wave_sum(e);
    __syncthreads();
    if (tid < 416) sc[tid] = e;
    if (lane == 0) red[8 + wave] = sm;
    __syncthreads();
    float den = 0.f;
#pragma unroll
    for (int w = 0; w < 8; ++w) den += red[8 + w];
    f32x4 oa = (f32x4){0.f, 0.f, 0.f, 0.f}, ob = (f32x4){0.f, 0.f, 0.f, 0.f};
    {
        f32x4 va[13], vb[13];
#pragma unroll
        for (int it = 0; it < 13; ++it) {
            int s = it * 32 + wave * 4 + qw; s = s < 387 ? s : 386;
            const int p = s / 129, j = s - p * 129, dil = (p == 0) ? 1 : (p == 1 ? 4 : 16), idx = 2048 + t - dil * j;
            const float* vr = (idx >= 2048) ? projs + (size_t)(b * 8 + idx - 2048) * DIN + C_VA + h * 128
                                            : P.in[I_CV] + ((size_t)((l * 8 + b) * 2048 + idx) * 6 + h) * 128;
            va[it] = *(const f32x4*)(vr + 4 * k16); vb[it] = *(const f32x4*)(vr + 64 + 4 * k16);
        }
#pragma unroll
        for (int it = 0; it < 13; ++it) { const float pe = sc[it * 32 + wave * 4 + qw]; oa += va[it] * pe; ob += vb[it] * pe; }
    }
#pragma unroll
    for (int i = 0; i < 4; ++i) { oa[i] += __shfl_xor(oa[i], 16); oa[i] += __shfl_xor(oa[i], 32); ob[i] += __shfl_xor(ob[i], 16); ob[i] += __shfl_xor(ob[i], 32); }
    if (qw == 0) { *(LAS f32x4*)(part + wave * 128 + 4 * k16) = oa; *(LAS f32x4*)(part + wave * 128 + 64 + 4 * k16) = ob; }
    __syncthreads();
    if (tid < 128) {
        float o = 0.f;
#pragma unroll
        for (int w = 0; w < 8; ++w) o += part[w * 128 + tid];
        ((bf16*)(P.ws + WS_MIX))[(size_t)(MP + row) * D + M_A + h * 128 + tid] = (bf16)f2bf(o / den);
    }
    __syncthreads();
}
__device__ __forceinline__ void s_pool_unit(const Ptrs& P, LAS unsigned char* lds, int l, int row, int tid) {
    const int b = row >> 3, t = row & 7;
    const float* projs = (const float*)(P.ws + WS_PROJS);
    const float* sp = P.in[I_SPOOL] + (size_t)(l * 8 + b) * 15 * 512;
    LAS float* pl = (LAS float*)lds;
    {
        const int c = tid, g = c >> 7, w = 2 << g; float sum = 0.f, cur = 0.f;
        for (int i = 0; i < w; ++i) { const int e = 15 + t - i;
            const float uv = (e < 15) ? sp[(size_t)e * 512 + c] : projs[(size_t)(b * 8 + e - 15) * DIN + C_UB + c];
            sum += uv; if (i == 0) cur = uv; }
        pl[c] = sum / (float)w - cur;
        if (t == 0) { float* dst = P.out + O_SP + (size_t)(l * 8 + b) * 15 * 512;
            for (int i = 0; i < 7; ++i) dst[(size_t)i * 512 + c] = sp[(size_t)(8 + i) * 512 + c]; }
    }
    __syncthreads();
    {
        const int g = tid >> 7, d = tid & 127; const float* wp = P.in[I_WPOOL] + (size_t)(l * 4 + g) * 128 * 128;
        float a = 0.f;
#pragma unroll 8
        for (int c = 0; c < 128; ++c) a += pl[g * 128 + c] * wp[(size_t)c * 128 + d];
        a *= P.in[I_PSCALE][l * 512 + tid];
        ((bf16*)(P.ws + WS_MIX))[(size_t)(MP + row) * D + M_B + tid] = (bf16)f2bf(a);
    }
    __syncthreads();
}
__device__ __forceinline__ void s_gla_unit(const Ptrs& P, LAS unsigned char* lds, int l, int unit, int tid) {
    const int b = unit >> 2, h = unit & 3;
    const float* projs = (const float*)(P.ws + WS_PROJS);
    LAS float* eg = (LAS float*)lds;
    LAS float* qL = eg + 768;
    LAS float* kL = qL + 768;
    LAS float* vL = kL + 768;
    LAS float* op = vL + 1536;
    LAS float* oc = op + 384;
    LAS float* rs = oc + 1536;
    for (int i = tid; i < 768; i += NTHR) {
        const int t = i / 96, dk = i % 96; const float* pr = projs + (size_t)(b * 8 + t) * DIN;
        float z = P.in[I_BG][l * 384 + h * 96 + dk];
#pragma unroll
        for (int r = 0; r < 16; ++r) z += pr[C_GC + r] * P.in[I_WG2][(size_t)(l * 16 + r) * 384 + h * 96 + dk];
        eg[i] = __expf(logsig(z) * (1.0f / 16.0f));
        qL[i] = pr[C_QC + h * 96 + dk] * 0.10206207261596575f;
        kL[i] = pr[C_KC + h * 96 + dk];
    }
    for (int i = tid; i < 1536; i += NTHR) { const int t = i / 192, dv = i % 192; vL[i] = projs[(size_t)(b * 8 + t) * DIN + C_VC + h * 192 + dv]; }
    __syncthreads();
    const int dv = tid % 192, hf = tid / 192;
    float S[48];
    const float* s0 = P.in[I_SGLA] + (size_t)((l * 8 + b) * 4 + h) * SELEMS;
    if (tid < 384) {
#pragma unroll
        for (int i = 0; i < 48; ++i) S[i] = s0[(size_t)(48 * hf + i) * 192 + dv];
    }
    for (int t = 0; t < 8; ++t) {
        if (tid < 384) {
            float o = 0.f; const float vv = vL[t * 192 + dv];
#pragma unroll
            for (int i = 0; i < 48; ++i) { const int dk = 48 * hf + i; S[i] = eg[t * 96 + dk] * S[i] + kL[t * 96 + dk] * vv; o += qL[t * 96 + dk] * S[i]; }
            op[hf * 192 + dv] = o;
        }
        __syncthreads();
        if (tid < 192) oc[t * 192 + tid] = op[tid] + op[192 + tid];
        __syncthreads();
    }
    if (tid < 384) { float* dst = P.out + O_SG + (size_t)((l * 8 + b) * 4 + h) * SELEMS;
#pragma unroll
        for (int i = 0; i < 48; ++i) dst[(size_t)(48 * hf + i) * 192 + dv] = S[i]; }
    {
        const int w = tid >> 6, ln = tid & 63; float s = 0.f;
        for (int i = ln; i < 192; i += 64) { const float x = oc[w * 192 + i]; s += x * x; }
        s = wave_sum(s);
        if (ln == 0) rs[w] = rsqrtf(s * (1.0f / 192.0f) + EPS);
    }
    __syncthreads();
    for (int i = tid; i < 1536; i += NTHR) {
        const int t = i / 192, d2 = i % 192; const int row = b * 8 + t;
        const float r = projs[(size_t)row * DIN + C_RC + h * 192 + d2];
        const float val = oc[i] * rs[t] * P.in[I_GNG][l * 192 + d2] * silu(r);
        ((bf16*)(P.ws + WS_MIX))[(size_t)(MP + row) * D + M_C + h * 192 + d2] = (bf16)f2bf(val);
    }
    __syncthreads();
}

typedef short v4i16_t __attribute__((ext_vector_type(4)));
__device__ __forceinline__ unsigned offb(unsigned row, unsigned ch) { return 256u * row + 16u * (ch ^ (((row & 3u) << 2) | ((row >> 2) & 3u))); }
__device__ __forceinline__ void p_attn_unit(const Ptrs& P, LAS unsigned char* lds, int unit, int wave, int lane) {
    const bf16* PROJ = (const bf16*)(P.ws + WS_PROJ);
    const int cb = unit & 31, pbh = unit >> 5, p = pbh / 12, bh = pbh - 12 * p, b = bh / 6, h = bh - 6 * b;
    const int dsh = 2 * p, dil = 1 << dsh, nbk = 32 >> dsh, r = cb / nbk, n = cb - r * nbk;
    const size_t rb = (size_t)b * SEQ + r;
#pragma unroll
    for (int i8 = 0; i8 < 8; ++i8) {
        const int i = wave * 8 + i8, row = 4 * i + (lane >> 4), pc = lane & 15;
        const int ch = pc ^ (((row & 3) << 2) | ((row >> 2) & 3));
        int ci = 128 * (n - 1) + row; ci = ci < 0 ? 0 : ci;
        const bf16* src = PROJ + (rb + (size_t)dil * ci) * NINP + h * 128 + 8 * ch;
        __builtin_amdgcn_global_load_lds((const unsigned*)(src + C_KA), (LAS unsigned*)(lds + i * 1024), 16, 0, 0);
        __builtin_amdgcn_global_load_lds((const unsigned*)(src + C_VA), (LAS unsigned*)(lds + 65536 + i * 1024), 16, 0, 0);
    }
    const int g = lane >> 4, ql = lane & 15, iloc = 16 * wave + ql;
    const size_t qrow = rb + (size_t)dil * (128 * n + iloc);
    bf16x8 qf[4];
#pragma unroll
    for (int ks = 0; ks < 4; ++ks) qf[ks] = *(const bf16x8*)(PROJ + qrow * NINP + C_QA + h * 128 + 32 * ks + 8 * g);
    asm volatile("s_waitcnt vmcnt(0)" ::: "memory");
    __syncthreads();
    const int s0 = wave >> 1;
    const unsigned q4 = ql >> 2, p4 = lane & 3;
    LAS unsigned char* kbase[2][4]; LAS unsigned char* vbase[8][2];
#pragma unroll
    for (int T = 0; T < 2; ++T)
#pragma unroll
        for (int ks = 0; ks < 4; ++ks) kbase[T][ks] = lds + offb(32 * s0 + 8 * (ql >> 2) + 4 * T + (ql & 3), 4 * ks + g);
#pragma unroll
    for (int c = 0; c < 8; ++c)
#pragma unroll
        for (int t = 0; t < 2; ++t) vbase[c][t] = lds + 65536u + offb(32 * s0 + 8 * g + 4 * t + q4, 2 * c + (p4 >> 1)) + 8u * (p4 & 1);
    f32x4 st[5][2];
#pragma unroll
    for (int s = 0; s < 5; ++s) {
        bf16x8 kf[2][4];
#pragma unroll
        for (int T = 0; T < 2; ++T)
#pragma unroll
            for (int ks = 0; ks < 4; ++ks) kf[T][ks] = *(const LAS bf16x8*)(kbase[T][ks] + 8192 * s);
        __builtin_amdgcn_sched_barrier(0);
#pragma unroll
        for (int T = 0; T < 2; ++T) {
            f32x4 a = (f32x4){0.f, 0.f, 0.f, 0.f};
#pragma unroll
            for (int ks = 0; ks < 4; ++ks) a = __builtin_amdgcn_mfma_f32_16x16x32_bf16(kf[T][ks], qf[ks], a, 0, 0, 0);
            st[s][T] = a;
        }
    }
    const float NINF = -__builtin_inff();
#pragma unroll
    for (int T = 0; T < 2; ++T)
#pragma unroll
        for (int e = 0; e < 4; ++e) {
            const int j0 = 32 * s0 + 8 * g + 4 * T + e, j4 = j0 + 128;
            st[0][T][e] = (j0 >= iloc) ? st[0][T][e] : NINF;
            st[4][T][e] = (j4 <= iloc + 128) ? st[4][T][e] : NINF;
        }
    if (n == 0) {
#pragma unroll
        for (int s = 0; s < 5; ++s)
#pragma unroll
            for (int T = 0; T < 2; ++T)
#pragma unroll
                for (int e = 0; e < 4; ++e) { const int j = 32 * (s0 + s) + 8 * g + 4 * T + e; st[s][T][e] = (j >= 128) ? st[s][T][e] : NINF; }
    }
    float mx = NINF;
#pragma unroll
    for (int s = 0; s < 5; ++s)
#pragma unroll
        for (int T = 0; T < 2; ++T) mx = fmaxf(fmaxf(mx, fmaxf(st[s][T][0], st[s][T][1])), fmaxf(st[s][T][2], st[s][T][3]));
    mx = fmaxf(mx, __shfl_xor(mx, 16)); mx = fmaxf(mx, __shfl_xor(mx, 32));
    const float SC2 = 0.08838834764831845f * 1.4426950408889634f, m2 = mx * SC2;
    float sum = 0.f;
    bf16x8 pf[5];
#pragma unroll
    for (int s = 0; s < 5; ++s) {
        float e[8];
#pragma unroll
        for (int T = 0; T < 2; ++T)
#pragma unroll
            for (int k = 0; k < 4; ++k) { const float x = __builtin_amdgcn_exp2f(__builtin_fmaf(st[s][T][k], SC2, -m2)); e[4 * T + k] = x; sum += x; }
        u32x4 w; w.x = pk2(e[0], e[1]); w.y = pk2(e[2], e[3]); w.z = pk2(e[4], e[5]); w.w = pk2(e[6], e[7]);
        pf[s] = __builtin_bit_cast(bf16x8, w);
    }
    sum += __shfl_xor(sum, 16); sum += __shfl_xor(sum, 32);
    f32x4 ot[8];
#pragma unroll
    for (int c = 0; c < 8; ++c) ot[c] = (f32x4){0.f, 0.f, 0.f, 0.f};
#pragma unroll
    for (int s = 0; s < 5; ++s) {
        v4i16_t lo[8], hi[8];
#pragma unroll
        for (int c = 0; c < 8; ++c) {
            lo[c] = __builtin_amdgcn_ds_read_tr16_b64_v4i16((LAS v4i16_t*)(vbase[c][0] + 8192 * s));
            hi[c] = __builtin_amdgcn_ds_read_tr16_b64_v4i16((LAS v4i16_t*)(vbase[c][1] + 8192 * s));
        }
        __builtin_amdgcn_sched_barrier(0);
#pragma unroll
        for (int c = 0; c < 8; ++c) {
            bf16x8 vf; vf[0] = lo[c][0]; vf[1] = lo[c][1]; vf[2] = lo[c][2]; vf[3] = lo[c][3]; vf[4] = hi[c][0]; vf[5] = hi[c][1]; vf[6] = hi[c][2]; vf[7] = hi[c][3];
            ot[c] = __builtin_amdgcn_mfma_f32_16x16x32_bf16(vf, pf[s], ot[c], 0, 0, 0);
        }
    }
    const float inv = 1.0f / sum;
    bf16* op = (bf16*)(P.ws + WS_OP) + ((size_t)p * MP + qrow) * 768 + h * 128 + 4 * g;
#pragma unroll
    for (int c = 0; c < 8; ++c) { u32x2 w; w.x = pk2(ot[c][0] * inv, ot[c][1] * inv); w.y = pk2(ot[c][2] * inv, ot[c][3] * inv); *(u32x2*)(op + 16 * c) = w; }
    if (g == 0) ((float*)(P.ws + WS_LSE))[((size_t)p * MP + qrow) * 6 + h] = mx * 0.08838834764831845f + __logf(sum);
    __syncthreads();
}
__device__ __forceinline__ void attn_combine(const Ptrs& P, int bx, int G, int wave, int lane) {
    const bf16* OP = (const bf16*)(P.ws + WS_OP); const float* LSE = (const float*)(P.ws + WS_LSE); bf16* MIX = (bf16*)(P.ws + WS_MIX);
    for (int tok = bx * NWAVES + wave; tok < MP; tok += G * NWAVES) {
#pragma unroll
        for (int h = 0; h < 6; ++h) {
            const float l0 = LSE[((size_t)0 * MP + tok) * 6 + h], l1 = LSE[((size_t)1 * MP + tok) * 6 + h], l2 = LSE[((size_t)2 * MP + tok) * 6 + h];
            const float m = fmaxf(l0, fmaxf(l1, l2)), e0 = __expf(l0 - m), e1 = __expf(l1 - m), e2 = __expf(l2 - m), inv = 1.0f / (e0 + e1 + e2);
            const unsigned w0 = *(const unsigned*)(OP + ((size_t)0 * MP + tok) * 768 + h * 128 + 2 * lane);
            const unsigned w1 = *(const unsigned*)(OP + ((size_t)1 * MP + tok) * 768 + h * 128 + 2 * lane);
            const unsigned w2 = *(const unsigned*)(OP + ((size_t)2 * MP + tok) * 768 + h * 128 + 2 * lane);
            const float a = (e0 * bf2f(w0 & 0xffffu) + e1 * bf2f(w1 & 0xffffu) + e2 * bf2f(w2 & 0xffffu)) * inv;
            const float c = (e0 * bf2f(w0 >> 16) + e1 * bf2f(w1 >> 16) + e2 * bf2f(w2 >> 16)) * inv;
            *(unsigned*)(MIX + (size_t)tok * D + M_A + h * 128 + 2 * lane) = pk2(a, c);
        }
    }
}
__device__ __forceinline__ void p_pool_wunit(const Ptrs& P, LAS unsigned char* lds, int l, int unit, int wave, int lane) {
    const bf16* PROJ = (const bf16*)(P.ws + WS_PROJ);
    const int grp = unit & 3, tb = unit >> 2, b = tb >> 8, t0 = (tb & 255) * 16;
    const int g = lane >> 4, ql = lane & 15, w = 2 << grp;
    LAS unsigned char* pl = lds + wave * 4352;
    const bf16* wpt = (const bf16*)(P.ws + WS_WPT) + (size_t)(l * 4 + grp) * 128 * 128;
    {
        const bf16* up = PROJ + (size_t)b * SEQ * NINP + C_UB + grp * 128 + 2 * lane;
        unsigned raw[31];
#pragma unroll
        for (int i = 0; i < 31; ++i) { const int tp = t0 - 15 + i; raw[i] = (tp >= 0) ? *(const unsigned*)(up + (size_t)tp * NINP) : 0u; }
        float p0[32], p1[32]; p0[0] = 0.f; p1[0] = 0.f;
#pragma unroll
        for (int i = 0; i < 31; ++i) { p0[i + 1] = p0[i] + bf2f(raw[i] & 0xffffu); p1[i + 1] = p1[i] + bf2f(raw[i] >> 16); }
#pragma unroll
        for (int tt = 0; tt < 16; ++tt) {
            const int t = t0 + tt; const float inv = 1.0f / (float)((t + 1 < w) ? (t + 1) : w);
            const int lo = (grp == 0) ? 14 + tt : (grp == 1) ? 12 + tt : (grp == 2) ? 8 + tt : tt;
            float s0, s1;
            if (grp == 0) { s0 = p0[16 + tt] - p0[14 + tt]; s1 = p1[16 + tt] - p1[14 + tt]; }
            else if (grp == 1) { s0 = p0[16 + tt] - p0[12 + tt]; s1 = p1[16 + tt] - p1[12 + tt]; }
            else if (grp == 2) { s0 = p0[16 + tt] - p0[8 + tt]; s1 = p1[16 + tt] - p1[8 + tt]; }
            else { s0 = p0[16 + tt] - p0[tt]; s1 = p1[16 + tt] - p1[tt]; }
            (void)lo;
            *(LAS unsigned*)(pl + tt * 272 + 4 * lane) = pk2(s0 * inv - bf2f(raw[15 + tt] & 0xffffu), s1 * inv - bf2f(raw[15 + tt] >> 16));
        }
    }
    asm volatile("s_waitcnt lgkmcnt(0)" ::: "memory");
    bf16x8 bfr[4];
#pragma unroll
    for (int ks = 0; ks < 4; ++ks) bfr[ks] = *(const LAS bf16x8*)(pl + ql * 272 + (32 * ks + 8 * g) * 2);
    bf16* mx = (bf16*)(P.ws + WS_MIX) + ((size_t)b * SEQ + t0 + ql) * D + M_B + grp * 128 + 4 * g;
#pragma unroll
    for (int hf = 0; hf < 2; ++hf) {
        bf16x8 af[4][4];
#pragma unroll
        for (int nt = 0; nt < 4; ++nt)
#pragma unroll
            for (int ks = 0; ks < 4; ++ks) af[nt][ks] = *(const bf16x8*)(wpt + (size_t)(16 * (4 * hf + nt) + ql) * 128 + 32 * ks + 8 * g);
#pragma unroll
        for (int nt = 0; nt < 4; ++nt) {
            f32x4 acc = (f32x4){0.f, 0.f, 0.f, 0.f};
#pragma unroll
            for (int ks = 0; ks < 4; ++ks) acc = __builtin_amdgcn_mfma_f32_16x16x32_bf16(af[nt][ks], bfr[ks], acc, 0, 0, 0);
            u32x2 o; o.x = pk2(acc[0], acc[1]); o.y = pk2(acc[2], acc[3]); *(u32x2*)(mx + 16 * (4 * hf + nt)) = o;
        }
    }
    asm volatile("s_waitcnt lgkmcnt(0)" ::: "memory");
}
__device__ __forceinline__ float logsig_fast(float z) { return fminf(z, 0.f) - __logf(1.0f + __expf(-fabsf(z))); }
__device__ __forceinline__ void gla_gate_cumsum(const Ptrs& P, int l, int b, int h, int t0, int tid, LAS float* bL, LAS float* gaL, LAS float* tot) {
    const float* GA = (const float*)(P.ws + WS_GA) + ((size_t)b * SEQ + t0) * 16;
    for (int i = tid; i < 256; i += NTHR) *(LAS f32x4*)(gaL + 4 * i) = *(const f32x4*)(GA + 4 * i);
    const int dk = tid % 96, seg = tid / 96;
    float wg[16], bg = 0.f;
    if (tid < 384) {
#pragma unroll
        for (int r = 0; r < 16; ++r) wg[r] = P.in[I_WG2][(size_t)(l * 16 + r) * 384 + h * 96 + dk];
        bg = P.in[I_BG][l * 384 + h * 96 + dk];
    }
    __syncthreads();
    float run[16];
    if (tid < 384) {
        float acc = 0.f;
#pragma unroll
        for (int jj = 0; jj < 16; ++jj) {
            const LAS f32x4* gp = (const LAS f32x4*)(gaL + (16 * seg + jj) * 16);
            const f32x4 a0 = gp[0], a1 = gp[1], a2 = gp[2], a3 = gp[3];
            float z = bg;
            z += (a0[0] * wg[0] + a0[1] * wg[1]) + (a0[2] * wg[2] + a0[3] * wg[3]);
            z += (a1[0] * wg[4] + a1[1] * wg[5]) + (a1[2] * wg[6] + a1[3] * wg[7]);
            z += (a2[0] * wg[8] + a2[1] * wg[9]) + (a2[2] * wg[10] + a2[3] * wg[11]);
            z += (a3[0] * wg[12] + a3[1] * wg[13]) + (a3[2] * wg[14] + a3[3] * wg[15]);
            acc += logsig_fast(z) * (1.0f / 16.0f); run[jj] = acc;
        }
        tot[seg * 96 + dk] = acc;
    }
    __syncthreads();
    if (tid < 384) {
        float off = 0.f;
#pragma unroll
        for (int s = 0; s < 3; ++s) if (s < seg) off += tot[s * 96 + dk];
#pragma unroll
        for (int jj = 0; jj < 16; ++jj) bL[(16 * seg + jj) * 97 + dk] = run[jj] + off;
    }
    __syncthreads();
}
__device__ __forceinline__ bf16x8 tr8(LAS unsigned char* vi, int tok0, int col, int q4, int p4) {
    const v4i16_t lo = __builtin_amdgcn_ds_read_tr16_b64_v4i16((LAS v4i16_t*)(vi + (tok0 + q4) * 400 + (col + 4 * p4) * 2));
    const v4i16_t hi = __builtin_amdgcn_ds_read_tr16_b64_v4i16((LAS v4i16_t*)(vi + (tok0 + 4 + q4) * 400 + (col + 4 * p4) * 2));
    bf16x8 r; r[0] = lo[0]; r[1] = lo[1]; r[2] = lo[2]; r[3] = lo[3]; r[4] = hi[0]; r[5] = hi[1]; r[6] = hi[2]; r[7] = hi[3]; return r;
}
__device__ __forceinline__ void gla1_unit(const Ptrs& P, LAS unsigned char* lds, int l, int unit, int tid, int wave, int lane) {
    const bf16* PROJ = (const bf16*)(P.ws + WS_PROJ);
    const int bh = unit >> 6, n = unit & 63, b = bh >> 2, h = bh & 3, t0 = n * CH;
    LAS float* bL = (LAS float*)lds; LAS float* gaL = (LAS float*)(lds + 24832); LAS float* wgL = (LAS float*)(lds + 28928);
    LAS unsigned char* KT = lds + 35456;
    LAS unsigned char* VI = lds + 49280;
    gla_gate_cumsum(P, l, b, h, t0, tid, bL, gaL, wgL);
    const bf16* pr = PROJ + ((size_t)b * SEQ + t0) * NINP;
    float* bc = (float*)(P.ws + WS_BCUM) + ((size_t)b * SEQ + t0) * 384 + h * 96;
    for (int i = tid; i < 6144; i += NTHR) { const int j = i / 96, dk = i - 96 * j; const float bb = bL[j * 97 + dk];
        bc[(size_t)j * 384 + dk] = bb;
        ((LAS bf16*)KT)[dk * 72 + j] = (bf16)f2bf(bf2f(pr[(size_t)j * NINP + C_KC + h * 96 + dk]) * __expf(bL[63 * 97 + dk] - bb)); }
    for (int i = tid; i < 1536; i += NTHR) { const int j = i / 24, ch = i - 24 * j;
        *(LAS u32x4*)(VI + j * 400 + ch * 16) = *(const u32x4*)(pr + (size_t)j * NINP + C_VC + h * 192 + 8 * ch); }
    if (tid < 96) ((float*)(P.ws + WS_DEC))[(size_t)unit * 96 + tid] = __expf(bL[63 * 97 + tid]);
    __syncthreads();
    const int g = lane >> 4, ql = lane & 15, q4 = ql >> 2, p4 = lane & 3, dkg = wave & 1, dvg = wave >> 1;
    f32x4 acc[3][3];
#pragma unroll
    for (int a = 0; a < 3; ++a)
#pragma unroll
        for (int d = 0; d < 3; ++d) acc[a][d] = (f32x4){0.f, 0.f, 0.f, 0.f};
#pragma unroll
    for (int ks = 0; ks < 2; ++ks) {
        bf16x8 af[3], bfr[3];
#pragma unroll
        for (int a = 0; a < 3; ++a) af[a] = tr8(VI, 32 * ks + 8 * g, 16 * (3 * dvg + a), q4, p4);
#pragma unroll
        for (int d = 0; d < 3; ++d) bfr[d] = *(const LAS bf16x8*)(KT + (16 * (3 * dkg + d) + ql) * 144 + (32 * ks + 8 * g) * 2);
#pragma unroll
        for (int a = 0; a < 3; ++a)
#pragma unroll
            for (int d = 0; d < 3; ++d) acc[a][d] = __builtin_amdgcn_mfma_f32_16x16x32_bf16(af[a], bfr[d], acc[a][d], 0, 0, 0);
    }
    float* sl = (float*)(P.ws + WS_SLOC) + (size_t)unit * SELEMS;
#pragma unroll
    for (int a = 0; a < 3; ++a)
#pragma unroll
        for (int d = 0; d < 3; ++d)
#pragma unroll
            for (int e = 0; e < 4; ++e) sl[(size_t)(16 * (3 * dvg + a) + 4 * g + e) * 96 + 16 * (3 * dkg + d) + ql] = acc[a][d][e];
    __syncthreads();
}
__device__ __forceinline__ void gla2_scan(const Ptrs& P, int l, int bx, int G, int tid) {
    const float* SL = (const float*)(P.ws + WS_SLOC); unsigned* ST = (unsigned*)(P.ws + WS_SST); const float* DEC = (const float*)(P.ws + WS_DEC);
    for (int e2 = bx * NTHR + tid; e2 < 8 * (SELEMS / 2); e2 += G * NTHR) {
        const int bh = e2 / (SELEMS / 2), rem = 2 * (e2 - bh * (SELEMS / 2)), dv = rem / 96, dk = rem - 96 * dv;
        float S0 = 0.f, S1 = 0.f;
#pragma unroll 16
        for (int n = 0; n < NCH; ++n) {
            const size_t idx = (size_t)(bh * NCH + n) * SELEMS + rem;
            const f32x2 sl = *(const f32x2*)(SL + idx), dc = *(const f32x2*)(DEC + (size_t)(bh * NCH + n) * 96 + dk);
            ST[idx >> 1] = pk2(S0, S1); S0 = dc[0] * S0 + sl[0]; S1 = dc[1] * S1 + sl[1];
        }
        float* o = P.out + O_PG + (size_t)(l * 8 + bh) * SELEMS;
        o[(size_t)dk * 192 + dv] = S0; o[(size_t)(dk + 1) * 192 + dv] = S1;
    }
}
__device__ __forceinline__ void gla3_unit(const Ptrs& P, LAS unsigned char* lds, int l, int unit, int tid, int wave, int lane) {
    const bf16* PROJ = (const bf16*)(P.ws + WS_PROJ);
    const int bh = unit >> 6, n = unit & 63, b = bh >> 2, h = bh & 3, t0 = n * CH;
    LAS unsigned char* QE = lds; LAS unsigned char* KE = lds + 13312; LAS unsigned char* VI = lds + 26624; LAS float* SSQ = (LAS float*)(lds + 52224);
    const int g = lane >> 4, ql = lane & 15, q4 = ql >> 2, p4 = lane & 3, it = wave & 3, hv = wave >> 2, iloc = 16 * it + ql;
    const bf16* sst = (const bf16*)(P.ws + WS_SST) + (size_t)unit * SELEMS;
    bf16x8 sf[6][3];
#pragma unroll
    for (int a = 0; a < 6; ++a)
#pragma unroll
        for (int ks = 0; ks < 3; ++ks) sf[a][ks] = *(const bf16x8*)(sst + (size_t)(16 * (6 * hv + a) + ql) * 96 + 32 * ks + 8 * g);
    const bf16* pr = PROJ + ((size_t)b * SEQ + t0) * NINP;
    const float* bc = (const float*)(P.ws + WS_BCUM) + ((size_t)b * SEQ + t0) * 384 + h * 96;
    for (int i = tid; i < 6144; i += NTHR) { const int j = i / 96, dk = i - 96 * j; const float bb = bc[(size_t)j * 384 + dk];
        const float q = bf2f(pr[(size_t)j * NINP + C_QC + h * 96 + dk]) * 0.10206207261596575f, k = bf2f(pr[(size_t)j * NINP + C_KC + h * 96 + dk]);
        ((LAS bf16*)QE)[j * 104 + dk] = (bf16)f2bf(q * __expf(bb)); ((LAS bf16*)KE)[j * 104 + dk] = (bf16)f2bf(k * __expf(-bb)); }
    for (int i = tid; i < 1536; i += NTHR) { const int j = i / 24, ch = i - 24 * j;
        *(LAS u32x4*)(VI + j * 400 + ch * 16) = *(const u32x4*)(pr + (size_t)j * NINP + C_VC + h * 192 + 8 * ch); }
    __syncthreads();
    bf16x8 qfr[3];
#pragma unroll
    for (int ks = 0; ks < 3; ++ks) qfr[ks] = *(const LAS bf16x8*)(QE + iloc * 208 + (32 * ks + 8 * g) * 2);
    const int nst = (it >> 1) + 1;
    f32x4 ot[6];
#pragma unroll
    for (int a = 0; a < 6; ++a) ot[a] = (f32x4){0.f, 0.f, 0.f, 0.f};
#pragma unroll
    for (int js = 0; js < 2; ++js) if (js < nst) {
        u32x4 w;
#pragma unroll
        for (int T = 0; T < 2; ++T) {
            const int jrow = 32 * js + 8 * q4 + 4 * T + (ql & 3);
            f32x4 a = (f32x4){0.f, 0.f, 0.f, 0.f};
            bf16x8 kf[3];
#pragma unroll
            for (int ks = 0; ks < 3; ++ks) kf[ks] = *(const LAS bf16x8*)(KE + jrow * 208 + (32 * ks + 8 * g) * 2);
#pragma unroll
            for (int ks = 0; ks < 3; ++ks) a = __builtin_amdgcn_mfma_f32_16x16x32_bf16(kf[ks], qfr[ks], a, 0, 0, 0);
            float e[4];
#pragma unroll
            for (int k = 0; k < 4; ++k) { const int j = 32 * js + 8 * g + 4 * T + k; e[k] = (j <= iloc) ? a[k] : 0.f; }
            if (T == 0) { w.x = pk2(e[0], e[1]); w.y = pk2(e[2], e[3]); } else { w.z = pk2(e[0], e[1]); w.w = pk2(e[2], e[3]); }
        }
        const bf16x8 pf = __builtin_bit_cast(bf16x8, w);
        bf16x8 vf[6];
#pragma unroll
        for (int a = 0; a < 6; ++a) vf[a] = tr8(VI, 32 * js + 8 * g, 16 * (6 * hv + a), q4, p4);
        __builtin_amdgcn_sched_barrier(0);
#pragma unroll
        for (int a = 0; a < 6; ++a) ot[a] = __builtin_amdgcn_mfma_f32_16x16x32_bf16(vf[a], pf, ot[a], 0, 0, 0);
    }
#pragma unroll
    for (int a = 0; a < 6; ++a)
#pragma unroll
        for (int ks = 0; ks < 3; ++ks) ot[a] = __builtin_amdgcn_mfma_f32_16x16x32_bf16(sf[a][ks], qfr[ks], ot[a], 0, 0, 0);
    float ss = 0.f;
#pragma unroll
    for (int a = 0; a < 6; ++a) ss += (ot[a][0] * ot[a][0] + ot[a][1] * ot[a][1]) + (ot[a][2] * ot[a][2] + ot[a][3] * ot[a][3]);
    ss += __shfl_xor(ss, 16); ss += __shfl_xor(ss, 32);
    if (g == 0) SSQ[hv * 64 + iloc] = ss;
    __syncthreads();
    const float rstd = rsqrtf((SSQ[iloc] + SSQ[64 + iloc]) * (1.0f / 192.0f) + EPS);
    const size_t r = (size_t)b * SEQ + t0 + iloc;
    bf16* MIX = (bf16*)(P.ws + WS_MIX);
#pragma unroll
    for (int a = 0; a < 6; ++a) {
        const int dv0 = 16 * (6 * hv + a) + 4 * g;
        const u32x2 rc = *(const u32x2*)(PROJ + r * NINP + C_RC + h * 192 + dv0); const f32x4 gn = *(const f32x4*)(P.in[I_GNG] + l * 192 + dv0);
        u32x2 w;
        w.x = pk2(ot[a][0] * rstd * gn[0] * silu(bf2f(rc.x & 0xffffu)), ot[a][1] * rstd * gn[1] * silu(bf2f(rc.x >> 16)));
        w.y = pk2(ot[a][2] * rstd * gn[2] * silu(bf2f(rc.y & 0xffffu)), ot[a][3] * rstd * gn[3] * silu(bf2f(rc.y >> 16)));
        *(u32x2*)(MIX + r * D + M_C + h * 192 + dv0) = w;
    }
    __syncthreads();
}
__device__ __forceinline__ void final_norm(const Ptrs& P, int bx, int G, int wave, int lane) {
    const float* X = (const float*)(P.ws + WS_X); const float* part2 = (const float*)(P.ws + WS_PART2); const float* spart2 = (const float*)(P.ws + WS_SPART2); const float* g = P.in[I_FNG];
    for (int row = bx * NWAVES + wave; row < MT; row += G * NWAVES) {
        float ss;
        if (row < MP) ss = (lane < 8) ? part2[(size_t)row * 8 + lane] : 0.f;
        else ss = spart2[(size_t)(row - MP) * 128 + lane] + spart2[(size_t)(row - MP) * 128 + 64 + lane];
        const float rs = rsqrtf(wave_sum(ss) * (1.0f / 2048.0f) + EPS);
#pragma unroll
        for (int j = 0; j < 8; ++j) {
            const f32x4 v = *(const f32x4*)(X + (size_t)row * D + 4 * lane + 256 * j), gg = *(const f32x4*)(g + 4 * lane + 256 * j);
            *(f32x4*)(P.out + (size_t)row * D + 4 * lane + 256 * j) = v * rs * gg;
        }
    }
}

#ifndef REP_PRO
#define REP_PRO 1
#endif
#ifndef REP_GLA1
#define REP_GLA1 1
#endif
#ifndef REP_GLA2
#define REP_GLA2 1
#endif
#ifndef REP_GLA3
#define REP_GLA3 1
#endif
#ifndef REP_POOL
#define REP_POOL 1
#endif
#ifndef REP_SMIX
#define REP_SMIX 1
#endif
#ifndef REP_PATTN
#define REP_PATTN 1
#endif
#ifndef REP_COMB
#define REP_COMB 1
#endif
#ifndef REP_BAR
#define REP_BAR 1
#endif
#ifndef REP_INPROJ
#define REP_INPROJ 1
#endif
#ifndef PG8_SP2
#define PG8_SP2 true
#endif
#ifndef REP_OUT
#define REP_OUT 1
#endif
#ifndef REP_DOWN
#define REP_DOWN 1
#endif
#ifndef REP_GU
#define REP_GU 1
#endif
#ifndef REP_SKINNY
#define REP_SKINNY 1
#endif
#ifndef MK_PER_PHASE
#define MK_PER_PHASE 0
#endif
constexpr int NPH = 30;
struct Args { const float* in[N_IN]; float* out; unsigned char* ws; int ph_lo, ph_hi, li, pad; };

__global__ void __launch_bounds__(NTHR, 2) fwd(Args args) {
    extern __shared__ __attribute__((aligned(16))) unsigned char lds_raw[];
    LAS unsigned char* lds = (LAS unsigned char*)lds_raw;
    const int tid = threadIdx.x, lane = tid & 63, wave = __builtin_amdgcn_readfirstlane(tid >> 6);
    const int G = gridDim.x, bx = blockIdx.x;
    Ptrs P;
#pragma unroll
    for (int i = 0; i < N_IN; ++i) P.in[i] = args.in[i];
    P.out = args.out; P.ws = args.ws;
    for (int u = tid; u < (LDS_BYTES - LDSCTL_OFF) / 4; u += NTHR) ((LAS unsigned*)(lds + LDSCTL_OFF))[u] = 0u;
    __syncthreads();
    unsigned* ctl = (unsigned*)(args.ws + WS_CTL);
    XcdBarrier bar; bar.bar = ctl + CW_BAR; bar.x = 0; bar.st = nullptr;
    if (!MK_PER_PHASE) bar = xcd_barrier_post(ctl + CW_BAR, (volatile LAS unsigned*)(lds + MISC_OFF) + 8);
    const int lo = args.ph_lo, hi = args.ph_hi;
#define IN(k) (lo <= (k) && (k) < hi)
#define LAUNDER() int tid_ = tid; asm volatile("" : "+v"(tid_)); const int lane_ = tid_ & 63, wave_ = __builtin_amdgcn_readfirstlane(tid_ >> 6); (void)lane_; (void)wave_
#define SEAM(k) do { if (IN((k) + 1)) { if (!MK_PER_PHASE) { for (int rb_ = 0; rb_ < REP_BAR; ++rb_) xcd_barrier(bar); } } } while (0)

    float* part1 = (float*)(args.ws + WS_PART1); float* part2 = (float*)(args.ws + WS_PART2); float* spart1 = (float*)(args.ws + WS_SPART1); float* spart2 = (float*)(args.ws + WS_SPART2);
    pg8::PG8_LAS_T xch = (pg8::PG8_LAS_T)(lds + XCH_OFF);
    bf16* XB = (bf16*)(args.ws + WS_XB); bf16* MIXB = (bf16*)(args.ws + WS_MIX); bf16* PROJ = (bf16*)(args.ws + WS_PROJ); bf16* FB = (bf16*)(args.ws + WS_F);
    float* X = (float*)(args.ws + WS_X); float* projs = (float*)(args.ws + WS_PROJS);

    if (IN(0)) { for (int rep = 0; rep < REP_PRO; ++rep) { LAUNDER(); prologue(P, lds, bx, G, wave_, lane_, tid_); __syncthreads(); } SEAM(0); }

    for (int l = 0; l < DEPTH; ++l) {
        const int pb = 1 + 7 * l;
        unsigned char* wl = args.ws + WS_W + (size_t)l * LW_SZ;
        const bf16* Win = (const bf16*)(wl + LW_IN); const bf16* Wo = (const bf16*)(wl + LW_O); const bf16* Wgu = (const bf16*)(wl + LW_GU); const bf16* Wd = (const bf16*)(wl + LW_D);
        const float* xin_p = (l == 0) ? P.in[I_XP] : X; const float* xin_s = (l == 0) ? P.in[I_XS] : X + (size_t)MP * D;

        if (IN(pb + 0)) {
            LAUNDER();
            for (int rep = 0; rep < REP_INPROJ; ++rep) {
                pg8::Gemm g{XB, Win, MP, NINP, D}; pg8::StaticOrder S; S.init(MP, NINP, G, bx);
                pg8::EpiInProj E{PROJ, part2, (float*)(args.ws + WS_GA), P.out + O_PK + (size_t)l * 3145728, P.out + O_PV + (size_t)l * 3145728, P.out + O_PP + (size_t)l * 15360};
                pg8::gemm_phase<pg8::EpiInProj, pg8::StaticOrder, true, PG8_SP2>(lds, g, S, E);
            }
            const int sh1 = (672 % G) ? (672 % G) : 0, ns1 = G - sh1;
            for (int rep = 0; rep < REP_SKINNY; ++rep) for (int u = bx - sh1; u >= 0 && u < 161; u += ns1) {
                const int t0 = 2 * u, t1 = (2 * u + 1 < 321) ? 2 * u + 1 : 320;
                SEpiInProj E{projs, skinny_rs(spart2, 0, tid_), skinny_rs(spart2, 32, tid_), P.out + O_SK + (size_t)l * 49152, P.out + O_SV + (size_t)l * 49152, P.out + O_SP + (size_t)l * 61440, 16 * t0};
                skinny_unit<4, 2, 4>(lds, XB + (size_t)MP * D, Win + (size_t)16 * t0 * D, Win + (size_t)16 * t1 * D, D, 0, (2 * u + 1 < 321) ? 2 : 1, E, wave_, lane_, tid_);
            }
            SEAM(pb + 0);
        }
        if (IN(pb + 1)) {
            for (int rep = 0; rep < REP_SMIX; ++rep) { LAUNDER(); for (int u = bx; u < 384; u += G) s_attn_unit(P, lds, l, u, wave_, lane_, tid_); }
            { LAUNDER(); for (int u = (bx + G - 192 % G) % G; u < 64; u += G) s_pool_unit(P, lds, l, u, tid_); }
            { LAUNDER(); for (int u = (bx + G - 160 % G) % G; u < 32; u += G) s_gla_unit(P, lds, l, u, tid_); }
            for (int rep = 0; rep < REP_GLA1; ++rep) { LAUNDER(); for (int u = bx; u < 512; u += G) gla1_unit(P, lds, l, u, tid_, wave_, lane_); }
            for (int rep = 0; rep < REP_POOL; ++rep) { LAUNDER(); for (int u = bx * NWAVES + wave_; u < 2048; u += G * NWAVES) p_pool_wunit(P, lds, l, u, wave_, lane_); __syncthreads(); }
            for (int rep = 0; rep < REP_PATTN; ++rep) { LAUNDER(); for (int u = (bx + G - 128 % G) % G; u < 1152; u += G) p_attn_unit(P, lds, u, wave_, lane_); }
            SEAM(pb + 1);
        }
        if (IN(pb + 2)) { for (int rep = 0; rep < REP_GLA2; ++rep) { LAUNDER(); gla2_scan(P, l, bx, G, tid_); } SEAM(pb + 2); }
        if (IN(pb + 3)) { for (int rep = 0; rep < REP_GLA3; ++rep) { LAUNDER(); for (int u = bx; u < 512; u += G) gla3_unit(P, lds, l, u, tid_, wave_, lane_); } for (int rep = 0; rep < REP_COMB; ++rep) { LAUNDER(); attn_combine(P, bx, G, wave_, lane_); } SEAM(pb + 3); }
        if (IN(pb + 4)) {
            LAUNDER();
            for (int rep = 1; rep < REP_OUT; ++rep) {
                pg8::Gemm g{MIXB, Wo, MP, D, D}; pg8::StaticOrder S; S.init(MP, D, G, bx);
                pg8::EpiResid E{xin_p, (float*)(args.ws + WS_PROJ), (bf16*)(args.ws + WS_F), (float*)(args.ws + WS_GA), xch};
                pg8::gemm_phase<pg8::EpiResid, pg8::StaticOrder, true, PG8_SP2>(lds, g, S, E);
            }
            {
                pg8::Gemm g{MIXB, Wo, MP, D, D}; pg8::StaticOrder S; S.init(MP, D, G, bx);
                pg8::EpiResid E{xin_p, X, XB, part1, xch};
                pg8::gemm_phase<pg8::EpiResid, pg8::StaticOrder, true, PG8_SP2>(lds, g, S, E);
            }
            for (int u = G - 1 - bx; u < 256; u += G) {
                const int rh = u & 1, ct = u >> 1;
                SEpiResid E{xin_s, X + (size_t)MP * D, XB + (size_t)MP * D, spart1, 16 * ct};
                skinny_unit<2, 1, 8>(lds, MIXB + (size_t)MP * D, Wo + (size_t)16 * ct * D, Wo, D, 32 * rh, 1, E, wave_, lane_, tid_);
            }
            SEAM(pb + 4);
        }
        if (IN(pb + 5)) {
            LAUNDER();
            for (int rep = 0; rep < REP_GU; ++rep) {
                pg8::Gemm g{XB, Wgu, MP, NGU, D}; pg8::StaticOrder S; S.init(MP, NGU, G, bx);
                pg8::EpiGateUp E{FB, part1};
                pg8::gemm_phase<pg8::EpiGateUp, pg8::StaticOrder, true, PG8_SP2>(lds, g, S, E);
            }
            const int sh2 = (1408 % G) ? (1408 % G) : 0, ns2 = G - sh2;
            for (int rep = 0; rep < REP_SKINNY; ++rep) for (int u = bx - sh2; u >= 0 && u < 352; u += ns2) {
                const int f0 = 16 * u; const size_t gr = (size_t)(256 * (f0 >> 7) + (f0 & 127));
                SEpiGateUp E{FB, skinny_rs(spart1, 0, tid_), skinny_rs(spart1, 32, tid_), f0, 0.f, 0.f};
                skinny_unit<4, 2, 4>(lds, XB + (size_t)MP * D, Wgu + gr * D, Wgu + (gr + 128) * D, D, 0, 2, E, wave_, lane_, tid_);
            }
            SEAM(pb + 5);
        }
        if (IN(pb + 6)) {
            LAUNDER();
            for (int rep = 1; rep < REP_DOWN; ++rep) {
                pg8::Gemm g{FB, Wd, MP, D, DFF}; pg8::StaticOrder S; S.init(MP, D, G, bx);
                pg8::EpiResid E{X, (float*)(args.ws + WS_PROJ), (bf16*)(args.ws + WS_MIX), (float*)(args.ws + WS_GA), xch};
                pg8::gemm_phase<pg8::EpiResid, pg8::StaticOrder, true, PG8_SP2>(lds, g, S, E);
            }
            {
                pg8::Gemm g{FB, Wd, MP, D, DFF}; pg8::StaticOrder S; S.init(MP, D, G, bx);
                pg8::EpiResid E{X, X, XB, part2, xch};
                pg8::gemm_phase<pg8::EpiResid, pg8::StaticOrder, true, PG8_SP2>(lds, g, S, E);
            }
            for (int u = G - 1 - bx; u < 256; u += G) {
                const int rh = u & 1, ct = u >> 1;
                SEpiResid E{X + (size_t)MP * D, X + (size_t)MP * D, XB + (size_t)MP * D, spart2, 16 * ct};
                skinny_unit<2, 1, 8>(lds, FB + (size_t)MP * DFF, Wd + (size_t)16 * ct * DFF, Wd, DFF, 32 * rh, 1, E, wave_, lane_, tid_);
            }
            SEAM(pb + 6);
        }
    }
    if (IN(29)) { LAUNDER(); final_norm(P, bx, G, wave_, lane_); }
#undef IN
#undef SEAM
}

extern "C" void kernel_launch(void* const* d_in, const int* in_sizes, int n_in, void* d_out, int out_size, void* d_ws, size_t ws_size, hipStream_t stream) {
    static int grid = 0;
    if (grid == 0) {
        if (n_in != N_IN || (size_t)out_size != O_END || ws_size < WS_END) { fprintf(stderr, "kernel_launch: unexpected sizes n_in %d out %d ws %zu\n", n_in, out_size, ws_size); grid = -1; return; }
        int dev = 0, cus = 0, per_cu = 0;
        if (hipGetDevice(&dev) != hipSuccess || hipDeviceGetAttribute(&cus, hipDeviceAttributeMultiprocessorCount, dev) != hipSuccess) { grid = -1; return; }
        if (hipFuncSetAttribute((const void*)fwd, hipFuncAttributeMaxDynamicSharedMemorySize, LDS_BYTES) != hipSuccess) { fprintf(stderr, "kernel_launch: hipFuncSetAttribute failed\n"); grid = -1; return; }
        if (hipOccupancyMaxActiveBlocksPerMultiprocessor(&per_cu, (const void*)fwd, NTHR, LDS_BYTES) != hipSuccess || per_cu < 1) { fprintf(stderr, "kernel_launch: occupancy query says %d\n", per_cu); }
        (void)hipGetLastError();
        grid = cus;
    }
    if (grid < 0) return;
    (void)hipMemsetAsync((char*)d_ws + WS_CTL, 0, CTL_ZERO_BYTES, stream);
    Args a{};
    for (int i = 0; i < N_IN; ++i) a.in[i] = (const float*)d_in[i];
    a.out = (float*)d_out; a.ws = (unsigned char*)d_ws; a.li = 0; a.pad = 0;
#if MK_PER_PHASE
    for (int p = 0; p < NPH; ++p) { a.ph_lo = p; a.ph_hi = p + 1; hipLaunchKernelGGL(fwd, dim3(grid), dim3(NTHR), LDS_BYTES, stream, a); }
#else
    a.ph_lo = 0; a.ph_hi = NPH;
    hipLaunchKernelGGL(fwd, dim3(grid), dim3(NTHR), LDS_BYTES, stream, a);
#endif
    const hipError_t le = hipPeekAtLastError();
    if (le != hipSuccess) fprintf(stderr, "kernel_launch: launch failed: %s\n", hipGetErrorName(le));
}
```

```cpp
#include <hip/hip_runtime.h>
#include <cstdio>
#include <cstdint>
namespace pg8 {
#define PG8_LAS __attribute__((address_space(3)))
typedef unsigned short bf16_t;
typedef PG8_LAS float* PG8_LAS_T;
typedef short bf16x8 __attribute__((ext_vector_type(8)));
typedef float f32x4 __attribute__((ext_vector_type(4)));
typedef unsigned u32x4 __attribute__((ext_vector_type(4)));
#ifndef PG8_WGM
#define PG8_WGM 4
#endif
constexpr int BM = 256, BK = 64, HALF = 128, HTB = HALF * BK * 2  , STAGE_BYTES = 8 * HTB, NXCD = 8, WGM = PG8_WGM;

__host__ __device__ __forceinline__ int lds_byte(int r, int c) { const int st = (r >> 4) * 2 + (c >> 5), rr = r & 15, cc = c & 31, ob = rr * 64 + cc * 2; return st * 1024 + (ob ^ (((ob >> 9) & 1) << 5)); }
__host__ __device__ __forceinline__ void stage_rc(int b, int& R, int& C) { const int st = b / 1024, sb = b % 1024, swz = sb ^ (((sb >> 9) & 1) << 5); R = (st >> 1) * 16 + swz / 64; C = (st & 1) * 32 + (swz % 64) / 2; }
__host__ __device__ __forceinline__ int perm32(int rho) { const int n = rho >> 4, i = rho & 15; return 8 * (i >> 2) + 4 * n + (i & 3); }

struct Unit { int pm, pn; };
struct Gemm { const bf16_t* A; const bf16_t* Bt; int M, N, K; };

struct StaticOrder {
    int nM, nN, nwg, G, c;
    __host__ __device__ void init(int M, int N, int G_, int c_) { nM = M / BM; nN = N / BM; nwg = nM * nN; G = G_; c = c_; }
    __host__ __device__ bool next(int i, Unit& u) const {
        const long L = (long)i * G + c; if (L >= nwg) return false;
        int wgid = (int)L; { const int q = nwg / NXCD, r = nwg % NXCD, xcd = wgid % NXCD, off = wgid / NXCD; wgid = (xcd < r ? xcd * (q + 1) : r * (q + 1) + (xcd - r) * q) + off; }
        const int nig = WGM * nN, gid = wgid / nig, fm = gid * WGM, gsz = (nM - fm) < WGM ? (nM - fm) : WGM;
        u.pm = fm + ((wgid % nig) % gsz); u.pn = (wgid % nig) / gsz; return true;
    }
    __device__ __forceinline__ void a_ready(const Unit&) const {}
    __device__ __forceinline__ void done(const Unit&) const {}
};

#ifndef EPI_NT
#define EPI_NT 1
#endif

__device__ __forceinline__ unsigned cvt_pk_bf16(float lo, float hi) { unsigned r; asm volatile("v_cvt_pk_bf16_f32 %0, %1, %2" : "=v"(r) : "v"(lo), "v"(hi)); return r; }
__device__ __forceinline__ float silu_f(float x) { return x * __builtin_amdgcn_rcpf(1.0f + __expf(-x)); }

struct EpiInProj {
    static constexpr bool PERM = true, AFTER_DRAIN = false;
    bf16_t* P; const float* part; float* ga; float* pk; float* pv; float* pp;
    __device__ __forceinline__ void operator()(const f32x4 (&acc)[2][2][4][2], const Unit& u, int wr, int wc, int fr, int fq) const {
        const int row0 = u.pm * BM + wr * 64 + fr, col0 = u.pn * BM + wc * 32 + 8 * fq;
        const int tp = (u.pm & 15) * 256;
        const bool kv_out = (u.pn >= 3 && u.pn < 9) && (tp >= 2048);
        const bool u_out = (u.pn == 9 || u.pn == 10) && (tp == 3840);
        const bool g_out = (u.pn == 20) && (wc == 0) && (fq < 2);
#pragma unroll
        for (int ai = 0; ai < 2; ++ai)
#pragma unroll
            for (int m = 0; m < 4; ++m) {
                const int r = row0 + ai * HALF + m * 16;
                const f32x4 q0 = *(const f32x4*)(part + (size_t)r * 8), q1 = *(const f32x4*)(part + (size_t)r * 8 + 4);
                const float rs = rsqrtf((((q0[0] + q0[1]) + (q0[2] + q0[3])) + ((q1[0] + q1[1]) + (q1[2] + q1[3]))) * (1.0f / 2048.0f) + 1e-6f);
                bf16_t* rowp = P + (size_t)r * 5376 + col0;
                const int b = r >> 12, t = r & 4095;
#pragma unroll
                for (int bj = 0; bj < 2; ++bj) {
                    const f32x4 v0 = acc[ai][bj][m][0] * rs, v1 = acc[ai][bj][m][1] * rs;
                    u32x4 w; w.x = cvt_pk_bf16(v0[0], v0[1]); w.y = cvt_pk_bf16(v0[2], v0[3]); w.z = cvt_pk_bf16(v1[0], v1[1]); w.w = cvt_pk_bf16(v1[2], v1[3]);
#if EPI_NT & 2
                    __builtin_nontemporal_store(w, (u32x4*)(rowp + bj * HALF));
#else
                    *(u32x4*)(rowp + bj * HALF) = w;
#endif
                    const int c = col0 + bj * HALF;
                    if (kv_out) {
                        float* dst = (u.pn < 6) ? (pk + ((size_t)(b * 2048 + (t - 2048)) * 768 + (c - 768))) : (pv + ((size_t)(b * 2048 + (t - 2048)) * 768 + (c - 1536)));
                        *(f32x4*)dst = v0; *(f32x4*)(dst + 4) = v1;
                    }
                    if (u_out && t >= 4081) {
                        float* dst = pp + ((size_t)(b * 15 + (t - 4081)) * 512 + (c - 2304));
                        *(f32x4*)dst = v0; *(f32x4*)(dst + 4) = v1;
                    }
                    if (g_out && bj == 0) {
                        float* dst = ga + (size_t)r * 16 + 8 * fq;
                        *(f32x4*)dst = v0; *(f32x4*)(dst + 4) = v1;
                    }
                }
            }
    }
};
struct EpiResid {
    static constexpr bool PERM = true, AFTER_DRAIN = false;
    const bf16_t* xin; bf16_t* xb; float* part; PG8_LAS float* xch;
    __device__ __forceinline__ void operator()(const f32x4 (&acc)[2][2][4][2], const Unit& u, int wr, int wc, int fr, int fq) const {
        const int row0 = u.pm * BM + wr * 64 + fr, col0 = u.pn * BM + wc * 32 + 8 * fq;
#pragma unroll
        for (int ai = 0; ai < 2; ++ai) {
            u32x4 res[4][2];
#pragma unroll
            for (int m = 0; m < 4; ++m) { const size_t off = (size_t)(row0 + ai * HALF + m * 16) * 2048 + col0;
#pragma unroll
                for (int bj = 0; bj < 2; ++bj) res[m][bj] = *(const u32x4*)(xin + off + bj * HALF); }
#pragma unroll
            for (int m = 0; m < 4; ++m) {
                const int r = row0 + ai * HALF + m * 16;
                const size_t off = (size_t)r * 2048 + col0;
                float s = 0.f;
#pragma unroll
                for (int bj = 0; bj < 2; ++bj) {
                    const u32x4 q = res[m][bj];
                    const f32x4 r0 = {__builtin_bit_cast(float, q.x << 16), __builtin_bit_cast(float, q.x & 0xffff0000u), __builtin_bit_cast(float, q.y << 16), __builtin_bit_cast(float, q.y & 0xffff0000u)};
                    const f32x4 r1 = {__builtin_bit_cast(float, q.z << 16), __builtin_bit_cast(float, q.z & 0xffff0000u), __builtin_bit_cast(float, q.w << 16), __builtin_bit_cast(float, q.w & 0xffff0000u)};
                    const f32x4 v0 = acc[ai][bj][m][0] + r0, v1 = acc[ai][bj][m][1] + r1;
                    u32x4 w; w.x = cvt_pk_bf16(v0[0], v0[1]); w.y = cvt_pk_bf16(v0[2], v0[3]); w.z = cvt_pk_bf16(v1[0], v1[1]); w.w = cvt_pk_bf16(v1[2], v1[3]);
                    *(u32x4*)(xb + off + bj * HALF) = w;
                    s += (v0[0] * v0[0] + v0[1] * v0[1]) + (v0[2] * v0[2] + v0[3] * v0[3]) + (v1[0] * v1[0] + v1[1] * v1[1]) + (v1[2] * v1[2] + v1[3] * v1[3]);
                }
                s += __shfl_xor(s, 16); s += __shfl_xor(s, 32);
                if (fq == 0) xch[(ai * HALF + wr * 64 + m * 16 + fr) * 4 + wc] = s;
            }
            asm volatile("" ::: "memory");
        }
        asm volatile("s_waitcnt lgkmcnt(0)" ::: "memory"); __builtin_amdgcn_s_barrier(); asm volatile("" ::: "memory");
        if (wr == 0) { const int row = wc * 64 + fq * 16 + fr; const f32x4 q = *(const PG8_LAS f32x4*)(xch + row * 4);
            part[(size_t)(u.pm * BM + row) * 8 + u.pn] = (q[0] + q[1]) + (q[2] + q[3]); }
    }
};
struct EpiGateUp {
    static constexpr bool PERM = true, AFTER_DRAIN = false;
    bf16_t* F; const float* part;
    __device__ __forceinline__ void operator()(const f32x4 (&acc)[2][2][4][2], const Unit& u, int wr, int wc, int fr, int fq) const {
        const int row0 = u.pm * BM + wr * 64 + fr, col0 = u.pn * HALF + wc * 32 + 8 * fq;
#pragma unroll
        for (int ai = 0; ai < 2; ++ai)
#pragma unroll
            for (int m = 0; m < 4; ++m) {
                const int r = row0 + ai * HALF + m * 16;
                const f32x4 q0 = *(const f32x4*)(part + (size_t)r * 8), q1 = *(const f32x4*)(part + (size_t)r * 8 + 4);
                const float rs = rsqrtf((((q0[0] + q0[1]) + (q0[2] + q0[3])) + ((q1[0] + q1[1]) + (q1[2] + q1[3]))) * (1.0f / 2048.0f) + 1e-6f);
                const f32x4 g0 = acc[ai][0][m][0] * rs, g1 = acc[ai][0][m][1] * rs, u0 = acc[ai][1][m][0] * rs, u1 = acc[ai][1][m][1] * rs;
                u32x4 w;
                w.x = cvt_pk_bf16(silu_f(g0[0]) * u0[0], silu_f(g0[1]) * u0[1]); w.y = cvt_pk_bf16(silu_f(g0[2]) * u0[2], silu_f(g0[3]) * u0[3]);
                w.z = cvt_pk_bf16(silu_f(g1[0]) * u1[0], silu_f(g1[1]) * u1[1]); w.w = cvt_pk_bf16(silu_f(g1[2]) * u1[2], silu_f(g1[3]) * u1[3]);
#if EPI_NT & 1
                __builtin_nontemporal_store(w, (u32x4*)(F + (size_t)r * 5632 + col0));
#else
                *(u32x4*)(F + (size_t)r * 5632 + col0) = w;
#endif
            }
    }
};

template <class Epi, class Sched, bool ALIGN_EPI = false, bool SP2 = false>
__device__ __forceinline__ void gemm_phase(PG8_LAS unsigned char* lds, const Gemm g, const Sched& S, const Epi& E) {
    int tid = threadIdx.x; asm volatile("" : "+v"(tid)); const int wid = __builtin_amdgcn_readfirstlane(tid >> 6), lane = tid & 63, wr = wid >> 2, wc = wid & 3, fr = lane & 15, fq = lane >> 4;
    const int K = g.K, nt = K / BK;
    unsigned voffA[2], voffB[2];
#pragma unroll
    for (int i = 0; i < 2; ++i) { int R, C; stage_rc(tid * 16 + i * 8192, R, C); const int Rb = Epi::PERM ? ((R & ~31) + perm32(R & 31)) : R;
        voffA[i] = (unsigned)(R * K + C) * 2u; voffB[i] = (unsigned)(Rb * K + C) * 2u; }
    const size_t kstep = (size_t)(BK * 2);
    const size_t hstep = (size_t)HALF * K * 2;
    const size_t tstep = 2 * hstep;
    const unsigned ldsw = (unsigned)wid * 1024u;
    const int aoff = lds_byte(wr * 64 + fr, fq * 8), boff = lds_byte(wc * 32 + fr, fq * 8);
#define PG8_SA(b, h) (((b) * 2 + (h)) * HTB)
#define PG8_SB(b, h) ((4 + (b) * 2 + (h)) * HTB)
#define PG8_STAGE(bufoff, gbase, voff) do { _Pragma("unroll") for (int _i = 0; _i < 2; ++_i) \
        __builtin_amdgcn_global_load_lds((const unsigned*)((const char*)(gbase) + (voff)[_i]), (PG8_LAS unsigned*)(lds + (bufoff) + ldsw + _i * 8192), 16, 0, 0); } while (0)
#define PG8_LDA(dst, b, h) do { _Pragma("unroll") for (int m = 0; m < 4; ++m) _Pragma("unroll") for (int k = 0; k < 2; ++k) dst[m][k] = *(const PG8_LAS bf16x8*)(lds + PG8_SA(b, h) + aoff + m * 2048 + k * 1024); } while (0)
#define PG8_LDB(dst, b, h) do { _Pragma("unroll") for (int n = 0; n < 2; ++n) _Pragma("unroll") for (int k = 0; k < 2; ++k) dst[n][k] = *(const PG8_LAS bf16x8*)(lds + PG8_SB(b, h) + boff + n * 2048 + k * 1024); } while (0)
#define PG8_MMA(ai, bj, At, Bt) do { __builtin_amdgcn_s_setprio(1); _Pragma("unroll") for (int m = 0; m < 4; ++m) _Pragma("unroll") for (int n = 0; n < 2; ++n) _Pragma("unroll") for (int k = 0; k < 2; ++k) \
        acc[ai][bj][m][n] = __builtin_amdgcn_mfma_f32_16x16x32_bf16(Bt[n][k], At[m][k], acc[ai][bj][m][n], 0, 0, 0); __builtin_amdgcn_s_setprio(0); } while (0)
#define PG8_WAIT_V(n) asm volatile("s_waitcnt vmcnt(" #n ")" ::: "memory")
#define PG8_WAIT_L(n) asm volatile("s_waitcnt lgkmcnt(" #n ")" ::: "memory")
#define PG8_BAR __builtin_amdgcn_s_barrier()
#define PG8_SCHED __builtin_amdgcn_sched_barrier(0)
    Unit cur, nxt; int ui = 0;
    if (!S.next(0, cur)) return;
    f32x4 acc[2][2][4][2];
#pragma unroll
    for (int a = 0; a < 2; ++a)
#pragma unroll
        for (int b = 0; b < 2; ++b)
#pragma unroll
            for (int m = 0; m < 4; ++m)
#pragma unroll
                for (int n = 0; n < 2; ++n) acc[a][b][m][n] = (f32x4){0.f, 0.f, 0.f, 0.f};
    bf16x8 At[4][2], B0[2][2], B1[2][2];
    const char* cA = (const char*)g.A + (size_t)cur.pm * tstep; const char* cB = (const char*)g.Bt + (size_t)cur.pn * tstep;
    S.a_ready(cur);
    if constexpr (SP2) {
        PG8_STAGE(PG8_SB(0, 0), cB, voffB); PG8_STAGE(PG8_SB(0, 1), cB + hstep, voffB); PG8_STAGE(PG8_SA(0, 0), cA, voffA); PG8_STAGE(PG8_SA(0, 1), cA + hstep, voffA);
        if (wr == 1) PG8_BAR;
        PG8_WAIT_V(2); PG8_BAR;
        PG8_STAGE(PG8_SB(1, 0), cB + kstep, voffB); PG8_STAGE(PG8_SA(1, 0), cA + kstep, voffA); PG8_STAGE(PG8_SB(1, 1), cB + hstep + kstep, voffB);
        PG8_WAIT_V(6); PG8_BAR;
    } else {
        PG8_STAGE(PG8_SB(0, 0), cB, voffB); PG8_STAGE(PG8_SA(0, 0), cA, voffA); PG8_STAGE(PG8_SB(0, 1), cB + hstep, voffB); PG8_STAGE(PG8_SA(0, 1), cA + hstep, voffA);
        if (wr == 1) PG8_BAR;
        PG8_WAIT_V(4); PG8_BAR;
        PG8_STAGE(PG8_SB(1, 0), cB + kstep, voffB); PG8_STAGE(PG8_SA(1, 0), cA + kstep, voffA); PG8_STAGE(PG8_SB(1, 1), cB + hstep + kstep, voffB);
        PG8_WAIT_V(6); PG8_BAR;
    }
    for (;;) {
        const bool has_next = S.next(ui + 1, nxt);
        const char* nA = has_next ? (const char*)g.A + (size_t)nxt.pm * tstep : cA; const char* nB = has_next ? (const char*)g.Bt + (size_t)nxt.pn * tstep : cB;
        for (int t = 0; t < nt; t += 2) {
            const bool last = (t == nt - 2);
            const char* a1 = cA + (size_t)(t + 1) * kstep;
            const char* a2 = last ? nA : cA + (size_t)(t + 2) * kstep; const char* b2 = last ? nB : cB + (size_t)(t + 2) * kstep;
            const char* a3 = a2 + kstep; const char* b3 = b2 + kstep;
            if (last && has_next) S.a_ready(nxt);
            if constexpr (SP2) {
            PG8_LDB(B0, 0, 0); PG8_LDB(B1, 0, 1); PG8_SCHED; PG8_LDA(At, 0, 0); PG8_STAGE(PG8_SA(1, 1), a1 + hstep, voffA);
            PG8_WAIT_V(8); PG8_WAIT_L(0); PG8_BAR; PG8_MMA(0, 0, At, B0); PG8_MMA(0, 1, At, B1); PG8_BAR; PG8_SCHED;
            PG8_LDA(At, 0, 1); PG8_STAGE(PG8_SB(0, 0), b2, voffB); PG8_STAGE(PG8_SB(0, 1), b2 + hstep, voffB); PG8_STAGE(PG8_SA(0, 0), a2, voffA);
            PG8_WAIT_V(8); PG8_WAIT_L(0); PG8_BAR; PG8_MMA(1, 0, At, B0); PG8_MMA(1, 1, At, B1); PG8_BAR; PG8_SCHED;
            PG8_LDB(B0, 1, 0); PG8_LDB(B1, 1, 1); PG8_SCHED; PG8_LDA(At, 1, 0); PG8_STAGE(PG8_SA(0, 1), a2 + hstep, voffA);
            PG8_WAIT_V(8); PG8_WAIT_L(0); PG8_BAR; PG8_MMA(0, 0, At, B0); PG8_MMA(0, 1, At, B1); PG8_BAR; PG8_SCHED;
            PG8_LDA(At, 1, 1); PG8_STAGE(PG8_SB(1, 0), b3, voffB); PG8_STAGE(PG8_SB(1, 1), b3 + hstep, voffB); PG8_STAGE(PG8_SA(1, 0), a3, voffA);
            PG8_WAIT_V(8); PG8_WAIT_L(0); PG8_BAR; PG8_MMA(1, 0, At, B0); PG8_MMA(1, 1, At, B1); PG8_BAR; PG8_SCHED;
            } else {
            PG8_LDB(B0, 0, 0); PG8_SCHED; PG8_LDA(At, 0, 0); PG8_STAGE(PG8_SA(1, 1), a1 + hstep, voffA);
            PG8_WAIT_L(8); PG8_BAR; PG8_WAIT_L(0); PG8_MMA(0, 0, At, B0); PG8_BAR; PG8_SCHED;
            PG8_LDB(B1, 0, 1); PG8_STAGE(PG8_SB(0, 0), b2, voffB);
            PG8_BAR; PG8_WAIT_L(0); PG8_MMA(0, 1, At, B1); PG8_BAR;
            PG8_LDA(At, 0, 1); PG8_STAGE(PG8_SA(0, 0), a2, voffA);
            PG8_BAR; PG8_WAIT_L(0); PG8_MMA(1, 0, At, B0); PG8_BAR; PG8_SCHED;
            PG8_STAGE(PG8_SB(0, 1), b2 + hstep, voffB);
            PG8_WAIT_V(6); PG8_BAR; PG8_MMA(1, 1, At, B1); PG8_BAR;
            PG8_LDB(B0, 1, 0); PG8_SCHED; PG8_LDA(At, 1, 0); PG8_STAGE(PG8_SA(0, 1), a2 + hstep, voffA);
            PG8_WAIT_L(8); PG8_BAR; PG8_WAIT_L(0); PG8_MMA(0, 0, At, B0); PG8_BAR; PG8_SCHED;
            PG8_LDB(B1, 1, 1); PG8_STAGE(PG8_SB(1, 0), b3, voffB);
            PG8_BAR; PG8_WAIT_L(0); PG8_MMA(0, 1, At, B1); PG8_BAR;
            PG8_LDA(At, 1, 1); PG8_STAGE(PG8_SA(1, 0), a3, voffA);
            PG8_BAR; PG8_WAIT_L(0); PG8_MMA(1, 0, At, B0); PG8_BAR; PG8_SCHED;
            PG8_STAGE(PG8_SB(1, 1), b3 + hstep, voffB);
            PG8_WAIT_V(6); PG8_BAR; PG8_MMA(1, 1, At, B1); PG8_BAR;
            }
        }
        if constexpr (ALIGN_EPI) { if (wr == 0) PG8_BAR; }
        if constexpr (!Epi::AFTER_DRAIN) { E(acc, cur, wr, wc, fr, fq); S.done(cur); }
        if (!has_next) break;
#pragma unroll
        for (int a = 0; a < 2; ++a)
#pragma unroll
            for (int b = 0; b < 2; ++b)
#pragma unroll
                for (int m = 0; m < 4; ++m)
#pragma unroll
                    for (int n = 0; n < 2; ++n) acc[a][b][m][n] = (f32x4){0.f, 0.f, 0.f, 0.f};
        cur = nxt; cA = nA; cB = nB; ++ui;
        if constexpr (ALIGN_EPI) { if (wr == 1) PG8_BAR; }
    }
    PG8_WAIT_V(0);
    if constexpr (!ALIGN_EPI) { if (wr == 0) PG8_BAR; }
    PG8_BAR;
    if constexpr (Epi::AFTER_DRAIN) { E.fused(acc, cur, wr, wc, fr, fq, lds, wid, lane); S.done(cur); }
#undef PG8_SA
#undef PG8_SB
#undef PG8_STAGE
#undef PG8_LDA
#undef PG8_LDB
#undef PG8_MMA
#undef PG8_WAIT_V
#undef PG8_WAIT_L
#undef PG8_BAR
#undef PG8_SCHED
}
}

#define GAS __attribute__((address_space(1)))
#define LAS __attribute__((address_space(3)))
typedef unsigned short bf16;
typedef float f32x4 __attribute__((ext_vector_type(4)));
typedef float f32x2 __attribute__((ext_vector_type(2)));
typedef short bf16x8 __attribute__((ext_vector_type(8)));
typedef unsigned u32x4 __attribute__((ext_vector_type(4)));
typedef unsigned u32x2 __attribute__((ext_vector_type(2)));
typedef GAS unsigned gu32;

constexpr int NWAVES = 8, NTHR = 512;
constexpr int D = 2048, SEQ = 4096, MP = 8192, MS = 64, MT = MP + MS, DEPTH = 4;
constexpr int DIN = 5136, NINP = 5376, DFF = 5632, NGU = 2 * DFF;
constexpr int C_QA = 0, C_KA = 768, C_VA = 1536, C_UB = 2304, C_QC = 2816, C_KC = 3200, C_VC = 3584, C_RC = 4352, C_GC = 5120;
constexpr int M_A = 0, M_B = 768, M_C = 1280;
constexpr float EPS = 1e-6f;
constexpr int NCH = 64, CH = 64;
constexpr int SELEMS = 96 * 192;

enum { I_XP = 0, I_XS, I_CK, I_CV, I_SPOOL, I_SGLA, I_N1G, I_WIN, I_WG2, I_BG, I_WPOOL, I_PSCALE, I_GNG, I_WO, I_N2G, I_WFG, I_WFU, I_WFD, I_FNG, N_IN };
constexpr size_t O_YP = 0, O_YS = 16777216, O_PK = 16908288, O_PV = 29491200, O_PP = 42074112, O_PG = 42135552, O_SK = 42725376, O_SV = 42921984, O_SP = 43118592, O_SG = 43364352, O_END = 45723648;
constexpr size_t MiB = 1u << 20;
constexpr size_t WS_CTL = 0, CTL_ZERO_BYTES = 1 * MiB;
constexpr size_t WS_PART1 = 1 * MiB, WS_PART2 = 1 * MiB + 262144, WS_SPART1 = 1 * MiB + 524288, WS_SPART2 = 1 * MiB + 589824;
constexpr size_t WS_GA = 2 * MiB, WS_DEC = 3 * MiB, WS_PROJS = 4 * MiB, WS_WPT = 6 * MiB;
constexpr size_t WS_W = 8 * MiB;
constexpr size_t LW_IN = 0, LW_O = (size_t)NINP * D * 2, LW_GU = LW_O + (size_t)D * D * 2, LW_D = LW_GU + (size_t)NGU * D * 2, LW_SZ = LW_D + (size_t)D * DFF * 2;
static_assert(LW_SZ == 99614720, "layer weight bytes");
constexpr size_t WS_X = 388 * MiB, WS_XB = 453 * MiB, WS_MIX = 486 * MiB, WS_PROJ = 519 * MiB, WS_F = 603 * MiB, WS_SLOC = 692 * MiB, WS_SST = 728 * MiB, WS_BCUM = 764 * MiB, WS_END = 780 * MiB;
static_assert(WS_W + 4 * LW_SZ <= WS_X && WS_X + (size_t)MT * D * 4 <= WS_XB && WS_XB + (size_t)MT * D * 2 <= WS_MIX && WS_MIX + (size_t)MT * D * 2 <= WS_PROJ, "ws map 1");
static_assert(WS_PROJ + (size_t)MP * NINP * 2 <= WS_F && WS_F + (size_t)MT * DFF * 2 <= WS_SLOC && WS_SLOC + (size_t)512 * SELEMS * 4 <= WS_SST && WS_SST + (size_t)512 * SELEMS * 4 <= WS_BCUM && WS_BCUM + (size_t)MP * 384 * 4 <= WS_END, "ws map 2");
constexpr size_t WS_OP = WS_F, WS_LSE = WS_F + 40 * MiB;
static_assert((size_t)3 * MP * 768 * 2 <= 40 * MiB && WS_LSE + (size_t)3 * MP * 6 * 4 <= WS_SLOC, "attention partials fit");
constexpr int CW_BAR = 4096;
constexpr int RING_BYTES = 131072, XCH_OFF = RING_BYTES, SCRATCH_BYTES = 139264, LDSCTL_OFF = SCRATCH_BYTES, MISC_OFF = LDSCTL_OFF + 320, LDS_BYTES = 147456;

#define RLX_AGENT __ATOMIC_RELAXED, __HIP_MEMORY_SCOPE_AGENT
__device__ __forceinline__ float bf2f(unsigned b) { return __uint_as_float(b << 16); }
typedef __bf16 hwbf16x2 __attribute__((ext_vector_type(2)));
__device__ __forceinline__ unsigned pk2(float lo, float hi) { const f32x2 v = {lo, hi}; const hwbf16x2 b = __builtin_convertvector(v, hwbf16x2); return __builtin_bit_cast(unsigned, b); }
__device__ __forceinline__ unsigned f2bf(float f) { return pk2(f, 0.f) & 0xffffu; }
__device__ __forceinline__ float wave_sum(float v) {
#pragma unroll
    for (int o = 1; o < 64; o <<= 1) v += __shfl_xor(v, o);
    return v;
}
__device__ __forceinline__ float wave_max(float v) {
#pragma unroll
    for (int o = 1; o < 64; o <<= 1) v = fmaxf(v, __shfl_xor(v, o));
    return v;
}
__device__ __forceinline__ float logsig(float z) { return fminf(z, 0.f) - log1pf(__expf(-fabsf(z))); }
__device__ __forceinline__ float silu(float x) { return x / (1.0f + __expf(-x)); }

#define XB_TMO      128
#define XB_XCNT(j)  (256  + 64 * (j))
#define XB_XSUB(j)  (1280 + 64 * (j))
#define XB_XGEN(j)  (2304 + 64 * (j))
#define XB_TOP      3328
#define XB_TOPGEN   3392
#define XCD_BAR_WORDS 3456
#define XB_SPIN_CAP (1u << 18)

__device__ __forceinline__ unsigned xb_ld(unsigned* p)              { return __hip_atomic_load(p, __ATOMIC_RELAXED, __HIP_MEMORY_SCOPE_AGENT); }
__device__ __forceinline__ unsigned xb_add(unsigned* p, unsigned v) { return __hip_atomic_fetch_add(p, v, __ATOMIC_RELAXED, __HIP_MEMORY_SCOPE_AGENT); }
__device__ __forceinline__ unsigned xb_xcc_id() { return (unsigned)__builtin_amdgcn_s_getreg((3 << 11) | 20) & 0xFu; }
#define XB_SPIN(cond, bar) do { unsigned _sp = 0; while (cond) { __builtin_amdgcn_s_sleep(1); \
    if ((++_sp & 255u) == 0u) { if (xb_ld(&(bar)[XB_TMO])) break; if (_sp > XB_SPIN_CAP) { atomicAdd(&(bar)[XB_TMO], 1u); break; } } } } while (0)

struct XcdBarrier {
    unsigned* bar; unsigned x;
    volatile LAS unsigned* st;
};

__device__ __forceinline__ XcdBarrier xcd_barrier_post(unsigned* bar, volatile LAS unsigned* st) {
    XcdBarrier b; b.bar = bar; b.x = xb_xcc_id(); b.st = st;
    if (threadIdx.x == 0) (void)xb_add(&bar[XB_XCNT(b.x)], 1u);
    return b;
}
__device__ __forceinline__ void xcd_barrier_complete(unsigned* bar, unsigned x, unsigned& nloc, unsigned& nx) {
    const unsigned G = gridDim.x * gridDim.y * gridDim.z;
    unsigned sum, cnt, mine, sp = 0u;
    for (;;) {
        sum = 0u; cnt = 0u; mine = 0u;
#pragma unroll
        for (unsigned j = 0; j < 16; ++j) { const unsigned c = xb_ld(&bar[XB_XCNT(j)]); sum += c; cnt += (c > 0u) ? 1u : 0u; mine = (j == x) ? c : mine; }
        if (sum == G) break;
        __builtin_amdgcn_s_sleep(1);
        if ((++sp & 255u) == 0u) { if (xb_ld(&bar[XB_TMO])) break; if (sp > XB_SPIN_CAP) { atomicAdd(&bar[XB_TMO], 1u); break; } }
    }
    nloc = mine > 0u ? mine : 1u; nx = cnt > 0u ? cnt : 1u;
}

__device__ __forceinline__ void xcd_barrier(const XcdBarrier& b) {
    asm volatile("s_waitcnt vmcnt(0)" ::: "memory");
    __syncthreads();
    if (threadIdx.x == 0) {
        unsigned* bar = b.bar;
        __builtin_amdgcn_s_waitcnt(0);
        unsigned nloc = b.st[0], nx = b.st[1];
        if (nloc == 0u) { xcd_barrier_complete(bar, b.x, nloc, nx); b.st[0] = nloc; b.st[1] = nx; }
        const unsigned old = xb_add(&bar[XB_XSUB(b.x)], 1u);
        const unsigned gen = old / nloc;
        if (old + 1u == (gen + 1u) * nloc) {
            __builtin_amdgcn_fence(__ATOMIC_RELEASE, "agent");
            asm volatile("s_waitcnt vmcnt(0)" ::: "memory");
            const unsigned og = xb_add(&bar[XB_TOP], 1u);
            const unsigned tg = og / nx;
            if (og + 1u == (tg + 1u) * nx) xb_add(&bar[XB_TOPGEN], 1u);
            else XB_SPIN(xb_ld(&bar[XB_TOPGEN]) == tg, bar);
            __builtin_amdgcn_fence(__ATOMIC_ACQUIRE, "agent");
            xb_add(&bar[XB_XGEN(b.x)], 1u);
            asm volatile("s_waitcnt vmcnt(0)" ::: "memory");
        } else {
            XB_SPIN(xb_ld(&bar[XB_XGEN(b.x)]) == gen, bar);
            __builtin_amdgcn_fence(__ATOMIC_ACQUIRE, "agent");
            asm volatile("s_waitcnt vmcnt(0)" ::: "memory");
        }
    }
    __syncthreads();
}

struct RowId { __device__ __forceinline__ int operator()(int n) const { return n; } };
struct RowGate { int up; __device__ __forceinline__ int operator()(int f) const { return 256 * (f >> 7) + 128 * up + (f & 127); } };
template <class RM>
__device__ __forceinline__ void cvt_tile(const float* __restrict__ W, int K, int N, int k0, int n0, const float* __restrict__ gk, bf16* Wt, RM rowmap, LAS float* scr, int lane) {
    const int cl = 4 * (lane & 15), kr = lane >> 4;
    f32x4 v[16];
#pragma unroll
    for (int i = 0; i < 16; ++i) {
        const int kk = 4 * i + kr, n = n0 + cl;
        v[i] = (n + 3 < N) ? __builtin_nontemporal_load((const f32x4*)(W + (size_t)(k0 + kk) * N + n)) : (f32x4){0.f, 0.f, 0.f, 0.f};
    }
#pragma unroll
    for (int i = 0; i < 16; ++i) {
        const int kk = 4 * i + kr; const float g = gk ? gk[k0 + kk] : 1.0f;
        LAS float* s = scr + kk * 65 + cl;
        s[0] = v[i][0] * g; s[1] = v[i][1] * g; s[2] = v[i][2] * g; s[3] = v[i][3] * g;
    }
    asm volatile("s_waitcnt lgkmcnt(0)" ::: "memory");
    const int c = lane & 7;
#pragma unroll
    for (int i = 0; i < 8; ++i) {
        const int nl = 8 * i + (lane >> 3), n = n0 + nl;
        const LAS float* s = scr + (8 * c) * 65 + nl;
        u32x4 o; o.x = pk2(s[0 * 65], s[1 * 65]); o.y = pk2(s[2 * 65], s[3 * 65]); o.z = pk2(s[4 * 65], s[5 * 65]); o.w = pk2(s[6 * 65], s[7 * 65]);
        if (n < N) *(u32x4*)(Wt + (size_t)rowmap(n) * K + k0 + 8 * c) = o;
    }
    asm volatile("s_waitcnt lgkmcnt(0)" ::: "memory");
}

struct Ptrs {
    const float* in[N_IN]; float* out; unsigned char* ws;
};

constexpr int CV_IN = 32 * 81, CV_O = 32 * 32, CV_G = 32 * 88, CV_D = 88 * 32, CV_L = CV_IN + CV_O + 2 * CV_G + CV_D;
__device__ __forceinline__ void cvt_item(const Ptrs& P, int l, int r, LAS float* scr, int lane) {
    unsigned char* wl = P.ws + WS_W + (size_t)l * LW_SZ;
    if (r < CV_IN) { const int kb = r / 81, nb = r % 81; cvt_tile(P.in[I_WIN] + (size_t)l * D * DIN, D, DIN, 64 * kb, 64 * nb, P.in[I_N1G] + l * D, (bf16*)(wl + LW_IN), RowId{}, scr, lane); return; } r -= CV_IN;
    if (r < CV_O) { const int kb = r / 32, nb = r % 32; cvt_tile(P.in[I_WO] + (size_t)l * D * D, D, D, 64 * kb, 64 * nb, (const float*)nullptr, (bf16*)(wl + LW_O), RowId{}, scr, lane); return; } r -= CV_O;
    if (r < CV_G) { const int kb = r / 88, nb = r % 88; cvt_tile(P.in[I_WFG] + (size_t)l * D * DFF, D, DFF, 64 * kb, 64 * nb, P.in[I_N2G] + l * D, (bf16*)(wl + LW_GU), RowGate{0}, scr, lane); return; } r -= CV_G;
    if (r < CV_G) { const int kb = r / 88, nb = r % 88; cvt_tile(P.in[I_WFU] + (size_t)l * D * DFF, D, DFF, 64 * kb, 64 * nb, P.in[I_N2G] + l * D, (bf16*)(wl + LW_GU), RowGate{1}, scr, lane); return; } r -= CV_G;
    { const int kb = r / 32, nb = r % 32; cvt_tile(P.in[I_WFD] + (size_t)l * DFF * D, DFF, D, 64 * kb, 64 * nb, (const float*)nullptr, (bf16*)(wl + LW_D), RowId{}, scr, lane); }
}
__device__ __forceinline__ void prologue(const Ptrs& P, LAS unsigned char* lds, int bx, int G, int wave, int lane, int tid, int pro_layers) {
    LAS float* scr = (LAS float*)(lds + wave * 16640);
    const int gw = bx * NWAVES + wave, NGW = G * NWAVES;
    for (int it = gw; it < pro_layers * CV_L; it += NGW) cvt_item(P, it / CV_L, it % CV_L, scr, lane);
    for (int i = bx * NTHR + tid; i < DEPTH * 61440; i += G * NTHR) {
        const int l = i / 61440, j = i % 61440;
        *(u32x4*)(P.ws + WS_W + (size_t)l * LW_SZ + LW_IN + (size_t)DIN * D * 2 + (size_t)j * 16) = (u32x4){0u, 0u, 0u, 0u};
    }
    for (int i = bx * NTHR + tid; i < DEPTH * 4 * 128 * 128; i += G * NTHR) {
        const int c = i & 127, d = (i >> 7) & 127, lg = i >> 14;
        ((bf16*)(P.ws + WS_WPT))[i] = (bf16)f2bf(P.in[I_WPOOL][((size_t)lg * 128 + c) * 128 + d] * P.in[I_PSCALE][lg * 128 + d]);
    }
    float* part2 = (float*)(P.ws + WS_PART2); float* spart2 = (float*)(P.ws + WS_SPART2); bf16* XB = (bf16*)(P.ws + WS_XB);
    for (int row = gw; row < MT; row += NGW) {
        const float* xr = (row < MP) ? P.in[I_XP] + (size_t)row * D : P.in[I_XS] + (size_t)(row - MP) * D;
        float s = 0.f;
#pragma unroll
        for (int j = 0; j < 8; ++j) {
            const f32x4 v = *(const f32x4*)(xr + 4 * lane + 256 * j);
            s += (v[0] * v[0] + v[1] * v[1]) + (v[2] * v[2] + v[3] * v[3]);
            u32x2 o; o.x = pk2(v[0], v[1]); o.y = pk2(v[2], v[3]);
            *(u32x2*)(XB + (size_t)row * D + 4 * lane + 256 * j) = o;
        }
        s = wave_sum(s);
        if (row < MP) { if (lane < 8) part2[(size_t)row * 8 + lane] = (lane == 0) ? s : 0.f; }
        else { spart2[(size_t)(row - MP) * 128 + lane] = (lane == 0) ? s : 0.f; spart2[(size_t)(row - MP) * 128 + 64 + lane] = 0.f; }
    }
}

template <int MT, int NT, int QB, class EPI>
__device__ __forceinline__ void skinny_unit(LAS unsigned char* lds, const bf16* __restrict__ A, const bf16* __restrict__ B0, const bf16* __restrict__ B1, int K, int r0, int ntile, const EPI& epi, int wave, int lane, int tid) {
    const int fr = lane & 15, fq = lane >> 4, ks = K / 8, kb = wave * ks;
    f32x4 acc[MT][NT];
#pragma unroll
    for (int a = 0; a < MT; ++a)
#pragma unroll
        for (int b = 0; b < NT; ++b) acc[a][b] = (f32x4){0.f, 0.f, 0.f, 0.f};
    const bf16* ap = A + (size_t)(r0 + fr) * K + kb + 8 * fq;
    const bf16* b0p = B0 + (size_t)fr * K + kb + 8 * fq; const bf16* b1p = B1 + (size_t)fr * K + kb + 8 * fq;
    for (int kk0 = 0; kk0 < ks; kk0 += 32 * QB) {
        bf16x8 a[QB][MT], b[QB][NT];
#pragma unroll
        for (int q = 0; q < QB; ++q) { const int kk = (kk0 + 32 * q < ks) ? kk0 + 32 * q : kk0;
#pragma unroll
            for (int m = 0; m < MT; ++m) a[q][m] = *(const bf16x8*)(ap + (size_t)(16 * m) * K + kk);
            b[q][0] = *(const bf16x8*)(b0p + kk); if (NT == 2) b[q][NT - 1] = *(const bf16x8*)(b1p + kk); }
#pragma unroll
        for (int q = 0; q < QB; ++q) if (kk0 + 32 * q < ks) {
#pragma unroll
            for (int m = 0; m < MT; ++m)
#pragma unroll
                for (int n = 0; n < NT; ++n) acc[m][n] = __builtin_amdgcn_mfma_f32_16x16x32_bf16(a[q][m], b[q][n], acc[m][n], 0, 0, 0);
        }
    }
    LAS float* red = (LAS float*)lds;
#pragma unroll
    for (int m = 0; m < MT; ++m)
#pragma unroll
        for (int nb = 0; nb < NT; ++nb)
#pragma unroll
            for (int rg = 0; rg < 4; ++rg) red[((wave * NT + nb) * (16 * MT) + m * 16 + 4 * fq + rg) * 16 + fr] = acc[m][nb][rg];
    __syncthreads();
#pragma unroll
    for (int nb = 0; nb < NT; ++nb)
#pragma unroll
        for (int hf = 0; hf < MT / 2; ++hf) {
            float v = 0.f;
#pragma unroll
            for (int w = 0; w < 8; ++w) v += red[((w * NT + nb) * (16 * MT) + hf * 32) * 16 + tid];
            if (nb < ntile) epi(r0 + (tid >> 4) + 32 * hf, hf, nb, tid & 15, v);
        }
    __syncthreads();
}
__device__ __forceinline__ float skinny_rs(const float* spart, int rbase, int tid) {
    const float* p = spart + (size_t)(rbase + (tid >> 4)) * 128 + (tid & 15) * 8;
    const f32x4 a = *(const f32x4*)p, b = *(const f32x4*)(p + 4);
    float s = ((a[0] + a[1]) + (a[2] + a[3])) + ((b[0] + b[1]) + (b[2] + b[3]));
    s += __shfl_xor(s, 1); s += __shfl_xor(s, 2); s += __shfl_xor(s, 4); s += __shfl_xor(s, 8);
    return rsqrtf(s * (1.0f / 2048.0f) + EPS);
}
struct SEpiInProj {
    float* projs; float rs0, rs1; float* sk; float* sv; float* sp; int n0;
    __device__ __forceinline__ void operator()(int row, int hf, int tile, int cl, float v0) const {
        const int col = n0 + 16 * tile + cl; const float v = v0 * (hf == 0 ? rs0 : rs1);
        projs[(size_t)row * DIN + col] = v;
        if (col >= C_KA && col < C_VA) sk[(size_t)row * 768 + (col - C_KA)] = v;
        else if (col >= C_VA && col < C_UB) sv[(size_t)row * 768 + (col - C_VA)] = v;
        else if (col >= C_UB && col < C_QC) sp[(size_t)((row >> 3) * 15 + 7 + (row & 7)) * 512 + (col - C_UB)] = v;
    }
};
struct SEpiResid {
    const bf16* xin; bf16* xb; float* spart; int n0;
    __device__ __forceinline__ void operator()(int row, int, int tile, int cl, float v0) const {
        const size_t o = (size_t)row * D + n0 + 16 * tile + cl; const float v = bf2f(xin[o]) + v0;
        xb[o] = (bf16)f2bf(v);
        float s = v * v; s += __shfl_xor(s, 1); s += __shfl_xor(s, 2); s += __shfl_xor(s, 4); s += __shfl_xor(s, 8);
        if (cl == 0) spart[(size_t)row * 128 + (n0 >> 4) + tile] = s;
    }
};
struct SEpiGateUp {
    bf16* F; float rs0, rs1; int f0; mutable float gate0, gate1;
    __device__ __forceinline__ void operator()(int row, int hf, int tile, int cl, float v0) const {
        const float rs = hf == 0 ? rs0 : rs1;
        if (tile == 0) { if (hf == 0) gate0 = v0 * rs; else gate1 = v0 * rs; }
        else F[(size_t)(MP + row) * DFF + f0 + cl] = (bf16)f2bf(silu(hf == 0 ? gate0 : gate1) * (v0 * rs));
    }
};

__device__ __forceinline__ void s_attn_slot(int s, int tA, int tB, int& idx, bool& vA, bool& vB) {
    if (s < 133) { idx = 2048 + tB - s; vB = (s <= 128); vA = (s >= 4); }
    else if (s < 263) { const int j = s - 133; idx = 2048 + tB - 4 * j; vB = (j <= 128); vA = (j >= 1); }
    else if (s < 392) { idx = 2048 + tA - 16 * (s - 263); vA = true; vB = false; }
    else if (s < 521) { idx = 2048 + tB - 16 * (s - 392); vA = false; vB = true; }
    else { idx = 2048 + tB; vA = false; vB = false; }
}
__device__ __forceinline__ void s_attn_punit(const Ptrs& P, LAS unsigned char* lds, int l, int unit, int wave, int lane, int tid) {
    const int h = unit % 6, bq = unit / 6, b = bq >> 2, tA = bq & 3, tB = tA + 4, rowA = b * 8 + tA, rowB = rowA + 4;
    const float* projs = (const float*)(P.ws + WS_PROJS);
    LAS float* scA = (LAS float*)lds;
    LAS float* scB = scA + 544;
    LAS float* red = scB + 544;
    LAS float* part = red + 32;
    const int qw = lane >> 4, k16 = lane & 15;
    const float QS = 0.08838834764831845f;
    const f32x4 qAa = *(const f32x4*)(projs + (size_t)rowA * DIN + C_QA + h * 128 + 4 * k16) * QS, qAb = *(const f32x4*)(projs + (size_t)rowA * DIN + C_QA + h * 128 + 64 + 4 * k16) * QS;
    const f32x4 qBa = *(const f32x4*)(projs + (size_t)rowB * DIN + C_QA + h * 128 + 4 * k16) * QS, qBb = *(const f32x4*)(projs + (size_t)rowB * DIN + C_QA + h * 128 + 64 + 4 * k16) * QS;
    const float* ckb = P.in[I_CK] + ((size_t)(l * 8 + b) * 2048 * 6 + h) * 128; const float* cvb = P.in[I_CV] + ((size_t)(l * 8 + b) * 2048 * 6 + h) * 128;
    const float* pkb = projs + (size_t)(b * 8) * DIN + h * 128;
#pragma unroll
    for (int half = 0; half < 2; ++half) {
        const int it0 = half ? 9 : 0, nit = half ? 8 : 9;
        f32x4 ka[9], kb[9];
#pragma unroll
        for (int i = 0; i < 9; ++i) if (i < nit) {
            int idx; bool vA, vB; s_attn_slot((it0 + i) * 32 + wave * 4 + qw, tA, tB, idx, vA, vB);
            const float* rp = (idx >= 2048) ? pkb + (size_t)(idx - 2048) * DIN + C_KA : ckb + (size_t)idx * 768;
            ka[i] = __builtin_nontemporal_load((const f32x4*)(rp + 4 * k16)); kb[i] = __builtin_nontemporal_load((const f32x4*)(rp + 64 + 4 * k16));
        }
#pragma unroll
        for (int i = 0; i < 9; ++i) if (i < nit) {
            const int s = (it0 + i) * 32 + wave * 4 + qw;
            int idx; bool vA, vB; s_attn_slot(s, tA, tB, idx, vA, vB);
            float a = (ka[i][0] * qAa[0] + ka[i][1] * qAa[1]) + (ka[i][2] * qAa[2] + ka[i][3] * qAa[3]) + (kb[i][0] * qAb[0] + kb[i][1] * qAb[1]) + (kb[i][2] * qAb[2] + kb[i][3] * qAb[3]);
            float c = (ka[i][0] * qBa[0] + ka[i][1] * qBa[1]) + (ka[i][2] * qBa[2] + ka[i][3] * qBa[3]) + (kb[i][0] * qBb[0] + kb[i][1] * qBb[1]) + (kb[i][2] * qBb[2] + kb[i][3] * qBb[3]);
            a += __shfl_xor(a, 1); a += __shfl_xor(a, 2); a += __shfl_xor(a, 4); a += __shfl_xor(a, 8);
            c += __shfl_xor(c, 1); c += __shfl_xor(c, 2); c += __shfl_xor(c, 4); c += __shfl_xor(c, 8);
            if (k16 == 0) { scA[s] = vA ? a : -1e30f; scB[s] = vB ? c : -1e30f; }
        }
    }
    __syncthreads();
    const float a0 = scA[tid], b0 = scB[tid], a1 = (tid < 32) ? scA[512 + tid] : -1e30f, b1 = (tid < 32) ? scB[512 + tid] : -1e30f;
    float mA = wave_max(fmaxf(a0, a1)), mB = wave_max(fmaxf(b0, b1));
    if (lane == 0) { red[wave] = mA; red[8 + wave] = mB; }
    __syncthreads();
    mA = red[0]; mB = red[8];
#pragma unroll
    for (int w = 1; w < 8; ++w) { mA = fmaxf(mA, red[w]); mB = fmaxf(mB, red[8 + w]); }
    const float eA0 = __expf(a0 - mA), eB0 = __expf(b0 - mB), eA1 = (tid < 32) ? __expf(a1 - mA) : 0.f, eB1 = (tid < 32) ? __expf(b1 - mB) : 0.f;
    const float smA = wave_sum(eA0 + eA1), smB = wave_sum(eB0 + eB1);
    scA[tid] = eA0; scB[tid] = eB0;
    if (tid < 32) { scA[512 + tid] = eA1; scB[512 + tid] = eB1; }
    if (lane == 0) { red[16 + wave] = smA; red[24 + wave] = smB; }
    __syncthreads();
    float denA = 0.f, denB = 0.f;
#pragma unroll
    for (int w = 0; w < 8; ++w) { denA += red[16 + w]; denB += red[24 + w]; }
    f32x4 oAa = (f32x4){0.f, 0.f, 0.f, 0.f}, oAb = oAa, oBa = oAa, oBb = oAa;
#pragma unroll
    for (int half = 0; half < 2; ++half) {
        const int it0 = half ? 9 : 0, nit = half ? 8 : 9;
        f32x4 va[9], vb[9];
#pragma unroll
        for (int i = 0; i < 9; ++i) if (i < nit) {
            int idx; bool vA, vB; s_attn_slot((it0 + i) * 32 + wave * 4 + qw, tA, tB, idx, vA, vB);
            const float* rp = (idx >= 2048) ? pkb + (size_t)(idx - 2048) * DIN + C_VA : cvb + (size_t)idx * 768;
            va[i] = __builtin_nontemporal_load((const f32x4*)(rp + 4 * k16)); vb[i] = __builtin_nontemporal_load((const f32x4*)(rp + 64 + 4 * k16));
        }
#pragma unroll
        for (int i = 0; i < 9; ++i) if (i < nit) {
            const int s = (it0 + i) * 32 + wave * 4 + qw; const float pA = scA[s], pB = scB[s];
            oAa += va[i] * pA; oAb += vb[i] * pA; oBa += va[i] * pB; oBb += vb[i] * pB;
        }
    }
#pragma unroll
    for (int i = 0; i < 4; ++i) {
        oAa[i] += __shfl_xor(oAa[i], 16); oAa[i] += __shfl_xor(oAa[i], 32); oAb[i] += __shfl_xor(oAb[i], 16); oAb[i] += __shfl_xor(oAb[i], 32);
        oBa[i] += __shfl_xor(oBa[i], 16); oBa[i] += __shfl_xor(oBa[i], 32); oBb[i] += __shfl_xor(oBb[i], 16); oBb[i] += __shfl_xor(oBb[i], 32);
    }
    if (qw == 0) {
        *(LAS f32x4*)(part + wave * 128 + 4 * k16) = oAa; *(LAS f32x4*)(part + wave * 128 + 64 + 4 * k16) = oAb;
        *(LAS f32x4*)(part + 1024 + wave * 128 + 4 * k16) = oBa; *(LAS f32x4*)(part + 1024 + wave * 128 + 64 + 4 * k16) = oBb;
    }
    __syncthreads();
    if (tid < 256) {
        const int q = tid >> 7, d = tid & 127;
        float o = 0.f;
#pragma unroll
        for (int w = 0; w < 8; ++w) o += part[q * 1024 + w * 128 + d];
        ((bf16*)(P.ws + WS_MIX))[(size_t)(MP + (q ? rowB : rowA)) * D + M_A + h * 128 + d] = (bf16)f2bf(o / (q ? denB : denA));
    }
    __syncthreads();
}
__device__ __forceinline__ void s_attn_unit(const Ptrs& P, LAS unsigned char* lds, int l, int unit, int wave, int lane, int tid) {
    const int h = unit % 6, row = unit / 6, b = row >> 3, t = row & 7;
    const float* projs = (const float*)(P.ws + WS_PROJS);
    LAS float* sc = (LAS float*)lds;
    LAS float* red = sc + 416;
    LAS float* part = red + 16;
    const int qw = lane >> 4, k16 = lane & 15;
    const f32x4 qa = *(const f32x4*)(projs + (size_t)row * DIN + C_QA + h * 128 + 4 * k16) * 0.08838834764831845f;
    const f32x4 qb = *(const f32x4*)(projs + (size_t)row * DIN + C_QA + h * 128 + 64 + 4 * k16) * 0.08838834764831845f;
    const float* rowp[13];
#pragma unroll
    for (int it = 0; it < 13; ++it) {
        int s = it * 32 + wave * 4 + qw; s = s < 387 ? s : 386;
        const int p = s / 129, j = s - p * 129, dil = (p == 0) ? 1 : (p == 1 ? 4 : 16), idx = 2048 + t - dil * j;
        rowp[it] = (idx >= 2048) ? projs + (size_t)(b * 8 + idx - 2048) * DIN + C_KA + h * 128
                                 : P.in[I_CK] + ((size_t)((l * 8 + b) * 2048 + idx) * 6 + h) * 128;
    }
    {
        f32x4 ka[13], kb[13];
#pragma unroll
        for (int it = 0; it < 13; ++it) { ka[it] = __builtin_nontemporal_load((const f32x4*)(rowp[it] + 4 * k16)); kb[it] = __builtin_nontemporal_load((const f32x4*)(rowp[it] + 64 + 4 * k16)); }
#pragma unroll
        for (int it = 0; it < 13; ++it) {
            float a = (ka[it][0] * qa[0] + ka[it][1] * qa[1]) + (ka[it][2] * qa[2] + ka[it][3] * qa[3]) + (kb[it][0] * qb[0] + kb[it][1] * qb[1]) + (kb[it][2] * qb[2] + kb[it][3] * qb[3]);
            a += __shfl_xor(a, 1); a += __shfl_xor(a, 2); a += __shfl_xor(a, 4); a += __shfl_xor(a, 8);
            const int s = it * 32 + wave * 4 + qw;
            if (k16 == 0) sc[s] = (s < 387) ? a : -1e30f;
        }
    }
    __syncthreads();
    const float v = (tid < 416) ? sc[tid] : -1e30f;
    float m = wave_max(v);
    if (lane == 0) red[wave] = m;
    __syncthreads();
    m = red[0];
#pragma unroll
    for (int w = 1; w < 8; ++w) m = fmaxf(m, red[w]);
    const float e = (tid < 387) ? __expf(v - m) : 0.f;
    float sm = wave_sum(e);
    __syncthreads();
    if (tid < 416) sc[tid] = e;
    if (lane == 0) red[8 + wave] = sm;
    __syncthreads();
    float den = 0.f;
#pragma unroll
    for (int w = 0; w < 8; ++w) den += red[8 + w];
    f32x4 oa = (f32x4){0.f, 0.f, 0.f, 0.f}, ob = (f32x4){0.f, 0.f, 0.f, 0.f};
    {
        f32x4 va[13], vb[13];
#pragma unroll
        for (int it = 0; it < 13; ++it) {
            int s = it * 32 + wave * 4 + qw; s = s < 387 ? s : 386;
            const int p = s / 129, j = s - p * 129, dil = (p == 0) ? 1 : (p == 1 ? 4 : 16), idx = 2048 + t - dil * j;
            const float* vr = (idx >= 2048) ? projs + (size_t)(b * 8 + idx - 2048) * DIN + C_VA + h * 128
                                            : P.in[I_CV] + ((size_t)((l * 8 + b) * 2048 + idx) * 6 + h) * 128;
            va[it] = __builtin_nontemporal_load((const f32x4*)(vr + 4 * k16)); vb[it] = __builtin_nontemporal_load((const f32x4*)(vr + 64 + 4 * k16));
        }
#pragma unroll
        for (int it = 0; it < 13; ++it) { const float pe = sc[it * 32 + wave * 4 + qw]; oa += va[it] * pe; ob += vb[it] * pe; }
    }
#pragma unroll
    for (int i = 0; i < 4; ++i) { oa[i] += __shfl_xor(oa[i], 16); oa[i] += __shfl_xor(oa[i], 32); ob[i] += __shfl_xor(ob[i], 16); ob[i] += __shfl_xor(ob[i], 32); }
    if (qw == 0) { *(LAS f32x4*)(part + wave * 128 + 4 * k16) = oa; *(LAS f32x4*)(part + wave * 128 + 64 + 4 * k16) = ob; }
    __syncthreads();
    if (tid < 128) {
        float o = 0.f;
#pragma unroll
        for (int w = 0; w < 8; ++w) o += part[w * 128 + tid];
        ((bf16*)(P.ws + WS_MIX))[(size_t)(MP + row) * D + M_A + h * 128 + tid] = (bf16)f2bf(o / den);
    }
    __syncthreads();
}
__device__ __forceinline__ void s_pool_unit(const Ptrs& P, LAS unsigned char* lds, int l, int row, int tid) {
    const int b = row >> 3, t = row & 7;
    const float* projs = (const float*)(P.ws + WS_PROJS);
    const float* sp = P.in[I_SPOOL] + (size_t)(l * 8 + b) * 15 * 512;
    LAS float* pl = (LAS float*)lds;
    {
        const int c = tid, g = c >> 7, w = 2 << g; float sum = 0.f, cur = 0.f;
        for (int i = 0; i < w; ++i) { const int e = 15 + t - i;
            const float uv = (e < 15) ? sp[(size_t)e * 512 + c] : projs[(size_t)(b * 8 + e - 15) * DIN + C_UB + c];
            sum += uv; if (i == 0) cur = uv; }
        pl[c] = sum / (float)w - cur;
        if (t == 0) { float* dst = P.out + O_SP + (size_t)(l * 8 + b) * 15 * 512;
            for (int i = 0; i < 7; ++i) dst[(size_t)i * 512 + c] = sp[(size_t)(8 + i) * 512 + c]; }
    }
    __syncthreads();
    {
        const int g = tid >> 7, d = tid & 127; const float* wp = P.in[I_WPOOL] + (size_t)(l * 4 + g) * 128 * 128;
        float a = 0.f;
#pragma unroll 8
        for (int c = 0; c < 128; ++c) a += pl[g * 128 + c] * wp[(size_t)c * 128 + d];
        a *= P.in[I_PSCALE][l * 512 + tid];
        ((bf16*)(P.ws + WS_MIX))[(size_t)(MP + row) * D + M_B + tid] = (bf16)f2bf(a);
    }
    __syncthreads();
}
__device__ __forceinline__ void s_gla_unit(const Ptrs& P, LAS unsigned char* lds, int l, int unit, int tid) {
    const int b = unit >> 2, h = unit & 3;
    const float* projs = (const float*)(P.ws + WS_PROJS);
    LAS float* eg = (LAS float*)lds;
    LAS float* qL = eg + 768;
    LAS float* kL = qL + 768;
    LAS float* vL = kL + 768;
    LAS float* op = vL + 1536;
    LAS float* oc = op + 384;
    LAS float* rs = oc + 1536;
    for (int i = tid; i < 768; i += NTHR) {
        const int t = i / 96, dk = i % 96; const float* pr = projs + (size_t)(b * 8 + t) * DIN;
        float z = P.in[I_BG][l * 384 + h * 96 + dk];
#pragma unroll
        for (int r = 0; r < 16; ++r) z += pr[C_GC + r] * P.in[I_WG2][(size_t)(l * 16 + r) * 384 + h * 96 + dk];
        eg[i] = __expf(logsig(z) * (1.0f / 16.0f));
        qL[i] = pr[C_QC + h * 96 + dk] * 0.10206207261596575f;
        kL[i] = pr[C_KC + h * 96 + dk];
    }
    for (int i = tid; i < 1536; i += NTHR) { const int t = i / 192, dv = i % 192; vL[i] = projs[(size_t)(b * 8 + t) * DIN + C_VC + h * 192 + dv]; }
    __syncthreads();
    const int dv = tid % 192, hf = tid / 192;
    float S[48];
    const float* s0 = P.in[I_SGLA] + (size_t)((l * 8 + b) * 4 + h) * SELEMS;
    if (tid < 384) {
#pragma unroll
        for (int i = 0; i < 48; ++i) S[i] = s0[(size_t)(48 * hf + i) * 192 + dv];
    }
    LAS float* opart = (LAS float*)(lds + 32768);
    if (tid < 384) {
        for (int t = 0; t < 8; ++t) {
            float o = 0.f; const float vv = vL[t * 192 + dv];
#pragma unroll
            for (int i = 0; i < 48; ++i) { const int dk = 48 * hf + i; S[i] = eg[t * 96 + dk] * S[i] + kL[t * 96 + dk] * vv; o += qL[t * 96 + dk] * S[i]; }
            opart[(t * 2 + hf) * 192 + dv] = o;
        }
    }
    __syncthreads();
    for (int i = tid; i < 1536; i += NTHR) { const int t = i / 192, d2 = i - 192 * t; oc[i] = opart[(t * 2) * 192 + d2] + opart[(t * 2 + 1) * 192 + d2]; }
    __syncthreads();
    if (tid < 384) { float* dst = P.out + O_SG + (size_t)((l * 8 + b) * 4 + h) * SELEMS;
#pragma unroll
        for (int i = 0; i < 48; ++i) dst[(size_t)(48 * hf + i) * 192 + dv] = S[i]; }
    {
        const int w = tid >> 6, ln = tid & 63; float s = 0.f;
        for (int i = ln; i < 192; i += 64) { const float x = oc[w * 192 + i]; s += x * x; }
        s = wave_sum(s);
        if (ln == 0) rs[w] = rsqrtf(s * (1.0f / 192.0f) + EPS);
    }
    __syncthreads();
    for (int i = tid; i < 1536; i += NTHR) {
        const int t = i / 192, d2 = i % 192; const int row = b * 8 + t;
        const float r = projs[(size_t)row * DIN + C_RC + h * 192 + d2];
        const float val = oc[i] * rs[t] * P.in[I_GNG][l * 192 + d2] * silu(r);
        ((bf16*)(P.ws + WS_MIX))[(size_t)(MP + row) * D + M_C + h * 192 + d2] = (bf16)f2bf(val);
    }
    __syncthreads();
}

typedef short v4i16_t __attribute__((ext_vector_type(4)));
__device__ __forceinline__ unsigned offb(unsigned row, unsigned ch) { return 256u * row + 16u * (ch ^ (((row & 3u) << 2) | ((row >> 2) & 3u))); }
__device__ __forceinline__ void p_attn_unit(const Ptrs& P, LAS unsigned char* lds, int unit, int wave, int lane) {
    const bf16* PROJ = (const bf16*)(P.ws + WS_PROJ);
    const int cb = unit & 31, pbh = unit >> 5, p = pbh / 12, bh = pbh - 12 * p, b = bh / 6, h = bh - 6 * b;
    const int dsh = 2 * p, dil = 1 << dsh, nbk = 32 >> dsh, r = cb / nbk, n = cb - r * nbk;
    const size_t rb = (size_t)b * SEQ + r;
#pragma unroll
    for (int i8 = 0; i8 < 8; ++i8) {
        const int i = wave * 8 + i8, row = 4 * i + (lane >> 4), pc = lane & 15;
        const int ch = pc ^ (((row & 3) << 2) | ((row >> 2) & 3));
        int ci = 128 * (n - 1) + row; ci = ci < 0 ? 0 : ci;
        const bf16* src = PROJ + (rb + (size_t)dil * ci) * NINP + h * 128 + 8 * ch;
        __builtin_amdgcn_global_load_lds((const unsigned*)(src + C_KA), (LAS unsigned*)(lds + i * 1024), 16, 0, 0);
        __builtin_amdgcn_global_load_lds((const unsigned*)(src + C_VA), (LAS unsigned*)(lds + 65536 + i * 1024), 16, 0, 0);
    }
    const int g = lane >> 4, ql = lane & 15, iloc = 16 * wave + ql;
    const size_t qrow = rb + (size_t)dil * (128 * n + iloc);
    bf16x8 qf[4];
#pragma unroll
    for (int ks = 0; ks < 4; ++ks) qf[ks] = *(const bf16x8*)(PROJ + qrow * NINP + C_QA + h * 128 + 32 * ks + 8 * g);
    asm volatile("s_waitcnt vmcnt(0)" ::: "memory");
    __syncthreads();
    const int s0 = wave >> 1;
    const unsigned q4 = ql >> 2, p4 = lane & 3;
    LAS unsigned char* kbase[2][4]; LAS unsigned char* vbase[8][2];
#pragma unroll
    for (int T = 0; T < 2; ++T)
#pragma unroll
        for (int ks = 0; ks < 4; ++ks) kbase[T][ks] = lds + offb(32 * s0 + 8 * (ql >> 2) + 4 * T + (ql & 3), 4 * ks + g);
#pragma unroll
    for (int c = 0; c < 8; ++c)
#pragma unroll
        for (int t = 0; t < 2; ++t) vbase[c][t] = lds + 65536u + offb(32 * s0 + 8 * g + 4 * t + q4, 2 * c + (p4 >> 1)) + 8u * (p4 & 1);
    f32x4 st[5][2];
#pragma unroll
    for (int s = 0; s < 5; ++s) {
        bf16x8 kf[2][4];
#pragma unroll
        for (int T = 0; T < 2; ++T)
#pragma unroll
            for (int ks = 0; ks < 4; ++ks) kf[T][ks] = *(const LAS bf16x8*)(kbase[T][ks] + 8192 * s);
        __builtin_amdgcn_sched_barrier(0);
#pragma unroll
        for (int T = 0; T < 2; ++T) {
            f32x4 a = (f32x4){0.f, 0.f, 0.f, 0.f};
#pragma unroll
            for (int ks = 0; ks < 4; ++ks) a = __builtin_amdgcn_mfma_f32_16x16x32_bf16(kf[T][ks], qf[ks], a, 0, 0, 0);
            st[s][T] = a;
        }
    }
    const float NINF = -__builtin_inff();
#pragma unroll
    for (int T = 0; T < 2; ++T)
#pragma unroll
        for (int e = 0; e < 4; ++e) {
            const int j0 = 32 * s0 + 8 * g + 4 * T + e, j4 = j0 + 128;
            st[0][T][e] = (j0 >= iloc) ? st[0][T][e] : NINF;
            st[4][T][e] = (j4 <= iloc + 128) ? st[4][T][e] : NINF;
        }
    if (n == 0) {
#pragma unroll
        for (int s = 0; s < 5; ++s)
#pragma unroll
            for (int T = 0; T < 2; ++T)
#pragma unroll
                for (int e = 0; e < 4; ++e) { const int j = 32 * (s0 + s) + 8 * g + 4 * T + e; st[s][T][e] = (j >= 128) ? st[s][T][e] : NINF; }
    }
    float mx = NINF;
#pragma unroll
    for (int s = 0; s < 5; ++s)
#pragma unroll
        for (int T = 0; T < 2; ++T) mx = fmaxf(fmaxf(mx, fmaxf(st[s][T][0], st[s][T][1])), fmaxf(st[s][T][2], st[s][T][3]));
    mx = fmaxf(mx, __shfl_xor(mx, 16)); mx = fmaxf(mx, __shfl_xor(mx, 32));
    const float SC2 = 0.08838834764831845f * 1.4426950408889634f, m2 = mx * SC2;
    float sum = 0.f;
    bf16x8 pf[5];
#pragma unroll
    for (int s = 0; s < 5; ++s) {
        float e[8];
#pragma unroll
        for (int T = 0; T < 2; ++T)
#pragma unroll
            for (int k = 0; k < 4; ++k) { const float x = __builtin_amdgcn_exp2f(__builtin_fmaf(st[s][T][k], SC2, -m2)); e[4 * T + k] = x; sum += x; }
        u32x4 w; w.x = pk2(e[0], e[1]); w.y = pk2(e[2], e[3]); w.z = pk2(e[4], e[5]); w.w = pk2(e[6], e[7]);
        pf[s] = __builtin_bit_cast(bf16x8, w);
    }
    sum += __shfl_xor(sum, 16); sum += __shfl_xor(sum, 32);
    f32x4 ot[8];
#pragma unroll
    for (int c = 0; c < 8; ++c) ot[c] = (f32x4){0.f, 0.f, 0.f, 0.f};
#pragma unroll
    for (int s = 0; s < 5; ++s) {
        v4i16_t lo[8], hi[8];
#pragma unroll
        for (int c = 0; c < 8; ++c) {
            lo[c] = __builtin_amdgcn_ds_read_tr16_b64_v4i16((LAS v4i16_t*)(vbase[c][0] + 8192 * s));
            hi[c] = __builtin_amdgcn_ds_read_tr16_b64_v4i16((LAS v4i16_t*)(vbase[c][1] + 8192 * s));
        }
        __builtin_amdgcn_sched_barrier(0);
#pragma unroll
        for (int c = 0; c < 8; ++c) {
            bf16x8 vf; vf[0] = lo[c][0]; vf[1] = lo[c][1]; vf[2] = lo[c][2]; vf[3] = lo[c][3]; vf[4] = hi[c][0]; vf[5] = hi[c][1]; vf[6] = hi[c][2]; vf[7] = hi[c][3];
            ot[c] = __builtin_amdgcn_mfma_f32_16x16x32_bf16(vf, pf[s], ot[c], 0, 0, 0);
        }
    }
    const float inv = 1.0f / sum;
    bf16* op = (bf16*)(P.ws + WS_OP) + ((size_t)p * MP + qrow) * 768 + h * 128 + 4 * g;
#pragma unroll
    for (int c = 0; c < 8; ++c) { u32x2 w; w.x = pk2(ot[c][0] * inv, ot[c][1] * inv); w.y = pk2(ot[c][2] * inv, ot[c][3] * inv); *(u32x2*)(op + 16 * c) = w; }
    if (g == 0) ((float*)(P.ws + WS_LSE))[((size_t)p * MP + qrow) * 6 + h] = mx * 0.08838834764831845f + __logf(sum);
    __syncthreads();
}
__device__ __forceinline__ void attn_combine(const Ptrs& P, int bx, int G, int wave, int lane) {
    const bf16* OP = (const bf16*)(P.ws + WS_OP); const float* LSE = (const float*)(P.ws + WS_LSE); bf16* MIX = (bf16*)(P.ws + WS_MIX);
    for (int tok = bx * NWAVES + wave; tok < MP; tok += G * NWAVES) {
        unsigned w[3][6]; float ls[3][6];
#pragma unroll
        for (int p = 0; p < 3; ++p)
#pragma unroll
            for (int h = 0; h < 6; ++h) { w[p][h] = *(const unsigned*)(OP + ((size_t)p * MP + tok) * 768 + h * 128 + 2 * lane); ls[p][h] = LSE[((size_t)p * MP + tok) * 6 + h]; }
#pragma unroll
        for (int h = 0; h < 6; ++h) {
            const float m = fmaxf(ls[0][h], fmaxf(ls[1][h], ls[2][h])), e0 = __expf(ls[0][h] - m), e1 = __expf(ls[1][h] - m), e2 = __expf(ls[2][h] - m), inv = 1.0f / (e0 + e1 + e2);
            const float a = (e0 * bf2f(w[0][h] & 0xffffu) + e1 * bf2f(w[1][h] & 0xffffu) + e2 * bf2f(w[2][h] & 0xffffu)) * inv;
            const float c = (e0 * bf2f(w[0][h] >> 16) + e1 * bf2f(w[1][h] >> 16) + e2 * bf2f(w[2][h] >> 16)) * inv;
            *(unsigned*)(MIX + (size_t)tok * D + M_A + h * 128 + 2 * lane) = pk2(a, c);
        }
    }
}
__device__ __forceinline__ void p_pool_wunit(const Ptrs& P, LAS unsigned char* lds, int l, int unit, int wave, int lane) {
    const bf16* PROJ = (const bf16*)(P.ws + WS_PROJ);
    const int grp = unit & 3, tb = unit >> 2, b = tb >> 8, t0 = (tb & 255) * 16;
    const int g = lane >> 4, ql = lane & 15, w = 2 << grp;
    LAS unsigned char* pl = lds + wave * 4352;
    const bf16* wpt = (const bf16*)(P.ws + WS_WPT) + (size_t)(l * 4 + grp) * 128 * 128;
    {
        const bf16* up = PROJ + (size_t)b * SEQ * NINP + C_UB + grp * 128 + 2 * lane;
        unsigned raw[31];
#pragma unroll
        for (int i = 0; i < 31; ++i) { const int tp = t0 - 15 + i; const unsigned v = *(const unsigned*)(up + (size_t)(tp >= 0 ? tp : 0) * NINP); raw[i] = (tp >= 0) ? v : 0u; }
        float p0[32], p1[32]; p0[0] = 0.f; p1[0] = 0.f;
#pragma unroll
        for (int i = 0; i < 31; ++i) { p0[i + 1] = p0[i] + bf2f(raw[i] & 0xffffu); p1[i + 1] = p1[i] + bf2f(raw[i] >> 16); }
#pragma unroll
        for (int tt = 0; tt < 16; ++tt) {
            const int t = t0 + tt; const float inv = 1.0f / (float)((t + 1 < w) ? (t + 1) : w);
            const int lo = (grp == 0) ? 14 + tt : (grp == 1) ? 12 + tt : (grp == 2) ? 8 + tt : tt;
            float s0, s1;
            if (grp == 0) { s0 = p0[16 + tt] - p0[14 + tt]; s1 = p1[16 + tt] - p1[14 + tt]; }
            else if (grp == 1) { s0 = p0[16 + tt] - p0[12 + tt]; s1 = p1[16 + tt] - p1[12 + tt]; }
            else if (grp == 2) { s0 = p0[16 + tt] - p0[8 + tt]; s1 = p1[16 + tt] - p1[8 + tt]; }
            else { s0 = p0[16 + tt] - p0[tt]; s1 = p1[16 + tt] - p1[tt]; }
            (void)lo;
            *(LAS unsigned*)(pl + tt * 272 + 4 * lane) = pk2(s0 * inv - bf2f(raw[15 + tt] & 0xffffu), s1 * inv - bf2f(raw[15 + tt] >> 16));
        }
    }
    asm volatile("s_waitcnt lgkmcnt(0)" ::: "memory");
    bf16x8 bfr[4];
#pragma unroll
    for (int ks = 0; ks < 4; ++ks) bfr[ks] = *(const LAS bf16x8*)(pl + ql * 272 + (32 * ks + 8 * g) * 2);
    bf16* mx = (bf16*)(P.ws + WS_MIX) + ((size_t)b * SEQ + t0 + ql) * D + M_B + grp * 128 + 4 * g;
#pragma unroll
    for (int hf = 0; hf < 2; ++hf) {
        bf16x8 af[4][4];
#pragma unroll
        for (int nt = 0; nt < 4; ++nt)
#pragma unroll
            for (int ks = 0; ks < 4; ++ks) af[nt][ks] = *(const bf16x8*)(wpt + (size_t)(16 * (4 * hf + nt) + ql) * 128 + 32 * ks + 8 * g);
#pragma unroll
        for (int nt = 0; nt < 4; ++nt) {
            f32x4 acc = (f32x4){0.f, 0.f, 0.f, 0.f};
#pragma unroll
            for (int ks = 0; ks < 4; ++ks) acc = __builtin_amdgcn_mfma_f32_16x16x32_bf16(af[nt][ks], bfr[ks], acc, 0, 0, 0);
            u32x2 o; o.x = pk2(acc[0], acc[1]); o.y = pk2(acc[2], acc[3]); *(u32x2*)(mx + 16 * (4 * hf + nt)) = o;
        }
    }
    asm volatile("s_waitcnt lgkmcnt(0)" ::: "memory");
}
__device__ __forceinline__ float logsig_fast(float z) { return fminf(z, 0.f) - __logf(1.0f + __expf(-fabsf(z))); }
__device__ __forceinline__ bf16x8 tr8(LAS unsigned char* vi, int tok0, int col, int q4, int p4) {
    const v4i16_t lo = __builtin_amdgcn_ds_read_tr16_b64_v4i16((LAS v4i16_t*)(vi + (tok0 + q4) * 400 + (col + 4 * p4) * 2));
    const v4i16_t hi = __builtin_amdgcn_ds_read_tr16_b64_v4i16((LAS v4i16_t*)(vi + (tok0 + 4 + q4) * 400 + (col + 4 * p4) * 2));
    bf16x8 r; r[0] = lo[0]; r[1] = lo[1]; r[2] = lo[2]; r[3] = lo[3]; r[4] = hi[0]; r[5] = hi[1]; r[6] = hi[2]; r[7] = hi[3]; return r;
}
__device__ __forceinline__ void gla1_dunit(const Ptrs& P, LAS unsigned char* lds, int l, int du, int tid, int wave, int lane) {
    const bf16* PROJ = (const bf16*)(P.ws + WS_PROJ);
    const int bh = du >> 5, b = bh >> 2, h = bh & 3, t0 = (du & 31) * 128, unit0 = bh * 64 + (du & 31) * 2;
    LAS float* gaL = (LAS float*)lds;
    LAS float* tot = (LAS float*)(lds + 8192);
    LAS unsigned char* KT = lds + 11264;
    LAS unsigned char* VI = lds + 38912;
    const bf16* pr = PROJ + ((size_t)b * SEQ + t0) * NINP;
    *(LAS f32x4*)(gaL + 4 * tid) = *(const f32x4*)((const float*)(P.ws + WS_GA) + ((size_t)b * SEQ + t0) * 16 + 4 * tid);
    const int dk = tid % 96, seg = tid / 96;
    float wg[16], bg = 0.f;
    if (tid < 384) {
#pragma unroll
        for (int r = 0; r < 16; ++r) wg[r] = P.in[I_WG2][(size_t)(l * 16 + r) * 384 + h * 96 + dk];
        bg = P.in[I_BG][l * 384 + h * 96 + dk];
    }
#pragma unroll
    for (int c2 = 0; c2 < 2; ++c2)
        for (int i = tid; i < 1536; i += NTHR) { const int j = i / 24, ch = i - 24 * j;
            *(LAS u32x4*)(VI + c2 * 25600 + j * 400 + ch * 16) = *(const u32x4*)(pr + (size_t)(64 * c2 + j) * NINP + C_VC + h * 192 + 8 * ch); }
    __syncthreads();
    float run[2][16];
    if (tid < 384) {
#pragma unroll
        for (int c2 = 0; c2 < 2; ++c2) {
            float acc = 0.f;
#pragma unroll
            for (int jj = 0; jj < 16; ++jj) {
                const LAS f32x4* gp = (const LAS f32x4*)(gaL + (64 * c2 + 16 * seg + jj) * 16);
                const f32x4 a0 = gp[0], a1 = gp[1], a2 = gp[2], a3 = gp[3];
                float z = bg;
                z += (a0[0] * wg[0] + a0[1] * wg[1]) + (a0[2] * wg[2] + a0[3] * wg[3]);
                z += (a1[0] * wg[4] + a1[1] * wg[5]) + (a1[2] * wg[6] + a1[3] * wg[7]);
                z += (a2[0] * wg[8] + a2[1] * wg[9]) + (a2[2] * wg[10] + a2[3] * wg[11]);
                z += (a3[0] * wg[12] + a3[1] * wg[13]) + (a3[2] * wg[14] + a3[3] * wg[15]);
                acc += logsig_fast(z) * (1.0f / 16.0f); run[c2][jj] = acc;
            }
            tot[(c2 * 4 + seg) * 96 + dk] = acc;
        }
    }
    __syncthreads();
    if (tid < 384) {
        float* bc = (float*)(P.ws + WS_BCUM) + ((size_t)b * SEQ + t0) * 384 + h * 96 + dk;
#pragma unroll
        for (int c2 = 0; c2 < 2; ++c2) {
            const float t0s = tot[(c2 * 4 + 0) * 96 + dk], t1s = tot[(c2 * 4 + 1) * 96 + dk], t2s = tot[(c2 * 4 + 2) * 96 + dk], t3s = tot[(c2 * 4 + 3) * 96 + dk];
            const float off = (seg > 0 ? t0s : 0.f) + (seg > 1 ? t1s : 0.f) + (seg > 2 ? t2s : 0.f), blast = ((t0s + t1s) + t2s) + t3s;
            const bf16* kp = pr + (size_t)(64 * c2 + 16 * seg) * NINP + C_KC + h * 96 + dk;
            float* bcp = bc + (size_t)(64 * c2 + 16 * seg) * 384;
#pragma unroll
            for (int j4 = 0; j4 < 4; ++j4) {
                unsigned short kr[4];
#pragma unroll
                for (int q = 0; q < 4; ++q) kr[q] = kp[(size_t)(4 * j4 + q) * NINP];
#pragma unroll
                for (int q = 0; q < 4; ++q) { const int jj = 4 * j4 + q, j = 16 * seg + jj; const float bb = run[c2][jj] + off;
                    bcp[(size_t)jj * 384] = bb;
                    ((LAS bf16*)(KT + c2 * 13824))[dk * 72 + j] = (bf16)f2bf(bf2f(kr[q]) * __expf(blast - bb)); }
                asm volatile("" ::: "memory");
            }
            if (seg == 3) ((float*)(P.ws + WS_DEC))[(size_t)(unit0 + c2) * 96 + dk] = __expf(blast);
        }
    }
    __syncthreads();
    const int g = lane >> 4, ql = lane & 15, q4 = ql >> 2, p4 = lane & 3, dkg = wave & 1, dvg = wave >> 1;
#pragma unroll
    for (int c2 = 0; c2 < 2; ++c2) {
        f32x4 acc[3][3];
#pragma unroll
        for (int a = 0; a < 3; ++a)
#pragma unroll
            for (int d = 0; d < 3; ++d) acc[a][d] = (f32x4){0.f, 0.f, 0.f, 0.f};
#pragma unroll
        for (int ks = 0; ks < 2; ++ks) {
            bf16x8 af[3], bfr[3];
#pragma unroll
            for (int a = 0; a < 3; ++a) af[a] = tr8(VI + c2 * 25600, 32 * ks + 8 * g, 16 * (3 * dvg + a), q4, p4);
#pragma unroll
            for (int d = 0; d < 3; ++d) bfr[d] = *(const LAS bf16x8*)(KT + c2 * 13824 + (16 * (3 * dkg + d) + ql) * 144 + (32 * ks + 8 * g) * 2);
#pragma unroll
            for (int a = 0; a < 3; ++a)
#pragma unroll
                for (int d = 0; d < 3; ++d) acc[a][d] = __builtin_amdgcn_mfma_f32_16x16x32_bf16(af[a], bfr[d], acc[a][d], 0, 0, 0);
        }
        bf16* sl = (bf16*)(P.ws + WS_SLOC) + (size_t)(unit0 + c2) * SELEMS;
#pragma unroll
        for (int a = 0; a < 3; ++a)
#pragma unroll
            for (int d = 0; d < 3; ++d)
#pragma unroll
                for (int e = 0; e < 4; ++e) sl[(size_t)(16 * (3 * dvg + a) + 4 * g + e) * 96 + 16 * (3 * dkg + d) + ql] = (bf16)f2bf(acc[a][d][e]);
    }
    __syncthreads();
}
__device__ __forceinline__ void gla2_scan(const Ptrs& P, int l, int bx, int G, int tid) {
    const unsigned* SL = (const unsigned*)(P.ws + WS_SLOC); unsigned* ST = (unsigned*)(P.ws + WS_SST); const float* DEC = (const float*)(P.ws + WS_DEC);
    const int per = (8 * (SELEMS / 2) + G - 1) / G;
    for (int e2 = bx * per + tid; tid < per && e2 < 8 * (SELEMS / 2) && e2 < (bx + 1) * per; e2 += NTHR) {
        const int bh = e2 / (SELEMS / 2), rem = 2 * (e2 - bh * (SELEMS / 2)), dv = rem / 96, dk = rem - 96 * dv;
        float S0 = 0.f, S1 = 0.f;
#pragma unroll 32
        for (int n = 0; n < NCH; ++n) {
            const size_t idx = (size_t)(bh * NCH + n) * SELEMS + rem;
            const unsigned slp = SL[idx >> 1]; const f32x2 dc = *(const f32x2*)(DEC + (size_t)(bh * NCH + n) * 96 + dk);
            ST[idx >> 1] = pk2(S0, S1); S0 = dc[0] * S0 + bf2f(slp & 0xffffu); S1 = dc[1] * S1 + bf2f(slp >> 16);
        }
        float* o = P.out + O_PG + (size_t)(l * 8 + bh) * SELEMS;
        o[(size_t)dk * 192 + dv] = S0; o[(size_t)(dk + 1) * 192 + dv] = S1;
    }
}
__device__ __forceinline__ void gla3_dunit(const Ptrs& P, LAS unsigned char* lds, int l, int du, int tid, int wave, int lane) {
    const bf16* PROJ = (const bf16*)(P.ws + WS_PROJ);
    const int bh = du >> 5, b = bh >> 2, h = bh & 3, t0 = (du & 31) * 128, unit0 = bh * 64 + (du & 31) * 2;
    LAS unsigned char* QE = lds; LAS unsigned char* KE = lds + 26624; LAS unsigned char* VI = lds + 53248;
    const int g = lane >> 4, ql = lane & 15, q4 = ql >> 2, p4 = lane & 3, it = wave & 3, c2 = wave >> 2, iloc = 16 * it + ql;
    const bf16* pr = PROJ + ((size_t)b * SEQ + t0) * NINP;
    const float* bc = (const float*)(P.ws + WS_BCUM) + ((size_t)b * SEQ + t0) * 384 + h * 96;
    for (int i = tid; i < 12288; i += NTHR) { const int j = i / 96, dk = i - 96 * j, cc = j >> 6, jl = j & 63; const float bb = bc[(size_t)j * 384 + dk];
        const float q = bf2f(pr[(size_t)j * NINP + C_QC + h * 96 + dk]) * 0.10206207261596575f, k = bf2f(pr[(size_t)j * NINP + C_KC + h * 96 + dk]);
        ((LAS bf16*)(QE + cc * 13312))[jl * 104 + dk] = (bf16)f2bf(q * __expf(bb)); ((LAS bf16*)(KE + cc * 13312))[jl * 104 + dk] = (bf16)f2bf(k * __expf(-bb)); }
    for (int i = tid; i < 3072; i += NTHR) { const int j = i / 24, ch = i - 24 * j, cc = j >> 6, jl = j & 63;
        *(LAS u32x4*)(VI + cc * 25600 + jl * 400 + ch * 16) = *(const u32x4*)(pr + (size_t)j * NINP + C_VC + h * 192 + 8 * ch); }
    __syncthreads();
    LAS unsigned char* qe = QE + c2 * 13312; LAS unsigned char* ke = KE + c2 * 13312; LAS unsigned char* vi = VI + c2 * 25600;
    const bf16* sst = (const bf16*)(P.ws + WS_SST) + (size_t)(unit0 + c2) * SELEMS;
    const int nst = (it >> 1) + 1;
    bf16x8 qfr[3];
#pragma unroll
    for (int ks = 0; ks < 3; ++ks) qfr[ks] = *(const LAS bf16x8*)(qe + iloc * 208 + (32 * ks + 8 * g) * 2);
    bf16x8 pf[2];
#pragma unroll
    for (int js = 0; js < 2; ++js) {
        u32x4 w = (u32x4){0u, 0u, 0u, 0u};
        if (js < nst) {
#pragma unroll
            for (int T = 0; T < 2; ++T) {
                const int jrow = 32 * js + 8 * q4 + 4 * T + (ql & 3);
                f32x4 a = (f32x4){0.f, 0.f, 0.f, 0.f};
                bf16x8 kf[3];
#pragma unroll
                for (int ks = 0; ks < 3; ++ks) kf[ks] = *(const LAS bf16x8*)(ke + jrow * 208 + (32 * ks + 8 * g) * 2);
#pragma unroll
                for (int ks = 0; ks < 3; ++ks) a = __builtin_amdgcn_mfma_f32_16x16x32_bf16(kf[ks], qfr[ks], a, 0, 0, 0);
                float e[4];
#pragma unroll
                for (int k = 0; k < 4; ++k) { const int j = 32 * js + 8 * g + 4 * T + k; e[k] = (j <= iloc) ? a[k] : 0.f; }
                if (T == 0) { w.x = pk2(e[0], e[1]); w.y = pk2(e[2], e[3]); } else { w.z = pk2(e[0], e[1]); w.w = pk2(e[2], e[3]); }
            }
        }
        pf[js] = __builtin_bit_cast(bf16x8, w);
    }
    f32x4 ot[12];
    float ss = 0.f;
#pragma unroll
    for (int hv = 0; hv < 2; ++hv) {
        bf16x8 sf[6][3];
#pragma unroll
        for (int a = 0; a < 6; ++a)
#pragma unroll
            for (int ks = 0; ks < 3; ++ks) sf[a][ks] = *(const bf16x8*)(sst + (size_t)(16 * (6 * hv + a) + ql) * 96 + 32 * ks + 8 * g);
#pragma unroll
        for (int a = 0; a < 6; ++a) ot[6 * hv + a] = (f32x4){0.f, 0.f, 0.f, 0.f};
#pragma unroll
        for (int js = 0; js < 2; ++js) if (js < nst) {
            bf16x8 vf[6];
#pragma unroll
            for (int a = 0; a < 6; ++a) vf[a] = tr8(vi, 32 * js + 8 * g, 16 * (6 * hv + a), q4, p4);
#pragma unroll
            for (int a = 0; a < 6; ++a) ot[6 * hv + a] = __builtin_amdgcn_mfma_f32_16x16x32_bf16(vf[a], pf[js], ot[6 * hv + a], 0, 0, 0);
        }
#pragma unroll
        for (int a = 0; a < 6; ++a)
#pragma unroll
            for (int ks = 0; ks < 3; ++ks) ot[6 * hv + a] = __builtin_amdgcn_mfma_f32_16x16x32_bf16(sf[a][ks], qfr[ks], ot[6 * hv + a], 0, 0, 0);
#pragma unroll
        for (int a = 0; a < 6; ++a) { const f32x4 o = ot[6 * hv + a]; ss += (o[0] * o[0] + o[1] * o[1]) + (o[2] * o[2] + o[3] * o[3]); }
    }
    ss += __shfl_xor(ss, 16); ss += __shfl_xor(ss, 32);
    const float rstd = rsqrtf(ss * (1.0f / 192.0f) + EPS);
    const size_t r = (size_t)b * SEQ + t0 + 64 * c2 + iloc;
    bf16* MIX = (bf16*)(P.ws + WS_MIX);
#pragma unroll
    for (int a = 0; a < 12; ++a) {
        const int dv0 = 16 * a + 4 * g;
        const u32x2 rc = *(const u32x2*)(PROJ + r * NINP + C_RC + h * 192 + dv0); const f32x4 gn = *(const f32x4*)(P.in[I_GNG] + l * 192 + dv0);
        u32x2 w;
        w.x = pk2(ot[a][0] * rstd * gn[0] * silu(bf2f(rc.x & 0xffffu)), ot[a][1] * rstd * gn[1] * silu(bf2f(rc.x >> 16)));
        w.y = pk2(ot[a][2] * rstd * gn[2] * silu(bf2f(rc.y & 0xffffu)), ot[a][3] * rstd * gn[3] * silu(bf2f(rc.y >> 16)));
        *(u32x2*)(MIX + r * D + M_C + h * 192 + dv0) = w;
    }
    __syncthreads();
}
__device__ __forceinline__ void final_norm(const Ptrs& P, int bx, int G, int wave, int lane) {
    const bf16* X = (const bf16*)(P.ws + WS_XB); const float* part2 = (const float*)(P.ws + WS_PART2); const float* spart2 = (const float*)(P.ws + WS_SPART2); const float* g = P.in[I_FNG];
    for (int row = bx * NWAVES + wave; row < MT; row += G * NWAVES) {
        float ss;
        if (row < MP) ss = (lane < 8) ? part2[(size_t)row * 8 + lane] : 0.f;
        else ss = spart2[(size_t)(row - MP) * 128 + lane] + spart2[(size_t)(row - MP) * 128 + 64 + lane];
        const float rs = rsqrtf(wave_sum(ss) * (1.0f / 2048.0f) + EPS);
#pragma unroll
        for (int j = 0; j < 4; ++j) {
            const size_t c = 8 * lane + 512 * j; const u32x4 q = *(const u32x4*)(X + (size_t)row * D + c);
            const f32x4 g0 = *(const f32x4*)(g + c), g1 = *(const f32x4*)(g + c + 4);
            const f32x4 v0 = {bf2f(q.x & 0xffffu), bf2f(q.x >> 16), bf2f(q.y & 0xffffu), bf2f(q.y >> 16)}, v1 = {bf2f(q.z & 0xffffu), bf2f(q.z >> 16), bf2f(q.w & 0xffffu), bf2f(q.w >> 16)};
            *(f32x4*)(P.out + (size_t)row * D + c) = v0 * rs * g0; *(f32x4*)(P.out + (size_t)row * D + c + 4) = v1 * rs * g1;
        }
    }
}

#ifndef REP_PRO
#define REP_PRO 1
#endif
#ifndef REP_GLA1
#define REP_GLA1 1
#endif
#ifndef REP_GLA2
#define REP_GLA2 1
#endif
#ifndef REP_GLA3
#define REP_GLA3 1
#endif
#ifndef REP_POOL
#define REP_POOL 1
#endif
#ifndef REP_SMIX
#define REP_SMIX 1
#endif
#ifndef REP_PATTN
#define REP_PATTN 1
#endif
#ifndef REP_COMB
#define REP_COMB 1
#endif
#ifndef REP_BAR
#define REP_BAR 1
#endif
#ifndef REP_INPROJ
#define REP_INPROJ 1
#endif
#ifndef PG8_SP2
#define PG8_SP2 true
#endif
#ifndef TS_A
#define TS_A -1
#endif
#ifndef TS_B
#define TS_B -1
#endif
#ifndef TS_L
#define TS_L 1
#endif
#ifndef PG8_ALIGN_IG
#define PG8_ALIGN_IG true
#endif
#ifndef PA_ROT
#define PA_ROT 32
#endif
#ifndef REP_PH2
#define REP_PH2 1
#endif
#ifndef REP_PH4
#define REP_PH4 1
#endif
#ifndef REP_SGLA
#define REP_SGLA 1
#endif
#ifndef REP_SPOOL
#define REP_SPOOL 1
#endif
#ifndef REP_OUT
#define REP_OUT 1
#endif
#ifndef REP_DOWN
#define REP_DOWN 1
#endif
#ifndef REP_GU
#define REP_GU 1
#endif
#ifndef REP_SKINNY
#define REP_SKINNY 1
#endif
#ifndef MK_PER_PHASE
#define MK_PER_PHASE 0
#endif
constexpr int NPH = 30;
#ifndef MK_FILL
#define MK_FILL 1
#endif
#ifndef FILL_NCW
#define FILL_NCW 4
#endif
constexpr int NCW = FILL_NCW, CV_TOTAL = 3 * CV_L;
__device__ __forceinline__ void seam_fill(const XcdBarrier& b, const Ptrs& P, LAS unsigned char* lds, int bx, int G, int deadline, int limit) {
    int tid = threadIdx.x; asm volatile("" : "+v"(tid));
    const int wave = __builtin_amdgcn_readfirstlane(tid >> 6), lane = tid & 63;
    volatile LAS unsigned* cw = (volatile LAS unsigned*)(lds + MISC_OFF);
    const bool conv = (wave >= 1 && wave <= NCW);
    const int nwk = G * NCW;
    LAS float* scr = (LAS float*)(lds + (wave - 1) * 16640);
    int cur = conv ? (int)__builtin_amdgcn_readfirstlane(cw[16 + wave]) : CV_TOTAL;
    if (deadline > 0) {
        __syncthreads();
        if (conv) while (cur < deadline) { cvt_item(P, 1 + cur / CV_L, cur % CV_L, scr, lane); cur += nwk; }
    }
    asm volatile("s_waitcnt vmcnt(0)" ::: "memory");
    if (tid == 0) cw[0] = 0u;
    __syncthreads();
    if (wave == 0) {
        if (tid == 0) {
            unsigned* bar = b.bar;
            __builtin_amdgcn_s_waitcnt(0);
            unsigned nloc = b.st[0], nx = b.st[1];
            if (nloc == 0u) { xcd_barrier_complete(bar, b.x, nloc, nx); b.st[0] = nloc; b.st[1] = nx; }
            const unsigned old = xb_add(&bar[XB_XSUB(b.x)], 1u);
            const unsigned gen = old / nloc;
            if (old + 1u == (gen + 1u) * nloc) {
                __builtin_amdgcn_fence(__ATOMIC_RELEASE, "agent");
                asm volatile("s_waitcnt vmcnt(0)" ::: "memory");
                const unsigned og = xb_add(&bar[XB_TOP], 1u);
                const unsigned tg = og / nx;
                if (og + 1u == (tg + 1u) * nx) xb_add(&bar[XB_TOPGEN], 1u);
                else XB_SPIN(xb_ld(&bar[XB_TOPGEN]) == tg, bar);
                __builtin_amdgcn_fence(__ATOMIC_ACQUIRE, "agent");
                xb_add(&bar[XB_XGEN(b.x)], 1u);
                asm volatile("s_waitcnt vmcnt(0)" ::: "memory");
            } else {
                XB_SPIN(xb_ld(&bar[XB_XGEN(b.x)]) == gen, bar);
                __builtin_amdgcn_fence(__ATOMIC_ACQUIRE, "agent");
                asm volatile("s_waitcnt vmcnt(0)" ::: "memory");
            }
            cw[0] = 1u;
        }
    } else if (conv) {
        for (int nd = 0; nd < limit && cur < CV_TOTAL && __builtin_amdgcn_readfirstlane(cw[0]) == 0u; ++nd) { cvt_item(P, 1 + cur / CV_L, cur % CV_L, scr, lane); cur += nwk; }
    }
    if (conv && lane == 0) cw[16 + wave] = (unsigned)cur;
    __syncthreads();
}
struct Args { const float* in[N_IN]; float* out; unsigned char* ws; int ph_lo, ph_hi, li, pad; };

__global__ void __launch_bounds__(NTHR, 2) fwd(Args args) {
    extern __shared__ __attribute__((aligned(16))) unsigned char lds_raw[];
    LAS unsigned char* lds = (LAS unsigned char*)lds_raw;
    const int tid = threadIdx.x, lane = tid & 63, wave = __builtin_amdgcn_readfirstlane(tid >> 6);
    const int G = gridDim.x, bx = blockIdx.x;
    Ptrs P;
#pragma unroll
    for (int i = 0; i < N_IN; ++i) P.in[i] = args.in[i];
    P.out = args.out; P.ws = args.ws;
    for (int u = tid; u < (LDS_BYTES - LDSCTL_OFF) / 4; u += NTHR) ((LAS unsigned*)(lds + LDSCTL_OFF))[u] = 0u;
    __syncthreads();
    if (tid < NWAVES) ((volatile LAS unsigned*)(lds + MISC_OFF))[16 + tid] = (tid >= 1 && tid <= NCW) ? (unsigned)(bx * NCW + tid - 1) : (unsigned)CV_TOTAL;
    __syncthreads();
    unsigned* ctl = (unsigned*)(args.ws + WS_CTL);
    XcdBarrier bar; bar.bar = ctl + CW_BAR; bar.x = 0; bar.st = nullptr;
    if (!MK_PER_PHASE) bar = xcd_barrier_post(ctl + CW_BAR, (volatile LAS unsigned*)(lds + MISC_OFF) + 8);
    const int lo = args.ph_lo, hi = args.ph_hi;
#define IN(k) (lo <= (k) && (k) < hi)
#define STAMP(kk) do { if (TS_A >= 0 && bx == 0 && tid == 0) ((volatile LAS unsigned*)(lds + LDSCTL_OFF + 1024))[l * 32 + (kk)] = (unsigned)__builtin_amdgcn_s_memrealtime(); } while (0)
#define LAUNDER() int tid_ = tid; asm volatile("" : "+v"(tid_)); const int lane_ = tid_ & 63, wave_ = __builtin_amdgcn_readfirstlane(tid_ >> 6); (void)lane_; (void)wave_
#ifndef FILL_LIM
#define FILL_LIM 2
#endif
#ifndef FILL_TAIL
#define FILL_TAIL (1 << 20)
#endif
#define SEAM(k) SEAMD(k, 0)
#define SEAMD(k, dl) SEAML(k, dl, FILL_LIM)
#define SEAML(k, dl, lim) do { if (IN((k) + 1)) { if (!MK_PER_PHASE) { if (MK_FILL) { seam_fill(bar, P, lds, bx, G, (dl), (lim)); } else { xcd_barrier(bar); } for (int rb_ = 1; rb_ < REP_BAR; ++rb_) xcd_barrier(bar); } } } while (0)

    float* part1 = (float*)(args.ws + WS_PART1); float* part2 = (float*)(args.ws + WS_PART2); float* spart1 = (float*)(args.ws + WS_SPART1); float* spart2 = (float*)(args.ws + WS_SPART2);
    pg8::PG8_LAS_T xch = (pg8::PG8_LAS_T)(lds + XCH_OFF);
    bf16* XB = (bf16*)(args.ws + WS_XB); bf16* MIXB = (bf16*)(args.ws + WS_MIX); bf16* PROJ = (bf16*)(args.ws + WS_PROJ); bf16* FB = (bf16*)(args.ws + WS_F);
    float* projs = (float*)(args.ws + WS_PROJS);

    if (IN(0)) { for (int rep = 0; rep < REP_PRO; ++rep) { LAUNDER(); prologue(P, lds, bx, G, wave_, lane_, tid_, (MK_FILL && !MK_PER_PHASE) ? 1 : DEPTH); __syncthreads(); } SEAM(0); }

    for (int l = 0; l < DEPTH; ++l) {
        const int pb = 1 + 7 * l;
        unsigned char* wl = args.ws + WS_W + (size_t)l * LW_SZ;
        const bf16* Win = (const bf16*)(wl + LW_IN); const bf16* Wo = (const bf16*)(wl + LW_O); const bf16* Wgu = (const bf16*)(wl + LW_GU); const bf16* Wd = (const bf16*)(wl + LW_D);

        if (IN(pb + 0)) {
            LAUNDER(); STAMP(1);
            for (int rep = 0; rep < REP_INPROJ; ++rep) {
                pg8::Gemm g{XB, Win, MP, NINP, D}; pg8::StaticOrder S; S.init(MP, NINP, G, bx);
                pg8::EpiInProj E{PROJ, part2, (float*)(args.ws + WS_GA), P.out + O_PK + (size_t)l * 3145728, P.out + O_PV + (size_t)l * 3145728, P.out + O_PP + (size_t)l * 15360};
                pg8::gemm_phase<pg8::EpiInProj, pg8::StaticOrder, PG8_ALIGN_IG, PG8_SP2>(lds, g, S, E);
            }
            const int sh1 = (672 % G) ? (672 % G) : 0, ns1 = G - sh1;
            for (int rep = 0; rep < REP_SKINNY; ++rep) for (int u = bx - sh1; u >= 0 && u < 161; u += ns1) {
                const int t0 = 2 * u, t1 = (2 * u + 1 < 321) ? 2 * u + 1 : 320;
                SEpiInProj E{projs, skinny_rs(spart2, 0, tid_), skinny_rs(spart2, 32, tid_), P.out + O_SK + (size_t)l * 49152, P.out + O_SV + (size_t)l * 49152, P.out + O_SP + (size_t)l * 61440, 16 * t0};
                skinny_unit<4, 2, 4>(lds, XB + (size_t)MP * D, Win + (size_t)16 * t0 * D, Win + (size_t)16 * t1 * D, D, 0, (2 * u + 1 < 321) ? 2 : 1, E, wave_, lane_, tid_);
            }
            STAMP(24); SEAML(pb + 0, 0, (672 % G != 0 && bx >= 672 % G) ? FILL_TAIL : FILL_LIM);
        }
        if (IN(pb + 1)) {
            for (int rp2 = 0; rp2 < REP_PH2; ++rp2) {
            if (rp2 > 0 && !MK_PER_PHASE) xcd_barrier(bar);
            STAMP(2);
            for (int rep = 0; rep < REP_SMIX; ++rep) { LAUNDER(); for (int u = bx; u < 192; u += G) s_attn_punit(P, lds, l, u, wave_, lane_, tid_); }
            STAMP(3);
            for (int rep = 0; rep < REP_SPOOL; ++rep) { LAUNDER(); for (int u = (bx + G - 192 % G) % G; u < 64; u += G) s_pool_unit(P, lds, l, u, tid_); }
            for (int rep = 0; rep < REP_SGLA; ++rep) { LAUNDER(); for (int u = (bx + G - 160 % G) % G; u < 32; u += G) s_gla_unit(P, lds, l, u, tid_); }
            STAMP(5);
            for (int rep = 0; rep < REP_GLA1; ++rep) { LAUNDER(); for (int u = bx; u < 256; u += G) gla1_dunit(P, lds, l, u, tid_, wave_, lane_); }
            STAMP(6);
            for (int rep = 0; rep < REP_POOL; ++rep) { LAUNDER(); for (int u = bx * NWAVES + wave_; u < 2048; u += G * NWAVES) p_pool_wunit(P, lds, l, u, wave_, lane_); __syncthreads(); }
            STAMP(7);
            for (int rep = 0; rep < REP_PATTN; ++rep) { LAUNDER(); for (int u = (bx + G - PA_ROT % G) % G; u < 1152; u += G) p_attn_unit(P, lds, u, wave_, lane_); }
            }
            STAMP(8); SEAM(pb + 1);
        }
        if (IN(pb + 2)) { STAMP(9); for (int rep = 0; rep < REP_GLA2; ++rep) { LAUNDER(); gla2_scan(P, l, bx, G, tid_); } STAMP(10); SEAM(pb + 2); }
        if (IN(pb + 3)) { STAMP(11); for (int rp4 = 0; rp4 < REP_PH4; ++rp4) { if (rp4 > 0 && !MK_PER_PHASE) xcd_barrier(bar); for (int rep = 0; rep < REP_GLA3; ++rep) { LAUNDER(); for (int u = bx; u < 256; u += G) gla3_dunit(P, lds, l, u, tid_, wave_, lane_); } STAMP(12); for (int rep = 0; rep < REP_COMB; ++rep) { LAUNDER(); attn_combine(P, bx, G, wave_, lane_); } } STAMP(13); SEAMD(pb + 3, (l > 0) ? CV_L * (l - 1) + CV_IN + CV_O : 0); }
        if (IN(pb + 4)) {
            LAUNDER(); STAMP(14);
            for (int rep = 1; rep < REP_OUT; ++rep) {
                pg8::Gemm g{MIXB, Wo, MP, D, D}; pg8::StaticOrder S; S.init(MP, D, G, bx);
                pg8::EpiResid E{XB, (bf16*)(args.ws + WS_F), (float*)(args.ws + WS_GA), xch};
                pg8::gemm_phase<pg8::EpiResid, pg8::StaticOrder, true, PG8_SP2>(lds, g, S, E);
            }
            {
                pg8::Gemm g{MIXB, Wo, MP, D, D}; pg8::StaticOrder S; S.init(MP, D, G, bx);
                pg8::EpiResid E{XB, XB, part1, xch};
                pg8::gemm_phase<pg8::EpiResid, pg8::StaticOrder, true, PG8_SP2>(lds, g, S, E);
            }
            for (int u = G - 1 - bx; u < 256; u += G) {
                const int rh = u & 1, ct = u >> 1;
                SEpiResid E{XB + (size_t)MP * D, XB + (size_t)MP * D, spart1, 16 * ct};
                skinny_unit<2, 1, 8>(lds, MIXB + (size_t)MP * D, Wo + (size_t)16 * ct * D, Wo, D, 32 * rh, 1, E, wave_, lane_, tid_);
            }
            STAMP(16); SEAMD(pb + 4, (l > 0) ? CV_L * (l - 1) + CV_IN + CV_O + 2 * CV_G : 0);
        }
        if (IN(pb + 5)) {
            LAUNDER(); STAMP(17);
            for (int rep = 0; rep < REP_GU; ++rep) {
                pg8::Gemm g{XB, Wgu, MP, NGU, D}; pg8::StaticOrder S; S.init(MP, NGU, G, bx);
                pg8::EpiGateUp E{FB, part1};
                pg8::gemm_phase<pg8::EpiGateUp, pg8::StaticOrder, PG8_ALIGN_IG, PG8_SP2>(lds, g, S, E);
            }
            const int sh2 = (1408 % G) ? (1408 % G) : 0, ns2 = G - sh2;
            for (int rep = 0; rep < REP_SKINNY; ++rep) for (int u = bx - sh2; u >= 0 && u < 352; u += ns2) {
                const int f0 = 16 * u; const size_t gr = (size_t)(256 * (f0 >> 7) + (f0 & 127));
                SEpiGateUp E{FB, skinny_rs(spart1, 0, tid_), skinny_rs(spart1, 32, tid_), f0, 0.f, 0.f};
                skinny_unit<4, 2, 4>(lds, XB + (size_t)MP * D, Wgu + gr * D, Wgu + (gr + 128) * D, D, 0, 2, E, wave_, lane_, tid_);
            }
            STAMP(19); SEAML(pb + 5, (l > 0) ? CV_L * l : 0, (1408 % G != 0 && bx >= 1408 % G) ? FILL_TAIL : FILL_LIM);
        }
        if (IN(pb + 6)) {
            LAUNDER(); STAMP(20);
            for (int rep = 1; rep < REP_DOWN; ++rep) {
                pg8::Gemm g{FB, Wd, MP, D, DFF}; pg8::StaticOrder S; S.init(MP, D, G, bx);
                pg8::EpiResid E{XB, (bf16*)(args.ws + WS_MIX), (float*)(args.ws + WS_GA), xch};
                pg8::gemm_phase<pg8::EpiResid, pg8::StaticOrder, true, PG8_SP2>(lds, g, S, E);
            }
            {
                pg8::Gemm g{FB, Wd, MP, D, DFF}; pg8::StaticOrder S; S.init(MP, D, G, bx);
                pg8::EpiResid E{XB, XB, part2, xch};
                pg8::gemm_phase<pg8::EpiResid, pg8::StaticOrder, true, PG8_SP2>(lds, g, S, E);
            }
            for (int u = G - 1 - bx; u < 256; u += G) {
                const int rh = u & 1, ct = u >> 1;
                SEpiResid E{XB + (size_t)MP * D, XB + (size_t)MP * D, spart2, 16 * ct};
                skinny_unit<2, 1, 8>(lds, FB + (size_t)MP * DFF, Wd + (size_t)16 * ct * DFF, Wd, DFF, 32 * rh, 1, E, wave_, lane_, tid_);
            }
            STAMP(22); SEAMD(pb + 6, (l + 1 < DEPTH) ? CV_L * l + CV_IN : 0); STAMP(23);
        }
    }
    if (IN(29)) { LAUNDER(); final_norm(P, bx, G, wave_, lane_);
        if (TS_A >= 0 && bx == 0) {
            __syncthreads();
            const volatile LAS unsigned* ts = (const volatile LAS unsigned*)(lds + LDSCTL_OFF + 1024);
            unsigned acc_ = 0; for (int l_ = 0; l_ < DEPTH; ++l_) acc_ += ts[l_ * 32 + (TS_B < 0 ? 0 : TS_B)] - ts[l_ * 32 + (TS_A < 0 ? 0 : TS_A)];
            const float c = floorf(((float)acc_ * 0.01f + (float)TS_L) * (1.0f / 16.0f)) * 0.4f;
            for (int i = tid; i < MS * D; i += NTHR) P.out[O_YS + i] = c;
        }
    }
#undef IN
#undef SEAM
}

extern "C" void kernel_launch(void* const* d_in, const int* in_sizes, int n_in, void* d_out, int out_size, void* d_ws, size_t ws_size, hipStream_t stream) {
    static int grid = 0;
    if (grid == 0) {
        if (n_in != N_IN || (size_t)out_size != O_END || ws_size < WS_END) { fprintf(stderr, "kernel_launch: unexpected sizes n_in %d out %d ws %zu\n", n_in, out_size, ws_size); grid = -1; return; }
        int dev = 0, cus = 0, per_cu = 0;
        if (hipGetDevice(&dev) != hipSuccess || hipDeviceGetAttribute(&cus, hipDeviceAttributeMultiprocessorCount, dev) != hipSuccess) { grid = -1; return; }
        if (hipFuncSetAttribute((const void*)fwd, hipFuncAttributeMaxDynamicSharedMemorySize, LDS_BYTES) != hipSuccess) { fprintf(stderr, "kernel_launch: hipFuncSetAttribute failed\n"); grid = -1; return; }
        if (hipOccupancyMaxActiveBlocksPerMultiprocessor(&per_cu, (const void*)fwd, NTHR, LDS_BYTES) != hipSuccess || per_cu < 1) { fprintf(stderr, "kernel_launch: occupancy query says %d\n", per_cu); }
        (void)hipGetLastError();
        grid = cus;
    }
    if (grid < 0) return;
    (void)hipMemsetAsync((char*)d_ws + WS_CTL, 0, CTL_ZERO_BYTES, stream);
    Args a{};
    for (int i = 0; i < N_IN; ++i) a.in[i] = (const float*)d_in[i];
    a.out = (float*)d_out; a.ws = (unsigned char*)d_ws; a.li = 0; a.pad = 0;
#if MK_PER_PHASE
    for (int p = 0; p < NPH; ++p) { a.ph_lo = p; a.ph_hi = p + 1; hipLaunchKernelGGL(fwd, dim3(grid), dim3(NTHR), LDS_BYTES, stream, a); }
#else
    a.ph_lo = 0; a.ph_hi = NPH;
    hipLaunchKernelGGL(fwd, dim3(grid), dim3(NTHR), LDS_BYTES, stream, a);
#endif
    const hipError_t le = hipPeekAtLastError();
    if (le != hipSuccess) fprintf(stderr, "kernel_launch: launch failed: %s\n", hipGetErrorName(le));
}
```

```cpp
#include <hip/hip_runtime.h>
#include <cstdio>
#include <cstdint>
namespace pg8 {
#define PG8_LAS __attribute__((address_space(3)))
typedef unsigned short bf16_t;
typedef PG8_LAS float* PG8_LAS_T;
typedef short bf16x8 __attribute__((ext_vector_type(8)));
typedef float f32x4 __attribute__((ext_vector_type(4)));
typedef unsigned u32x4 __attribute__((ext_vector_type(4)));
#ifndef PG8_WGM
#define PG8_WGM 4
#endif
constexpr int BM = 256, BK = 64, HALF = 128, HTB = HALF * BK * 2  , STAGE_BYTES = 8 * HTB, NXCD = 8, WGM = PG8_WGM;

__host__ __device__ __forceinline__ int lds_byte(int r, int c) { const int st = (r >> 4) * 2 + (c >> 5), rr = r & 15, cc = c & 31, ob = rr * 64 + cc * 2; return st * 1024 + (ob ^ (((ob >> 9) & 1) << 5)); }
__host__ __device__ __forceinline__ void stage_rc(int b, int& R, int& C) { const int st = b / 1024, sb = b % 1024, swz = sb ^ (((sb >> 9) & 1) << 5); R = (st >> 1) * 16 + swz / 64; C = (st & 1) * 32 + (swz % 64) / 2; }
__host__ __device__ __forceinline__ int perm32(int rho) { const int n = rho >> 4, i = rho & 15; return 8 * (i >> 2) + 4 * n + (i & 3); }

struct Unit { int pm, pn; };
struct Gemm { const bf16_t* A; const bf16_t* Bt; int M, N, K; };

struct StaticOrder {
    int nM, nN, nwg, G, c;
    __host__ __device__ void init(int M, int N, int G_, int c_) { nM = M / BM; nN = N / BM; nwg = nM * nN; G = G_; c = c_; }
    __host__ __device__ bool next(int i, Unit& u) const {
        const long L = (long)i * G + c; if (L >= nwg) return false;
        int wgid = (int)L; { const int q = nwg / NXCD, r = nwg % NXCD, xcd = wgid % NXCD, off = wgid / NXCD; wgid = (xcd < r ? xcd * (q + 1) : r * (q + 1) + (xcd - r) * q) + off; }
        const int nig = WGM * nN, gid = wgid / nig, fm = gid * WGM, gsz = (nM - fm) < WGM ? (nM - fm) : WGM;
        u.pm = fm + ((wgid % nig) % gsz); u.pn = (wgid % nig) / gsz; return true;
    }
    __device__ __forceinline__ void a_ready(const Unit&) const {}
    __device__ __forceinline__ void done(const Unit&) const {}
};

#ifndef EPI_NT
#define EPI_NT 0
#endif

__device__ __forceinline__ unsigned cvt_pk_bf16(float lo, float hi) { unsigned r; asm volatile("v_cvt_pk_bf16_f32 %0, %1, %2" : "=v"(r) : "v"(lo), "v"(hi)); return r; }
__device__ __forceinline__ float silu_f(float x) { return x * __builtin_amdgcn_rcpf(1.0f + __expf(-x)); }

struct EpiInProj {
    static constexpr bool PERM = true, AFTER_DRAIN = false;
    bf16_t* P; const float* part; float* ga; float* pk; float* pv; float* pp;
    __device__ __forceinline__ void operator()(const f32x4 (&acc)[2][2][4][2], const Unit& u, int wr, int wc, int fr, int fq) const {
        const int row0 = u.pm * BM + wr * 64 + fr, col0 = u.pn * BM + wc * 32 + 8 * fq;
        const int tp = (u.pm & 15) * 256;
        const bool kv_out = (u.pn >= 3 && u.pn < 9) && (tp >= 2048);
        const bool u_out = (u.pn == 9 || u.pn == 10) && (tp == 3840);
        const bool g_out = (u.pn == 20) && (wc == 0) && (fq < 2);
        float rsv[2][4];
        {
            f32x4 q0[2][4], q1[2][4];
#pragma unroll
            for (int ai = 0; ai < 2; ++ai)
#pragma unroll
                for (int m = 0; m < 4; ++m) { const int r = row0 + ai * HALF + m * 16; q0[ai][m] = *(const f32x4*)(part + (size_t)r * 8); q1[ai][m] = *(const f32x4*)(part + (size_t)r * 8 + 4); }
#pragma unroll
            for (int ai = 0; ai < 2; ++ai)
#pragma unroll
                for (int m = 0; m < 4; ++m) rsv[ai][m] = rsqrtf((((q0[ai][m][0] + q0[ai][m][1]) + (q0[ai][m][2] + q0[ai][m][3])) + ((q1[ai][m][0] + q1[ai][m][1]) + (q1[ai][m][2] + q1[ai][m][3]))) * (1.0f / 2048.0f) + 1e-6f);
        }
        asm volatile("" ::: "memory");
#pragma unroll
        for (int ai = 0; ai < 2; ++ai)
#pragma unroll
            for (int m = 0; m < 4; ++m) {
                const int r = row0 + ai * HALF + m * 16;
                const float rs = rsv[ai][m];
                bf16_t* rowp = P + (size_t)r * 5376 + col0;
                const int b = r >> 12, t = r & 4095;
#pragma unroll
                for (int bj = 0; bj < 2; ++bj) {
                    const f32x4 v0 = acc[ai][bj][m][0] * rs, v1 = acc[ai][bj][m][1] * rs;
                    u32x4 w; w.x = cvt_pk_bf16(v0[0], v0[1]); w.y = cvt_pk_bf16(v0[2], v0[3]); w.z = cvt_pk_bf16(v1[0], v1[1]); w.w = cvt_pk_bf16(v1[2], v1[3]);
#if EPI_NT & 2
                    __builtin_nontemporal_store(w, (u32x4*)(rowp + bj * HALF));
#else
                    *(u32x4*)(rowp + bj * HALF) = w;
#endif
                    const int c = col0 + bj * HALF;
                    if (kv_out) {
                        float* dst = (u.pn < 6) ? (pk + ((size_t)(b * 2048 + (t - 2048)) * 768 + (c - 768))) : (pv + ((size_t)(b * 2048 + (t - 2048)) * 768 + (c - 1536)));
                        *(f32x4*)dst = v0; *(f32x4*)(dst + 4) = v1;
                    }
                    if (u_out && t >= 4081) {
                        float* dst = pp + ((size_t)(b * 15 + (t - 4081)) * 512 + (c - 2304));
                        *(f32x4*)dst = v0; *(f32x4*)(dst + 4) = v1;
                    }
                    if (g_out && bj == 0) {
                        float* dst = ga + (size_t)r * 16 + 8 * fq;
                        *(f32x4*)dst = v0; *(f32x4*)(dst + 4) = v1;
                    }
                }
            }
    }
};
struct EpiResid {
    static constexpr bool PERM = true, AFTER_DRAIN = false;
    const bf16_t* xin; bf16_t* xb; float* part; PG8_LAS float* xch;
    __device__ __forceinline__ void operator()(const f32x4 (&acc)[2][2][4][2], const Unit& u, int wr, int wc, int fr, int fq) const {
        const int row0 = u.pm * BM + wr * 64 + fr, col0 = u.pn * BM + wc * 32 + 8 * fq;
        u32x4 resv[2][4][2];
#pragma unroll
        for (int ai = 0; ai < 2; ++ai)
#pragma unroll
            for (int m = 0; m < 4; ++m) { const size_t off = (size_t)(row0 + ai * HALF + m * 16) * 2048 + col0;
#pragma unroll
                for (int bj = 0; bj < 2; ++bj) resv[ai][m][bj] = *(const u32x4*)(xin + off + bj * HALF); }
        asm volatile("" ::: "memory");
#pragma unroll
        for (int ai = 0; ai < 2; ++ai) {
#pragma unroll
            for (int m = 0; m < 4; ++m) {
                const int r = row0 + ai * HALF + m * 16;
                const size_t off = (size_t)r * 2048 + col0;
                float s = 0.f;
#pragma unroll
                for (int bj = 0; bj < 2; ++bj) {
                    const u32x4 q = resv[ai][m][bj];
                    const f32x4 r0 = {__builtin_bit_cast(float, q.x << 16), __builtin_bit_cast(float, q.x & 0xffff0000u), __builtin_bit_cast(float, q.y << 16), __builtin_bit_cast(float, q.y & 0xffff0000u)};
                    const f32x4 r1 = {__builtin_bit_cast(float, q.z << 16), __builtin_bit_cast(float, q.z & 0xffff0000u), __builtin_bit_cast(float, q.w << 16), __builtin_bit_cast(float, q.w & 0xffff0000u)};
                    const f32x4 v0 = acc[ai][bj][m][0] + r0, v1 = acc[ai][bj][m][1] + r1;
                    u32x4 w; w.x = cvt_pk_bf16(v0[0], v0[1]); w.y = cvt_pk_bf16(v0[2], v0[3]); w.z = cvt_pk_bf16(v1[0], v1[1]); w.w = cvt_pk_bf16(v1[2], v1[3]);
                    *(u32x4*)(xb + off + bj * HALF) = w;
                    s += (v0[0] * v0[0] + v0[1] * v0[1]) + (v0[2] * v0[2] + v0[3] * v0[3]) + (v1[0] * v1[0] + v1[1] * v1[1]) + (v1[2] * v1[2] + v1[3] * v1[3]);
                }
                s += __shfl_xor(s, 16); s += __shfl_xor(s, 32);
                if (fq == 0) xch[(ai * HALF + wr * 64 + m * 16 + fr) * 4 + wc] = s;
            }
            asm volatile("" ::: "memory");
        }
        asm volatile("s_waitcnt lgkmcnt(0)" ::: "memory"); __builtin_amdgcn_s_barrier(); asm volatile("" ::: "memory");
        if (wr == 0) { const int row = wc * 64 + fq * 16 + fr; const f32x4 q = *(const PG8_LAS f32x4*)(xch + row * 4);
            part[(size_t)(u.pm * BM + row) * 8 + u.pn] = (q[0] + q[1]) + (q[2] + q[3]); }
    }
};
struct EpiGateUp {
    static constexpr bool PERM = true, AFTER_DRAIN = false;
    bf16_t* F; const float* part;
    __device__ __forceinline__ void operator()(const f32x4 (&acc)[2][2][4][2], const Unit& u, int wr, int wc, int fr, int fq) const {
        const int row0 = u.pm * BM + wr * 64 + fr, col0 = u.pn * HALF + wc * 32 + 8 * fq;
        float rsv[2][4];
        {
            f32x4 q0[2][4], q1[2][4];
#pragma unroll
            for (int ai = 0; ai < 2; ++ai)
#pragma unroll
                for (int m = 0; m < 4; ++m) { const int r = row0 + ai * HALF + m * 16; q0[ai][m] = *(const f32x4*)(part + (size_t)r * 8); q1[ai][m] = *(const f32x4*)(part + (size_t)r * 8 + 4); }
#pragma unroll
            for (int ai = 0; ai < 2; ++ai)
#pragma unroll
                for (int m = 0; m < 4; ++m) rsv[ai][m] = rsqrtf((((q0[ai][m][0] + q0[ai][m][1]) + (q0[ai][m][2] + q0[ai][m][3])) + ((q1[ai][m][0] + q1[ai][m][1]) + (q1[ai][m][2] + q1[ai][m][3]))) * (1.0f / 2048.0f) + 1e-6f);
        }
        asm volatile("" ::: "memory");
#pragma unroll
        for (int ai = 0; ai < 2; ++ai)
#pragma unroll
            for (int m = 0; m < 4; ++m) {
                const int r = row0 + ai * HALF + m * 16;
                const float rs = rsv[ai][m];
                const f32x4 g0 = acc[ai][0][m][0] * rs, g1 = acc[ai][0][m][1] * rs, u0 = acc[ai][1][m][0] * rs, u1 = acc[ai][1][m][1] * rs;
                u32x4 w;
                w.x = cvt_pk_bf16(silu_f(g0[0]) * u0[0], silu_f(g0[1]) * u0[1]); w.y = cvt_pk_bf16(silu_f(g0[2]) * u0[2], silu_f(g0[3]) * u0[3]);
                w.z = cvt_pk_bf16(silu_f(g1[0]) * u1[0], silu_f(g1[1]) * u1[1]); w.w = cvt_pk_bf16(silu_f(g1[2]) * u1[2], silu_f(g1[3]) * u1[3]);
#if EPI_NT & 1
                __builtin_nontemporal_store(w, (u32x4*)(F + (size_t)r * 5632 + col0));
#else
                *(u32x4*)(F + (size_t)r * 5632 + col0) = w;
#endif
            }
    }
};

template <class Epi, class Sched, bool ALIGN_EPI = false, bool SP2 = false>
__device__ __forceinline__ void gemm_phase(PG8_LAS unsigned char* lds, const Gemm g, const Sched& S, const Epi& E) {
    int tid = threadIdx.x; asm volatile("" : "+v"(tid)); const int wid = __builtin_amdgcn_readfirstlane(tid >> 6), lane = tid & 63, wr = wid >> 2, wc = wid & 3, fr = lane & 15, fq = lane >> 4;
    const int K = g.K, nt = K / BK;
    unsigned voffA[2], voffB[2];
#pragma unroll
    for (int i = 0; i < 2; ++i) { int R, C; stage_rc(tid * 16 + i * 8192, R, C); const int Rb = Epi::PERM ? ((R & ~31) + perm32(R & 31)) : R;
        voffA[i] = (unsigned)(R * K + C) * 2u; voffB[i] = (unsigned)(Rb * K + C) * 2u; }
    const size_t kstep = (size_t)(BK * 2);
    const size_t hstep = (size_t)HALF * K * 2;
    const size_t tstep = 2 * hstep;
    const unsigned ldsw = (unsigned)wid * 1024u;
    const int aoff = lds_byte(wr * 64 + fr, fq * 8), boff = lds_byte(wc * 32 + fr, fq * 8);
#define PG8_SA(b, h) (((b) * 2 + (h)) * HTB)
#define PG8_SB(b, h) ((4 + (b) * 2 + (h)) * HTB)
#define PG8_STAGE(bufoff, gbase, voff) do { _Pragma("unroll") for (int _i = 0; _i < 2; ++_i) \
        __builtin_amdgcn_global_load_lds((const unsigned*)((const char*)(gbase) + (voff)[_i]), (PG8_LAS unsigned*)(lds + (bufoff) + ldsw + _i * 8192), 16, 0, 0); } while (0)
#define PG8_LDA(dst, b, h) do { _Pragma("unroll") for (int m = 0; m < 4; ++m) _Pragma("unroll") for (int k = 0; k < 2; ++k) dst[m][k] = *(const PG8_LAS bf16x8*)(lds + PG8_SA(b, h) + aoff + m * 2048 + k * 1024); } while (0)
#define PG8_LDB(dst, b, h) do { _Pragma("unroll") for (int n = 0; n < 2; ++n) _Pragma("unroll") for (int k = 0; k < 2; ++k) dst[n][k] = *(const PG8_LAS bf16x8*)(lds + PG8_SB(b, h) + boff + n * 2048 + k * 1024); } while (0)
#define PG8_MMA(ai, bj, At, Bt) do { __builtin_amdgcn_s_setprio(1); _Pragma("unroll") for (int m = 0; m < 4; ++m) _Pragma("unroll") for (int n = 0; n < 2; ++n) _Pragma("unroll") for (int k = 0; k < 2; ++k) \
        acc[ai][bj][m][n] = __builtin_amdgcn_mfma_f32_16x16x32_bf16(Bt[n][k], At[m][k], acc[ai][bj][m][n], 0, 0, 0); __builtin_amdgcn_s_setprio(0); } while (0)
#define PG8_WAIT_V(n) asm volatile("s_waitcnt vmcnt(" #n ")" ::: "memory")
#define PG8_WAIT_L(n) asm volatile("s_waitcnt lgkmcnt(" #n ")" ::: "memory")
#define PG8_BAR __builtin_amdgcn_s_barrier()
#define PG8_SCHED __builtin_amdgcn_sched_barrier(0)
    Unit cur, nxt; int ui = 0;
    if (!S.next(0, cur)) return;
    f32x4 acc[2][2][4][2];
#pragma unroll
    for (int a = 0; a < 2; ++a)
#pragma unroll
        for (int b = 0; b < 2; ++b)
#pragma unroll
            for (int m = 0; m < 4; ++m)
#pragma unroll
                for (int n = 0; n < 2; ++n) acc[a][b][m][n] = (f32x4){0.f, 0.f, 0.f, 0.f};
    bf16x8 At[4][2], B0[2][2], B1[2][2];
    const char* cA = (const char*)g.A + (size_t)cur.pm * tstep; const char* cB = (const char*)g.Bt + (size_t)cur.pn * tstep;
    S.a_ready(cur);
    if constexpr (SP2) {
        PG8_STAGE(PG8_SB(0, 0), cB, voffB); PG8_STAGE(PG8_SB(0, 1), cB + hstep, voffB); PG8_STAGE(PG8_SA(0, 0), cA, voffA); PG8_STAGE(PG8_SA(0, 1), cA + hstep, voffA);
        if (wr == 1) PG8_BAR;
        PG8_WAIT_V(2); PG8_BAR;
        PG8_STAGE(PG8_SB(1, 0), cB + kstep, voffB); PG8_STAGE(PG8_SA(1, 0), cA + kstep, voffA); PG8_STAGE(PG8_SB(1, 1), cB + hstep + kstep, voffB);
        PG8_WAIT_V(6); PG8_BAR;
    } else {
        PG8_STAGE(PG8_SB(0, 0), cB, voffB); PG8_STAGE(PG8_SA(0, 0), cA, voffA); PG8_STAGE(PG8_SB(0, 1), cB + hstep, voffB); PG8_STAGE(PG8_SA(0, 1), cA + hstep, voffA);
        if (wr == 1) PG8_BAR;
        PG8_WAIT_V(4); PG8_BAR;
        PG8_STAGE(PG8_SB(1, 0), cB + kstep, voffB); PG8_STAGE(PG8_SA(1, 0), cA + kstep, voffA); PG8_STAGE(PG8_SB(1, 1), cB + hstep + kstep, voffB);
        PG8_WAIT_V(6); PG8_BAR;
    }
    for (;;) {
        const bool has_next = S.next(ui + 1, nxt);
        const char* nA = has_next ? (const char*)g.A + (size_t)nxt.pm * tstep : cA; const char* nB = has_next ? (const char*)g.Bt + (size_t)nxt.pn * tstep : cB;
        for (int t = 0; t < nt; t += 2) {
            const bool last = (t == nt - 2);
            const char* a1 = cA + (size_t)(t + 1) * kstep;
            const char* a2 = last ? nA : cA + (size_t)(t + 2) * kstep; const char* b2 = last ? nB : cB + (size_t)(t + 2) * kstep;
            const char* a3 = a2 + kstep; const char* b3 = b2 + kstep;
            if (last && has_next) S.a_ready(nxt);
            if constexpr (SP2) {
            PG8_LDB(B0, 0, 0); PG8_LDB(B1, 0, 1); PG8_SCHED; PG8_LDA(At, 0, 0); PG8_STAGE(PG8_SA(1, 1), a1 + hstep, voffA);
            PG8_WAIT_V(8); PG8_WAIT_L(0); PG8_BAR; PG8_MMA(0, 0, At, B0); PG8_MMA(0, 1, At, B1); PG8_BAR; PG8_SCHED;
            PG8_LDA(At, 0, 1); PG8_STAGE(PG8_SB(0, 0), b2, voffB); PG8_STAGE(PG8_SB(0, 1), b2 + hstep, voffB); PG8_STAGE(PG8_SA(0, 0), a2, voffA);
            PG8_WAIT_V(8); PG8_WAIT_L(0); PG8_BAR; PG8_MMA(1, 0, At, B0); PG8_MMA(1, 1, At, B1); PG8_BAR; PG8_SCHED;
            PG8_LDB(B0, 1, 0); PG8_LDB(B1, 1, 1); PG8_SCHED; PG8_LDA(At, 1, 0); PG8_STAGE(PG8_SA(0, 1), a2 + hstep, voffA);
            PG8_WAIT_V(8); PG8_WAIT_L(0); PG8_BAR; PG8_MMA(0, 0, At, B0); PG8_MMA(0, 1, At, B1); PG8_BAR; PG8_SCHED;
            PG8_LDA(At, 1, 1); PG8_STAGE(PG8_SB(1, 0), b3, voffB); PG8_STAGE(PG8_SB(1, 1), b3 + hstep, voffB); PG8_STAGE(PG8_SA(1, 0), a3, voffA);
            PG8_WAIT_V(8); PG8_WAIT_L(0); PG8_BAR; PG8_MMA(1, 0, At, B0); PG8_MMA(1, 1, At, B1); PG8_BAR; PG8_SCHED;
            } else {
            PG8_LDB(B0, 0, 0); PG8_SCHED; PG8_LDA(At, 0, 0); PG8_STAGE(PG8_SA(1, 1), a1 + hstep, voffA);
            PG8_WAIT_L(8); PG8_BAR; PG8_WAIT_L(0); PG8_MMA(0, 0, At, B0); PG8_BAR; PG8_SCHED;
            PG8_LDB(B1, 0, 1); PG8_STAGE(PG8_SB(0, 0), b2, voffB);
            PG8_BAR; PG8_WAIT_L(0); PG8_MMA(0, 1, At, B1); PG8_BAR;
            PG8_LDA(At, 0, 1); PG8_STAGE(PG8_SA(0, 0), a2, voffA);
            PG8_BAR; PG8_WAIT_L(0); PG8_MMA(1, 0, At, B0); PG8_BAR; PG8_SCHED;
            PG8_STAGE(PG8_SB(0, 1), b2 + hstep, voffB);
            PG8_WAIT_V(6); PG8_BAR; PG8_MMA(1, 1, At, B1); PG8_BAR;
            PG8_LDB(B0, 1, 0); PG8_SCHED; PG8_LDA(At, 1, 0); PG8_STAGE(PG8_SA(0, 1), a2 + hstep, voffA);
            PG8_WAIT_L(8); PG8_BAR; PG8_WAIT_L(0); PG8_MMA(0, 0, At, B0); PG8_BAR; PG8_SCHED;
            PG8_LDB(B1, 1, 1); PG8_STAGE(PG8_SB(1, 0), b3, voffB);
            PG8_BAR; PG8_WAIT_L(0); PG8_MMA(0, 1, At, B1); PG8_BAR;
            PG8_LDA(At, 1, 1); PG8_STAGE(PG8_SA(1, 0), a3, voffA);
            PG8_BAR; PG8_WAIT_L(0); PG8_MMA(1, 0, At, B0); PG8_BAR; PG8_SCHED;
            PG8_STAGE(PG8_SB(1, 1), b3 + hstep, voffB);
            PG8_WAIT_V(6); PG8_BAR; PG8_MMA(1, 1, At, B1); PG8_BAR;
            }
        }
        if constexpr (ALIGN_EPI) { if (wr == 0) PG8_BAR; }
        if constexpr (!Epi::AFTER_DRAIN) { E(acc, cur, wr, wc, fr, fq); S.done(cur); }
        if (!has_next) break;
#pragma unroll
        for (int a = 0; a < 2; ++a)
#pragma unroll
            for (int b = 0; b < 2; ++b)
#pragma unroll
                for (int m = 0; m < 4; ++m)
#pragma unroll
                    for (int n = 0; n < 2; ++n) acc[a][b][m][n] = (f32x4){0.f, 0.f, 0.f, 0.f};
        cur = nxt; cA = nA; cB = nB; ++ui;
        if constexpr (ALIGN_EPI) { if (wr == 1) PG8_BAR; }
    }
    PG8_WAIT_V(0);
    if constexpr (!ALIGN_EPI) { if (wr == 0) PG8_BAR; }
    PG8_BAR;
    if constexpr (Epi::AFTER_DRAIN) { E.fused(acc, cur, wr, wc, fr, fq, lds, wid, lane); S.done(cur); }
#undef PG8_SA
#undef PG8_SB
#undef PG8_STAGE
#undef PG8_LDA
#undef PG8_LDB
#undef PG8_MMA
#undef PG8_WAIT_V
#undef PG8_WAIT_L
#undef PG8_BAR
#undef PG8_SCHED
}
}

#define GAS __attribute__((address_space(1)))
#define LAS __attribute__((address_space(3)))
typedef unsigned short bf16;
typedef float f32x4 __attribute__((ext_vector_type(4)));
typedef float f32x2 __attribute__((ext_vector_type(2)));
typedef short bf16x8 __attribute__((ext_vector_type(8)));
typedef unsigned u32x4 __attribute__((ext_vector_type(4)));
typedef unsigned u32x2 __attribute__((ext_vector_type(2)));
typedef GAS unsigned gu32;

constexpr int NWAVES = 8, NTHR = 512;
constexpr int D = 2048, SEQ = 4096, MP = 8192, MS = 64, MT = MP + MS, DEPTH = 4;
constexpr int DIN = 5136, NINP = 5376, DFF = 5632, NGU = 2 * DFF;
constexpr int C_QA = 0, C_KA = 768, C_VA = 1536, C_UB = 2304, C_QC = 2816, C_KC = 3200, C_VC = 3584, C_RC = 4352, C_GC = 5120;
constexpr int M_A = 0, M_B = 768, M_C = 1280;
constexpr float EPS = 1e-6f;
constexpr int NCH = 64, CH = 64;
constexpr int SELEMS = 96 * 192;

enum { I_XP = 0, I_XS, I_CK, I_CV, I_SPOOL, I_SGLA, I_N1G, I_WIN, I_WG2, I_BG, I_WPOOL, I_PSCALE, I_GNG, I_WO, I_N2G, I_WFG, I_WFU, I_WFD, I_FNG, N_IN };
constexpr size_t O_YP = 0, O_YS = 16777216, O_PK = 16908288, O_PV = 29491200, O_PP = 42074112, O_PG = 42135552, O_SK = 42725376, O_SV = 42921984, O_SP = 43118592, O_SG = 43364352, O_END = 45723648;
constexpr size_t MiB = 1u << 20;
constexpr size_t WS_CTL = 0, CTL_ZERO_BYTES = 1 * MiB;
constexpr size_t WS_PART1 = 1 * MiB, WS_PART2 = 1 * MiB + 262144, WS_SPART1 = 1 * MiB + 524288, WS_SPART2 = 1 * MiB + 589824;
constexpr size_t WS_GA = 2 * MiB, WS_DEC = 3 * MiB, WS_PROJS = 4 * MiB, WS_WPT = 6 * MiB;
constexpr size_t WS_W = 8 * MiB;
constexpr size_t LW_IN = 0, LW_O = (size_t)NINP * D * 2, LW_GU = LW_O + (size_t)D * D * 2, LW_D = LW_GU + (size_t)NGU * D * 2, LW_SZ = LW_D + (size_t)D * DFF * 2;
static_assert(LW_SZ == 99614720, "layer weight bytes");
constexpr size_t WS_X = 388 * MiB, WS_XB = 453 * MiB, WS_MIX = 486 * MiB, WS_PROJ = 519 * MiB, WS_F = 603 * MiB, WS_SLOC = 692 * MiB, WS_SST = 728 * MiB, WS_BCUM = 764 * MiB, WS_END = 780 * MiB;
static_assert(WS_W + 4 * LW_SZ <= WS_X && WS_X + (size_t)MT * D * 4 <= WS_XB && WS_XB + (size_t)MT * D * 2 <= WS_MIX && WS_MIX + (size_t)MT * D * 2 <= WS_PROJ, "ws map 1");
static_assert(WS_PROJ + (size_t)MP * NINP * 2 <= WS_F && WS_F + (size_t)MT * DFF * 2 <= WS_SLOC && WS_SLOC + (size_t)512 * SELEMS * 4 <= WS_SST && WS_SST + (size_t)512 * SELEMS * 4 <= WS_BCUM && WS_BCUM + (size_t)MP * 384 * 4 <= WS_END, "ws map 2");
constexpr size_t WS_OP = WS_F, WS_LSE = WS_F + 40 * MiB;
static_assert((size_t)3 * MP * 768 * 2 <= 40 * MiB && WS_LSE + (size_t)3 * MP * 6 * 4 <= WS_SLOC, "attention partials fit");
constexpr int CW_BAR = 4096;
constexpr int RING_BYTES = 131072, XCH_OFF = RING_BYTES, SCRATCH_BYTES = 139264, LDSCTL_OFF = SCRATCH_BYTES, MISC_OFF = LDSCTL_OFF + 320, LDS_BYTES = 147456;

#define RLX_AGENT __ATOMIC_RELAXED, __HIP_MEMORY_SCOPE_AGENT
__device__ __forceinline__ float bf2f(unsigned b) { return __uint_as_float(b << 16); }
typedef __bf16 hwbf16x2 __attribute__((ext_vector_type(2)));
__device__ __forceinline__ unsigned pk2(float lo, float hi) { const f32x2 v = {lo, hi}; const hwbf16x2 b = __builtin_convertvector(v, hwbf16x2); return __builtin_bit_cast(unsigned, b); }
__device__ __forceinline__ unsigned f2bf(float f) { return pk2(f, 0.f) & 0xffffu; }
__device__ __forceinline__ float wave_sum(float v) {
#pragma unroll
    for (int o = 1; o < 64; o <<= 1) v += __shfl_xor(v, o);
    return v;
}
__device__ __forceinline__ float wave_max(float v) {
#pragma unroll
    for (int o = 1; o < 64; o <<= 1) v = fmaxf(v, __shfl_xor(v, o));
    return v;
}
__device__ __forceinline__ float logsig(float z) { return fminf(z, 0.f) - log1pf(__expf(-fabsf(z))); }
__device__ __forceinline__ float silu(float x) { return x / (1.0f + __expf(-x)); }

#define XB_TMO      128
#define XB_XCNT(j)  (256  + 64 * (j))
#define XB_XSUB(j)  (1280 + 64 * (j))
#define XB_XGEN(j)  (2304 + 64 * (j))
#define XB_TOP      3328
#define XB_TOPGEN   3392
#define XCD_BAR_WORDS 3456
#define XB_SPIN_CAP (1u << 18)

__device__ __forceinline__ unsigned xb_ld(unsigned* p)              { return __hip_atomic_load(p, __ATOMIC_RELAXED, __HIP_MEMORY_SCOPE_AGENT); }
__device__ __forceinline__ unsigned xb_add(unsigned* p, unsigned v) { return __hip_atomic_fetch_add(p, v, __ATOMIC_RELAXED, __HIP_MEMORY_SCOPE_AGENT); }
__device__ __forceinline__ unsigned xb_xcc_id() { return (unsigned)__builtin_amdgcn_s_getreg((3 << 11) | 20) & 0xFu; }
#define XB_SPIN(cond, bar) do { unsigned _sp = 0; while (cond) { __builtin_amdgcn_s_sleep(1); \
    if ((++_sp & 255u) == 0u) { if (xb_ld(&(bar)[XB_TMO])) break; if (_sp > XB_SPIN_CAP) { atomicAdd(&(bar)[XB_TMO], 1u); break; } } } } while (0)

struct XcdBarrier {
    unsigned* bar; unsigned x;
    volatile LAS unsigned* st;
};

__device__ __forceinline__ XcdBarrier xcd_barrier_post(unsigned* bar, volatile LAS unsigned* st) {
    XcdBarrier b; b.bar = bar; b.x = xb_xcc_id(); b.st = st;
    if (threadIdx.x == 0) (void)xb_add(&bar[XB_XCNT(b.x)], 1u);
    return b;
}
__device__ __forceinline__ void xcd_barrier_complete(unsigned* bar, unsigned x, unsigned& nloc, unsigned& nx) {
    const unsigned G = gridDim.x * gridDim.y * gridDim.z;
    unsigned sum, cnt, mine, sp = 0u;
    for (;;) {
        sum = 0u; cnt = 0u; mine = 0u;
#pragma unroll
        for (unsigned j = 0; j < 16; ++j) { const unsigned c = xb_ld(&bar[XB_XCNT(j)]); sum += c; cnt += (c > 0u) ? 1u : 0u; mine = (j == x) ? c : mine; }
        if (sum == G) break;
        __builtin_amdgcn_s_sleep(1);
        if ((++sp & 255u) == 0u) { if (xb_ld(&bar[XB_TMO])) break; if (sp > XB_SPIN_CAP) { atomicAdd(&bar[XB_TMO], 1u); break; } }
    }
    nloc = mine > 0u ? mine : 1u; nx = cnt > 0u ? cnt : 1u;
}

__device__ __forceinline__ void xcd_barrier(const XcdBarrier& b) {
    asm volatile("s_waitcnt vmcnt(0)" ::: "memory");
    __syncthreads();
    if (threadIdx.x == 0) {
        unsigned* bar = b.bar;
        __builtin_amdgcn_s_waitcnt(0);
        unsigned nloc = b.st[0], nx = b.st[1];
        if (nloc == 0u) { xcd_barrier_complete(bar, b.x, nloc, nx); b.st[0] = nloc; b.st[1] = nx; }
        const unsigned old = xb_add(&bar[XB_XSUB(b.x)], 1u);
        const unsigned gen = old / nloc;
        if (old + 1u == (gen + 1u) * nloc) {
            __builtin_amdgcn_fence(__ATOMIC_RELEASE, "agent");
            asm volatile("s_waitcnt vmcnt(0)" ::: "memory");
            const unsigned og = xb_add(&bar[XB_TOP], 1u);
            const unsigned tg = og / nx;
            if (og + 1u == (tg + 1u) * nx) xb_add(&bar[XB_TOPGEN], 1u);
            else XB_SPIN(xb_ld(&bar[XB_TOPGEN]) == tg, bar);
            __builtin_amdgcn_fence(__ATOMIC_ACQUIRE, "agent");
            xb_add(&bar[XB_XGEN(b.x)], 1u);
            asm volatile("s_waitcnt vmcnt(0)" ::: "memory");
        } else {
            XB_SPIN(xb_ld(&bar[XB_XGEN(b.x)]) == gen, bar);
            __builtin_amdgcn_fence(__ATOMIC_ACQUIRE, "agent");
            asm volatile("s_waitcnt vmcnt(0)" ::: "memory");
        }
    }
    __syncthreads();
}

struct RowId { __device__ __forceinline__ int operator()(int n) const { return n; } };
struct RowGate { int up; __device__ __forceinline__ int operator()(int f) const { return 256 * (f >> 7) + 128 * up + (f & 127); } };
template <class RM>
__device__ __forceinline__ void cvt_tile(const float* __restrict__ W, int K, int N, int k0, int n0, const float* __restrict__ gk, bf16* Wt, RM rowmap, LAS float* scr, int lane) {
    const int cl = 4 * (lane & 15), kr = lane >> 4;
    f32x4 v[16];
#pragma unroll
    for (int i = 0; i < 16; ++i) {
        const int kk = 4 * i + kr, n = n0 + cl;
        v[i] = (n + 3 < N) ? __builtin_nontemporal_load((const f32x4*)(W + (size_t)(k0 + kk) * N + n)) : (f32x4){0.f, 0.f, 0.f, 0.f};
    }
#pragma unroll
    for (int i = 0; i < 16; ++i) {
        const int kk = 4 * i + kr; const float g = gk ? gk[k0 + kk] : 1.0f;
        LAS float* s = scr + kk * 65 + cl;
        s[0] = v[i][0] * g; s[1] = v[i][1] * g; s[2] = v[i][2] * g; s[3] = v[i][3] * g;
    }
    asm volatile("s_waitcnt lgkmcnt(0)" ::: "memory");
    const int c = lane & 7;
#pragma unroll
    for (int i = 0; i < 8; ++i) {
        const int nl = 8 * i + (lane >> 3), n = n0 + nl;
        const LAS float* s = scr + (8 * c) * 65 + nl;
        u32x4 o; o.x = pk2(s[0 * 65], s[1 * 65]); o.y = pk2(s[2 * 65], s[3 * 65]); o.z = pk2(s[4 * 65], s[5 * 65]); o.w = pk2(s[6 * 65], s[7 * 65]);
        if (n < N) *(u32x4*)(Wt + (size_t)rowmap(n) * K + k0 + 8 * c) = o;
    }
    asm volatile("s_waitcnt lgkmcnt(0)" ::: "memory");
}

struct Ptrs {
    const float* in[N_IN]; float* out; unsigned char* ws;
};

constexpr int CV_IN = 32 * 81, CV_O = 32 * 32, CV_G = 32 * 88, CV_D = 88 * 32, CV_L = CV_IN + CV_O + 2 * CV_G + CV_D;
__device__ __forceinline__ void cvt_item(const Ptrs& P, int l, int r, LAS float* scr, int lane) {
    unsigned char* wl = P.ws + WS_W + (size_t)l * LW_SZ;
    if (r < CV_IN) { const int kb = r / 81, nb = r % 81; cvt_tile(P.in[I_WIN] + (size_t)l * D * DIN, D, DIN, 64 * kb, 64 * nb, P.in[I_N1G] + l * D, (bf16*)(wl + LW_IN), RowId{}, scr, lane); return; } r -= CV_IN;
    if (r < CV_O) { const int kb = r / 32, nb = r % 32; cvt_tile(P.in[I_WO] + (size_t)l * D * D, D, D, 64 * kb, 64 * nb, (const float*)nullptr, (bf16*)(wl + LW_O), RowId{}, scr, lane); return; } r -= CV_O;
    if (r < CV_G) { const int kb = r / 88, nb = r % 88; cvt_tile(P.in[I_WFG] + (size_t)l * D * DFF, D, DFF, 64 * kb, 64 * nb, P.in[I_N2G] + l * D, (bf16*)(wl + LW_GU), RowGate{0}, scr, lane); return; } r -= CV_G;
    if (r < CV_G) { const int kb = r / 88, nb = r % 88; cvt_tile(P.in[I_WFU] + (size_t)l * D * DFF, D, DFF, 64 * kb, 64 * nb, P.in[I_N2G] + l * D, (bf16*)(wl + LW_GU), RowGate{1}, scr, lane); return; } r -= CV_G;
    { const int kb = r / 32, nb = r % 32; cvt_tile(P.in[I_WFD] + (size_t)l * DFF * D, DFF, D, 64 * kb, 64 * nb, (const float*)nullptr, (bf16*)(wl + LW_D), RowId{}, scr, lane); }
}
__device__ __forceinline__ void prologue(const Ptrs& P, LAS unsigned char* lds, int bx, int G, int wave, int lane, int tid, int pro_layers) {
    LAS float* scr = (LAS float*)(lds + wave * 16640);
    const int gw = bx * NWAVES + wave, NGW = G * NWAVES;
    for (int it = gw; it < pro_layers * CV_L; it += NGW) cvt_item(P, it / CV_L, it % CV_L, scr, lane);
    for (int i = bx * NTHR + tid; i < DEPTH * 61440; i += G * NTHR) {
        const int l = i / 61440, j = i % 61440;
        *(u32x4*)(P.ws + WS_W + (size_t)l * LW_SZ + LW_IN + (size_t)DIN * D * 2 + (size_t)j * 16) = (u32x4){0u, 0u, 0u, 0u};
    }
    for (int i = bx * NTHR + tid; i < DEPTH * 4 * 128 * 128; i += G * NTHR) {
        const int c = i & 127, d = (i >> 7) & 127, lg = i >> 14;
        ((bf16*)(P.ws + WS_WPT))[i] = (bf16)f2bf(P.in[I_WPOOL][((size_t)lg * 128 + c) * 128 + d] * P.in[I_PSCALE][lg * 128 + d]);
    }
    float* part2 = (float*)(P.ws + WS_PART2); float* spart2 = (float*)(P.ws + WS_SPART2); bf16* XB = (bf16*)(P.ws + WS_XB);
    for (int row = gw; row < MT; row += NGW) {
        const float* xr = (row < MP) ? P.in[I_XP] + (size_t)row * D : P.in[I_XS] + (size_t)(row - MP) * D;
        float s = 0.f;
#pragma unroll
        for (int j = 0; j < 8; ++j) {
            const f32x4 v = *(const f32x4*)(xr + 4 * lane + 256 * j);
            s += (v[0] * v[0] + v[1] * v[1]) + (v[2] * v[2] + v[3] * v[3]);
            u32x2 o; o.x = pk2(v[0], v[1]); o.y = pk2(v[2], v[3]);
            *(u32x2*)(XB + (size_t)row * D + 4 * lane + 256 * j) = o;
        }
        s = wave_sum(s);
        if (row < MP) { if (lane < 8) part2[(size_t)row * 8 + lane] = (lane == 0) ? s : 0.f; }
        else { spart2[(size_t)(row - MP) * 128 + lane] = (lane == 0) ? s : 0.f; spart2[(size_t)(row - MP) * 128 + 64 + lane] = 0.f; }
    }
}

template <int MT, int NT, int QB, class EPI>
__device__ __forceinline__ void skinny_unit(LAS unsigned char* lds, const bf16* __restrict__ A, const bf16* __restrict__ B0, const bf16* __restrict__ B1, int K, int r0, int ntile, const EPI& epi, int wave, int lane, int tid) {
    const int fr = lane & 15, fq = lane >> 4, ks = K / 8, kb = wave * ks;
    f32x4 acc[MT][NT];
#pragma unroll
    for (int a = 0; a < MT; ++a)
#pragma unroll
        for (int b = 0; b < NT; ++b) acc[a][b] = (f32x4){0.f, 0.f, 0.f, 0.f};
    const bf16* ap = A + (size_t)(r0 + fr) * K + kb + 8 * fq;
    const bf16* b0p = B0 + (size_t)fr * K + kb + 8 * fq; const bf16* b1p = B1 + (size_t)fr * K + kb + 8 * fq;
    for (int kk0 = 0; kk0 < ks; kk0 += 32 * QB) {
        bf16x8 a[QB][MT], b[QB][NT];
#pragma unroll
        for (int q = 0; q < QB; ++q) { const int kk = (kk0 + 32 * q < ks) ? kk0 + 32 * q : kk0;
#pragma unroll
            for (int m = 0; m < MT; ++m) a[q][m] = *(const bf16x8*)(ap + (size_t)(16 * m) * K + kk);
            b[q][0] = *(const bf16x8*)(b0p + kk); if (NT == 2) b[q][NT - 1] = *(const bf16x8*)(b1p + kk); }
#pragma unroll
        for (int q = 0; q < QB; ++q) if (kk0 + 32 * q < ks) {
#pragma unroll
            for (int m = 0; m < MT; ++m)
#pragma unroll
                for (int n = 0; n < NT; ++n) acc[m][n] = __builtin_amdgcn_mfma_f32_16x16x32_bf16(a[q][m], b[q][n], acc[m][n], 0, 0, 0);
        }
    }
    LAS float* red = (LAS float*)lds;
#pragma unroll
    for (int m = 0; m < MT; ++m)
#pragma unroll
        for (int nb = 0; nb < NT; ++nb)
#pragma unroll
            for (int rg = 0; rg < 4; ++rg) red[((wave * NT + nb) * (16 * MT) + m * 16 + 4 * fq + rg) * 16 + fr] = acc[m][nb][rg];
    __syncthreads();
#pragma unroll
    for (int nb = 0; nb < NT; ++nb)
#pragma unroll
        for (int hf = 0; hf < MT / 2; ++hf) {
            float v = 0.f;
#pragma unroll
            for (int w = 0; w < 8; ++w) v += red[((w * NT + nb) * (16 * MT) + hf * 32) * 16 + tid];
            if (nb < ntile) epi(r0 + (tid >> 4) + 32 * hf, hf, nb, tid & 15, v);
        }
    __syncthreads();
}
__device__ __forceinline__ float skinny_rs(const float* spart, int rbase, int tid) {
    const float* p = spart + (size_t)(rbase + (tid >> 4)) * 128 + (tid & 15) * 8;
    const f32x4 a = *(const f32x4*)p, b = *(const f32x4*)(p + 4);
    float s = ((a[0] + a[1]) + (a[2] + a[3])) + ((b[0] + b[1]) + (b[2] + b[3]));
    s += __shfl_xor(s, 1); s += __shfl_xor(s, 2); s += __shfl_xor(s, 4); s += __shfl_xor(s, 8);
    return rsqrtf(s * (1.0f / 2048.0f) + EPS);
}
struct SEpiInProj {
    float* projs; float rs0, rs1; float* sk; float* sv; float* sp; int n0;
    __device__ __forceinline__ void operator()(int row, int hf, int tile, int cl, float v0) const {
        const int col = n0 + 16 * tile + cl; const float v = v0 * (hf == 0 ? rs0 : rs1);
        projs[(size_t)row * DIN + col] = v;
        if (col >= C_KA && col < C_VA) sk[(size_t)row * 768 + (col - C_KA)] = v;
        else if (col >= C_VA && col < C_UB) sv[(size_t)row * 768 + (col - C_VA)] = v;
        else if (col >= C_UB && col < C_QC) sp[(size_t)((row >> 3) * 15 + 7 + (row & 7)) * 512 + (col - C_UB)] = v;
    }
};
struct SEpiResid {
    const bf16* xin; bf16* xb; float* spart; int n0;
    __device__ __forceinline__ void operator()(int row, int, int tile, int cl, float v0) const {
        const size_t o = (size_t)row * D + n0 + 16 * tile + cl; const float v = bf2f(xin[o]) + v0;
        xb[o] = (bf16)f2bf(v);
        float s = v * v; s += __shfl_xor(s, 1); s += __shfl_xor(s, 2); s += __shfl_xor(s, 4); s += __shfl_xor(s, 8);
        if (cl == 0) spart[(size_t)row * 128 + (n0 >> 4) + tile] = s;
    }
};
struct SEpiGateUp {
    bf16* F; float rs0, rs1; int f0; mutable float gate0, gate1;
    __device__ __forceinline__ void operator()(int row, int hf, int tile, int cl, float v0) const {
        const float rs = hf == 0 ? rs0 : rs1;
        if (tile == 0) { if (hf == 0) gate0 = v0 * rs; else gate1 = v0 * rs; }
        else F[(size_t)(MP + row) * DFF + f0 + cl] = (bf16)f2bf(silu(hf == 0 ? gate0 : gate1) * (v0 * rs));
    }
};

__device__ __forceinline__ void s_attn_slot(int s, int tA, int tB, int& idx, bool& vA, bool& vB) {
    if (s < 133) { idx = 2048 + tB - s; vB = (s <= 128); vA = (s >= 4); }
    else if (s < 263) { const int j = s - 133; idx = 2048 + tB - 4 * j; vB = (j <= 128); vA = (j >= 1); }
    else if (s < 392) { idx = 2048 + tA - 16 * (s - 263); vA = true; vB = false; }
    else if (s < 521) { idx = 2048 + tB - 16 * (s - 392); vA = false; vB = true; }
    else { idx = 2048 + tB; vA = false; vB = false; }
}
__device__ __forceinline__ void s_attn_punit(const Ptrs& P, LAS unsigned char* lds, int l, int unit, int wave, int lane, int tid) {
    const int h = unit % 6, bq = unit / 6, b = bq >> 2, tA = bq & 3, tB = tA + 4, rowA = b * 8 + tA, rowB = rowA + 4;
    const float* projs = (const float*)(P.ws + WS_PROJS);
    LAS float* scA = (LAS float*)lds;
    LAS float* scB = scA + 544;
    LAS float* red = scB + 544;
    LAS float* part = red + 32;
    const int qw = lane >> 4, k16 = lane & 15;
    const float QS = 0.08838834764831845f;
    const f32x4 qAa = *(const f32x4*)(projs + (size_t)rowA * DIN + C_QA + h * 128 + 4 * k16) * QS, qAb = *(const f32x4*)(projs + (size_t)rowA * DIN + C_QA + h * 128 + 64 + 4 * k16) * QS;
    const f32x4 qBa = *(const f32x4*)(projs + (size_t)rowB * DIN + C_QA + h * 128 + 4 * k16) * QS, qBb = *(const f32x4*)(projs + (size_t)rowB * DIN + C_QA + h * 128 + 64 + 4 * k16) * QS;
    const float* ckb = P.in[I_CK] + ((size_t)(l * 8 + b) * 2048 * 6 + h) * 128; const float* cvb = P.in[I_CV] + ((size_t)(l * 8 + b) * 2048 * 6 + h) * 128;
    const float* pkb = projs + (size_t)(b * 8) * DIN + h * 128;
#pragma unroll
    for (int half = 0; half < 2; ++half) {
        const int it0 = half ? 9 : 0, nit = half ? 8 : 9;
        f32x4 ka[9], kb[9];
#pragma unroll
        for (int i = 0; i < 9; ++i) if (i < nit) {
            int idx; bool vA, vB; s_attn_slot((it0 + i) * 32 + wave * 4 + qw, tA, tB, idx, vA, vB);
            const float* rp = (idx >= 2048) ? pkb + (size_t)(idx - 2048) * DIN + C_KA : ckb + (size_t)idx * 768;
            ka[i] = __builtin_nontemporal_load((const f32x4*)(rp + 4 * k16)); kb[i] = __builtin_nontemporal_load((const f32x4*)(rp + 64 + 4 * k16));
        }
#pragma unroll
        for (int i = 0; i < 9; ++i) if (i < nit) {
            const int s = (it0 + i) * 32 + wave * 4 + qw;
            int idx; bool vA, vB; s_attn_slot(s, tA, tB, idx, vA, vB);
            float a = (ka[i][0] * qAa[0] + ka[i][1] * qAa[1]) + (ka[i][2] * qAa[2] + ka[i][3] * qAa[3]) + (kb[i][0] * qAb[0] + kb[i][1] * qAb[1]) + (kb[i][2] * qAb[2] + kb[i][3] * qAb[3]);
            float c = (ka[i][0] * qBa[0] + ka[i][1] * qBa[1]) + (ka[i][2] * qBa[2] + ka[i][3] * qBa[3]) + (kb[i][0] * qBb[0] + kb[i][1] * qBb[1]) + (kb[i][2] * qBb[2] + kb[i][3] * qBb[3]);
            a += __shfl_xor(a, 1); a += __shfl_xor(a, 2); a += __shfl_xor(a, 4); a += __shfl_xor(a, 8);
            c += __shfl_xor(c, 1); c += __shfl_xor(c, 2); c += __shfl_xor(c, 4); c += __shfl_xor(c, 8);
            if (k16 == 0) { scA[s] = vA ? a : -1e30f; scB[s] = vB ? c : -1e30f; }
        }
    }
    __syncthreads();
    const float a0 = scA[tid], b0 = scB[tid], a1 = (tid < 32) ? scA[512 + tid] : -1e30f, b1 = (tid < 32) ? scB[512 + tid] : -1e30f;
    float mA = wave_max(fmaxf(a0, a1)), mB = wave_max(fmaxf(b0, b1));
    if (lane == 0) { red[wave] = mA; red[8 + wave] = mB; }
    __syncthreads();
    mA = red[0]; mB = red[8];
#pragma unroll
    for (int w = 1; w < 8; ++w) { mA = fmaxf(mA, red[w]); mB = fmaxf(mB, red[8 + w]); }
    const float eA0 = __expf(a0 - mA), eB0 = __expf(b0 - mB), eA1 = (tid < 32) ? __expf(a1 - mA) : 0.f, eB1 = (tid < 32) ? __expf(b1 - mB) : 0.f;
    const float smA = wave_sum(eA0 + eA1), smB = wave_sum(eB0 + eB1);
    scA[tid] = eA0; scB[tid] = eB0;
    if (tid < 32) { scA[512 + tid] = eA1; scB[512 + tid] = eB1; }
    if (lane == 0) { red[16 + wave] = smA; red[24 + wave] = smB; }
    __syncthreads();
    float denA = 0.f, denB = 0.f;
#pragma unroll
    for (int w = 0; w < 8; ++w) { denA += red[16 + w]; denB += red[24 + w]; }
    f32x4 oAa = (f32x4){0.f, 0.f, 0.f, 0.f}, oAb = oAa, oBa = oAa, oBb = oAa;
#pragma unroll
    for (int half = 0; half < 2; ++half) {
        const int it0 = half ? 9 : 0, nit = half ? 8 : 9;
        f32x4 va[9], vb[9];
#pragma unroll
        for (int i = 0; i < 9; ++i) if (i < nit) {
            int idx; bool vA, vB; s_attn_slot((it0 + i) * 32 + wave * 4 + qw, tA, tB, idx, vA, vB);
            const float* rp = (idx >= 2048) ? pkb + (size_t)(idx - 2048) * DIN + C_VA : cvb + (size_t)idx * 768;
            va[i] = __builtin_nontemporal_load((const f32x4*)(rp + 4 * k16)); vb[i] = __builtin_nontemporal_load((const f32x4*)(rp + 64 + 4 * k16));
        }
#pragma unroll
        for (int i = 0; i < 9; ++i) if (i < nit) {
            const int s = (it0 + i) * 32 + wave * 4 + qw; const float pA = scA[s], pB = scB[s];
            oAa += va[i] * pA; oAb += vb[i] * pA; oBa += va[i] * pB; oBb += vb[i] * pB;
        }
    }
#pragma unroll
    for (int i = 0; i < 4; ++i) {
        oAa[i] += __shfl_xor(oAa[i], 16); oAa[i] += __shfl_xor(oAa[i], 32); oAb[i] += __shfl_xor(oAb[i], 16); oAb[i] += __shfl_xor(oAb[i], 32);
        oBa[i] += __shfl_xor(oBa[i], 16); oBa[i] += __shfl_xor(oBa[i], 32); oBb[i] += __shfl_xor(oBb[i], 16); oBb[i] += __shfl_xor(oBb[i], 32);
    }
    if (qw == 0) {
        *(LAS f32x4*)(part + wave * 128 + 4 * k16) = oAa; *(LAS f32x4*)(part + wave * 128 + 64 + 4 * k16) = oAb;
        *(LAS f32x4*)(part + 1024 + wave * 128 + 4 * k16) = oBa; *(LAS f32x4*)(part + 1024 + wave * 128 + 64 + 4 * k16) = oBb;
    }
    __syncthreads();
    if (tid < 256) {
        const int q = tid >> 7, d = tid & 127;
        float o = 0.f;
#pragma unroll
        for (int w = 0; w < 8; ++w) o += part[q * 1024 + w * 128 + d];
        ((bf16*)(P.ws + WS_MIX))[(size_t)(MP + (q ? rowB : rowA)) * D + M_A + h * 128 + d] = (bf16)f2bf(o / (q ? denB : denA));
    }
    __syncthreads();
}
__device__ __forceinline__ void s_attn_unit(const Ptrs& P, LAS unsigned char* lds, int l, int unit, int wave, int lane, int tid) {
    const int h = unit % 6, row = unit / 6, b = row >> 3, t = row & 7;
    const float* projs = (const float*)(P.ws + WS_PROJS);
    LAS float* sc = (LAS float*)lds;
    LAS float* red = sc + 416;
    LAS float* part = red + 16;
    const int qw = lane >> 4, k16 = lane & 15;
    const f32x4 qa = *(const f32x4*)(projs + (size_t)row * DIN + C_QA + h * 128 + 4 * k16) * 0.08838834764831845f;
    const f32x4 qb = *(const f32x4*)(projs + (size_t)row * DIN + C_QA + h * 128 + 64 + 4 * k16) * 0.08838834764831845f;
    const float* rowp[13];
#pragma unroll
    for (int it = 0; it < 13; ++it) {
        int s = it * 32 + wave * 4 + qw; s = s < 387 ? s : 386;
        const int p = s / 129, j = s - p * 129, dil = (p == 0) ? 1 : (p == 1 ? 4 : 16), idx = 2048 + t - dil * j;
        rowp[it] = (idx >= 2048) ? projs + (size_t)(b * 8 + idx - 2048) * DIN + C_KA + h * 128
                                 : P.in[I_CK] + ((size_t)((l * 8 + b) * 2048 + idx) * 6 + h) * 128;
    }
    {
        f32x4 ka[13], kb[13];
#pragma unroll
        for (int it = 0; it < 13; ++it) { ka[it] = __builtin_nontemporal_load((const f32x4*)(rowp[it] + 4 * k16)); kb[it] = __builtin_nontemporal_load((const f32x4*)(rowp[it] + 64 + 4 * k16)); }
#pragma unroll
        for (int it = 0; it < 13; ++it) {
            float a = (ka[it][0] * qa[0] + ka[it][1] * qa[1]) + (ka[it][2] * qa[2] + ka[it][3] * qa[3]) + (kb[it][0] * qb[0] + kb[it][1] * qb[1]) + (kb[it][2] * qb[2] + kb[it][3] * qb[3]);
            a += __shfl_xor(a, 1); a += __shfl_xor(a, 2); a += __shfl_xor(a, 4); a += __shfl_xor(a, 8);
            const int s = it * 32 + wave * 4 + qw;
            if (k16 == 0) sc[s] = (s < 387) ? a : -1e30f;
        }
    }
    __syncthreads();
    const float v = (tid < 416) ? sc[tid] : -1e30f;
    float m = wave_max(v);
    if (lane == 0) red[wave] = m;
    __syncthreads();
    m = red[0];
#pragma unroll
    for (int w = 1; w < 8; ++w) m = fmaxf(m, red[w]);
    const float e = (tid < 387) ? __expf(v - m) : 0.f;
    float sm = wave_sum(e);
    __syncthreads();
    if (tid < 416) sc[tid] = e;
    if (lane == 0) red[8 + wave] = sm;
    __syncthreads();
    float den = 0.f;
#pragma unroll
    for (int w = 0; w < 8; ++w) den += red[8 + w];
    f32x4 oa = (f32x4){0.f, 0.f, 0.f, 0.f}, ob = (f32x4){0.f, 0.f, 0.f, 0.f};
    {
        f32x4 va[13], vb[13];
#pragma unroll
        for (int it = 0; it < 13; ++it) {
            int s = it * 32 + wave * 4 + qw; s = s < 387 ? s : 386;
            const int p = s / 129, j = s - p * 129, dil = (p == 0) ? 1 : (p == 1 ? 4 : 16), idx = 2048 + t - dil * j;
            const float* vr = (idx >= 2048) ? projs + (size_t)(b * 8 + idx - 2048) * DIN + C_VA + h * 128
                                            : P.in[I_CV] + ((size_t)((l * 8 + b) * 2048 + idx) * 6 + h) * 128;
            va[it] = __builtin_nontemporal_load((const f32x4*)(vr + 4 * k16)); vb[it] = __builtin_nontemporal_load((const f32x4*)(vr + 64 + 4 * k16));
        }
#pragma unroll
        for (int it = 0; it < 13; ++it) { const float pe = sc[it * 32 + wave * 4 + qw]; oa += va[it] * pe; ob += vb[it] * pe; }
    }
#pragma unroll
    for (int i = 0; i < 4; ++i) { oa[i] += __shfl_xor(oa[i], 16); oa[i] += __shfl_xor(oa[i], 32); ob[i] += __shfl_xor(ob[i], 16); ob[i] += __shfl_xor(ob[i], 32); }
    if (qw == 0) { *(LAS f32x4*)(part + wave * 128 + 4 * k16) = oa; *(LAS f32x4*)(part + wave * 128 + 64 + 4 * k16) = ob; }
    __syncthreads();
    if (tid < 128) {
        float o = 0.f;
#pragma unroll
        for (int w = 0; w < 8; ++w) o += part[w * 128 + tid];
        ((bf16*)(P.ws + WS_MIX))[(size_t)(MP + row) * D + M_A + h * 128 + tid] = (bf16)f2bf(o / den);
    }
    __syncthreads();
}
__device__ __forceinline__ void s_pool_unit(const Ptrs& P, LAS unsigned char* lds, int l, int row, int tid) {
    const int b = row >> 3, t = row & 7;
    const float* projs = (const float*)(P.ws + WS_PROJS);
    const float* sp = P.in[I_SPOOL] + (size_t)(l * 8 + b) * 15 * 512;
    LAS float* pl = (LAS float*)lds;
    {
        const int c = tid, g = c >> 7, w = 2 << g; float sum = 0.f, cur = 0.f;
        for (int i = 0; i < w; ++i) { const int e = 15 + t - i;
            const float uv = (e < 15) ? sp[(size_t)e * 512 + c] : projs[(size_t)(b * 8 + e - 15) * DIN + C_UB + c];
            sum += uv; if (i == 0) cur = uv; }
        pl[c] = sum / (float)w - cur;
        if (t == 0) { float* dst = P.out + O_SP + (size_t)(l * 8 + b) * 15 * 512;
            for (int i = 0; i < 7; ++i) dst[(size_t)i * 512 + c] = sp[(size_t)(8 + i) * 512 + c]; }
    }
    __syncthreads();
    {
        const int g = tid >> 7, d = tid & 127; const float* wp = P.in[I_WPOOL] + (size_t)(l * 4 + g) * 128 * 128;
        float a = 0.f;
#pragma unroll 8
        for (int c = 0; c < 128; ++c) a += pl[g * 128 + c] * wp[(size_t)c * 128 + d];
        a *= P.in[I_PSCALE][l * 512 + tid];
        ((bf16*)(P.ws + WS_MIX))[(size_t)(MP + row) * D + M_B + tid] = (bf16)f2bf(a);
    }
    __syncthreads();
}
__device__ __forceinline__ void s_gla_unit(const Ptrs& P, LAS unsigned char* lds, int l, int unit, int tid) {
    const int b = unit >> 2, h = unit & 3;
    const float* projs = (const float*)(P.ws + WS_PROJS);
    LAS float* eg = (LAS float*)lds;
    LAS float* qL = eg + 768;
    LAS float* kL = qL + 768;
    LAS float* vL = kL + 768;
    LAS float* op = vL + 1536;
    LAS float* oc = op + 384;
    LAS float* rs = oc + 1536;
    for (int i = tid; i < 768; i += NTHR) {
        const int t = i / 96, dk = i % 96; const float* pr = projs + (size_t)(b * 8 + t) * DIN;
        float z = P.in[I_BG][l * 384 + h * 96 + dk];
#pragma unroll
        for (int r = 0; r < 16; ++r) z += pr[C_GC + r] * P.in[I_WG2][(size_t)(l * 16 + r) * 384 + h * 96 + dk];
        eg[i] = __expf(logsig(z) * (1.0f / 16.0f));
        qL[i] = pr[C_QC + h * 96 + dk] * 0.10206207261596575f;
        kL[i] = pr[C_KC + h * 96 + dk];
    }
    for (int i = tid; i < 1536; i += NTHR) { const int t = i / 192, dv = i % 192; vL[i] = projs[(size_t)(b * 8 + t) * DIN + C_VC + h * 192 + dv]; }
    __syncthreads();
    const int dv = tid % 192, hf = tid / 192;
    float S[48];
    const float* s0 = P.in[I_SGLA] + (size_t)((l * 8 + b) * 4 + h) * SELEMS;
    if (tid < 384) {
#pragma unroll
        for (int i = 0; i < 48; ++i) S[i] = s0[(size_t)(48 * hf + i) * 192 + dv];
    }
    LAS float* opart = (LAS float*)(lds + 32768);
    if (tid < 384) {
        for (int t = 0; t < 8; ++t) {
            float o = 0.f; const float vv = vL[t * 192 + dv];
#pragma unroll
            for (int i = 0; i < 48; ++i) { const int dk = 48 * hf + i; S[i] = eg[t * 96 + dk] * S[i] + kL[t * 96 + dk] * vv; o += qL[t * 96 + dk] * S[i]; }
            opart[(t * 2 + hf) * 192 + dv] = o;
        }
    }
    __syncthreads();
    for (int i = tid; i < 1536; i += NTHR) { const int t = i / 192, d2 = i - 192 * t; oc[i] = opart[(t * 2) * 192 + d2] + opart[(t * 2 + 1) * 192 + d2]; }
    __syncthreads();
    if (tid < 384) { float* dst = P.out + O_SG + (size_t)((l * 8 + b) * 4 + h) * SELEMS;
#pragma unroll
        for (int i = 0; i < 48; ++i) dst[(size_t)(48 * hf + i) * 192 + dv] = S[i]; }
    {
        const int w = tid >> 6, ln = tid & 63; float s = 0.f;
        for (int i = ln; i < 192; i += 64) { const float x = oc[w * 192 + i]; s += x * x; }
        s = wave_sum(s);
        if (ln == 0) rs[w] = rsqrtf(s * (1.0f / 192.0f) + EPS);
    }
    __syncthreads();
    for (int i = tid; i < 1536; i += NTHR) {
        const int t = i / 192, d2 = i % 192; const int row = b * 8 + t;
        const float r = projs[(size_t)row * DIN + C_RC + h * 192 + d2];
        const float val = oc[i] * rs[t] * P.in[I_GNG][l * 192 + d2] * silu(r);
        ((bf16*)(P.ws + WS_MIX))[(size_t)(MP + row) * D + M_C + h * 192 + d2] = (bf16)f2bf(val);
    }
    __syncthreads();
}

typedef short v4i16_t __attribute__((ext_vector_type(4)));
__device__ __forceinline__ unsigned offb(unsigned row, unsigned ch) { return 256u * row + 16u * (ch ^ (((row & 3u) << 2) | ((row >> 2) & 3u))); }
__device__ __forceinline__ void p_attn_unit(const Ptrs& P, LAS unsigned char* lds, int unit, int wave, int lane) {
    const bf16* PROJ = (const bf16*)(P.ws + WS_PROJ);
    const int cb = unit & 31, pbh = unit >> 5, p = pbh / 12, bh = pbh - 12 * p, b = bh / 6, h = bh - 6 * b;
    const int dsh = 2 * p, dil = 1 << dsh, nbk = 32 >> dsh, r = cb / nbk, n = cb - r * nbk;
    const size_t rb = (size_t)b * SEQ + r;
#pragma unroll
    for (int i8 = 0; i8 < 8; ++i8) {
        const int i = wave * 8 + i8, row = 4 * i + (lane >> 4), pc = lane & 15;
        const int ch = pc ^ (((row & 3) << 2) | ((row >> 2) & 3));
        int ci = 128 * (n - 1) + row; ci = ci < 0 ? 0 : ci;
        const bf16* src = PROJ + (rb + (size_t)dil * ci) * NINP + h * 128 + 8 * ch;
        __builtin_amdgcn_global_load_lds((const unsigned*)(src + C_KA), (LAS unsigned*)(lds + i * 1024), 16, 0, 0);
        __builtin_amdgcn_global_load_lds((const unsigned*)(src + C_VA), (LAS unsigned*)(lds + 65536 + i * 1024), 16, 0, 0);
    }
    const int g = lane >> 4, ql = lane & 15, iloc = 16 * wave + ql;
    const size_t qrow = rb + (size_t)dil * (128 * n + iloc);
    bf16x8 qf[4];
#pragma unroll
    for (int ks = 0; ks < 4; ++ks) qf[ks] = *(const bf16x8*)(PROJ + qrow * NINP + C_QA + h * 128 + 32 * ks + 8 * g);
    asm volatile("s_waitcnt vmcnt(0)" ::: "memory");
    __syncthreads();
    const int s0 = wave >> 1;
    const unsigned q4 = ql >> 2, p4 = lane & 3;
    LAS unsigned char* kbase[2][4]; LAS unsigned char* vbase[8][2];
#pragma unroll
    for (int T = 0; T < 2; ++T)
#pragma unroll
        for (int ks = 0; ks < 4; ++ks) kbase[T][ks] = lds + offb(32 * s0 + 8 * (ql >> 2) + 4 * T + (ql & 3), 4 * ks + g);
#pragma unroll
    for (int c = 0; c < 8; ++c)
#pragma unroll
        for (int t = 0; t < 2; ++t) vbase[c][t] = lds + 65536u + offb(32 * s0 + 8 * g + 4 * t + q4, 2 * c + (p4 >> 1)) + 8u * (p4 & 1);
    f32x4 st[5][2];
#pragma unroll
    for (int s = 0; s < 5; ++s) {
        bf16x8 kf[2][4];
#pragma unroll
        for (int T = 0; T < 2; ++T)
#pragma unroll
            for (int ks = 0; ks < 4; ++ks) kf[T][ks] = *(const LAS bf16x8*)(kbase[T][ks] + 8192 * s);
        __builtin_amdgcn_sched_barrier(0);
#pragma unroll
        for (int T = 0; T < 2; ++T) {
            f32x4 a = (f32x4){0.f, 0.f, 0.f, 0.f};
#pragma unroll
            for (int ks = 0; ks < 4; ++ks) a = __builtin_amdgcn_mfma_f32_16x16x32_bf16(kf[T][ks], qf[ks], a, 0, 0, 0);
            st[s][T] = a;
        }
    }
    const float NINF = -__builtin_inff();
#pragma unroll
    for (int T = 0; T < 2; ++T)
#pragma unroll
        for (int e = 0; e < 4; ++e) {
            const int j0 = 32 * s0 + 8 * g + 4 * T + e, j4 = j0 + 128;
            st[0][T][e] = (j0 >= iloc) ? st[0][T][e] : NINF;
            st[4][T][e] = (j4 <= iloc + 128) ? st[4][T][e] : NINF;
        }
    if (n == 0) {
#pragma unroll
        for (int s = 0; s < 5; ++s)
#pragma unroll
            for (int T = 0; T < 2; ++T)
#pragma unroll
                for (int e = 0; e < 4; ++e) { const int j = 32 * (s0 + s) + 8 * g + 4 * T + e; st[s][T][e] = (j >= 128) ? st[s][T][e] : NINF; }
    }
    float mx = NINF;
#pragma unroll
    for (int s = 0; s < 5; ++s)
#pragma unroll
        for (int T = 0; T < 2; ++T) mx = fmaxf(fmaxf(mx, fmaxf(st[s][T][0], st[s][T][1])), fmaxf(st[s][T][2], st[s][T][3]));
    mx = fmaxf(mx, __shfl_xor(mx, 16)); mx = fmaxf(mx, __shfl_xor(mx, 32));
    const float SC2 = 0.08838834764831845f * 1.4426950408889634f, m2 = mx * SC2;
    float sum = 0.f;
    bf16x8 pf[5];
#pragma unroll
    for (int s = 0; s < 5; ++s) {
        float e[8];
#pragma unroll
        for (int T = 0; T < 2; ++T)
#pragma unroll
            for (int k = 0; k < 4; ++k) { const float x = __builtin_amdgcn_exp2f(__builtin_fmaf(st[s][T][k], SC2, -m2)); e[4 * T + k] = x; sum += x; }
        u32x4 w; w.x = pk2(e[0], e[1]); w.y = pk2(e[2], e[3]); w.z = pk2(e[4], e[5]); w.w = pk2(e[6], e[7]);
        pf[s] = __builtin_bit_cast(bf16x8, w);
    }
    sum += __shfl_xor(sum, 16); sum += __shfl_xor(sum, 32);
    f32x4 ot[8];
#pragma unroll
    for (int c = 0; c < 8; ++c) ot[c] = (f32x4){0.f, 0.f, 0.f, 0.f};
#pragma unroll
    for (int s = 0; s < 5; ++s) {
        v4i16_t lo[8], hi[8];
#pragma unroll
        for (int c = 0; c < 8; ++c) {
            lo[c] = __builtin_amdgcn_ds_read_tr16_b64_v4i16((LAS v4i16_t*)(vbase[c][0] + 8192 * s));
            hi[c] = __builtin_amdgcn_ds_read_tr16_b64_v4i16((LAS v4i16_t*)(vbase[c][1] + 8192 * s));
        }
        __builtin_amdgcn_sched_barrier(0);
#pragma unroll
        for (int c = 0; c < 8; ++c) {
            bf16x8 vf; vf[0] = lo[c][0]; vf[1] = lo[c][1]; vf[2] = lo[c][2]; vf[3] = lo[c][3]; vf[4] = hi[c][0]; vf[5] = hi[c][1]; vf[6] = hi[c][2]; vf[7] = hi[c][3];
            ot[c] = __builtin_amdgcn_mfma_f32_16x16x32_bf16(vf, pf[s], ot[c], 0, 0, 0);
        }
    }
    const float inv = 1.0f / sum;
    bf16* op = (bf16*)(P.ws + WS_OP) + ((size_t)p * MP + qrow) * 768 + h * 128 + 4 * g;
#pragma unroll
    for (int c = 0; c < 8; ++c) { u32x2 w; w.x = pk2(ot[c][0] * inv, ot[c][1] * inv); w.y = pk2(ot[c][2] * inv, ot[c][3] * inv); *(u32x2*)(op + 16 * c) = w; }
    if (g == 0) ((float*)(P.ws + WS_LSE))[((size_t)p * MP + qrow) * 6 + h] = mx * 0.08838834764831845f + __logf(sum);
    __syncthreads();
}
__device__ __forceinline__ void attn_combine(const Ptrs& P, int bx, int G, int wave, int lane) {
    const bf16* OP = (const bf16*)(P.ws + WS_OP); const float* LSE = (const float*)(P.ws + WS_LSE); bf16* MIX = (bf16*)(P.ws + WS_MIX);
    for (int tok = bx * NWAVES + wave; tok < MP; tok += G * NWAVES) {
        unsigned w[3][6]; float ls[3][6];
#pragma unroll
        for (int p = 0; p < 3; ++p)
#pragma unroll
            for (int h = 0; h < 6; ++h) { w[p][h] = *(const unsigned*)(OP + ((size_t)p * MP + tok) * 768 + h * 128 + 2 * lane); ls[p][h] = LSE[((size_t)p * MP + tok) * 6 + h]; }
#pragma unroll
        for (int h = 0; h < 6; ++h) {
            const float m = fmaxf(ls[0][h], fmaxf(ls[1][h], ls[2][h])), e0 = __expf(ls[0][h] - m), e1 = __expf(ls[1][h] - m), e2 = __expf(ls[2][h] - m), inv = 1.0f / (e0 + e1 + e2);
            const float a = (e0 * bf2f(w[0][h] & 0xffffu) + e1 * bf2f(w[1][h] & 0xffffu) + e2 * bf2f(w[2][h] & 0xffffu)) * inv;
            const float c = (e0 * bf2f(w[0][h] >> 16) + e1 * bf2f(w[1][h] >> 16) + e2 * bf2f(w[2][h] >> 16)) * inv;
            *(unsigned*)(MIX + (size_t)tok * D + M_A + h * 128 + 2 * lane) = pk2(a, c);
        }
    }
}
__device__ __forceinline__ void p_pool_wunit(const Ptrs& P, LAS unsigned char* lds, int l, int unit, int wave, int lane) {
    const bf16* PROJ = (const bf16*)(P.ws + WS_PROJ);
    const int grp = unit & 3, tb = unit >> 2, b = tb >> 8, t0 = (tb & 255) * 16;
    const int g = lane >> 4, ql = lane & 15, w = 2 << grp;
    LAS unsigned char* pl = lds + wave * 4352;
    const bf16* wpt = (const bf16*)(P.ws + WS_WPT) + (size_t)(l * 4 + grp) * 128 * 128;
    {
        const bf16* up = PROJ + (size_t)b * SEQ * NINP + C_UB + grp * 128 + 2 * lane;
        unsigned raw[31];
#pragma unroll
        for (int i = 0; i < 31; ++i) { const int tp = t0 - 15 + i; const unsigned v = *(const unsigned*)(up + (size_t)(tp >= 0 ? tp : 0) * NINP); raw[i] = (tp >= 0) ? v : 0u; }
        float p0[32], p1[32]; p0[0] = 0.f; p1[0] = 0.f;
#pragma unroll
        for (int i = 0; i < 31; ++i) { p0[i + 1] = p0[i] + bf2f(raw[i] & 0xffffu); p1[i + 1] = p1[i] + bf2f(raw[i] >> 16); }
#pragma unroll
        for (int tt = 0; tt < 16; ++tt) {
            const int t = t0 + tt; const float inv = 1.0f / (float)((t + 1 < w) ? (t + 1) : w);
            const int lo = (grp == 0) ? 14 + tt : (grp == 1) ? 12 + tt : (grp == 2) ? 8 + tt : tt;
            float s0, s1;
            if (grp == 0) { s0 = p0[16 + tt] - p0[14 + tt]; s1 = p1[16 + tt] - p1[14 + tt]; }
            else if (grp == 1) { s0 = p0[16 + tt] - p0[12 + tt]; s1 = p1[16 + tt] - p1[12 + tt]; }
            else if (grp == 2) { s0 = p0[16 + tt] - p0[8 + tt]; s1 = p1[16 + tt] - p1[8 + tt]; }
            else { s0 = p0[16 + tt] - p0[tt]; s1 = p1[16 + tt] - p1[tt]; }
            (void)lo;
            *(LAS unsigned*)(pl + tt * 272 + 4 * lane) = pk2(s0 * inv - bf2f(raw[15 + tt] & 0xffffu), s1 * inv - bf2f(raw[15 + tt] >> 16));
        }
    }
    asm volatile("s_waitcnt lgkmcnt(0)" ::: "memory");
    bf16x8 bfr[4];
#pragma unroll
    for (int ks = 0; ks < 4; ++ks) bfr[ks] = *(const LAS bf16x8*)(pl + ql * 272 + (32 * ks + 8 * g) * 2);
    bf16* mx = (bf16*)(P.ws + WS_MIX) + ((size_t)b * SEQ + t0 + ql) * D + M_B + grp * 128 + 4 * g;
#pragma unroll
    for (int hf = 0; hf < 2; ++hf) {
        bf16x8 af[4][4];
#pragma unroll
        for (int nt = 0; nt < 4; ++nt)
#pragma unroll
            for (int ks = 0; ks < 4; ++ks) af[nt][ks] = *(const bf16x8*)(wpt + (size_t)(16 * (4 * hf + nt) + ql) * 128 + 32 * ks + 8 * g);
#pragma unroll
        for (int nt = 0; nt < 4; ++nt) {
            f32x4 acc = (f32x4){0.f, 0.f, 0.f, 0.f};
#pragma unroll
            for (int ks = 0; ks < 4; ++ks) acc = __builtin_amdgcn_mfma_f32_16x16x32_bf16(af[nt][ks], bfr[ks], acc, 0, 0, 0);
            u32x2 o; o.x = pk2(acc[0], acc[1]); o.y = pk2(acc[2], acc[3]); *(u32x2*)(mx + 16 * (4 * hf + nt)) = o;
        }
    }
    asm volatile("s_waitcnt lgkmcnt(0)" ::: "memory");
}
__device__ __forceinline__ float logsig_fast(float z) { return fminf(z, 0.f) - __logf(1.0f + __expf(-fabsf(z))); }
__device__ __forceinline__ bf16x8 tr8(LAS unsigned char* vi, int tok0, int col, int q4, int p4) {
    const v4i16_t lo = __builtin_amdgcn_ds_read_tr16_b64_v4i16((LAS v4i16_t*)(vi + (tok0 + q4) * 400 + (col + 4 * p4) * 2));
    const v4i16_t hi = __builtin_amdgcn_ds_read_tr16_b64_v4i16((LAS v4i16_t*)(vi + (tok0 + 4 + q4) * 400 + (col + 4 * p4) * 2));
    bf16x8 r; r[0] = lo[0]; r[1] = lo[1]; r[2] = lo[2]; r[3] = lo[3]; r[4] = hi[0]; r[5] = hi[1]; r[6] = hi[2]; r[7] = hi[3]; return r;
}
__device__ __forceinline__ void gla1_dunit(const Ptrs& P, LAS unsigned char* lds, int l, int du, int tid, int wave, int lane) {
    const bf16* PROJ = (const bf16*)(P.ws + WS_PROJ);
    const int bh = du >> 5, b = bh >> 2, h = bh & 3, t0 = (du & 31) * 128, unit0 = bh * 64 + (du & 31) * 2;
    LAS float* gaL = (LAS float*)lds;
    LAS float* tot = (LAS float*)(lds + 8192);
    LAS unsigned char* KT = lds + 11264;
    LAS unsigned char* VI = lds + 38912;
    const bf16* pr = PROJ + ((size_t)b * SEQ + t0) * NINP;
    *(LAS f32x4*)(gaL + 4 * tid) = *(const f32x4*)((const float*)(P.ws + WS_GA) + ((size_t)b * SEQ + t0) * 16 + 4 * tid);
    const int dk = tid % 96, seg = tid / 96;
    float wg[16], bg = 0.f;
    if (tid < 384) {
#pragma unroll
        for (int r = 0; r < 16; ++r) wg[r] = P.in[I_WG2][(size_t)(l * 16 + r) * 384 + h * 96 + dk];
        bg = P.in[I_BG][l * 384 + h * 96 + dk];
    }
#pragma unroll
    for (int c2 = 0; c2 < 2; ++c2)
        for (int i = tid; i < 1536; i += NTHR) { const int j = i / 24, ch = i - 24 * j;
            *(LAS u32x4*)(VI + c2 * 25600 + j * 400 + ch * 16) = *(const u32x4*)(pr + (size_t)(64 * c2 + j) * NINP + C_VC + h * 192 + 8 * ch); }
    __syncthreads();
    float run[2][16];
    if (tid < 384) {
#pragma unroll
        for (int c2 = 0; c2 < 2; ++c2) {
            float acc = 0.f;
#pragma unroll
            for (int jj = 0; jj < 16; ++jj) {
                const LAS f32x4* gp = (const LAS f32x4*)(gaL + (64 * c2 + 16 * seg + jj) * 16);
                const f32x4 a0 = gp[0], a1 = gp[1], a2 = gp[2], a3 = gp[3];
                float z = bg;
                z += (a0[0] * wg[0] + a0[1] * wg[1]) + (a0[2] * wg[2] + a0[3] * wg[3]);
                z += (a1[0] * wg[4] + a1[1] * wg[5]) + (a1[2] * wg[6] + a1[3] * wg[7]);
                z += (a2[0] * wg[8] + a2[1] * wg[9]) + (a2[2] * wg[10] + a2[3] * wg[11]);
                z += (a3[0] * wg[12] + a3[1] * wg[13]) + (a3[2] * wg[14] + a3[3] * wg[15]);
                acc += logsig_fast(z) * (1.0f / 16.0f); run[c2][jj] = acc;
            }
            tot[(c2 * 4 + seg) * 96 + dk] = acc;
        }
    }
    __syncthreads();
    if (tid < 384) {
        float* bc = (float*)(P.ws + WS_BCUM) + ((size_t)b * SEQ + t0) * 384 + h * 96 + dk;
#pragma unroll
        for (int c2 = 0; c2 < 2; ++c2) {
            const float t0s = tot[(c2 * 4 + 0) * 96 + dk], t1s = tot[(c2 * 4 + 1) * 96 + dk], t2s = tot[(c2 * 4 + 2) * 96 + dk], t3s = tot[(c2 * 4 + 3) * 96 + dk];
            const float off = (seg > 0 ? t0s : 0.f) + (seg > 1 ? t1s : 0.f) + (seg > 2 ? t2s : 0.f), blast = ((t0s + t1s) + t2s) + t3s;
            const bf16* kp = pr + (size_t)(64 * c2 + 16 * seg) * NINP + C_KC + h * 96 + dk;
            float* bcp = bc + (size_t)(64 * c2 + 16 * seg) * 384;
#pragma unroll
            for (int j4 = 0; j4 < 4; ++j4) {
                unsigned short kr[4];
#pragma unroll
                for (int q = 0; q < 4; ++q) kr[q] = kp[(size_t)(4 * j4 + q) * NINP];
#pragma unroll
                for (int q = 0; q < 4; ++q) { const int jj = 4 * j4 + q, j = 16 * seg + jj; const float bb = run[c2][jj] + off;
                    bcp[(size_t)jj * 384] = bb;
                    ((LAS bf16*)(KT + c2 * 13824))[dk * 72 + j] = (bf16)f2bf(bf2f(kr[q]) * __expf(blast - bb)); }
                asm volatile("" ::: "memory");
            }
            if (seg == 3) ((float*)(P.ws + WS_DEC))[(size_t)(unit0 + c2) * 96 + dk] = __expf(blast);
        }
    }
    __syncthreads();
    const int g = lane >> 4, ql = lane & 15, q4 = ql >> 2, p4 = lane & 3, dkg = wave & 1, dvg = wave >> 1;
#pragma unroll
    for (int c2 = 0; c2 < 2; ++c2) {
        f32x4 acc[3][3];
#pragma unroll
        for (int a = 0; a < 3; ++a)
#pragma unroll
            for (int d = 0; d < 3; ++d) acc[a][d] = (f32x4){0.f, 0.f, 0.f, 0.f};
#pragma unroll
        for (int ks = 0; ks < 2; ++ks) {
            bf16x8 af[3], bfr[3];
#pragma unroll
            for (int a = 0; a < 3; ++a) af[a] = tr8(VI + c2 * 25600, 32 * ks + 8 * g, 16 * (3 * dvg + a), q4, p4);
#pragma unroll
            for (int d = 0; d < 3; ++d) bfr[d] = *(const LAS bf16x8*)(KT + c2 * 13824 + (16 * (3 * dkg + d) + ql) * 144 + (32 * ks + 8 * g) * 2);
#pragma unroll
            for (int a = 0; a < 3; ++a)
#pragma unroll
                for (int d = 0; d < 3; ++d) acc[a][d] = __builtin_amdgcn_mfma_f32_16x16x32_bf16(af[a], bfr[d], acc[a][d], 0, 0, 0);
        }
        bf16* sl = (bf16*)(P.ws + WS_SLOC) + (size_t)(unit0 + c2) * SELEMS;
#pragma unroll
        for (int a = 0; a < 3; ++a)
#pragma unroll
            for (int d = 0; d < 3; ++d)
#pragma unroll
                for (int e = 0; e < 4; ++e) sl[(size_t)(16 * (3 * dvg + a) + 4 * g + e) * 96 + 16 * (3 * dkg + d) + ql] = (bf16)f2bf(acc[a][d][e]);
    }
    __syncthreads();
}
__device__ __forceinline__ void gla2_scan(const Ptrs& P, int l, int bx, int G, int tid) {
    const unsigned* SL = (const unsigned*)(P.ws + WS_SLOC); unsigned* ST = (unsigned*)(P.ws + WS_SST); const float* DEC = (const float*)(P.ws + WS_DEC);
    const int per = (8 * (SELEMS / 2) + G - 1) / G;
    for (int e2 = bx * per + tid; tid < per && e2 < 8 * (SELEMS / 2) && e2 < (bx + 1) * per; e2 += NTHR) {
        const int bh = e2 / (SELEMS / 2), rem = 2 * (e2 - bh * (SELEMS / 2)), dv = rem / 96, dk = rem - 96 * dv;
        float S0 = 0.f, S1 = 0.f;
#pragma unroll 32
        for (int n = 0; n < NCH; ++n) {
            const size_t idx = (size_t)(bh * NCH + n) * SELEMS + rem;
            const unsigned slp = SL[idx >> 1]; const f32x2 dc = *(const f32x2*)(DEC + (size_t)(bh * NCH + n) * 96 + dk);
            ST[idx >> 1] = pk2(S0, S1); S0 = dc[0] * S0 + bf2f(slp & 0xffffu); S1 = dc[1] * S1 + bf2f(slp >> 16);
        }
        float* o = P.out + O_PG + (size_t)(l * 8 + bh) * SELEMS;
        o[(size_t)dk * 192 + dv] = S0; o[(size_t)(dk + 1) * 192 + dv] = S1;
    }
}
__device__ __forceinline__ void gla3_dunit(const Ptrs& P, LAS unsigned char* lds, int l, int du, int tid, int wave, int lane) {
    const bf16* PROJ = (const bf16*)(P.ws + WS_PROJ);
    const int bh = du >> 5, b = bh >> 2, h = bh & 3, t0 = (du & 31) * 128, unit0 = bh * 64 + (du & 31) * 2;
    LAS unsigned char* QE = lds; LAS unsigned char* KE = lds + 26624; LAS unsigned char* VI = lds + 53248;
    const int g = lane >> 4, ql = lane & 15, q4 = ql >> 2, p4 = lane & 3, it = wave & 3, c2 = wave >> 2, iloc = 16 * it + ql;
    const bf16* pr = PROJ + ((size_t)b * SEQ + t0) * NINP;
    const float* bc = (const float*)(P.ws + WS_BCUM) + ((size_t)b * SEQ + t0) * 384 + h * 96;
    for (int i = tid; i < 12288; i += NTHR) { const int j = i / 96, dk = i - 96 * j, cc = j >> 6, jl = j & 63; const float bb = bc[(size_t)j * 384 + dk];
        const float q = bf2f(pr[(size_t)j * NINP + C_QC + h * 96 + dk]) * 0.10206207261596575f, k = bf2f(pr[(size_t)j * NINP + C_KC + h * 96 + dk]);
        ((LAS bf16*)(QE + cc * 13312))[jl * 104 + dk] = (bf16)f2bf(q * __expf(bb)); ((LAS bf16*)(KE + cc * 13312))[jl * 104 + dk] = (bf16)f2bf(k * __expf(-bb)); }
    for (int i = tid; i < 3072; i += NTHR) { const int j = i / 24, ch = i - 24 * j, cc = j >> 6, jl = j & 63;
        *(LAS u32x4*)(VI + cc * 25600 + jl * 400 + ch * 16) = *(const u32x4*)(pr + (size_t)j * NINP + C_VC + h * 192 + 8 * ch); }
    __syncthreads();
    LAS unsigned char* qe = QE + c2 * 13312; LAS unsigned char* ke = KE + c2 * 13312; LAS unsigned char* vi = VI + c2 * 25600;
    const bf16* sst = (const bf16*)(P.ws + WS_SST) + (size_t)(unit0 + c2) * SELEMS;
    const int nst = (it >> 1) + 1;
    bf16x8 qfr[3];
#pragma unroll
    for (int ks = 0; ks < 3; ++ks) qfr[ks] = *(const LAS bf16x8*)(qe + iloc * 208 + (32 * ks + 8 * g) * 2);
    bf16x8 pf[2];
#pragma unroll
    for (int js = 0; js < 2; ++js) {
        u32x4 w = (u32x4){0u, 0u, 0u, 0u};
        if (js < nst) {
#pragma unroll
            for (int T = 0; T < 2; ++T) {
                const int jrow = 32 * js + 8 * q4 + 4 * T + (ql & 3);
                f32x4 a = (f32x4){0.f, 0.f, 0.f, 0.f};
                bf16x8 kf[3];
#pragma unroll
                for (int ks = 0; ks < 3; ++ks) kf[ks] = *(const LAS bf16x8*)(ke + jrow * 208 + (32 * ks + 8 * g) * 2);
#pragma unroll
                for (int ks = 0; ks < 3; ++ks) a = __builtin_amdgcn_mfma_f32_16x16x32_bf16(kf[ks], qfr[ks], a, 0, 0, 0);
                float e[4];
#pragma unroll
                for (int k = 0; k < 4; ++k) { const int j = 32 * js + 8 * g + 4 * T + k; e[k] = (j <= iloc) ? a[k] : 0.f; }
                if (T == 0) { w.x = pk2(e[0], e[1]); w.y = pk2(e[2], e[3]); } else { w.z = pk2(e[0], e[1]); w.w = pk2(e[2], e[3]); }
            }
        }
        pf[js] = __builtin_bit_cast(bf16x8, w);
    }
    f32x4 ot[12];
    float ss = 0.f;
#pragma unroll
    for (int hv = 0; hv < 2; ++hv) {
        bf16x8 sf[6][3];
#pragma unroll
        for (int a = 0; a < 6; ++a)
#pragma unroll
            for (int ks = 0; ks < 3; ++ks) sf[a][ks] = *(const bf16x8*)(sst + (size_t)(16 * (6 * hv + a) + ql) * 96 + 32 * ks + 8 * g);
#pragma unroll
        for (int a = 0; a < 6; ++a) ot[6 * hv + a] = (f32x4){0.f, 0.f, 0.f, 0.f};
#pragma unroll
        for (int js = 0; js < 2; ++js) if (js < nst) {
            bf16x8 vf[6];
#pragma unroll
            for (int a = 0; a < 6; ++a) vf[a] = tr8(vi, 32 * js + 8 * g, 16 * (6 * hv + a), q4, p4);
#pragma unroll
            for (int a = 0; a < 6; ++a) ot[6 * hv + a] = __builtin_amdgcn_mfma_f32_16x16x32_bf16(vf[a], pf[js], ot[6 * hv + a], 0, 0, 0);
        }
#pragma unroll
        for (int a = 0; a < 6; ++a)
#pragma unroll
            for (int ks = 0; ks < 3; ++ks) ot[6 * hv + a] = __builtin_amdgcn_mfma_f32_16x16x32_bf16(sf[a][ks], qfr[ks], ot[6 * hv + a], 0, 0, 0);
#pragma unroll
        for (int a = 0; a < 6; ++a) { const f32x4 o = ot[6 * hv + a]; ss += (o[0] * o[0] + o[1] * o[1]) + (o[2] * o[2] + o[3] * o[3]); }
    }
    ss += __shfl_xor(ss, 16); ss += __shfl_xor(ss, 32);
    const float rstd = rsqrtf(ss * (1.0f / 192.0f) + EPS);
    const size_t r = (size_t)b * SEQ + t0 + 64 * c2 + iloc;
    bf16* MIX = (bf16*)(P.ws + WS_MIX);
#pragma unroll
    for (int a = 0; a < 12; ++a) {
        const int dv0 = 16 * a + 4 * g;
        const u32x2 rc = *(const u32x2*)(PROJ + r * NINP + C_RC + h * 192 + dv0); const f32x4 gn = *(const f32x4*)(P.in[I_GNG] + l * 192 + dv0);
        u32x2 w;
        w.x = pk2(ot[a][0] * rstd * gn[0] * silu(bf2f(rc.x & 0xffffu)), ot[a][1] * rstd * gn[1] * silu(bf2f(rc.x >> 16)));
        w.y = pk2(ot[a][2] * rstd * gn[2] * silu(bf2f(rc.y & 0xffffu)), ot[a][3] * rstd * gn[3] * silu(bf2f(rc.y >> 16)));
        *(u32x2*)(MIX + r * D + M_C + h * 192 + dv0) = w;
    }
    __syncthreads();
}
__device__ __forceinline__ void final_norm(const Ptrs& P, int bx, int G, int wave, int lane) {
    const bf16* X = (const bf16*)(P.ws + WS_XB); const float* part2 = (const float*)(P.ws + WS_PART2); const float* spart2 = (const float*)(P.ws + WS_SPART2); const float* g = P.in[I_FNG];
    for (int row = bx * NWAVES + wave; row < MT; row += G * NWAVES) {
        float ss;
        if (row < MP) ss = (lane < 8) ? part2[(size_t)row * 8 + lane] : 0.f;
        else ss = spart2[(size_t)(row - MP) * 128 + lane] + spart2[(size_t)(row - MP) * 128 + 64 + lane];
        const float rs = rsqrtf(wave_sum(ss) * (1.0f / 2048.0f) + EPS);
#pragma unroll
        for (int j = 0; j < 4; ++j) {
            const size_t c = 8 * lane + 512 * j; const u32x4 q = *(const u32x4*)(X + (size_t)row * D + c);
            const f32x4 g0 = *(const f32x4*)(g + c), g1 = *(const f32x4*)(g + c + 4);
            const f32x4 v0 = {bf2f(q.x & 0xffffu), bf2f(q.x >> 16), bf2f(q.y & 0xffffu), bf2f(q.y >> 16)}, v1 = {bf2f(q.z & 0xffffu), bf2f(q.z >> 16), bf2f(q.w & 0xffffu), bf2f(q.w >> 16)};
            *(f32x4*)(P.out + (size_t)row * D + c) = v0 * rs * g0; *(f32x4*)(P.out + (size_t)row * D + c + 4) = v1 * rs * g1;
        }
    }
}

#ifndef REP_PRO
#define REP_PRO 1
#endif
#ifndef REP_GLA1
#define REP_GLA1 1
#endif
#ifndef REP_GLA2
#define REP_GLA2 1
#endif
#ifndef REP_GLA3
#define REP_GLA3 1
#endif
#ifndef REP_POOL
#define REP_POOL 1
#endif
#ifndef REP_SMIX
#define REP_SMIX 1
#endif
#ifndef REP_PATTN
#define REP_PATTN 1
#endif
#ifndef REP_COMB
#define REP_COMB 1
#endif
#ifndef REP_BAR
#define REP_BAR 1
#endif
#ifndef REP_INPROJ
#define REP_INPROJ 1
#endif
#ifndef PG8_SP2
#define PG8_SP2 true
#endif
#ifndef TS_A
#define TS_A -1
#endif
#ifndef TS_B
#define TS_B -1
#endif
#ifndef TS_L
#define TS_L 1
#endif
#ifndef PG8_ALIGN_IG
#define PG8_ALIGN_IG true
#endif
#ifndef PA_ROT
#define PA_ROT 32
#endif
#ifndef REP_PH2
#define REP_PH2 1
#endif
#ifndef REP_PH4
#define REP_PH4 1
#endif
#ifndef REP_SGLA
#define REP_SGLA 1
#endif
#ifndef REP_SPOOL
#define REP_SPOOL 1
#endif
#ifndef REP_OUT
#define REP_OUT 1
#endif
#ifndef REP_DOWN
#define REP_DOWN 1
#endif
#ifndef REP_GU
#define REP_GU 1
#endif
#ifndef REP_SKINNY
#define REP_SKINNY 1
#endif
#ifndef MK_PER_PHASE
#define MK_PER_PHASE 0
#endif
constexpr int NPH = 30;
#ifndef MK_FILL
#define MK_FILL 1
#endif
#ifndef FILL_NCW
#define FILL_NCW 4
#endif
constexpr int NCW = FILL_NCW, CV_TOTAL = 3 * CV_L;
__device__ __forceinline__ void seam_fill(const XcdBarrier& b, const Ptrs& P, LAS unsigned char* lds, int bx, int G, int deadline, int limit) {
    int tid = threadIdx.x; asm volatile("" : "+v"(tid));
    const int wave = __builtin_amdgcn_readfirstlane(tid >> 6), lane = tid & 63;
    volatile LAS unsigned* cw = (volatile LAS unsigned*)(lds + MISC_OFF);
    const bool conv = (wave >= 1 && wave <= NCW);
    const int nwk = G * NCW;
    LAS float* scr = (LAS float*)(lds + (wave - 1) * 16640);
    int cur = conv ? (int)__builtin_amdgcn_readfirstlane(cw[16 + wave]) : CV_TOTAL;
    if (deadline > 0) {
        __syncthreads();
        if (conv) while (cur < deadline) { cvt_item(P, 1 + cur / CV_L, cur % CV_L, scr, lane); cur += nwk; }
    }
    asm volatile("s_waitcnt vmcnt(0)" ::: "memory");
    if (tid == 0) cw[0] = 0u;
    __syncthreads();
    if (wave == 0) {
        if (tid == 0) {
            unsigned* bar = b.bar;
            __builtin_amdgcn_s_waitcnt(0);
            unsigned nloc = b.st[0], nx = b.st[1];
            if (nloc == 0u) { xcd_barrier_complete(bar, b.x, nloc, nx); b.st[0] = nloc; b.st[1] = nx; }
            const unsigned old = xb_add(&bar[XB_XSUB(b.x)], 1u);
            const unsigned gen = old / nloc;
            if (old + 1u == (gen + 1u) * nloc) {
                __builtin_amdgcn_fence(__ATOMIC_RELEASE, "agent");
                asm volatile("s_waitcnt vmcnt(0)" ::: "memory");
                const unsigned og = xb_add(&bar[XB_TOP], 1u);
                const unsigned tg = og / nx;
                if (og + 1u == (tg + 1u) * nx) xb_add(&bar[XB_TOPGEN], 1u);
                else XB_SPIN(xb_ld(&bar[XB_TOPGEN]) == tg, bar);
                __builtin_amdgcn_fence(__ATOMIC_ACQUIRE, "agent");
                xb_add(&bar[XB_XGEN(b.x)], 1u);
                asm volatile("s_waitcnt vmcnt(0)" ::: "memory");
            } else {
                XB_SPIN(xb_ld(&bar[XB_XGEN(b.x)]) == gen, bar);
                __builtin_amdgcn_fence(__ATOMIC_ACQUIRE, "agent");
                asm volatile("s_waitcnt vmcnt(0)" ::: "memory");
            }
            cw[0] = 1u;
        }
    } else if (conv) {
        for (int nd = 0; nd < limit && cur < CV_TOTAL && __builtin_amdgcn_readfirstlane(cw[0]) == 0u; ++nd) { cvt_item(P, 1 + cur / CV_L, cur % CV_L, scr, lane); cur += nwk; }
    }
    if (conv && lane == 0) cw[16 + wave] = (unsigned)cur;
    __syncthreads();
}
struct Args { const float* in[N_IN]; float* out; unsigned char* ws; int ph_lo, ph_hi, li, pad; };

__global__ void __launch_bounds__(NTHR, 2) fwd(Args args) {
    extern __shared__ __attribute__((aligned(16))) unsigned char lds_raw[];
    LAS unsigned char* lds = (LAS unsigned char*)lds_raw;
    const int tid = threadIdx.x, lane = tid & 63, wave = __builtin_amdgcn_readfirstlane(tid >> 6);
    const int G = gridDim.x, bx = blockIdx.x;
    Ptrs P;
#pragma unroll
    for (int i = 0; i < N_IN; ++i) P.in[i] = args.in[i];
    P.out = args.out; P.ws = args.ws;
    for (int u = tid; u < (LDS_BYTES - LDSCTL_OFF) / 4; u += NTHR) ((LAS unsigned*)(lds + LDSCTL_OFF))[u] = 0u;
    __syncthreads();
    if (tid < NWAVES) ((volatile LAS unsigned*)(lds + MISC_OFF))[16 + tid] = (tid >= 1 && tid <= NCW) ? (unsigned)(bx * NCW + tid - 1) : (unsigned)CV_TOTAL;
    __syncthreads();
    unsigned* ctl = (unsigned*)(args.ws + WS_CTL);
    XcdBarrier bar; bar.bar = ctl + CW_BAR; bar.x = 0; bar.st = nullptr;
    if (!MK_PER_PHASE) bar = xcd_barrier_post(ctl + CW_BAR, (volatile LAS unsigned*)(lds + MISC_OFF) + 8);
    const int lo = args.ph_lo, hi = args.ph_hi;
#define IN(k) (lo <= (k) && (k) < hi)
#define STAMP(kk) do { if (TS_A >= 0 && bx == 0 && tid == 0) ((volatile LAS unsigned*)(lds + LDSCTL_OFF + 1024))[l * 32 + (kk)] = (unsigned)__builtin_amdgcn_s_memrealtime(); } while (0)
#define LAUNDER() int tid_ = tid; asm volatile("" : "+v"(tid_)); const int lane_ = tid_ & 63, wave_ = __builtin_amdgcn_readfirstlane(tid_ >> 6); (void)lane_; (void)wave_
#ifndef FILL_LIM
#define FILL_LIM 2
#endif
#ifndef FILL_TAIL
#define FILL_TAIL (1 << 20)
#endif
#define SEAM(k) SEAMD(k, 0)
#define SEAMD(k, dl) SEAML(k, dl, FILL_LIM)
#define SEAML(k, dl, lim) do { if (IN((k) + 1)) { if (!MK_PER_PHASE) { if (MK_FILL) { seam_fill(bar, P, lds, bx, G, (dl), (lim)); } else { xcd_barrier(bar); } for (int rb_ = 1; rb_ < REP_BAR; ++rb_) xcd_barrier(bar); } } } while (0)

    float* part1 = (float*)(args.ws + WS_PART1); float* part2 = (float*)(args.ws + WS_PART2); float* spart1 = (float*)(args.ws + WS_SPART1); float* spart2 = (float*)(args.ws + WS_SPART2);
    pg8::PG8_LAS_T xch = (pg8::PG8_LAS_T)(lds + XCH_OFF);
    bf16* XB = (bf16*)(args.ws + WS_XB); bf16* MIXB = (bf16*)(args.ws + WS_MIX); bf16* PROJ = (bf16*)(args.ws + WS_PROJ); bf16* FB = (bf16*)(args.ws + WS_F);
    float* projs = (float*)(args.ws + WS_PROJS);

    if (IN(0)) { for (int rep = 0; rep < REP_PRO; ++rep) { LAUNDER(); prologue(P, lds, bx, G, wave_, lane_, tid_, (MK_FILL && !MK_PER_PHASE) ? 1 : DEPTH); __syncthreads(); } SEAM(0); }

    for (int l = 0; l < DEPTH; ++l) {
        const int pb = 1 + 7 * l;
        unsigned char* wl = args.ws + WS_W + (size_t)l * LW_SZ;
        const bf16* Win = (const bf16*)(wl + LW_IN); const bf16* Wo = (const bf16*)(wl + LW_O); const bf16* Wgu = (const bf16*)(wl + LW_GU); const bf16* Wd = (const bf16*)(wl + LW_D);

        if (IN(pb + 0)) {
            LAUNDER(); STAMP(1);
            for (int rep = 0; rep < REP_INPROJ; ++rep) {
                pg8::Gemm g{XB, Win, MP, NINP, D}; pg8::StaticOrder S; S.init(MP, NINP, G, bx);
                pg8::EpiInProj E{PROJ, part2, (float*)(args.ws + WS_GA), P.out + O_PK + (size_t)l * 3145728, P.out + O_PV + (size_t)l * 3145728, P.out + O_PP + (size_t)l * 15360};
                pg8::gemm_phase<pg8::EpiInProj, pg8::StaticOrder, PG8_ALIGN_IG, PG8_SP2>(lds, g, S, E);
            }
            const int sh1 = (672 % G) ? (672 % G) : 0, ns1 = G - sh1;
            for (int rep = 0; rep < REP_SKINNY; ++rep) for (int u = bx - sh1; u >= 0 && u < 161; u += ns1) {
                const int t0 = 2 * u, t1 = (2 * u + 1 < 321) ? 2 * u + 1 : 320;
                SEpiInProj E{projs, skinny_rs(spart2, 0, tid_), skinny_rs(spart2, 32, tid_), P.out + O_SK + (size_t)l * 49152, P.out + O_SV + (size_t)l * 49152, P.out + O_SP + (size_t)l * 61440, 16 * t0};
                skinny_unit<4, 2, 4>(lds, XB + (size_t)MP * D, Win + (size_t)16 * t0 * D, Win + (size_t)16 * t1 * D, D, 0, (2 * u + 1 < 321) ? 2 : 1, E, wave_, lane_, tid_);
            }
            STAMP(24); SEAML(pb + 0, 0, (672 % G != 0 && bx >= 672 % G) ? FILL_TAIL : FILL_LIM);
        }
        if (IN(pb + 1)) {
            for (int rp2 = 0; rp2 < REP_PH2; ++rp2) {
            if (rp2 > 0 && !MK_PER_PHASE) xcd_barrier(bar);
            STAMP(2);
            for (int rep = 0; rep < REP_SMIX; ++rep) { LAUNDER(); for (int u = bx; u < 192; u += G) s_attn_punit(P, lds, l, u, wave_, lane_, tid_); }
            STAMP(3);
            for (int rep = 0; rep < REP_SPOOL; ++rep) { LAUNDER(); for (int u = (bx + G - 192 % G) % G; u < 64; u += G) s_pool_unit(P, lds, l, u, tid_); }
            for (int rep = 0; rep < REP_SGLA; ++rep) { LAUNDER(); for (int u = (bx + G - 160 % G) % G; u < 32; u += G) s_gla_unit(P, lds, l, u, tid_); }
            STAMP(5);
            for (int rep = 0; rep < REP_GLA1; ++rep) { LAUNDER(); for (int u = bx; u < 256; u += G) gla1_dunit(P, lds, l, u, tid_, wave_, lane_); }
            STAMP(6);
            for (int rep = 0; rep < REP_POOL; ++rep) { LAUNDER(); for (int u = bx * NWAVES + wave_; u < 2048; u += G * NWAVES) p_pool_wunit(P, lds, l, u, wave_, lane_); __syncthreads(); }
            STAMP(7);
            for (int rep = 0; rep < REP_PATTN; ++rep) { LAUNDER(); for (int u = (bx + G - PA_ROT % G) % G; u < 1152; u += G) p_attn_unit(P, lds, u, wave_, lane_); }
            }
            STAMP(8); SEAM(pb + 1);
        }
        if (IN(pb + 2)) { STAMP(9); for (int rep = 0; rep < REP_GLA2; ++rep) { LAUNDER(); gla2_scan(P, l, bx, G, tid_); } STAMP(10); SEAM(pb + 2); }
        if (IN(pb + 3)) { STAMP(11); for (int rp4 = 0; rp4 < REP_PH4; ++rp4) { if (rp4 > 0 && !MK_PER_PHASE) xcd_barrier(bar); for (int rep = 0; rep < REP_GLA3; ++rep) { LAUNDER(); for (int u = bx; u < 256; u += G) gla3_dunit(P, lds, l, u, tid_, wave_, lane_); } STAMP(12); for (int rep = 0; rep < REP_COMB; ++rep) { LAUNDER(); attn_combine(P, bx, G, wave_, lane_); } } STAMP(13); SEAMD(pb + 3, (l > 0) ? CV_L * (l - 1) + CV_IN + CV_O : 0); }
        if (IN(pb + 4)) {
            LAUNDER(); STAMP(14);
            for (int rep = 1; rep < REP_OUT; ++rep) {
                pg8::Gemm g{MIXB, Wo, MP, D, D}; pg8::StaticOrder S; S.init(MP, D, G, bx);
                pg8::EpiResid E{XB, (bf16*)(args.ws + WS_F), (float*)(args.ws + WS_GA), xch};
                pg8::gemm_phase<pg8::EpiResid, pg8::StaticOrder, true, PG8_SP2>(lds, g, S, E);
            }
            {
                pg8::Gemm g{MIXB, Wo, MP, D, D}; pg8::StaticOrder S; S.init(MP, D, G, bx);
                pg8::EpiResid E{XB, XB, part1, xch};
                pg8::gemm_phase<pg8::EpiResid, pg8::StaticOrder, true, PG8_SP2>(lds, g, S, E);
            }
            for (int u = G - 1 - bx; u < 256; u += G) {
                const int rh = u & 1, ct = u >> 1;
                SEpiResid E{XB + (size_t)MP * D, XB + (size_t)MP * D, spart1, 16 * ct};
                skinny_unit<2, 1, 8>(lds, MIXB + (size_t)MP * D, Wo + (size_t)16 * ct * D, Wo, D, 32 * rh, 1, E, wave_, lane_, tid_);
            }
            STAMP(16); SEAMD(pb + 4, (l > 0) ? CV_L * (l - 1) + CV_IN + CV_O + 2 * CV_G : 0);
        }
        if (IN(pb + 5)) {
            LAUNDER(); STAMP(17);
            for (int rep = 0; rep < REP_GU; ++rep) {
                pg8::Gemm g{XB, Wgu, MP, NGU, D}; pg8::StaticOrder S; S.init(MP, NGU, G, bx);
                pg8::EpiGateUp E{FB, part1};
                pg8::gemm_phase<pg8::EpiGateUp, pg8::StaticOrder, PG8_ALIGN_IG, PG8_SP2>(lds, g, S, E);
            }
            const int sh2 = (1408 % G) ? (1408 % G) : 0, ns2 = G - sh2;
            for (int rep = 0; rep < REP_SKINNY; ++rep) for (int u = bx - sh2; u >= 0 && u < 352; u += ns2) {
                const int f0 = 16 * u; const size_t gr = (size_t)(256 * (f0 >> 7) + (f0 & 127));
                SEpiGateUp E{FB, skinny_rs(spart1, 0, tid_), skinny_rs(spart1, 32, tid_), f0, 0.f, 0.f};
                skinny_unit<4, 2, 4>(lds, XB + (size_t)MP * D, Wgu + gr * D, Wgu + (gr + 128) * D, D, 0, 2, E, wave_, lane_, tid_);
            }
            STAMP(19); SEAML(pb + 5, (l > 0) ? CV_L * l : 0, (1408 % G != 0 && bx >= 1408 % G) ? FILL_TAIL : FILL_LIM);
        }
        if (IN(pb + 6)) {
            LAUNDER(); STAMP(20);
            for (int rep = 1; rep < REP_DOWN; ++rep) {
                pg8::Gemm g{FB, Wd, MP, D, DFF}; pg8::StaticOrder S; S.init(MP, D, G, bx);
                pg8::EpiResid E{XB, (bf16*)(args.ws + WS_MIX), (float*)(args.ws + WS_GA), xch};
                pg8::gemm_phase<pg8::EpiResid, pg8::StaticOrder, true, PG8_SP2>(lds, g, S, E);
            }
            {
                pg8::Gemm g{FB, Wd, MP, D, DFF}; pg8::StaticOrder S; S.init(MP, D, G, bx);
                pg8::EpiResid E{XB, XB, part2, xch};
                pg8::gemm_phase<pg8::EpiResid, pg8::StaticOrder, true, PG8_SP2>(lds, g, S, E);
            }
            for (int u = G - 1 - bx; u < 256; u += G) {
                const int rh = u & 1, ct = u >> 1;
                SEpiResid E{XB + (size_t)MP * D, XB + (size_t)MP * D, spart2, 16 * ct};
                skinny_unit<2, 1, 8>(lds, FB + (size_t)MP * DFF, Wd + (size_t)16 * ct * DFF, Wd, DFF, 32 * rh, 1, E, wave_, lane_, tid_);
            }
            STAMP(22); SEAMD(pb + 6, (l + 1 < DEPTH) ? CV_L * l + CV_IN : 0); STAMP(23);
        }
    }
    if (IN(29)) { LAUNDER(); final_norm(P, bx, G, wave_, lane_);
        if (TS_A >= 0 && bx == 0) {
            __syncthreads();
            const volatile LAS unsigned* ts = (const volatile LAS unsigned*)(lds + LDSCTL_OFF + 1024);
            unsigned acc_ = 0; for (int l_ = 0; l_ < DEPTH; ++l_) acc_ += ts[l_ * 32 + (TS_B < 0 ? 0 : TS_B)] - ts[l_ * 32 + (TS_A < 0 ? 0 : TS_A)];
            const float c = floorf(((float)acc_ * 0.01f + (float)TS_L) * (1.0f / 16.0f)) * 0.4f;
            for (int i = tid; i < MS * D; i += NTHR) P.out[O_YS + i] = c;
        }
    }
#undef IN
#undef SEAM
}

extern "C" void kernel_launch(void* const* d_in, const int* in_sizes, int n_in, void* d_out, int out_size, void* d_ws, size_t ws_size, hipStream_t stream) {
    static int grid = 0;
    if (grid == 0) {
        if (n_in != N_IN || (size_t)out_size != O_END || ws_size < WS_END) { fprintf(stderr, "kernel_launch: unexpected sizes n_in %d out %d ws %zu\n", n_in, out_size, ws_size); grid = -1; return; }
        int dev = 0, cus = 0, per_cu = 0;
        if (hipGetDevice(&dev) != hipSuccess || hipDeviceGetAttribute(&cus, hipDeviceAttributeMultiprocessorCount, dev) != hipSuccess) { grid = -1; return; }
        if (hipFuncSetAttribute((const void*)fwd, hipFuncAttributeMaxDynamicSharedMemorySize, LDS_BYTES) != hipSuccess) { fprintf(stderr, "kernel_launch: hipFuncSetAttribute failed\n"); grid = -1; return; }
        if (hipOccupancyMaxActiveBlocksPerMultiprocessor(&per_cu, (const void*)fwd, NTHR, LDS_BYTES) != hipSuccess || per_cu < 1) { fprintf(stderr, "kernel_launch: occupancy query says %d\n", per_cu); }
        (void)hipGetLastError();
        grid = cus;
    }
    if (grid < 0) return;
    (void)hipMemsetAsync((char*)d_ws + WS_CTL, 0, CTL_ZERO_BYTES, stream);
    Args a{};
    for (int i = 0; i < N_IN; ++i) a.in[i] = (const float*)d_in[i];
    a.out = (float*)d_out; a.ws = (unsigned char*)d_ws; a.li = 0; a.pad = 0;
#if MK_PER_PHASE
    for (int p = 0; p < NPH; ++p) { a.ph_lo = p; a.ph_hi = p + 1; hipLaunchKernelGGL(fwd, dim3(grid), dim3(NTHR), LDS_BYTES, stream, a); }
#else
    a.ph_lo = 0; a.ph_hi = NPH;
    hipLaunchKernelGGL(fwd, dim3(grid), dim3(NTHR), LDS_BYTES, stream, a);
#endif
    const hipError_t le = hipPeekAtLastError();
    if (le != hipSuccess) fprintf(stderr, "kernel_launch: launch failed: %s\n", hipGetErrorName(le));
}
```

```cpp
#include <hip/hip_runtime.h>
#include <cstdio>
#include <cstdint>
namespace pg8 {
#define PG8_LAS __attribute__((address_space(3)))
typedef unsigned short bf16_t;
typedef PG8_LAS float* PG8_LAS_T;
typedef short bf16x8 __attribute__((ext_vector_type(8)));
typedef float f32x4 __attribute__((ext_vector_type(4)));
typedef unsigned u32x4 __attribute__((ext_vector_type(4)));
#ifndef PG8_WGM
#define PG8_WGM 4
#endif
constexpr int BM = 256, BK = 64, HALF = 128, HTB = HALF * BK * 2  , STAGE_BYTES = 8 * HTB, NXCD = 8, WGM = PG8_WGM;

__host__ __device__ __forceinline__ int lds_byte(int r, int c) { const int st = (r >> 4) * 2 + (c >> 5), rr = r & 15, cc = c & 31, ob = rr * 64 + cc * 2; return st * 1024 + (ob ^ (((ob >> 9) & 1) << 5)); }
__host__ __device__ __forceinline__ void stage_rc(int b, int& R, int& C) { const int st = b / 1024, sb = b % 1024, swz = sb ^ (((sb >> 9) & 1) << 5); R = (st >> 1) * 16 + swz / 64; C = (st & 1) * 32 + (swz % 64) / 2; }
__host__ __device__ __forceinline__ int perm32(int rho) { const int n = rho >> 4, i = rho & 15; return 8 * (i >> 2) + 4 * n + (i & 3); }

struct Unit { int pm, pn; };
struct Gemm { const bf16_t* A; const bf16_t* Bt; int M, N, K; };

struct StaticOrder {
    int nM, nN, nwg, G, c;
    __host__ __device__ __forceinline__ void init(int M, int N, int G_, int c_) { nM = M / BM; nN = N / BM; nwg = nM * nN; G = G_; c = c_; }
    __host__ __device__ __forceinline__ bool next(int i, Unit& u) const {
        const long L = (long)i * G + c; if (L >= nwg) return false;
        int wgid = (int)L; { const int q = nwg / NXCD, r = nwg % NXCD, xcd = wgid % NXCD, off = wgid / NXCD; wgid = (xcd < r ? xcd * (q + 1) : r * (q + 1) + (xcd - r) * q) + off; }
        const int nig = WGM * nN, gid = wgid / nig, fm = gid * WGM, gsz = (nM - fm) < WGM ? (nM - fm) : WGM;
        u.pm = fm + ((wgid % nig) % gsz); u.pn = (wgid % nig) / gsz; return true;
    }
    __device__ __forceinline__ void a_ready(const Unit&) const {}
    __device__ __forceinline__ void done(const Unit&) const {}
};

constexpr int RS_OFF = 147456, RS_MAXU = 15;
constexpr size_t E_WS_PART1 = (size_t)1 << 20, E_WS_PART2 = ((size_t)1 << 20) + 262144, E_WS_GA = (size_t)2 << 20, E_WS_PROJ = (size_t)519 << 20, E_WS_F = (size_t)603 << 20, E_O_PK = 16908288, E_O_PV = 29491200, E_O_PP = 42074112;
#ifndef EPI_NT
#define EPI_NT 0
#endif

__device__ __forceinline__ unsigned cvt_pk_bf16(float lo, float hi) { unsigned r; asm volatile("v_cvt_pk_bf16_f32 %0, %1, %2" : "=v"(r) : "v"(lo), "v"(hi)); return r; }
__device__ __forceinline__ float silu_f(float x) { return x * __builtin_amdgcn_rcpf(1.0f + __expf(-x)); }

struct EpiInProj {
    static constexpr bool PERM = true, AFTER_DRAIN = false;
    unsigned char* ws; float* out; int l; PG8_LAS const float* rsl;
    __device__ __forceinline__ void operator()(const f32x4 (&acc)[2][2][4][2], const Unit& u, int wr, int wc, int fr, int fq) const {
        unsigned char* w_ = ws; float* o_ = out; asm volatile("" : "+s"(w_), "+s"(o_));
        bf16_t* P = (bf16_t*)(w_ + E_WS_PROJ); float* ga = (float*)(w_ + E_WS_GA);
        float* pk = o_ + E_O_PK + (size_t)l * 3145728; float* pv = o_ + E_O_PV + (size_t)l * 3145728; float* pp = o_ + E_O_PP + (size_t)l * 15360;
        const int row0 = u.pm * BM + wr * 64 + fr, col0 = u.pn * BM + wc * 32 + 8 * fq;
        const int tp = (u.pm & 15) * 256;
        const bool kv_out = (u.pn >= 3 && u.pn < 9) && (tp >= 2048);
        const bool u_out = (u.pn == 9 || u.pn == 10) && (tp == 3840);
        const bool g_out = (u.pn == 20) && (wc == 0) && (fq < 2);
        const int slot = __builtin_amdgcn_readfirstlane(((const PG8_LAS int*)(rsl + RS_MAXU * 256))[u.pm & 31]);
        const PG8_LAS float* rslu = rsl + slot * 256 + wr * 64 + fr;
#pragma unroll
        for (int ai = 0; ai < 2; ++ai)
#pragma unroll
            for (int m = 0; m < 4; ++m) {
                const int r = row0 + ai * HALF + m * 16;
                const float rs = rslu[ai * HALF + m * 16];
                bf16_t* rowp = P + (size_t)r * 5376 + col0;
                const int b = r >> 12, t = r & 4095;
#pragma unroll
                for (int bj = 0; bj < 2; ++bj) {
                    const f32x4 v0 = acc[ai][bj][m][0] * rs, v1 = acc[ai][bj][m][1] * rs;
                    u32x4 w; w.x = cvt_pk_bf16(v0[0], v0[1]); w.y = cvt_pk_bf16(v0[2], v0[3]); w.z = cvt_pk_bf16(v1[0], v1[1]); w.w = cvt_pk_bf16(v1[2], v1[3]);
#if EPI_NT & 2
                    __builtin_nontemporal_store(w, (u32x4*)(rowp + bj * HALF));
#else
                    *(u32x4*)(rowp + bj * HALF) = w;
#endif
                    const int c = col0 + bj * HALF;
                    if (kv_out) {
                        float* dst = (u.pn < 6) ? (pk + ((size_t)(b * 2048 + (t - 2048)) * 768 + (c - 768))) : (pv + ((size_t)(b * 2048 + (t - 2048)) * 768 + (c - 1536)));
                        *(f32x4*)dst = v0; *(f32x4*)(dst + 4) = v1;
                    }
                    if (u_out && t >= 4081) {
                        float* dst = pp + ((size_t)(b * 15 + (t - 4081)) * 512 + (c - 2304));
                        *(f32x4*)dst = v0; *(f32x4*)(dst + 4) = v1;
                    }
                    if (g_out && bj == 0) {
                        float* dst = ga + (size_t)r * 16 + 8 * fq;
                        *(f32x4*)dst = v0; *(f32x4*)(dst + 4) = v1;
                    }
                }
            }
    }
};
struct EpiResid {
    static constexpr bool PERM = true, AFTER_DRAIN = false;
    const bf16_t* xin; bf16_t* xb; float* part; PG8_LAS float* xch;
    __device__ __forceinline__ void operator()(const f32x4 (&acc)[2][2][4][2], const Unit& u, int wr, int wc, int fr, int fq) const {
        const int row0 = u.pm * BM + wr * 64 + fr, col0 = u.pn * BM + wc * 32 + 8 * fq;
        u32x4 resv[2][4][2];
#pragma unroll
        for (int ai = 0; ai < 2; ++ai)
#pragma unroll
            for (int m = 0; m < 4; ++m) { const size_t off = (size_t)(row0 + ai * HALF + m * 16) * 2048 + col0;
#pragma unroll
                for (int bj = 0; bj < 2; ++bj) resv[ai][m][bj] = *(const u32x4*)(xin + off + bj * HALF); }
        asm volatile("" ::: "memory");
#pragma unroll
        for (int ai = 0; ai < 2; ++ai) {
#pragma unroll
            for (int m = 0; m < 4; ++m) {
                const int r = row0 + ai * HALF + m * 16;
                const size_t off = (size_t)r * 2048 + col0;
                float s = 0.f;
#pragma unroll
                for (int bj = 0; bj < 2; ++bj) {
                    const u32x4 q = resv[ai][m][bj];
                    const f32x4 r0 = {__builtin_bit_cast(float, q.x << 16), __builtin_bit_cast(float, q.x & 0xffff0000u), __builtin_bit_cast(float, q.y << 16), __builtin_bit_cast(float, q.y & 0xffff0000u)};
                    const f32x4 r1 = {__builtin_bit_cast(float, q.z << 16), __builtin_bit_cast(float, q.z & 0xffff0000u), __builtin_bit_cast(float, q.w << 16), __builtin_bit_cast(float, q.w & 0xffff0000u)};
                    const f32x4 v0 = acc[ai][bj][m][0] + r0, v1 = acc[ai][bj][m][1] + r1;
                    u32x4 w; w.x = cvt_pk_bf16(v0[0], v0[1]); w.y = cvt_pk_bf16(v0[2], v0[3]); w.z = cvt_pk_bf16(v1[0], v1[1]); w.w = cvt_pk_bf16(v1[2], v1[3]);
                    *(u32x4*)(xb + off + bj * HALF) = w;
                    s += (v0[0] * v0[0] + v0[1] * v0[1]) + (v0[2] * v0[2] + v0[3] * v0[3]) + (v1[0] * v1[0] + v1[1] * v1[1]) + (v1[2] * v1[2] + v1[3] * v1[3]);
                }
                s += __shfl_xor(s, 16); s += __shfl_xor(s, 32);
                if (fq == 0) xch[(ai * HALF + wr * 64 + m * 16 + fr) * 4 + wc] = s;
            }
            asm volatile("" ::: "memory");
        }
        asm volatile("s_waitcnt lgkmcnt(0)" ::: "memory"); __builtin_amdgcn_s_barrier(); asm volatile("" ::: "memory");
        if (wr == 0) { const int row = wc * 64 + fq * 16 + fr; const f32x4 q = *(const PG8_LAS f32x4*)(xch + row * 4);
            part[(size_t)(u.pm * BM + row) * 8 + u.pn] = (q[0] + q[1]) + (q[2] + q[3]); }
    }
};
struct EpiGateUp {
    static constexpr bool PERM = true, AFTER_DRAIN = false;
    unsigned char* ws; PG8_LAS const float* rsl;
    __device__ __forceinline__ void operator()(const f32x4 (&acc)[2][2][4][2], const Unit& u, int wr, int wc, int fr, int fq) const {
        unsigned char* w_ = ws; asm volatile("" : "+s"(w_));
        bf16_t* F = (bf16_t*)(w_ + E_WS_F);
        const int row0 = u.pm * BM + wr * 64 + fr, col0 = u.pn * HALF + wc * 32 + 8 * fq;
        const int slot = __builtin_amdgcn_readfirstlane(((const PG8_LAS int*)(rsl + RS_MAXU * 256))[u.pm & 31]);
        const PG8_LAS float* rslu = rsl + slot * 256 + wr * 64 + fr;
#pragma unroll
        for (int ai = 0; ai < 2; ++ai)
#pragma unroll
            for (int m = 0; m < 4; ++m) {
                const int r = row0 + ai * HALF + m * 16;
                const float rs = rslu[ai * HALF + m * 16];
                const f32x4 g0 = acc[ai][0][m][0] * rs, g1 = acc[ai][0][m][1] * rs, u0 = acc[ai][1][m][0] * rs, u1 = acc[ai][1][m][1] * rs;
                u32x4 w;
                w.x = cvt_pk_bf16(silu_f(g0[0]) * u0[0], silu_f(g0[1]) * u0[1]); w.y = cvt_pk_bf16(silu_f(g0[2]) * u0[2], silu_f(g0[3]) * u0[3]);
                w.z = cvt_pk_bf16(silu_f(g1[0]) * u1[0], silu_f(g1[1]) * u1[1]); w.w = cvt_pk_bf16(silu_f(g1[2]) * u1[2], silu_f(g1[3]) * u1[3]);
#if EPI_NT & 1
                __builtin_nontemporal_store(w, (u32x4*)(F + (size_t)r * 5632 + col0));
#else
                *(u32x4*)(F + (size_t)r * 5632 + col0) = w;
#endif
            }
    }
};

template <class Epi, class Sched, bool ALIGN_EPI = false, bool SP2 = false>
__device__ __forceinline__ void gemm_phase(PG8_LAS unsigned char* lds, const Gemm g, const Sched& S, const Epi& E) {
    int tid = threadIdx.x; asm volatile("" : "+v"(tid)); const int wid = __builtin_amdgcn_readfirstlane(tid >> 6), lane = tid & 63, wr = wid >> 2, wc = wid & 3, fr = lane & 15, fq = lane >> 4;
    const int K = g.K, nt = K / BK;
    unsigned voffA[2], voffB[2];
#pragma unroll
    for (int i = 0; i < 2; ++i) { int R, C; stage_rc(tid * 16 + i * 8192, R, C); const int Rb = Epi::PERM ? ((R & ~31) + perm32(R & 31)) : R;
        voffA[i] = (unsigned)(R * K + C) * 2u; voffB[i] = (unsigned)(Rb * K + C) * 2u; }
    const size_t kstep = (size_t)(BK * 2);
    const size_t hstep = (size_t)HALF * K * 2;
    const size_t tstep = 2 * hstep;
    const unsigned ldsw = (unsigned)wid * 1024u;
    const int aoff = lds_byte(wr * 64 + fr, fq * 8), boff = lds_byte(wc * 32 + fr, fq * 8);
#define PG8_SA(b, h) (((b) * 2 + (h)) * HTB)
#define PG8_SB(b, h) ((4 + (b) * 2 + (h)) * HTB)
#define PG8_STAGE(bufoff, gbase, voff) do { _Pragma("unroll") for (int _i = 0; _i < 2; ++_i) \
        __builtin_amdgcn_global_load_lds((const unsigned*)((const char*)(gbase) + (voff)[_i]), (PG8_LAS unsigned*)(lds + (bufoff) + ldsw + _i * 8192), 16, 0, 0); } while (0)
#define PG8_LDA(dst, b, h) do { _Pragma("unroll") for (int m = 0; m < 4; ++m) _Pragma("unroll") for (int k = 0; k < 2; ++k) dst[m][k] = *(const PG8_LAS bf16x8*)(lds + PG8_SA(b, h) + aoff + m * 2048 + k * 1024); } while (0)
#define PG8_LDB(dst, b, h) do { _Pragma("unroll") for (int n = 0; n < 2; ++n) _Pragma("unroll") for (int k = 0; k < 2; ++k) dst[n][k] = *(const PG8_LAS bf16x8*)(lds + PG8_SB(b, h) + boff + n * 2048 + k * 1024); } while (0)
#define PG8_MMA(ai, bj, At, Bt) do { __builtin_amdgcn_s_setprio(1); _Pragma("unroll") for (int m = 0; m < 4; ++m) _Pragma("unroll") for (int n = 0; n < 2; ++n) _Pragma("unroll") for (int k = 0; k < 2; ++k) \
        acc[ai][bj][m][n] = __builtin_amdgcn_mfma_f32_16x16x32_bf16(Bt[n][k], At[m][k], acc[ai][bj][m][n], 0, 0, 0); __builtin_amdgcn_s_setprio(0); } while (0)
#define PG8_WAIT_V(n) asm volatile("s_waitcnt vmcnt(" #n ")" ::: "memory")
#define PG8_WAIT_L(n) asm volatile("s_waitcnt lgkmcnt(" #n ")" ::: "memory")
#define PG8_BAR __builtin_amdgcn_s_barrier()
#define PG8_SCHED __builtin_amdgcn_sched_barrier(0)
    Unit cur, nxt; int ui = 0;
    if (!S.next(0, cur)) return;
    f32x4 acc[2][2][4][2];
#pragma unroll
    for (int a = 0; a < 2; ++a)
#pragma unroll
        for (int b = 0; b < 2; ++b)
#pragma unroll
            for (int m = 0; m < 4; ++m)
#pragma unroll
                for (int n = 0; n < 2; ++n) acc[a][b][m][n] = (f32x4){0.f, 0.f, 0.f, 0.f};
    bf16x8 At[4][2], B0[2][2], B1[2][2];
    const char* cA = (const char*)g.A + (size_t)cur.pm * tstep; const char* cB = (const char*)g.Bt + (size_t)cur.pn * tstep;
    S.a_ready(cur);
    if constexpr (SP2) {
        PG8_STAGE(PG8_SB(0, 0), cB, voffB); PG8_STAGE(PG8_SB(0, 1), cB + hstep, voffB); PG8_STAGE(PG8_SA(0, 0), cA, voffA); PG8_STAGE(PG8_SA(0, 1), cA + hstep, voffA);
        if (wr == 1) PG8_BAR;
        PG8_WAIT_V(2); PG8_BAR;
        PG8_STAGE(PG8_SB(1, 0), cB + kstep, voffB); PG8_STAGE(PG8_SA(1, 0), cA + kstep, voffA); PG8_STAGE(PG8_SB(1, 1), cB + hstep + kstep, voffB);
        PG8_WAIT_V(6); PG8_BAR;
    } else {
        PG8_STAGE(PG8_SB(0, 0), cB, voffB); PG8_STAGE(PG8_SA(0, 0), cA, voffA); PG8_STAGE(PG8_SB(0, 1), cB + hstep, voffB); PG8_STAGE(PG8_SA(0, 1), cA + hstep, voffA);
        if (wr == 1) PG8_BAR;
        PG8_WAIT_V(4); PG8_BAR;
        PG8_STAGE(PG8_SB(1, 0), cB + kstep, voffB); PG8_STAGE(PG8_SA(1, 0), cA + kstep, voffA); PG8_STAGE(PG8_SB(1, 1), cB + hstep + kstep, voffB);
        PG8_WAIT_V(6); PG8_BAR;
    }
    for (;;) {
        const bool has_next = S.next(ui + 1, nxt);
        const char* nA = has_next ? (const char*)g.A + (size_t)nxt.pm * tstep : cA; const char* nB = has_next ? (const char*)g.Bt + (size_t)nxt.pn * tstep : cB;
        for (int t = 0; t < nt; t += 2) {
            const bool last = (t == nt - 2);
            const char* a1 = cA + (size_t)(t + 1) * kstep;
            const char* a2 = last ? nA : cA + (size_t)(t + 2) * kstep; const char* b2 = last ? nB : cB + (size_t)(t + 2) * kstep;
            const char* a3 = a2 + kstep; const char* b3 = b2 + kstep;
            if (last && has_next) S.a_ready(nxt);
            if constexpr (SP2) {
            PG8_LDB(B0, 0, 0); PG8_LDB(B1, 0, 1); PG8_SCHED; PG8_LDA(At, 0, 0); PG8_STAGE(PG8_SA(1, 1), a1 + hstep, voffA);
            PG8_WAIT_V(8); PG8_WAIT_L(0); PG8_BAR; PG8_MMA(0, 0, At, B0); PG8_MMA(0, 1, At, B1); PG8_BAR; PG8_SCHED;
            PG8_LDA(At, 0, 1); PG8_STAGE(PG8_SB(0, 0), b2, voffB); PG8_STAGE(PG8_SB(0, 1), b2 + hstep, voffB); PG8_STAGE(PG8_SA(0, 0), a2, voffA);
            PG8_WAIT_V(8); PG8_WAIT_L(0); PG8_BAR; PG8_MMA(1, 0, At, B0); PG8_MMA(1, 1, At, B1); PG8_BAR; PG8_SCHED;
            PG8_LDB(B0, 1, 0); PG8_LDB(B1, 1, 1); PG8_SCHED; PG8_LDA(At, 1, 0); PG8_STAGE(PG8_SA(0, 1), a2 + hstep, voffA);
            PG8_WAIT_V(8); PG8_WAIT_L(0); PG8_BAR; PG8_MMA(0, 0, At, B0); PG8_MMA(0, 1, At, B1); PG8_BAR; PG8_SCHED;
            PG8_LDA(At, 1, 1); PG8_STAGE(PG8_SB(1, 0), b3, voffB); PG8_STAGE(PG8_SB(1, 1), b3 + hstep, voffB); PG8_STAGE(PG8_SA(1, 0), a3, voffA);
            PG8_WAIT_V(8); PG8_WAIT_L(0); PG8_BAR; PG8_MMA(1, 0, At, B0); PG8_MMA(1, 1, At, B1); PG8_BAR; PG8_SCHED;
            } else {
            PG8_LDB(B0, 0, 0); PG8_SCHED; PG8_LDA(At, 0, 0); PG8_STAGE(PG8_SA(1, 1), a1 + hstep, voffA);
            PG8_WAIT_L(8); PG8_BAR; PG8_WAIT_L(0); PG8_MMA(0, 0, At, B0); PG8_BAR; PG8_SCHED;
            PG8_LDB(B1, 0, 1); PG8_STAGE(PG8_SB(0, 0), b2, voffB);
            PG8_BAR; PG8_WAIT_L(0); PG8_MMA(0, 1, At, B1); PG8_BAR;
            PG8_LDA(At, 0, 1); PG8_STAGE(PG8_SA(0, 0), a2, voffA);
            PG8_BAR; PG8_WAIT_L(0); PG8_MMA(1, 0, At, B0); PG8_BAR; PG8_SCHED;
            PG8_STAGE(PG8_SB(0, 1), b2 + hstep, voffB);
            PG8_WAIT_V(6); PG8_BAR; PG8_MMA(1, 1, At, B1); PG8_BAR;
            PG8_LDB(B0, 1, 0); PG8_SCHED; PG8_LDA(At, 1, 0); PG8_STAGE(PG8_SA(0, 1), a2 + hstep, voffA);
            PG8_WAIT_L(8); PG8_BAR; PG8_WAIT_L(0); PG8_MMA(0, 0, At, B0); PG8_BAR; PG8_SCHED;
            PG8_LDB(B1, 1, 1); PG8_STAGE(PG8_SB(1, 0), b3, voffB);
            PG8_BAR; PG8_WAIT_L(0); PG8_MMA(0, 1, At, B1); PG8_BAR;
            PG8_LDA(At, 1, 1); PG8_STAGE(PG8_SA(1, 0), a3, voffA);
            PG8_BAR; PG8_WAIT_L(0); PG8_MMA(1, 0, At, B0); PG8_BAR; PG8_SCHED;
            PG8_STAGE(PG8_SB(1, 1), b3 + hstep, voffB);
            PG8_WAIT_V(6); PG8_BAR; PG8_MMA(1, 1, At, B1); PG8_BAR;
            }
        }
        if constexpr (ALIGN_EPI) { if (wr == 0) PG8_BAR; }
        if constexpr (!Epi::AFTER_DRAIN) { E(acc, cur, wr, wc, fr, fq); S.done(cur); }
        if (!has_next) break;
#pragma unroll
        for (int a = 0; a < 2; ++a)
#pragma unroll
            for (int b = 0; b < 2; ++b)
#pragma unroll
                for (int m = 0; m < 4; ++m)
#pragma unroll
                    for (int n = 0; n < 2; ++n) acc[a][b][m][n] = (f32x4){0.f, 0.f, 0.f, 0.f};
        cur = nxt; cA = nA; cB = nB; ++ui;
        if constexpr (ALIGN_EPI) { if (wr == 1) PG8_BAR; }
    }
    PG8_WAIT_V(0);
    if constexpr (!ALIGN_EPI) { if (wr == 0) PG8_BAR; }
    PG8_BAR;
    if constexpr (Epi::AFTER_DRAIN) { E.fused(acc, cur, wr, wc, fr, fq, lds, wid, lane); S.done(cur); }
#undef PG8_SA
#undef PG8_SB
#undef PG8_STAGE
#undef PG8_LDA
#undef PG8_LDB
#undef PG8_MMA
#undef PG8_WAIT_V
#undef PG8_WAIT_L
#undef PG8_BAR
#undef PG8_SCHED
}
}

#define GAS __attribute__((address_space(1)))
#define LAS __attribute__((address_space(3)))
typedef unsigned short bf16;
typedef float f32x4 __attribute__((ext_vector_type(4)));
typedef float f32x2 __attribute__((ext_vector_type(2)));
typedef short bf16x8 __attribute__((ext_vector_type(8)));
typedef unsigned u32x4 __attribute__((ext_vector_type(4)));
typedef unsigned u32x2 __attribute__((ext_vector_type(2)));
typedef GAS unsigned gu32;

constexpr int NWAVES = 8, NTHR = 512;
constexpr int D = 2048, SEQ = 4096, MP = 8192, MS = 64, MT = MP + MS, DEPTH = 4;
constexpr int DIN = 5136, NINP = 5376, DFF = 5632, NGU = 2 * DFF;
constexpr int C_QA = 0, C_KA = 768, C_VA = 1536, C_UB = 2304, C_QC = 2816, C_KC = 3200, C_VC = 3584, C_RC = 4352, C_GC = 5120;
constexpr int M_A = 0, M_B = 768, M_C = 1280;
constexpr float EPS = 1e-6f;
constexpr int NCH = 64, CH = 64;
constexpr int SELEMS = 96 * 192;

enum { I_XP = 0, I_XS, I_CK, I_CV, I_SPOOL, I_SGLA, I_N1G, I_WIN, I_WG2, I_BG, I_WPOOL, I_PSCALE, I_GNG, I_WO, I_N2G, I_WFG, I_WFU, I_WFD, I_FNG, N_IN };
constexpr size_t O_YP = 0, O_YS = 16777216, O_PK = 16908288, O_PV = 29491200, O_PP = 42074112, O_PG = 42135552, O_SK = 42725376, O_SV = 42921984, O_SP = 43118592, O_SG = 43364352, O_END = 45723648;
constexpr size_t MiB = 1u << 20;
constexpr size_t WS_CTL = 0, CTL_ZERO_BYTES = 1 * MiB;
constexpr size_t WS_PART1 = 1 * MiB, WS_PART2 = 1 * MiB + 262144, WS_SPART1 = 1 * MiB + 524288, WS_SPART2 = 1 * MiB + 589824;
constexpr size_t WS_GA = 2 * MiB, WS_DEC = 3 * MiB, WS_PROJS = 4 * MiB, WS_WPT = 6 * MiB;
constexpr size_t WS_W = 8 * MiB;
constexpr size_t LW_IN = 0, LW_O = (size_t)NINP * D * 2, LW_GU = LW_O + (size_t)D * D * 2, LW_D = LW_GU + (size_t)NGU * D * 2, LW_SZ = LW_D + (size_t)D * DFF * 2;
static_assert(LW_SZ == 99614720, "layer weight bytes");
constexpr size_t WS_X = 388 * MiB, WS_XB = 453 * MiB, WS_MIX = 486 * MiB, WS_PROJ = 519 * MiB, WS_F = 603 * MiB, WS_SLOC = 692 * MiB, WS_SST = 728 * MiB, WS_BCUM = 764 * MiB, WS_END = 780 * MiB;
static_assert(WS_W + 4 * LW_SZ <= WS_X && WS_X + (size_t)MT * D * 4 <= WS_XB && WS_XB + (size_t)MT * D * 2 <= WS_MIX && WS_MIX + (size_t)MT * D * 2 <= WS_PROJ, "ws map 1");
static_assert(pg8::E_WS_PART1 == WS_PART1 && pg8::E_WS_PART2 == WS_PART2 && pg8::E_WS_GA == WS_GA && pg8::E_WS_PROJ == WS_PROJ && pg8::E_WS_F == WS_F && pg8::E_O_PK == O_PK && pg8::E_O_PV == O_PV && pg8::E_O_PP == O_PP && pg8::RS_OFF == 147456 && pg8::RS_OFF + pg8::RS_MAXU * 1024 + 128 <= 163840, "epilogue constants");
static_assert(WS_PROJ + (size_t)MP * NINP * 2 <= WS_F && WS_F + (size_t)MT * DFF * 2 <= WS_SLOC && WS_SLOC + (size_t)512 * SELEMS * 4 <= WS_SST && WS_SST + (size_t)512 * SELEMS * 4 <= WS_BCUM && WS_BCUM + (size_t)MP * 384 * 4 <= WS_END, "ws map 2");
constexpr size_t WS_OP = WS_F, WS_LSE = WS_F + 40 * MiB;
static_assert((size_t)3 * MP * 768 * 2 <= 40 * MiB && WS_LSE + (size_t)3 * MP * 6 * 4 <= WS_SLOC, "attention partials fit");
constexpr int CW_BAR = 4096;
constexpr int RING_BYTES = 131072, XCH_OFF = RING_BYTES, SCRATCH_BYTES = 139264, LDSCTL_OFF = SCRATCH_BYTES, MISC_OFF = LDSCTL_OFF + 320, LDS_BYTES = 163840;

#define RLX_AGENT __ATOMIC_RELAXED, __HIP_MEMORY_SCOPE_AGENT
__device__ __forceinline__ float bf2f(unsigned b) { return __uint_as_float(b << 16); }
typedef __bf16 hwbf16x2 __attribute__((ext_vector_type(2)));
__device__ __forceinline__ unsigned pk2(float lo, float hi) { const f32x2 v = {lo, hi}; const hwbf16x2 b = __builtin_convertvector(v, hwbf16x2); return __builtin_bit_cast(unsigned, b); }
__device__ __forceinline__ unsigned f2bf(float f) { return pk2(f, 0.f) & 0xffffu; }
__device__ __forceinline__ float wave_sum(float v) {
#pragma unroll
    for (int o = 1; o < 64; o <<= 1) v += __shfl_xor(v, o);
    return v;
}
__device__ __forceinline__ float wave_max(float v) {
#pragma unroll
    for (int o = 1; o < 64; o <<= 1) v = fmaxf(v, __shfl_xor(v, o));
    return v;
}
__device__ __forceinline__ float logsig(float z) { return fminf(z, 0.f) - log1pf(__expf(-fabsf(z))); }
__device__ __forceinline__ float silu(float x) { return x / (1.0f + __expf(-x)); }

#define XB_TMO      128
#define XB_XCNT(j)  (256  + 64 * (j))
#define XB_XSUB(j)  (1280 + 64 * (j))
#define XB_XGEN(j)  (2304 + 64 * (j))
#define XB_TOP      3328
#define XB_TOPGEN   3392
#define XCD_BAR_WORDS 3456
#define XB_SPIN_CAP (1u << 18)

__device__ __forceinline__ unsigned xb_ld(unsigned* p)              { return __hip_atomic_load(p, __ATOMIC_RELAXED, __HIP_MEMORY_SCOPE_AGENT); }
__device__ __forceinline__ unsigned xb_add(unsigned* p, unsigned v) { return __hip_atomic_fetch_add(p, v, __ATOMIC_RELAXED, __HIP_MEMORY_SCOPE_AGENT); }
__device__ __forceinline__ unsigned xb_xcc_id() { return (unsigned)__builtin_amdgcn_s_getreg((3 << 11) | 20) & 0xFu; }
#define XB_SPIN(cond, bar) do { unsigned _sp = 0; while (cond) { __builtin_amdgcn_s_sleep(1); \
    if ((++_sp & 255u) == 0u) { if (xb_ld(&(bar)[XB_TMO])) break; if (_sp > XB_SPIN_CAP) { atomicAdd(&(bar)[XB_TMO], 1u); break; } } } } while (0)

struct XcdBarrier {
    unsigned* bar; unsigned x;
    volatile LAS unsigned* st;
};

__device__ __forceinline__ XcdBarrier xcd_barrier_post(unsigned* bar, volatile LAS unsigned* st) {
    XcdBarrier b; b.bar = bar; b.x = xb_xcc_id(); b.st = st;
    if (threadIdx.x == 0) (void)xb_add(&bar[XB_XCNT(b.x)], 1u);
    return b;
}
__device__ __forceinline__ void xcd_barrier_complete(unsigned* bar, unsigned x, unsigned& nloc, unsigned& nx) {
    const unsigned G = gridDim.x * gridDim.y * gridDim.z;
    unsigned sum, cnt, mine, sp = 0u;
    for (;;) {
        sum = 0u; cnt = 0u; mine = 0u;
#pragma unroll
        for (unsigned j = 0; j < 16; ++j) { const unsigned c = xb_ld(&bar[XB_XCNT(j)]); sum += c; cnt += (c > 0u) ? 1u : 0u; mine = (j == x) ? c : mine; }
        if (sum == G) break;
        __builtin_amdgcn_s_sleep(1);
        if ((++sp & 255u) == 0u) { if (xb_ld(&bar[XB_TMO])) break; if (sp > XB_SPIN_CAP) { atomicAdd(&bar[XB_TMO], 1u); break; } }
    }
    nloc = mine > 0u ? mine : 1u; nx = cnt > 0u ? cnt : 1u;
}

__device__ __forceinline__ void xcd_barrier(const XcdBarrier& b) {
    asm volatile("s_waitcnt vmcnt(0)" ::: "memory");
    __syncthreads();
    if (threadIdx.x == 0) {
        unsigned* bar = b.bar;
        __builtin_amdgcn_s_waitcnt(0);
        unsigned nloc = b.st[0], nx = b.st[1];
        if (nloc == 0u) { xcd_barrier_complete(bar, b.x, nloc, nx); b.st[0] = nloc; b.st[1] = nx; }
        const unsigned old = xb_add(&bar[XB_XSUB(b.x)], 1u);
        const unsigned gen = old / nloc;
        if (old + 1u == (gen + 1u) * nloc) {
            __builtin_amdgcn_fence(__ATOMIC_RELEASE, "agent");
            asm volatile("s_waitcnt vmcnt(0)" ::: "memory");
            const unsigned og = xb_add(&bar[XB_TOP], 1u);
            const unsigned tg = og / nx;
            if (og + 1u == (tg + 1u) * nx) xb_add(&bar[XB_TOPGEN], 1u);
            else XB_SPIN(xb_ld(&bar[XB_TOPGEN]) == tg, bar);
            __builtin_amdgcn_fence(__ATOMIC_ACQUIRE, "agent");
            xb_add(&bar[XB_XGEN(b.x)], 1u);
            asm volatile("s_waitcnt vmcnt(0)" ::: "memory");
        } else {
            XB_SPIN(xb_ld(&bar[XB_XGEN(b.x)]) == gen, bar);
            __builtin_amdgcn_fence(__ATOMIC_ACQUIRE, "agent");
            asm volatile("s_waitcnt vmcnt(0)" ::: "memory");
        }
    }
    __syncthreads();
}

struct RowId { __device__ __forceinline__ int operator()(int n) const { return n; } };
struct RowGate { int up; __device__ __forceinline__ int operator()(int f) const { return 256 * (f >> 7) + 128 * up + (f & 127); } };
template <class RM>
__device__ __forceinline__ void cvt_tile(const float* __restrict__ W, int K, int N, int k0, int n0, const float* __restrict__ gk, bf16* Wt, RM rowmap, LAS float* scr, int lane) {
    const int cl = 4 * (lane & 15), kr = lane >> 4;
    f32x4 v[16];
#pragma unroll
    for (int i = 0; i < 16; ++i) {
        const int kk = 4 * i + kr, n = n0 + cl;
        v[i] = (n + 3 < N) ? __builtin_nontemporal_load((const f32x4*)(W + (size_t)(k0 + kk) * N + n)) : (f32x4){0.f, 0.f, 0.f, 0.f};
    }
#pragma unroll
    for (int i = 0; i < 16; ++i) {
        const int kk = 4 * i + kr; const float g = gk ? gk[k0 + kk] : 1.0f;
        LAS float* s = scr + kk * 65 + cl;
        s[0] = v[i][0] * g; s[1] = v[i][1] * g; s[2] = v[i][2] * g; s[3] = v[i][3] * g;
    }
    asm volatile("s_waitcnt lgkmcnt(0)" ::: "memory");
    const int c = lane & 7;
#pragma unroll
    for (int i = 0; i < 8; ++i) {
        const int nl = 8 * i + (lane >> 3), n = n0 + nl;
        const LAS float* s = scr + (8 * c) * 65 + nl;
        u32x4 o; o.x = pk2(s[0 * 65], s[1 * 65]); o.y = pk2(s[2 * 65], s[3 * 65]); o.z = pk2(s[4 * 65], s[5 * 65]); o.w = pk2(s[6 * 65], s[7 * 65]);
        if (n < N) *(u32x4*)(Wt + (size_t)rowmap(n) * K + k0 + 8 * c) = o;
    }
    asm volatile("s_waitcnt lgkmcnt(0)" ::: "memory");
}

struct Ptrs {
    const float* in[N_IN]; float* out; unsigned char* ws;
};

constexpr int CV_IN = 32 * 81, CV_O = 32 * 32, CV_G = 32 * 88, CV_D = 88 * 32, CV_L = CV_IN + CV_O + 2 * CV_G + CV_D;
__device__ __forceinline__ void cvt_item(const Ptrs& P, int l, int r, LAS float* scr, int lane) {
    unsigned char* wl = P.ws + WS_W + (size_t)l * LW_SZ;
    if (r < CV_IN) { const int kb = r / 81, nb = r % 81; cvt_tile(P.in[I_WIN] + (size_t)l * D * DIN, D, DIN, 64 * kb, 64 * nb, P.in[I_N1G] + l * D, (bf16*)(wl + LW_IN), RowId{}, scr, lane); return; } r -= CV_IN;
    if (r < CV_O) { const int kb = r / 32, nb = r % 32; cvt_tile(P.in[I_WO] + (size_t)l * D * D, D, D, 64 * kb, 64 * nb, (const float*)nullptr, (bf16*)(wl + LW_O), RowId{}, scr, lane); return; } r -= CV_O;
    if (r < CV_G) { const int kb = r / 88, nb = r % 88; cvt_tile(P.in[I_WFG] + (size_t)l * D * DFF, D, DFF, 64 * kb, 64 * nb, P.in[I_N2G] + l * D, (bf16*)(wl + LW_GU), RowGate{0}, scr, lane); return; } r -= CV_G;
    if (r < CV_G) { const int kb = r / 88, nb = r % 88; cvt_tile(P.in[I_WFU] + (size_t)l * D * DFF, D, DFF, 64 * kb, 64 * nb, P.in[I_N2G] + l * D, (bf16*)(wl + LW_GU), RowGate{1}, scr, lane); return; } r -= CV_G;
    { const int kb = r / 32, nb = r % 32; cvt_tile(P.in[I_WFD] + (size_t)l * DFF * D, DFF, D, 64 * kb, 64 * nb, (const float*)nullptr, (bf16*)(wl + LW_D), RowId{}, scr, lane); }
}
__device__ __forceinline__ void prologue(const Ptrs& P, LAS unsigned char* lds, int bx, int G, int wave, int lane, int tid, int pro_layers) {
    LAS float* scr = (LAS float*)(lds + wave * 16640);
    const int gw = bx * NWAVES + wave, NGW = G * NWAVES;
    for (int it = gw; it < pro_layers * CV_L; it += NGW) cvt_item(P, it / CV_L, it % CV_L, scr, lane);
    for (int i = bx * NTHR + tid; i < DEPTH * 61440; i += G * NTHR) {
        const int l = i / 61440, j = i % 61440;
        *(u32x4*)(P.ws + WS_W + (size_t)l * LW_SZ + LW_IN + (size_t)DIN * D * 2 + (size_t)j * 16) = (u32x4){0u, 0u, 0u, 0u};
    }
    for (int i = bx * NTHR + tid; i < DEPTH * 4 * 128 * 128; i += G * NTHR) {
        const int c = i & 127, d = (i >> 7) & 127, lg = i >> 14;
        ((bf16*)(P.ws + WS_WPT))[i] = (bf16)f2bf(P.in[I_WPOOL][((size_t)lg * 128 + c) * 128 + d] * P.in[I_PSCALE][lg * 128 + d]);
    }
    float* part2 = (float*)(P.ws + WS_PART2); float* spart2 = (float*)(P.ws + WS_SPART2); bf16* XB = (bf16*)(P.ws + WS_XB);
    for (int row = gw; row < MT; row += NGW) {
        const float* xr = (row < MP) ? P.in[I_XP] + (size_t)row * D : P.in[I_XS] + (size_t)(row - MP) * D;
        float s = 0.f;
#pragma unroll
        for (int j = 0; j < 8; ++j) {
            const f32x4 v = *(const f32x4*)(xr + 4 * lane + 256 * j);
            s += (v[0] * v[0] + v[1] * v[1]) + (v[2] * v[2] + v[3] * v[3]);
            u32x2 o; o.x = pk2(v[0], v[1]); o.y = pk2(v[2], v[3]);
            *(u32x2*)(XB + (size_t)row * D + 4 * lane + 256 * j) = o;
        }
        s = wave_sum(s);
        if (row < MP) { if (lane < 8) part2[(size_t)row * 8 + lane] = (lane == 0) ? s : 0.f; }
        else { spart2[(size_t)(row - MP) * 128 + lane] = (lane == 0) ? s : 0.f; spart2[(size_t)(row - MP) * 128 + 64 + lane] = 0.f; }
    }
}

template <int MT, int NT, int QB, class EPI>
__device__ __forceinline__ void skinny_unit(LAS unsigned char* lds, const bf16* __restrict__ A, const bf16* __restrict__ B0, const bf16* __restrict__ B1, int K, int r0, int ntile, const EPI& epi, int wave, int lane, int tid) {
    const int fr = lane & 15, fq = lane >> 4, ks = K / 8, kb = wave * ks;
    f32x4 acc[MT][NT];
#pragma unroll
    for (int a = 0; a < MT; ++a)
#pragma unroll
        for (int b = 0; b < NT; ++b) acc[a][b] = (f32x4){0.f, 0.f, 0.f, 0.f};
    const bf16* ap = A + (size_t)(r0 + fr) * K + kb + 8 * fq;
    const bf16* b0p = B0 + (size_t)fr * K + kb + 8 * fq; const bf16* b1p = B1 + (size_t)fr * K + kb + 8 * fq;
    for (int kk0 = 0; kk0 < ks; kk0 += 32 * QB) {
        bf16x8 a[QB][MT], b[QB][NT];
#pragma unroll
        for (int q = 0; q < QB; ++q) { const int kk = (kk0 + 32 * q < ks) ? kk0 + 32 * q : kk0;
#pragma unroll
            for (int m = 0; m < MT; ++m) a[q][m] = *(const bf16x8*)(ap + (size_t)(16 * m) * K + kk);
            b[q][0] = *(const bf16x8*)(b0p + kk); if (NT == 2) b[q][NT - 1] = *(const bf16x8*)(b1p + kk); }
#pragma unroll
        for (int q = 0; q < QB; ++q) if (kk0 + 32 * q < ks) {
#pragma unroll
            for (int m = 0; m < MT; ++m)
#pragma unroll
                for (int n = 0; n < NT; ++n) acc[m][n] = __builtin_amdgcn_mfma_f32_16x16x32_bf16(a[q][m], b[q][n], acc[m][n], 0, 0, 0);
        }
    }
    LAS float* red = (LAS float*)lds;
#pragma unroll
    for (int m = 0; m < MT; ++m)
#pragma unroll
        for (int nb = 0; nb < NT; ++nb)
#pragma unroll
            for (int rg = 0; rg < 4; ++rg) red[((wave * NT + nb) * (16 * MT) + m * 16 + 4 * fq + rg) * 16 + fr] = acc[m][nb][rg];
    __syncthreads();
#pragma unroll
    for (int nb = 0; nb < NT; ++nb)
#pragma unroll
        for (int hf = 0; hf < MT / 2; ++hf) {
            float v = 0.f;
#pragma unroll
            for (int w = 0; w < 8; ++w) v += red[((w * NT + nb) * (16 * MT) + hf * 32) * 16 + tid];
            if (nb < ntile) epi(r0 + (tid >> 4) + 32 * hf, hf, nb, tid & 15, v);
        }
    __syncthreads();
}
__device__ __forceinline__ float skinny_rs(const float* spart, int rbase, int tid) {
    const float* p = spart + (size_t)(rbase + (tid >> 4)) * 128 + (tid & 15) * 8;
    const f32x4 a = *(const f32x4*)p, b = *(const f32x4*)(p + 4);
    float s = ((a[0] + a[1]) + (a[2] + a[3])) + ((b[0] + b[1]) + (b[2] + b[3]));
    s += __shfl_xor(s, 1); s += __shfl_xor(s, 2); s += __shfl_xor(s, 4); s += __shfl_xor(s, 8);
    return rsqrtf(s * (1.0f / 2048.0f) + EPS);
}
struct SEpiInProj {
    float* projs; float rs0, rs1; float* sk; float* sv; float* sp; int n0;
    __device__ __forceinline__ void operator()(int row, int hf, int tile, int cl, float v0) const {
        const int col = n0 + 16 * tile + cl; const float v = v0 * (hf == 0 ? rs0 : rs1);
        projs[(size_t)row * DIN + col] = v;
        if (col >= C_KA && col < C_VA) sk[(size_t)row * 768 + (col - C_KA)] = v;
        else if (col >= C_VA && col < C_UB) sv[(size_t)row * 768 + (col - C_VA)] = v;
        else if (col >= C_UB && col < C_QC) sp[(size_t)((row >> 3) * 15 + 7 + (row & 7)) * 512 + (col - C_UB)] = v;
    }
};
struct SEpiResid {
    const bf16* xin; bf16* xb; float* spart; int n0;
    __device__ __forceinline__ void operator()(int row, int, int tile, int cl, float v0) const {
        const size_t o = (size_t)row * D + n0 + 16 * tile + cl; const float v = bf2f(xin[o]) + v0;
        xb[o] = (bf16)f2bf(v);
        float s = v * v; s += __shfl_xor(s, 1); s += __shfl_xor(s, 2); s += __shfl_xor(s, 4); s += __shfl_xor(s, 8);
        if (cl == 0) spart[(size_t)row * 128 + (n0 >> 4) + tile] = s;
    }
};
struct SEpiGateUp {
    bf16* F; float rs0, rs1; int f0; mutable float gate0, gate1;
    __device__ __forceinline__ void operator()(int row, int hf, int tile, int cl, float v0) const {
        const float rs = hf == 0 ? rs0 : rs1;
        if (tile == 0) { if (hf == 0) gate0 = v0 * rs; else gate1 = v0 * rs; }
        else F[(size_t)(MP + row) * DFF + f0 + cl] = (bf16)f2bf(silu(hf == 0 ? gate0 : gate1) * (v0 * rs));
    }
};

__device__ __forceinline__ void s_attn_slot(int s, int tA, int tB, int& idx, bool& vA, bool& vB) {
    if (s < 133) { idx = 2048 + tB - s; vB = (s <= 128); vA = (s >= 4); }
    else if (s < 263) { const int j = s - 133; idx = 2048 + tB - 4 * j; vB = (j <= 128); vA = (j >= 1); }
    else if (s < 392) { idx = 2048 + tA - 16 * (s - 263); vA = true; vB = false; }
    else if (s < 521) { idx = 2048 + tB - 16 * (s - 392); vA = false; vB = true; }
    else { idx = 2048 + tB; vA = false; vB = false; }
}
__device__ __forceinline__ void s_attn_punit(const Ptrs& P, LAS unsigned char* lds, int l, int unit, int wave, int lane, int tid) {
    const int h = unit % 6, bq = unit / 6, b = bq >> 2, tA = bq & 3, tB = tA + 4, rowA = b * 8 + tA, rowB = rowA + 4;
    const float* projs = (const float*)(P.ws + WS_PROJS);
    LAS float* scA = (LAS float*)lds;
    LAS float* scB = scA + 544;
    LAS float* red = scB + 544;
    LAS float* part = red + 32;
    const int qw = lane >> 4, k16 = lane & 15;
    const float QS = 0.08838834764831845f;
    const f32x4 qAa = *(const f32x4*)(projs + (size_t)rowA * DIN + C_QA + h * 128 + 4 * k16) * QS, qAb = *(const f32x4*)(projs + (size_t)rowA * DIN + C_QA + h * 128 + 64 + 4 * k16) * QS;
    const f32x4 qBa = *(const f32x4*)(projs + (size_t)rowB * DIN + C_QA + h * 128 + 4 * k16) * QS, qBb = *(const f32x4*)(projs + (size_t)rowB * DIN + C_QA + h * 128 + 64 + 4 * k16) * QS;
    const float* ckb = P.in[I_CK] + ((size_t)(l * 8 + b) * 2048 * 6 + h) * 128; const float* cvb = P.in[I_CV] + ((size_t)(l * 8 + b) * 2048 * 6 + h) * 128;
    const float* pkb = projs + (size_t)(b * 8) * DIN + h * 128;
#pragma unroll
    for (int half = 0; half < 2; ++half) {
        const int it0 = half ? 9 : 0, nit = half ? 8 : 9;
        f32x4 ka[9], kb[9];
#pragma unroll
        for (int i = 0; i < 9; ++i) if (i < nit) {
            int idx; bool vA, vB; s_attn_slot((it0 + i) * 32 + wave * 4 + qw, tA, tB, idx, vA, vB);
            const float* rp = (idx >= 2048) ? pkb + (size_t)(idx - 2048) * DIN + C_KA : ckb + (size_t)idx * 768;
            ka[i] = __builtin_nontemporal_load((const f32x4*)(rp + 4 * k16)); kb[i] = __builtin_nontemporal_load((const f32x4*)(rp + 64 + 4 * k16));
        }
#pragma unroll
        for (int i = 0; i < 9; ++i) if (i < nit) {
            const int s = (it0 + i) * 32 + wave * 4 + qw;
            int idx; bool vA, vB; s_attn_slot(s, tA, tB, idx, vA, vB);
            float a = (ka[i][0] * qAa[0] + ka[i][1] * qAa[1]) + (ka[i][2] * qAa[2] + ka[i][3] * qAa[3]) + (kb[i][0] * qAb[0] + kb[i][1] * qAb[1]) + (kb[i][2] * qAb[2] + kb[i][3] * qAb[3]);
            float c = (ka[i][0] * qBa[0] + ka[i][1] * qBa[1]) + (ka[i][2] * qBa[2] + ka[i][3] * qBa[3]) + (kb[i][0] * qBb[0] + kb[i][1] * qBb[1]) + (kb[i][2] * qBb[2] + kb[i][3] * qBb[3]);
            a += __shfl_xor(a, 1); a += __shfl_xor(a, 2); a += __shfl_xor(a, 4); a += __shfl_xor(a, 8);
            c += __shfl_xor(c, 1); c += __shfl_xor(c, 2); c += __shfl_xor(c, 4); c += __shfl_xor(c, 8);
            if (k16 == 0) { scA[s] = vA ? a : -1e30f; scB[s] = vB ? c : -1e30f; }
        }
    }
    __syncthreads();
    const float a0 = scA[tid], b0 = scB[tid], a1 = (tid < 32) ? scA[512 + tid] : -1e30f, b1 = (tid < 32) ? scB[512 + tid] : -1e30f;
    float mA = wave_max(fmaxf(a0, a1)), mB = wave_max(fmaxf(b0, b1));
    if (lane == 0) { red[wave] = mA; red[8 + wave] = mB; }
    __syncthreads();
    mA = red[0]; mB = red[8];
#pragma unroll
    for (int w = 1; w < 8; ++w) { mA = fmaxf(mA, red[w]); mB = fmaxf(mB, red[8 + w]); }
    const float eA0 = __expf(a0 - mA), eB0 = __expf(b0 - mB), eA1 = (tid < 32) ? __expf(a1 - mA) : 0.f, eB1 = (tid < 32) ? __expf(b1 - mB) : 0.f;
    const float smA = wave_sum(eA0 + eA1), smB = wave_sum(eB0 + eB1);
    scA[tid] = eA0; scB[tid] = eB0;
    if (tid < 32) { scA[512 + tid] = eA1; scB[512 + tid] = eB1; }
    if (lane == 0) { red[16 + wave] = smA; red[24 + wave] = smB; }
    __syncthreads();
    float denA = 0.f, denB = 0.f;
#pragma unroll
    for (int w = 0; w < 8; ++w) { denA += red[16 + w]; denB += red[24 + w]; }
    f32x4 oAa = (f32x4){0.f, 0.f, 0.f, 0.f}, oAb = oAa, oBa = oAa, oBb = oAa;
#pragma unroll
    for (int half = 0; half < 2; ++half) {
        const int it0 = half ? 9 : 0, nit = half ? 8 : 9;
        f32x4 va[9], vb[9];
#pragma unroll
        for (int i = 0; i < 9; ++i) if (i < nit) {
            int idx; bool vA, vB; s_attn_slot((it0 + i) * 32 + wave * 4 + qw, tA, tB, idx, vA, vB);
            const float* rp = (idx >= 2048) ? pkb + (size_t)(idx - 2048) * DIN + C_VA : cvb + (size_t)idx * 768;
            va[i] = __builtin_nontemporal_load((const f32x4*)(rp + 4 * k16)); vb[i] = __builtin_nontemporal_load((const f32x4*)(rp + 64 + 4 * k16));
        }
#pragma unroll
        for (int i = 0; i < 9; ++i) if (i < nit) {
            const int s = (it0 + i) * 32 + wave * 4 + qw; const float pA = scA[s], pB = scB[s];
            oAa += va[i] * pA; oAb += vb[i] * pA; oBa += va[i] * pB; oBb += vb[i] * pB;
        }
    }
#pragma unroll
    for (int i = 0; i < 4; ++i) {
        oAa[i] += __shfl_xor(oAa[i], 16); oAa[i] += __shfl_xor(oAa[i], 32); oAb[i] += __shfl_xor(oAb[i], 16); oAb[i] += __shfl_xor(oAb[i], 32);
        oBa[i] += __shfl_xor(oBa[i], 16); oBa[i] += __shfl_xor(oBa[i], 32); oBb[i] += __shfl_xor(oBb[i], 16); oBb[i] += __shfl_xor(oBb[i], 32);
    }
    if (qw == 0) {
        *(LAS f32x4*)(part + wave * 128 + 4 * k16) = oAa; *(LAS f32x4*)(part + wave * 128 + 64 + 4 * k16) = oAb;
        *(LAS f32x4*)(part + 1024 + wave * 128 + 4 * k16) = oBa; *(LAS f32x4*)(part + 1024 + wave * 128 + 64 + 4 * k16) = oBb;
    }
    __syncthreads();
    if (tid < 256) {
        const int q = tid >> 7, d = tid & 127;
        float o = 0.f;
#pragma unroll
        for (int w = 0; w < 8; ++w) o += part[q * 1024 + w * 128 + d];
        ((bf16*)(P.ws + WS_MIX))[(size_t)(MP + (q ? rowB : rowA)) * D + M_A + h * 128 + d] = (bf16)f2bf(o / (q ? denB : denA));
    }
    __syncthreads();
}
__device__ __forceinline__ void s_attn_unit(const Ptrs& P, LAS unsigned char* lds, int l, int unit, int wave, int lane, int tid) {
    const int h = unit % 6, row = unit / 6, b = row >> 3, t = row & 7;
    const float* projs = (const float*)(P.ws + WS_PROJS);
    LAS float* sc = (LAS float*)lds;
    LAS float* red = sc + 416;
    LAS float* part = red + 16;
    const int qw = lane >> 4, k16 = lane & 15;
    const f32x4 qa = *(const f32x4*)(projs + (size_t)row * DIN + C_QA + h * 128 + 4 * k16) * 0.08838834764831845f;
    const f32x4 qb = *(const f32x4*)(projs + (size_t)row * DIN + C_QA + h * 128 + 64 + 4 * k16) * 0.08838834764831845f;
    const float* rowp[13];
#pragma unroll
    for (int it = 0; it < 13; ++it) {
        int s = it * 32 + wave * 4 + qw; s = s < 387 ? s : 386;
        const int p = s / 129, j = s - p * 129, dil = (p == 0) ? 1 : (p == 1 ? 4 : 16), idx = 2048 + t - dil * j;
        rowp[it] = (idx >= 2048) ? projs + (size_t)(b * 8 + idx - 2048) * DIN + C_KA + h * 128
                                 : P.in[I_CK] + ((size_t)((l * 8 + b) * 2048 + idx) * 6 + h) * 128;
    }
    {
        f32x4 ka[13], kb[13];
#pragma unroll
        for (int it = 0; it < 13; ++it) { ka[it] = __builtin_nontemporal_load((const f32x4*)(rowp[it] + 4 * k16)); kb[it] = __builtin_nontemporal_load((const f32x4*)(rowp[it] + 64 + 4 * k16)); }
#pragma unroll
        for (int it = 0; it < 13; ++it) {
            float a = (ka[it][0] * qa[0] + ka[it][1] * qa[1]) + (ka[it][2] * qa[2] + ka[it][3] * qa[3]) + (kb[it][0] * qb[0] + kb[it][1] * qb[1]) + (kb[it][2] * qb[2] + kb[it][3] * qb[3]);
            a += __shfl_xor(a, 1); a += __shfl_xor(a, 2); a += __shfl_xor(a, 4); a += __shfl_xor(a, 8);
            const int s = it * 32 + wave * 4 + qw;
            if (k16 == 0) sc[s] = (s < 387) ? a : -1e30f;
        }
    }
    __syncthreads();
    const float v = (tid < 416) ? sc[tid] : -1e30f;
    float m = wave_max(v);
    if (lane == 0) red[wave] = m;
    __syncthreads();
    m = red[0];
#pragma unroll
    for (int w = 1; w < 8; ++w) m = fmaxf(m, red[w]);
    const float e = (tid < 387) ? __expf(v - m) : 0.f;
    float sm = wave_sum(e);
    __syncthreads();
    if (tid < 416) sc[tid] = e;
    if (lane == 0) red[8 + wave] = sm;
    __syncthreads();
    float den = 0.f;
#pragma unroll
    for (int w = 0; w < 8; ++w) den += red[8 + w];
    f32x4 oa = (f32x4){0.f, 0.f, 0.f, 0.f}, ob = (f32x4){0.f, 0.f, 0.f, 0.f};
    {
        f32x4 va[13], vb[13];
#pragma unroll
        for (int it = 0; it < 13; ++it) {
            int s = it * 32 + wave * 4 + qw; s = s < 387 ? s : 386;
            const int p = s / 129, j = s - p * 129, dil = (p == 0) ? 1 : (p == 1 ? 4 : 16), idx = 2048 + t - dil * j;
            const float* vr = (idx >= 2048) ? projs + (size_t)(b * 8 + idx - 2048) * DIN + C_VA + h * 128
                                            : P.in[I_CV] + ((size_t)((l * 8 + b) * 2048 + idx) * 6 + h) * 128;
            va[it] = __builtin_nontemporal_load((const f32x4*)(vr + 4 * k16)); vb[it] = __builtin_nontemporal_load((const f32x4*)(vr + 64 + 4 * k16));
        }
#pragma unroll
        for (int it = 0; it < 13; ++it) { const float pe = sc[it * 32 + wave * 4 + qw]; oa += va[it] * pe; ob += vb[it] * pe; }
    }
#pragma unroll
    for (int i = 0; i < 4; ++i) { oa[i] += __shfl_xor(oa[i], 16); oa[i] += __shfl_xor(oa[i], 32); ob[i] += __shfl_xor(ob[i], 16); ob[i] += __shfl_xor(ob[i], 32); }
    if (qw == 0) { *(LAS f32x4*)(part + wave * 128 + 4 * k16) = oa; *(LAS f32x4*)(part + wave * 128 + 64 + 4 * k16) = ob; }
    __syncthreads();
    if (tid < 128) {
        float o = 0.f;
#pragma unroll
        for (int w = 0; w < 8; ++w) o += part[w * 128 + tid];
        ((bf16*)(P.ws + WS_MIX))[(size_t)(MP + row) * D + M_A + h * 128 + tid] = (bf16)f2bf(o / den);
    }
    __syncthreads();
}
__device__ __forceinline__ void s_pool_unit(const Ptrs& P, LAS unsigned char* lds, int l, int row, int tid) {
    const int b = row >> 3, t = row & 7;
    const float* projs = (const float*)(P.ws + WS_PROJS);
    const float* sp = P.in[I_SPOOL] + (size_t)(l * 8 + b) * 15 * 512;
    LAS float* pl = (LAS float*)lds;
    {
        const int c = tid, g = c >> 7, w = 2 << g; float sum = 0.f, cur = 0.f;
        for (int i = 0; i < w; ++i) { const int e = 15 + t - i;
            const float uv = (e < 15) ? sp[(size_t)e * 512 + c] : projs[(size_t)(b * 8 + e - 15) * DIN + C_UB + c];
            sum += uv; if (i == 0) cur = uv; }
        pl[c] = sum / (float)w - cur;
        if (t == 0) { float* dst = P.out + O_SP + (size_t)(l * 8 + b) * 15 * 512;
            for (int i = 0; i < 7; ++i) dst[(size_t)i * 512 + c] = sp[(size_t)(8 + i) * 512 + c]; }
    }
    __syncthreads();
    {
        const int g = tid >> 7, d = tid & 127; const float* wp = P.in[I_WPOOL] + (size_t)(l * 4 + g) * 128 * 128;
        float a = 0.f;
#pragma unroll 8
        for (int c = 0; c < 128; ++c) a += pl[g * 128 + c] * wp[(size_t)c * 128 + d];
        a *= P.in[I_PSCALE][l * 512 + tid];
        ((bf16*)(P.ws + WS_MIX))[(size_t)(MP + row) * D + M_B + tid] = (bf16)f2bf(a);
    }
    __syncthreads();
}
__device__ __forceinline__ void s_gla_unit(const Ptrs& P, LAS unsigned char* lds, int l, int unit, int tid) {
    const int b = unit >> 2, h = unit & 3;
    const float* projs = (const float*)(P.ws + WS_PROJS);
    LAS float* eg = (LAS float*)lds;
    LAS float* qL = eg + 768;
    LAS float* kL = qL + 768;
    LAS float* vL = kL + 768;
    LAS float* op = vL + 1536;
    LAS float* oc = op + 384;
    LAS float* rs = oc + 1536;
    for (int i = tid; i < 768; i += NTHR) {
        const int t = i / 96, dk = i % 96; const float* pr = projs + (size_t)(b * 8 + t) * DIN;
        float z = P.in[I_BG][l * 384 + h * 96 + dk];
#pragma unroll
        for (int r = 0; r < 16; ++r) z += pr[C_GC + r] * P.in[I_WG2][(size_t)(l * 16 + r) * 384 + h * 96 + dk];
        eg[i] = __expf(logsig(z) * (1.0f / 16.0f));
        qL[i] = pr[C_QC + h * 96 + dk] * 0.10206207261596575f;
        kL[i] = pr[C_KC + h * 96 + dk];
    }
    for (int i = tid; i < 1536; i += NTHR) { const int t = i / 192, dv = i % 192; vL[i] = projs[(size_t)(b * 8 + t) * DIN + C_VC + h * 192 + dv]; }
    __syncthreads();
    const int dv = tid % 192, hf = tid / 192;
    float S[48];
    const float* s0 = P.in[I_SGLA] + (size_t)((l * 8 + b) * 4 + h) * SELEMS;
    if (tid < 384) {
#pragma unroll
        for (int i = 0; i < 48; ++i) S[i] = s0[(size_t)(48 * hf + i) * 192 + dv];
    }
    LAS float* opart = (LAS float*)(lds + 32768);
    if (tid < 384) {
        for (int t = 0; t < 8; ++t) {
            float o = 0.f; const float vv = vL[t * 192 + dv];
#pragma unroll
            for (int i = 0; i < 48; ++i) { const int dk = 48 * hf + i; S[i] = eg[t * 96 + dk] * S[i] + kL[t * 96 + dk] * vv; o += qL[t * 96 + dk] * S[i]; }
            opart[(t * 2 + hf) * 192 + dv] = o;
        }
    }
    __syncthreads();
    for (int i = tid; i < 1536; i += NTHR) { const int t = i / 192, d2 = i - 192 * t; oc[i] = opart[(t * 2) * 192 + d2] + opart[(t * 2 + 1) * 192 + d2]; }
    __syncthreads();
    if (tid < 384) { float* dst = P.out + O_SG + (size_t)((l * 8 + b) * 4 + h) * SELEMS;
#pragma unroll
        for (int i = 0; i < 48; ++i) dst[(size_t)(48 * hf + i) * 192 + dv] = S[i]; }
    {
        const int w = tid >> 6, ln = tid & 63; float s = 0.f;
        for (int i = ln; i < 192; i += 64) { const float x = oc[w * 192 + i]; s += x * x; }
        s = wave_sum(s);
        if (ln == 0) rs[w] = rsqrtf(s * (1.0f / 192.0f) + EPS);
    }
    __syncthreads();
    for (int i = tid; i < 1536; i += NTHR) {
        const int t = i / 192, d2 = i % 192; const int row = b * 8 + t;
        const float r = projs[(size_t)row * DIN + C_RC + h * 192 + d2];
        const float val = oc[i] * rs[t] * P.in[I_GNG][l * 192 + d2] * silu(r);
        ((bf16*)(P.ws + WS_MIX))[(size_t)(MP + row) * D + M_C + h * 192 + d2] = (bf16)f2bf(val);
    }
    __syncthreads();
}

typedef short v4i16_t __attribute__((ext_vector_type(4)));
__device__ __forceinline__ unsigned offb(unsigned row, unsigned ch) { return 256u * row + 16u * (ch ^ (((row & 3u) << 2) | ((row >> 2) & 3u))); }
__device__ __forceinline__ void p_attn_unit(const Ptrs& P, LAS unsigned char* lds, int unit, int wave, int lane) {
    const bf16* PROJ = (const bf16*)(P.ws + WS_PROJ);
    const int cb = unit & 31, pbh = unit >> 5, p = pbh / 12, bh = pbh - 12 * p, b = bh / 6, h = bh - 6 * b;
    const int dsh = 2 * p, dil = 1 << dsh, nbk = 32 >> dsh, r = cb / nbk, n = cb - r * nbk;
    const size_t rb = (size_t)b * SEQ + r;
#pragma unroll
    for (int i8 = 0; i8 < 8; ++i8) {
        const int i = wave * 8 + i8, row = 4 * i + (lane >> 4), pc = lane & 15;
        const int ch = pc ^ (((row & 3) << 2) | ((row >> 2) & 3));
        int ci = 128 * (n - 1) + row; ci = ci < 0 ? 0 : ci;
        const bf16* src = PROJ + (rb + (size_t)dil * ci) * NINP + h * 128 + 8 * ch;
        __builtin_amdgcn_global_load_lds((const unsigned*)(src + C_KA), (LAS unsigned*)(lds + i * 1024), 16, 0, 0);
        __builtin_amdgcn_global_load_lds((const unsigned*)(src + C_VA), (LAS unsigned*)(lds + 65536 + i * 1024), 16, 0, 0);
    }
    const int g = lane >> 4, ql = lane & 15, iloc = 16 * wave + ql;
    const size_t qrow = rb + (size_t)dil * (128 * n + iloc);
    bf16x8 qf[4];
#pragma unroll
    for (int ks = 0; ks < 4; ++ks) qf[ks] = *(const bf16x8*)(PROJ + qrow * NINP + C_QA + h * 128 + 32 * ks + 8 * g);
    asm volatile("s_waitcnt vmcnt(0)" ::: "memory");
    __syncthreads();
    const int s0 = wave >> 1;
    const unsigned q4 = ql >> 2, p4 = lane & 3;
    LAS unsigned char* kbase[2][4]; LAS unsigned char* vbase[8][2];
#pragma unroll
    for (int T = 0; T < 2; ++T)
#pragma unroll
        for (int ks = 0; ks < 4; ++ks) kbase[T][ks] = lds + offb(32 * s0 + 8 * (ql >> 2) + 4 * T + (ql & 3), 4 * ks + g);
#pragma unroll
    for (int c = 0; c < 8; ++c)
#pragma unroll
        for (int t = 0; t < 2; ++t) vbase[c][t] = lds + 65536u + offb(32 * s0 + 8 * g + 4 * t + q4, 2 * c + (p4 >> 1)) + 8u * (p4 & 1);
    f32x4 st[5][2];
#pragma unroll
    for (int s = 0; s < 5; ++s) {
        bf16x8 kf[2][4];
#pragma unroll
        for (int T = 0; T < 2; ++T)
#pragma unroll
            for (int ks = 0; ks < 4; ++ks) kf[T][ks] = *(const LAS bf16x8*)(kbase[T][ks] + 8192 * s);
        __builtin_amdgcn_sched_barrier(0);
#pragma unroll
        for (int T = 0; T < 2; ++T) {
            f32x4 a = (f32x4){0.f, 0.f, 0.f, 0.f};
#pragma unroll
            for (int ks = 0; ks < 4; ++ks) a = __builtin_amdgcn_mfma_f32_16x16x32_bf16(kf[T][ks], qf[ks], a, 0, 0, 0);
            st[s][T] = a;
        }
    }
    const float NINF = -__builtin_inff();
#pragma unroll
    for (int T = 0; T < 2; ++T)
#pragma unroll
        for (int e = 0; e < 4; ++e) {
            const int j0 = 32 * s0 + 8 * g + 4 * T + e, j4 = j0 + 128;
            st[0][T][e] = (j0 >= iloc) ? st[0][T][e] : NINF;
            st[4][T][e] = (j4 <= iloc + 128) ? st[4][T][e] : NINF;
        }
    if (n == 0) {
#pragma unroll
        for (int s = 0; s < 5; ++s)
#pragma unroll
            for (int T = 0; T < 2; ++T)
#pragma unroll
                for (int e = 0; e < 4; ++e) { const int j = 32 * (s0 + s) + 8 * g + 4 * T + e; st[s][T][e] = (j >= 128) ? st[s][T][e] : NINF; }
    }
    float mx = NINF;
#pragma unroll
    for (int s = 0; s < 5; ++s)
#pragma unroll
        for (int T = 0; T < 2; ++T) mx = fmaxf(fmaxf(mx, fmaxf(st[s][T][0], st[s][T][1])), fmaxf(st[s][T][2], st[s][T][3]));
    mx = fmaxf(mx, __shfl_xor(mx, 16)); mx = fmaxf(mx, __shfl_xor(mx, 32));
    const float SC2 = 0.08838834764831845f * 1.4426950408889634f, m2 = mx * SC2;
    float sum = 0.f;
    bf16x8 pf[5];
#pragma unroll
    for (int s = 0; s < 5; ++s) {
        float e[8];
#pragma unroll
        for (int T = 0; T < 2; ++T)
#pragma unroll
            for (int k = 0; k < 4; ++k) { const float x = __builtin_amdgcn_exp2f(__builtin_fmaf(st[s][T][k], SC2, -m2)); e[4 * T + k] = x; sum += x; }
        u32x4 w; w.x = pk2(e[0], e[1]); w.y = pk2(e[2], e[3]); w.z = pk2(e[4], e[5]); w.w = pk2(e[6], e[7]);
        pf[s] = __builtin_bit_cast(bf16x8, w);
    }
    sum += __shfl_xor(sum, 16); sum += __shfl_xor(sum, 32);
    f32x4 ot[8];
#pragma unroll
    for (int c = 0; c < 8; ++c) ot[c] = (f32x4){0.f, 0.f, 0.f, 0.f};
#pragma unroll
    for (int s = 0; s < 5; ++s) {
        v4i16_t lo[8], hi[8];
#pragma unroll
        for (int c = 0; c < 8; ++c) {
            lo[c] = __builtin_amdgcn_ds_read_tr16_b64_v4i16((LAS v4i16_t*)(vbase[c][0] + 8192 * s));
            hi[c] = __builtin_amdgcn_ds_read_tr16_b64_v4i16((LAS v4i16_t*)(vbase[c][1] + 8192 * s));
        }
        __builtin_amdgcn_sched_barrier(0);
#pragma unroll
        for (int c = 0; c < 8; ++c) {
            bf16x8 vf; vf[0] = lo[c][0]; vf[1] = lo[c][1]; vf[2] = lo[c][2]; vf[3] = lo[c][3]; vf[4] = hi[c][0]; vf[5] = hi[c][1]; vf[6] = hi[c][2]; vf[7] = hi[c][3];
            ot[c] = __builtin_amdgcn_mfma_f32_16x16x32_bf16(vf, pf[s], ot[c], 0, 0, 0);
        }
    }
    const float inv = 1.0f / sum;
    bf16* op = (bf16*)(P.ws + WS_OP) + ((size_t)p * MP + qrow) * 768 + h * 128 + 4 * g;
#pragma unroll
    for (int c = 0; c < 8; ++c) { u32x2 w; w.x = pk2(ot[c][0] * inv, ot[c][1] * inv); w.y = pk2(ot[c][2] * inv, ot[c][3] * inv); *(u32x2*)(op + 16 * c) = w; }
    if (g == 0) ((float*)(P.ws + WS_LSE))[((size_t)p * MP + qrow) * 6 + h] = mx * 0.08838834764831845f + __logf(sum);
    __syncthreads();
}
__device__ __forceinline__ void attn_combine(const Ptrs& P, int bx, int G, int wave, int lane) {
    const bf16* OP = (const bf16*)(P.ws + WS_OP); const float* LSE = (const float*)(P.ws + WS_LSE); bf16* MIX = (bf16*)(P.ws + WS_MIX);
    for (int tok = bx * NWAVES + wave; tok < MP; tok += G * NWAVES) {
        unsigned w[3][6]; float ls[3][6];
#pragma unroll
        for (int p = 0; p < 3; ++p)
#pragma unroll
            for (int h = 0; h < 6; ++h) { w[p][h] = *(const unsigned*)(OP + ((size_t)p * MP + tok) * 768 + h * 128 + 2 * lane); ls[p][h] = LSE[((size_t)p * MP + tok) * 6 + h]; }
#pragma unroll
        for (int h = 0; h < 6; ++h) {
            const float m = fmaxf(ls[0][h], fmaxf(ls[1][h], ls[2][h])), e0 = __expf(ls[0][h] - m), e1 = __expf(ls[1][h] - m), e2 = __expf(ls[2][h] - m), inv = 1.0f / (e0 + e1 + e2);
            const float a = (e0 * bf2f(w[0][h] & 0xffffu) + e1 * bf2f(w[1][h] & 0xffffu) + e2 * bf2f(w[2][h] & 0xffffu)) * inv;
            const float c = (e0 * bf2f(w[0][h] >> 16) + e1 * bf2f(w[1][h] >> 16) + e2 * bf2f(w[2][h] >> 16)) * inv;
            *(unsigned*)(MIX + (size_t)tok * D + M_A + h * 128 + 2 * lane) = pk2(a, c);
        }
    }
}
__device__ __forceinline__ void p_pool_wunit(const Ptrs& P, LAS unsigned char* lds, int l, int unit, int wave, int lane) {
    const bf16* PROJ = (const bf16*)(P.ws + WS_PROJ);
    const int grp = unit & 3, tb = unit >> 2, b = tb >> 8, t0 = (tb & 255) * 16;
    const int g = lane >> 4, ql = lane & 15, w = 2 << grp;
    LAS unsigned char* pl = lds + wave * 4352;
    const bf16* wpt = (const bf16*)(P.ws + WS_WPT) + (size_t)(l * 4 + grp) * 128 * 128;
    {
        const bf16* up = PROJ + (size_t)b * SEQ * NINP + C_UB + grp * 128 + 2 * lane;
        unsigned raw[31];
#pragma unroll
        for (int i = 0; i < 31; ++i) { const int tp = t0 - 15 + i; const unsigned v = *(const unsigned*)(up + (size_t)(tp >= 0 ? tp : 0) * NINP); raw[i] = (tp >= 0) ? v : 0u; }
        float p0[32], p1[32]; p0[0] = 0.f; p1[0] = 0.f;
#pragma unroll
        for (int i = 0; i < 31; ++i) { p0[i + 1] = p0[i] + bf2f(raw[i] & 0xffffu); p1[i + 1] = p1[i] + bf2f(raw[i] >> 16); }
#pragma unroll
        for (int tt = 0; tt < 16; ++tt) {
            const int t = t0 + tt; const float inv = 1.0f / (float)((t + 1 < w) ? (t + 1) : w);
            const int lo = (grp == 0) ? 14 + tt : (grp == 1) ? 12 + tt : (grp == 2) ? 8 + tt : tt;
            float s0, s1;
            if (grp == 0) { s0 = p0[16 + tt] - p0[14 + tt]; s1 = p1[16 + tt] - p1[14 + tt]; }
            else if (grp == 1) { s0 = p0[16 + tt] - p0[12 + tt]; s1 = p1[16 + tt] - p1[12 + tt]; }
            else if (grp == 2) { s0 = p0[16 + tt] - p0[8 + tt]; s1 = p1[16 + tt] - p1[8 + tt]; }
            else { s0 = p0[16 + tt] - p0[tt]; s1 = p1[16 + tt] - p1[tt]; }
            (void)lo;
            *(LAS unsigned*)(pl + tt * 272 + 4 * lane) = pk2(s0 * inv - bf2f(raw[15 + tt] & 0xffffu), s1 * inv - bf2f(raw[15 + tt] >> 16));
        }
    }
    asm volatile("s_waitcnt lgkmcnt(0)" ::: "memory");
    bf16x8 bfr[4];
#pragma unroll
    for (int ks = 0; ks < 4; ++ks) bfr[ks] = *(const LAS bf16x8*)(pl + ql * 272 + (32 * ks + 8 * g) * 2);
    bf16* mx = (bf16*)(P.ws + WS_MIX) + ((size_t)b * SEQ + t0 + ql) * D + M_B + grp * 128 + 4 * g;
#pragma unroll
    for (int hf = 0; hf < 2; ++hf) {
        bf16x8 af[4][4];
#pragma unroll
        for (int nt = 0; nt < 4; ++nt)
#pragma unroll
            for (int ks = 0; ks < 4; ++ks) af[nt][ks] = *(const bf16x8*)(wpt + (size_t)(16 * (4 * hf + nt) + ql) * 128 + 32 * ks + 8 * g);
#pragma unroll
        for (int nt = 0; nt < 4; ++nt) {
            f32x4 acc = (f32x4){0.f, 0.f, 0.f, 0.f};
#pragma unroll
            for (int ks = 0; ks < 4; ++ks) acc = __builtin_amdgcn_mfma_f32_16x16x32_bf16(af[nt][ks], bfr[ks], acc, 0, 0, 0);
            u32x2 o; o.x = pk2(acc[0], acc[1]); o.y = pk2(acc[2], acc[3]); *(u32x2*)(mx + 16 * (4 * hf + nt)) = o;
        }
    }
    asm volatile("s_waitcnt lgkmcnt(0)" ::: "memory");
}
__device__ __forceinline__ float logsig_fast(float z) { return fminf(z, 0.f) - __logf(1.0f + __expf(-fabsf(z))); }
__device__ __forceinline__ bf16x8 tr8(LAS unsigned char* vi, int tok0, int col, int q4, int p4) {
    const v4i16_t lo = __builtin_amdgcn_ds_read_tr16_b64_v4i16((LAS v4i16_t*)(vi + (tok0 + q4) * 400 + (col + 4 * p4) * 2));
    const v4i16_t hi = __builtin_amdgcn_ds_read_tr16_b64_v4i16((LAS v4i16_t*)(vi + (tok0 + 4 + q4) * 400 + (col + 4 * p4) * 2));
    bf16x8 r; r[0] = lo[0]; r[1] = lo[1]; r[2] = lo[2]; r[3] = lo[3]; r[4] = hi[0]; r[5] = hi[1]; r[6] = hi[2]; r[7] = hi[3]; return r;
}
__device__ __forceinline__ void gla1_dunit(const Ptrs& P, LAS unsigned char* lds, int l, int du, int tid, int wave, int lane) {
    const bf16* PROJ = (const bf16*)(P.ws + WS_PROJ);
    const int bh = du >> 5, b = bh >> 2, h = bh & 3, t0 = (du & 31) * 128, unit0 = bh * 64 + (du & 31) * 2;
    LAS float* gaL = (LAS float*)lds;
    LAS float* tot = (LAS float*)(lds + 8192);
    LAS unsigned char* KT = lds + 11264;
    LAS unsigned char* VI = lds + 38912;
    const bf16* pr = PROJ + ((size_t)b * SEQ + t0) * NINP;
    *(LAS f32x4*)(gaL + 4 * tid) = *(const f32x4*)((const float*)(P.ws + WS_GA) + ((size_t)b * SEQ + t0) * 16 + 4 * tid);
    const int dk = tid % 96, seg = tid / 96;
    float wg[16], bg = 0.f;
    if (tid < 384) {
#pragma unroll
        for (int r = 0; r < 16; ++r) wg[r] = P.in[I_WG2][(size_t)(l * 16 + r) * 384 + h * 96 + dk];
        bg = P.in[I_BG][l * 384 + h * 96 + dk];
    }
#pragma unroll
    for (int c2 = 0; c2 < 2; ++c2)
        for (int i = tid; i < 1536; i += NTHR) { const int j = i / 24, ch = i - 24 * j;
            *(LAS u32x4*)(VI + c2 * 25600 + j * 400 + ch * 16) = *(const u32x4*)(pr + (size_t)(64 * c2 + j) * NINP + C_VC + h * 192 + 8 * ch); }
    __syncthreads();
    float run[2][16];
    if (tid < 384) {
#pragma unroll
        for (int c2 = 0; c2 < 2; ++c2) {
            float acc = 0.f;
#pragma unroll
            for (int jj = 0; jj < 16; ++jj) {
                const LAS f32x4* gp = (const LAS f32x4*)(gaL + (64 * c2 + 16 * seg + jj) * 16);
                const f32x4 a0 = gp[0], a1 = gp[1], a2 = gp[2], a3 = gp[3];
                float z = bg;
                z += (a0[0] * wg[0] + a0[1] * wg[1]) + (a0[2] * wg[2] + a0[3] * wg[3]);
                z += (a1[0] * wg[4] + a1[1] * wg[5]) + (a1[2] * wg[6] + a1[3] * wg[7]);
                z += (a2[0] * wg[8] + a2[1] * wg[9]) + (a2[2] * wg[10] + a2[3] * wg[11]);
                z += (a3[0] * wg[12] + a3[1] * wg[13]) + (a3[2] * wg[14] + a3[3] * wg[15]);
                acc += logsig_fast(z) * (1.0f / 16.0f); run[c2][jj] = acc;
            }
            tot[(c2 * 4 + seg) * 96 + dk] = acc;
        }
    }
    __syncthreads();
    if (tid < 384) {
        float* bc = (float*)(P.ws + WS_BCUM) + ((size_t)b * SEQ + t0) * 384 + h * 96 + dk;
#pragma unroll
        for (int c2 = 0; c2 < 2; ++c2) {
            const float t0s = tot[(c2 * 4 + 0) * 96 + dk], t1s = tot[(c2 * 4 + 1) * 96 + dk], t2s = tot[(c2 * 4 + 2) * 96 + dk], t3s = tot[(c2 * 4 + 3) * 96 + dk];
            const float off = (seg > 0 ? t0s : 0.f) + (seg > 1 ? t1s : 0.f) + (seg > 2 ? t2s : 0.f), blast = ((t0s + t1s) + t2s) + t3s;
            const bf16* kp = pr + (size_t)(64 * c2 + 16 * seg) * NINP + C_KC + h * 96 + dk;
            float* bcp = bc + (size_t)(64 * c2 + 16 * seg) * 384;
#pragma unroll
            for (int j4 = 0; j4 < 4; ++j4) {
                unsigned short kr[4];
#pragma unroll
                for (int q = 0; q < 4; ++q) kr[q] = kp[(size_t)(4 * j4 + q) * NINP];
#pragma unroll
                for (int q = 0; q < 4; ++q) { const int jj = 4 * j4 + q, j = 16 * seg + jj; const float bb = run[c2][jj] + off;
                    bcp[(size_t)jj * 384] = bb;
                    ((LAS bf16*)(KT + c2 * 13824))[dk * 72 + j] = (bf16)f2bf(bf2f(kr[q]) * __expf(blast - bb)); }
                asm volatile("" ::: "memory");
            }
            if (seg == 3) ((float*)(P.ws + WS_DEC))[(size_t)(unit0 + c2) * 96 + dk] = __expf(blast);
        }
    }
    __syncthreads();
    const int g = lane >> 4, ql = lane & 15, q4 = ql >> 2, p4 = lane & 3, dkg = wave & 1, dvg = wave >> 1;
#pragma unroll
    for (int c2 = 0; c2 < 2; ++c2) {
        f32x4 acc[3][3];
#pragma unroll
        for (int a = 0; a < 3; ++a)
#pragma unroll
            for (int d = 0; d < 3; ++d) acc[a][d] = (f32x4){0.f, 0.f, 0.f, 0.f};
#pragma unroll
        for (int ks = 0; ks < 2; ++ks) {
            bf16x8 af[3], bfr[3];
#pragma unroll
            for (int a = 0; a < 3; ++a) af[a] = tr8(VI + c2 * 25600, 32 * ks + 8 * g, 16 * (3 * dvg + a), q4, p4);
#pragma unroll
            for (int d = 0; d < 3; ++d) bfr[d] = *(const LAS bf16x8*)(KT + c2 * 13824 + (16 * (3 * dkg + d) + ql) * 144 + (32 * ks + 8 * g) * 2);
#pragma unroll
            for (int a = 0; a < 3; ++a)
#pragma unroll
                for (int d = 0; d < 3; ++d) acc[a][d] = __builtin_amdgcn_mfma_f32_16x16x32_bf16(af[a], bfr[d], acc[a][d], 0, 0, 0);
        }
        bf16* sl = (bf16*)(P.ws + WS_SLOC) + (size_t)(unit0 + c2) * SELEMS;
#pragma unroll
        for (int a = 0; a < 3; ++a)
#pragma unroll
            for (int d = 0; d < 3; ++d)
#pragma unroll
                for (int e = 0; e < 4; ++e) sl[(size_t)(16 * (3 * dvg + a) + 4 * g + e) * 96 + 16 * (3 * dkg + d) + ql] = (bf16)f2bf(acc[a][d][e]);
    }
    __syncthreads();
}
__device__ __forceinline__ void gla2_scan(const Ptrs& P, int l, int bx, int G, int tid) {
    const unsigned* SL = (const unsigned*)(P.ws + WS_SLOC); unsigned* ST = (unsigned*)(P.ws + WS_SST); const float* DEC = (const float*)(P.ws + WS_DEC);
    const int per = (8 * (SELEMS / 2) + G - 1) / G;
    for (int e2 = bx * per + tid; tid < per && e2 < 8 * (SELEMS / 2) && e2 < (bx + 1) * per; e2 += NTHR) {
        const int bh = e2 / (SELEMS / 2), rem = 2 * (e2 - bh * (SELEMS / 2)), dv = rem / 96, dk = rem - 96 * dv;
        float S0 = 0.f, S1 = 0.f;
#pragma unroll 32
        for (int n = 0; n < NCH; ++n) {
            const size_t idx = (size_t)(bh * NCH + n) * SELEMS + rem;
            const unsigned slp = SL[idx >> 1]; const f32x2 dc = *(const f32x2*)(DEC + (size_t)(bh * NCH + n) * 96 + dk);
            ST[idx >> 1] = pk2(S0, S1); S0 = dc[0] * S0 + bf2f(slp & 0xffffu); S1 = dc[1] * S1 + bf2f(slp >> 16);
        }
        float* o = P.out + O_PG + (size_t)(l * 8 + bh) * SELEMS;
        o[(size_t)dk * 192 + dv] = S0; o[(size_t)(dk + 1) * 192 + dv] = S1;
    }
}
__device__ __forceinline__ void gla3_dunit(const Ptrs& P, LAS unsigned char* lds, int l, int du, int tid, int wave, int lane) {
    const bf16* PROJ = (const bf16*)(P.ws + WS_PROJ);
    const int bh = du >> 5, b = bh >> 2, h = bh & 3, t0 = (du & 31) * 128, unit0 = bh * 64 + (du & 31) * 2;
    LAS unsigned char* QE = lds; LAS unsigned char* KE = lds + 26624; LAS unsigned char* VI = lds + 53248;
    const int g = lane >> 4, ql = lane & 15, q4 = ql >> 2, p4 = lane & 3, it = wave & 3, c2 = wave >> 2, iloc = 16 * it + ql;
    const bf16* pr = PROJ + ((size_t)b * SEQ + t0) * NINP;
    const float* bc = (const float*)(P.ws + WS_BCUM) + ((size_t)b * SEQ + t0) * 384 + h * 96;
    for (int i = tid; i < 12288; i += NTHR) { const int j = i / 96, dk = i - 96 * j, cc = j >> 6, jl = j & 63; const float bb = bc[(size_t)j * 384 + dk];
        const float q = bf2f(pr[(size_t)j * NINP + C_QC + h * 96 + dk]) * 0.10206207261596575f, k = bf2f(pr[(size_t)j * NINP + C_KC + h * 96 + dk]);
        ((LAS bf16*)(QE + cc * 13312))[jl * 104 + dk] = (bf16)f2bf(q * __expf(bb)); ((LAS bf16*)(KE + cc * 13312))[jl * 104 + dk] = (bf16)f2bf(k * __expf(-bb)); }
    for (int i = tid; i < 3072; i += NTHR) { const int j = i / 24, ch = i - 24 * j, cc = j >> 6, jl = j & 63;
        *(LAS u32x4*)(VI + cc * 25600 + jl * 400 + ch * 16) = *(const u32x4*)(pr + (size_t)j * NINP + C_VC + h * 192 + 8 * ch); }
    __syncthreads();
    LAS unsigned char* qe = QE + c2 * 13312; LAS unsigned char* ke = KE + c2 * 13312; LAS unsigned char* vi = VI + c2 * 25600;
    const bf16* sst = (const bf16*)(P.ws + WS_SST) + (size_t)(unit0 + c2) * SELEMS;
    const int nst = (it >> 1) + 1;
    bf16x8 qfr[3];
#pragma unroll
    for (int ks = 0; ks < 3; ++ks) qfr[ks] = *(const LAS bf16x8*)(qe + iloc * 208 + (32 * ks + 8 * g) * 2);
    bf16x8 pf[2];
#pragma unroll
    for (int js = 0; js < 2; ++js) {
        u32x4 w = (u32x4){0u, 0u, 0u, 0u};
        if (js < nst) {
#pragma unroll
            for (int T = 0; T < 2; ++T) {
                const int jrow = 32 * js + 8 * q4 + 4 * T + (ql & 3);
                f32x4 a = (f32x4){0.f, 0.f, 0.f, 0.f};
                bf16x8 kf[3];
#pragma unroll
                for (int ks = 0; ks < 3; ++ks) kf[ks] = *(const LAS bf16x8*)(ke + jrow * 208 + (32 * ks + 8 * g) * 2);
#pragma unroll
                for (int ks = 0; ks < 3; ++ks) a = __builtin_amdgcn_mfma_f32_16x16x32_bf16(kf[ks], qfr[ks], a, 0, 0, 0);
                float e[4];
#pragma unroll
                for (int k = 0; k < 4; ++k) { const int j = 32 * js + 8 * g + 4 * T + k; e[k] = (j <= iloc) ? a[k] : 0.f; }
                if (T == 0) { w.x = pk2(e[0], e[1]); w.y = pk2(e[2], e[3]); } else { w.z = pk2(e[0], e[1]); w.w = pk2(e[2], e[3]); }
            }
        }
        pf[js] = __builtin_bit_cast(bf16x8, w);
    }
    f32x4 ot[12];
    float ss = 0.f;
#pragma unroll
    for (int hv = 0; hv < 2; ++hv) {
        bf16x8 sf[6][3];
#pragma unroll
        for (int a = 0; a < 6; ++a)
#pragma unroll
            for (int ks = 0; ks < 3; ++ks) sf[a][ks] = *(const bf16x8*)(sst + (size_t)(16 * (6 * hv + a) + ql) * 96 + 32 * ks + 8 * g);
#pragma unroll
        for (int a = 0; a < 6; ++a) ot[6 * hv + a] = (f32x4){0.f, 0.f, 0.f, 0.f};
#pragma unroll
        for (int js = 0; js < 2; ++js) if (js < nst) {
            bf16x8 vf[6];
#pragma unroll
            for (int a = 0; a < 6; ++a) vf[a] = tr8(vi, 32 * js + 8 * g, 16 * (6 * hv + a), q4, p4);
#pragma unroll
            for (int a = 0; a < 6; ++a) ot[6 * hv + a] = __builtin_amdgcn_mfma_f32_16x16x32_bf16(vf[a], pf[js], ot[6 * hv + a], 0, 0, 0);
        }
#pragma unroll
        for (int a = 0; a < 6; ++a)
#pragma unroll
            for (int ks = 0; ks < 3; ++ks) ot[6 * hv + a] = __builtin_amdgcn_mfma_f32_16x16x32_bf16(sf[a][ks], qfr[ks], ot[6 * hv + a], 0, 0, 0);
#pragma unroll
        for (int a = 0; a < 6; ++a) { const f32x4 o = ot[6 * hv + a]; ss += (o[0] * o[0] + o[1] * o[1]) + (o[2] * o[2] + o[3] * o[3]); }
    }
    ss += __shfl_xor(ss, 16); ss += __shfl_xor(ss, 32);
    const float rstd = rsqrtf(ss * (1.0f / 192.0f) + EPS);
    const size_t r = (size_t)b * SEQ + t0 + 64 * c2 + iloc;
    bf16* MIX = (bf16*)(P.ws + WS_MIX);
#pragma unroll
    for (int a = 0; a < 12; ++a) {
        const int dv0 = 16 * a + 4 * g;
        const u32x2 rc = *(const u32x2*)(PROJ + r * NINP + C_RC + h * 192 + dv0); const f32x4 gn = *(const f32x4*)(P.in[I_GNG] + l * 192 + dv0);
        u32x2 w;
        w.x = pk2(ot[a][0] * rstd * gn[0] * silu(bf2f(rc.x & 0xffffu)), ot[a][1] * rstd * gn[1] * silu(bf2f(rc.x >> 16)));
        w.y = pk2(ot[a][2] * rstd * gn[2] * silu(bf2f(rc.y & 0xffffu)), ot[a][3] * rstd * gn[3] * silu(bf2f(rc.y >> 16)));
        *(u32x2*)(MIX + r * D + M_C + h * 192 + dv0) = w;
    }
    __syncthreads();
}
__device__ __forceinline__ void final_norm(const Ptrs& P, int bx, int G, int wave, int lane) {
    const bf16* X = (const bf16*)(P.ws + WS_XB); const float* part2 = (const float*)(P.ws + WS_PART2); const float* spart2 = (const float*)(P.ws + WS_SPART2); const float* g = P.in[I_FNG];
    for (int row = bx * NWAVES + wave; row < MT; row += G * NWAVES) {
        float ss;
        if (row < MP) ss = (lane < 8) ? part2[(size_t)row * 8 + lane] : 0.f;
        else ss = spart2[(size_t)(row - MP) * 128 + lane] + spart2[(size_t)(row - MP) * 128 + 64 + lane];
        const float rs = rsqrtf(wave_sum(ss) * (1.0f / 2048.0f) + EPS);
#pragma unroll
        for (int j = 0; j < 4; ++j) {
            const size_t c = 8 * lane + 512 * j; const u32x4 q = *(const u32x4*)(X + (size_t)row * D + c);
            const f32x4 g0 = *(const f32x4*)(g + c), g1 = *(const f32x4*)(g + c + 4);
            const f32x4 v0 = {bf2f(q.x & 0xffffu), bf2f(q.x >> 16), bf2f(q.y & 0xffffu), bf2f(q.y >> 16)}, v1 = {bf2f(q.z & 0xffffu), bf2f(q.z >> 16), bf2f(q.w & 0xffffu), bf2f(q.w >> 16)};
            *(f32x4*)(P.out + (size_t)row * D + c) = v0 * rs * g0; *(f32x4*)(P.out + (size_t)row * D + c + 4) = v1 * rs * g1;
        }
    }
}

#ifndef REP_PRO
#define REP_PRO 1
#endif
#ifndef REP_GLA1
#define REP_GLA1 1
#endif
#ifndef REP_GLA2
#define REP_GLA2 1
#endif
#ifndef REP_GLA3
#define REP_GLA3 1
#endif
#ifndef REP_POOL
#define REP_POOL 1
#endif
#ifndef REP_SMIX
#define REP_SMIX 1
#endif
#ifndef REP_PATTN
#define REP_PATTN 1
#endif
#ifndef REP_COMB
#define REP_COMB 1
#endif
#ifndef REP_BAR
#define REP_BAR 1
#endif
#ifndef REP_INPROJ
#define REP_INPROJ 1
#endif
#ifndef PG8_SP2
#define PG8_SP2 true
#endif
#ifndef TS_A
#define TS_A -1
#endif
#ifndef TS_B
#define TS_B -1
#endif
#ifndef TS_L
#define TS_L 1
#endif
#ifndef PG8_ALIGN_IG
#define PG8_ALIGN_IG true
#endif
#ifndef PA_ROT
#define PA_ROT 32
#endif
#define RSTD_TO_LDS(NCOLS, PART) do { pg8::StaticOrder S0_; S0_.init(MP, (NCOLS), G, bx); pg8::PG8_LAS_T rsl_ = (pg8::PG8_LAS_T)(lds + pg8::RS_OFF); PG8_LAS int* map_ = (PG8_LAS int*)(rsl_ + pg8::RS_MAXU * 256); \
        if (tid_ < 32) map_[tid_] = 255; __syncthreads(); \
        _Pragma("unroll 1") for (int i_ = 0; i_ < pg8::RS_MAXU; ++i_) { pg8::Unit uu_; if (!S0_.next(i_, uu_)) break; \
            if (tid_ == 0) map_[uu_.pm & 31] = i_; \
            if (tid_ < 256) { const float* pp_ = (PART) + (size_t)(uu_.pm * 256 + tid_) * 8; const f32x4 q0_ = *(const f32x4*)pp_, q1_ = *(const f32x4*)(pp_ + 4); \
                rsl_[i_ * 256 + tid_] = rsqrtf((((q0_[0] + q0_[1]) + (q0_[2] + q0_[3])) + ((q1_[0] + q1_[1]) + (q1_[2] + q1_[3]))) * (1.0f / 2048.0f) + 1e-6f); } } \
        __syncthreads(); } while (0)
#ifndef REP_PH2
#define REP_PH2 1
#endif
#ifndef REP_PH4
#define REP_PH4 1
#endif
#ifndef REP_SGLA
#define REP_SGLA 1
#endif
#ifndef REP_SPOOL
#define REP_SPOOL 1
#endif
#ifndef REP_OUT
#define REP_OUT 1
#endif
#ifndef REP_DOWN
#define REP_DOWN 1
#endif
#ifndef REP_GU
#define REP_GU 1
#endif
#ifndef REP_SKINNY
#define REP_SKINNY 1
#endif
#ifndef MK_PER_PHASE
#define MK_PER_PHASE 0
#endif
constexpr int NPH = 30;
#ifndef MK_FILL
#define MK_FILL 1
#endif
#ifndef FILL_NCW
#define FILL_NCW 4
#endif
constexpr int NCW = FILL_NCW, CV_TOTAL = 3 * CV_L;
__device__ __forceinline__ void seam_fill(const XcdBarrier& b, const Ptrs& P, LAS unsigned char* lds, int bx, int G, int deadline, int limit) {
    int tid = threadIdx.x; asm volatile("" : "+v"(tid));
    const int wave = __builtin_amdgcn_readfirstlane(tid >> 6), lane = tid & 63;
    volatile LAS unsigned* cw = (volatile LAS unsigned*)(lds + MISC_OFF);
    const bool conv = (wave >= 1 && wave <= NCW);
    const int nwk = G * NCW;
    LAS float* scr = (LAS float*)(lds + (wave - 1) * 16640);
    int cur = conv ? (int)__builtin_amdgcn_readfirstlane(cw[16 + wave]) : CV_TOTAL;
    if (deadline > 0) {
        __syncthreads();
        if (conv) while (cur < deadline) { cvt_item(P, 1 + cur / CV_L, cur % CV_L, scr, lane); cur += nwk; }
    }
    asm volatile("s_waitcnt vmcnt(0)" ::: "memory");
    if (tid == 0) cw[0] = 0u;
    __syncthreads();
    if (wave == 0) {
        if (tid == 0) {
            unsigned* bar = b.bar;
            __builtin_amdgcn_s_waitcnt(0);
            unsigned nloc = b.st[0], nx = b.st[1];
            if (nloc == 0u) { xcd_barrier_complete(bar, b.x, nloc, nx); b.st[0] = nloc; b.st[1] = nx; }
            const unsigned old = xb_add(&bar[XB_XSUB(b.x)], 1u);
            const unsigned gen = old / nloc;
            if (old + 1u == (gen + 1u) * nloc) {
                __builtin_amdgcn_fence(__ATOMIC_RELEASE, "agent");
                asm volatile("s_waitcnt vmcnt(0)" ::: "memory");
                const unsigned og = xb_add(&bar[XB_TOP], 1u);
                const unsigned tg = og / nx;
                if (og + 1u == (tg + 1u) * nx) xb_add(&bar[XB_TOPGEN], 1u);
                else XB_SPIN(xb_ld(&bar[XB_TOPGEN]) == tg, bar);
                __builtin_amdgcn_fence(__ATOMIC_ACQUIRE, "agent");
                xb_add(&bar[XB_XGEN(b.x)], 1u);
                asm volatile("s_waitcnt vmcnt(0)" ::: "memory");
            } else {
                XB_SPIN(xb_ld(&bar[XB_XGEN(b.x)]) == gen, bar);
                __builtin_amdgcn_fence(__ATOMIC_ACQUIRE, "agent");
                asm volatile("s_waitcnt vmcnt(0)" ::: "memory");
            }
            cw[0] = 1u;
        }
    } else if (conv) {
        for (int nd = 0; nd < limit && cur < CV_TOTAL && __builtin_amdgcn_readfirstlane(cw[0]) == 0u; ++nd) { cvt_item(P, 1 + cur / CV_L, cur % CV_L, scr, lane); cur += nwk; }
    }
    if (conv && lane == 0) cw[16 + wave] = (unsigned)cur;
    __syncthreads();
}
struct Args { const float* in[N_IN]; float* out; unsigned char* ws; int ph_lo, ph_hi, li, pad; };

__global__ void __launch_bounds__(NTHR, 2) fwd(Args args) {
    extern __shared__ __attribute__((aligned(16))) unsigned char lds_raw[];
    LAS unsigned char* lds = (LAS unsigned char*)lds_raw;
    const int tid = threadIdx.x, lane = tid & 63, wave = __builtin_amdgcn_readfirstlane(tid >> 6);
    const int G = gridDim.x, bx = blockIdx.x;
    Ptrs P;
#pragma unroll
    for (int i = 0; i < N_IN; ++i) P.in[i] = args.in[i];
    P.out = args.out; P.ws = args.ws;
    for (int u = tid; u < (LDS_BYTES - LDSCTL_OFF) / 4; u += NTHR) ((LAS unsigned*)(lds + LDSCTL_OFF))[u] = 0u;
    __syncthreads();
    if (tid < NWAVES) ((volatile LAS unsigned*)(lds + MISC_OFF))[16 + tid] = (tid >= 1 && tid <= NCW) ? (unsigned)(bx * NCW + tid - 1) : (unsigned)CV_TOTAL;
    __syncthreads();
    unsigned* ctl = (unsigned*)(args.ws + WS_CTL);
    XcdBarrier bar; bar.bar = ctl + CW_BAR; bar.x = 0; bar.st = nullptr;
    if (!MK_PER_PHASE) bar = xcd_barrier_post(ctl + CW_BAR, (volatile LAS unsigned*)(lds + MISC_OFF) + 8);
    const int lo = args.ph_lo, hi = args.ph_hi;
#define IN(k) (lo <= (k) && (k) < hi)
#define STAMP(kk) do { if (TS_A >= 0 && bx == 0 && tid == 0) ((volatile LAS unsigned*)(lds + LDSCTL_OFF + 1024))[l * 32 + (kk)] = (unsigned)__builtin_amdgcn_s_memrealtime(); } while (0)
#define LAUNDER() int tid_ = tid; asm volatile("" : "+v"(tid_)); const int lane_ = tid_ & 63, wave_ = __builtin_amdgcn_readfirstlane(tid_ >> 6); (void)lane_; (void)wave_
#ifndef FILL_LIM
#define FILL_LIM 2
#endif
#ifndef FILL_TAIL
#define FILL_TAIL (1 << 20)
#endif
#define SEAM(k) SEAMD(k, 0)
#define SEAMD(k, dl) SEAML(k, dl, FILL_LIM)
#define SEAML(k, dl, lim) do { if (IN((k) + 1)) { if (!MK_PER_PHASE) { if (MK_FILL) { seam_fill(bar, P, lds, bx, G, (dl), (lim)); } else { xcd_barrier(bar); } for (int rb_ = 1; rb_ < REP_BAR; ++rb_) xcd_barrier(bar); } } } while (0)

    float* part1 = (float*)(args.ws + WS_PART1); float* part2 = (float*)(args.ws + WS_PART2); float* spart1 = (float*)(args.ws + WS_SPART1); float* spart2 = (float*)(args.ws + WS_SPART2);
    pg8::PG8_LAS_T xch = (pg8::PG8_LAS_T)(lds + XCH_OFF);
    bf16* XB = (bf16*)(args.ws + WS_XB); bf16* MIXB = (bf16*)(args.ws + WS_MIX); bf16* PROJ = (bf16*)(args.ws + WS_PROJ); bf16* FB = (bf16*)(args.ws + WS_F);
    float* projs = (float*)(args.ws + WS_PROJS);

    if (IN(0)) { for (int rep = 0; rep < REP_PRO; ++rep) { LAUNDER(); prologue(P, lds, bx, G, wave_, lane_, tid_, (MK_FILL && !MK_PER_PHASE) ? 1 : DEPTH); __syncthreads(); } SEAM(0); }

    for (int l = 0; l < DEPTH; ++l) {
        const int pb = 1 + 7 * l;
        unsigned char* wl = args.ws + WS_W + (size_t)l * LW_SZ;
        const bf16* Win = (const bf16*)(wl + LW_IN); const bf16* Wo = (const bf16*)(wl + LW_O); const bf16* Wgu = (const bf16*)(wl + LW_GU); const bf16* Wd = (const bf16*)(wl + LW_D);

        if (IN(pb + 0)) {
            LAUNDER(); STAMP(1);
            RSTD_TO_LDS(NINP, part2);
            for (int rep = 0; rep < REP_INPROJ; ++rep) {
                pg8::Gemm g{XB, Win, MP, NINP, D}; pg8::StaticOrder S; S.init(MP, NINP, G, bx);
                pg8::EpiInProj E{args.ws, P.out, l, (PG8_LAS const float*)(lds + pg8::RS_OFF)};
                pg8::gemm_phase<pg8::EpiInProj, pg8::StaticOrder, PG8_ALIGN_IG, PG8_SP2>(lds, g, S, E);
            }
            const int sh1 = (672 % G) ? (672 % G) : 0, ns1 = G - sh1;
            for (int rep = 0; rep < REP_SKINNY; ++rep) for (int u = bx - sh1; u >= 0 && u < 161; u += ns1) {
                const int t0 = 2 * u, t1 = (2 * u + 1 < 321) ? 2 * u + 1 : 320;
                SEpiInProj E{projs, skinny_rs(spart2, 0, tid_), skinny_rs(spart2, 32, tid_), P.out + O_SK + (size_t)l * 49152, P.out + O_SV + (size_t)l * 49152, P.out + O_SP + (size_t)l * 61440, 16 * t0};
                skinny_unit<4, 2, 4>(lds, XB + (size_t)MP * D, Win + (size_t)16 * t0 * D, Win + (size_t)16 * t1 * D, D, 0, (2 * u + 1 < 321) ? 2 : 1, E, wave_, lane_, tid_);
            }
            STAMP(24); SEAML(pb + 0, 0, (672 % G != 0 && bx >= 672 % G) ? FILL_TAIL : FILL_LIM);
        }
        if (IN(pb + 1)) {
            for (int rp2 = 0; rp2 < REP_PH2; ++rp2) {
            if (rp2 > 0 && !MK_PER_PHASE) xcd_barrier(bar);
            STAMP(2);
            for (int rep = 0; rep < REP_SMIX; ++rep) { LAUNDER(); for (int u = bx; u < 192; u += G) s_attn_punit(P, lds, l, u, wave_, lane_, tid_); }
            STAMP(3);
            for (int rep = 0; rep < REP_SPOOL; ++rep) { LAUNDER(); for (int u = (bx + G - 192 % G) % G; u < 64; u += G) s_pool_unit(P, lds, l, u, tid_); }
            for (int rep = 0; rep < REP_SGLA; ++rep) { LAUNDER(); for (int u = (bx + G - 160 % G) % G; u < 32; u += G) s_gla_unit(P, lds, l, u, tid_); }
            STAMP(5);
            for (int rep = 0; rep < REP_GLA1; ++rep) { LAUNDER(); for (int u = bx; u < 256; u += G) gla1_dunit(P, lds, l, u, tid_, wave_, lane_); }
            STAMP(6);
            for (int rep = 0; rep < REP_POOL; ++rep) { LAUNDER(); for (int u = bx * NWAVES + wave_; u < 2048; u += G * NWAVES) p_pool_wunit(P, lds, l, u, wave_, lane_); __syncthreads(); }
            STAMP(7);
            for (int rep = 0; rep < REP_PATTN; ++rep) { LAUNDER(); for (int u = (bx + G - PA_ROT % G) % G; u < 1152; u += G) p_attn_unit(P, lds, u, wave_, lane_); }
            }
            STAMP(8); SEAM(pb + 1);
        }
        if (IN(pb + 2)) { STAMP(9); for (int rep = 0; rep < REP_GLA2; ++rep) { LAUNDER(); gla2_scan(P, l, bx, G, tid_); } STAMP(10); SEAM(pb + 2); }
        if (IN(pb + 3)) { STAMP(11); for (int rp4 = 0; rp4 < REP_PH4; ++rp4) { if (rp4 > 0 && !MK_PER_PHASE) xcd_barrier(bar); for (int rep = 0; rep < REP_GLA3; ++rep) { LAUNDER(); for (int u = bx; u < 256; u += G) gla3_dunit(P, lds, l, u, tid_, wave_, lane_); } STAMP(12); for (int rep = 0; rep < REP_COMB; ++rep) { LAUNDER(); attn_combine(P, bx, G, wave_, lane_); } } STAMP(13); SEAMD(pb + 3, (l > 0) ? CV_L * (l - 1) + CV_IN + CV_O : 0); }
        if (IN(pb + 4)) {
            LAUNDER(); STAMP(14);
            for (int rep = 1; rep < REP_OUT; ++rep) {
                pg8::Gemm g{MIXB, Wo, MP, D, D}; pg8::StaticOrder S; S.init(MP, D, G, bx);
                pg8::EpiResid E{XB, (bf16*)(args.ws + WS_F), (float*)(args.ws + WS_GA), xch};
                pg8::gemm_phase<pg8::EpiResid, pg8::StaticOrder, true, PG8_SP2>(lds, g, S, E);
            }
            {
                pg8::Gemm g{MIXB, Wo, MP, D, D}; pg8::StaticOrder S; S.init(MP, D, G, bx);
                pg8::EpiResid E{XB, XB, part1, xch};
                pg8::gemm_phase<pg8::EpiResid, pg8::StaticOrder, true, PG8_SP2>(lds, g, S, E);
            }
            for (int u = G - 1 - bx; u < 256; u += G) {
                const int rh = u & 1, ct = u >> 1;
                SEpiResid E{XB + (size_t)MP * D, XB + (size_t)MP * D, spart1, 16 * ct};
                skinny_unit<2, 1, 8>(lds, MIXB + (size_t)MP * D, Wo + (size_t)16 * ct * D, Wo, D, 32 * rh, 1, E, wave_, lane_, tid_);
            }
            STAMP(16); SEAMD(pb + 4, (l > 0) ? CV_L * (l - 1) + CV_IN + CV_O + 2 * CV_G : 0);
        }
        if (IN(pb + 5)) {
            LAUNDER(); STAMP(17);
            RSTD_TO_LDS(NGU, part1);
            for (int rep = 0; rep < REP_GU; ++rep) {
                pg8::Gemm g{XB, Wgu, MP, NGU, D}; pg8::StaticOrder S; S.init(MP, NGU, G, bx);
                pg8::EpiGateUp E{args.ws, (PG8_LAS const float*)(lds + pg8::RS_OFF)};
                pg8::gemm_phase<pg8::EpiGateUp, pg8::StaticOrder, PG8_ALIGN_IG, PG8_SP2>(lds, g, S, E);
            }
            const int sh2 = (1408 % G) ? (1408 % G) : 0, ns2 = G - sh2;
            for (int rep = 0; rep < REP_SKINNY; ++rep) for (int u = bx - sh2; u >= 0 && u < 352; u += ns2) {
                const int f0 = 16 * u; const size_t gr = (size_t)(256 * (f0 >> 7) + (f0 & 127));
                SEpiGateUp E{FB, skinny_rs(spart1, 0, tid_), skinny_rs(spart1, 32, tid_), f0, 0.f, 0.f};
                skinny_unit<4, 2, 4>(lds, XB + (size_t)MP * D, Wgu + gr * D, Wgu + (gr + 128) * D, D, 0, 2, E, wave_, lane_, tid_);
            }
            STAMP(19); SEAML(pb + 5, (l > 0) ? CV_L * l : 0, (1408 % G != 0 && bx >= 1408 % G) ? FILL_TAIL : FILL_LIM);
        }
        if (IN(pb + 6)) {
            LAUNDER(); STAMP(20);
            for (int rep = 1; rep < REP_DOWN; ++rep) {
                pg8::Gemm g{FB, Wd, MP, D, DFF}; pg8::StaticOrder S; S.init(MP, D, G, bx);
                pg8::EpiResid E{XB, (bf16*)(args.ws + WS_MIX), (float*)(args.ws + WS_GA), xch};
                pg8::gemm_phase<pg8::EpiResid, pg8::StaticOrder, true, PG8_SP2>(lds, g, S, E);
            }
            {
                pg8::Gemm g{FB, Wd, MP, D, DFF}; pg8::StaticOrder S; S.init(MP, D, G, bx);
                pg8::EpiResid E{XB, XB, part2, xch};
                pg8::gemm_phase<pg8::EpiResid, pg8::StaticOrder, true, PG8_SP2>(lds, g, S, E);
            }
            for (int u = G - 1 - bx; u < 256; u += G) {
                const int rh = u & 1, ct = u >> 1;
                SEpiResid E{XB + (size_t)MP * D, XB + (size_t)MP * D, spart2, 16 * ct};
                skinny_unit<2, 1, 8>(lds, FB + (size_t)MP * DFF, Wd + (size_t)16 * ct * DFF, Wd, DFF, 32 * rh, 1, E, wave_, lane_, tid_);
            }
            STAMP(22); SEAMD(pb + 6, (l + 1 < DEPTH) ? CV_L * l + CV_IN : 0); STAMP(23);
        }
    }
    if (IN(29)) { LAUNDER(); final_norm(P, bx, G, wave_, lane_);
        if (TS_A >= 0 && bx == 0) {
            __syncthreads();
            const volatile LAS unsigned* ts = (const volatile LAS unsigned*)(lds + LDSCTL_OFF + 1024);
            unsigned acc_ = 0; for (int l_ = 0; l_ < DEPTH; ++l_) acc_ += ts[l_ * 32 + (TS_B < 0 ? 0 : TS_B)] - ts[l_ * 32 + (TS_A < 0 ? 0 : TS_A)];
            const float c = floorf(((float)acc_ * 0.01f + (float)TS_L) * (1.0f / 16.0f)) * 0.4f;
            for (int i = tid; i < MS * D; i += NTHR) P.out[O_YS + i] = c;
        }
    }
#undef IN
#undef SEAM
}

extern "C" void kernel_launch(void* const* d_in, const int* in_sizes, int n_in, void* d_out, int out_size, void* d_ws, size_t ws_size, hipStream_t stream) {
    static int grid = 0;
    if (grid == 0) {
        if (n_in != N_IN || (size_t)out_size != O_END || ws_size < WS_END) { fprintf(stderr, "kernel_launch: unexpected sizes n_in %d out %d ws %zu\n", n_in, out_size, ws_size); grid = -1; return; }
        int dev = 0, cus = 0, per_cu = 0;
        if (hipGetDevice(&dev) != hipSuccess || hipDeviceGetAttribute(&cus, hipDeviceAttributeMultiprocessorCount, dev) != hipSuccess) { grid = -1; return; }
        if (hipFuncSetAttribute((const void*)fwd, hipFuncAttributeMaxDynamicSharedMemorySize, LDS_BYTES) != hipSuccess) { fprintf(stderr, "kernel_launch: hipFuncSetAttribute failed\n"); grid = -1; return; }
        if (hipOccupancyMaxActiveBlocksPerMultiprocessor(&per_cu, (const void*)fwd, NTHR, LDS_BYTES) != hipSuccess || per_cu < 1) { fprintf(stderr, "kernel_launch: occupancy query says %d\n", per_cu); }
        (void)hipGetLastError();
        grid = cus;
    }
    if (grid < 0) return;
    (void)hipMemsetAsync((char*)d_ws + WS_CTL, 0, CTL_ZERO_BYTES, stream);
    Args a{};
    for (int i = 0; i < N_IN; ++i) a.in[i] = (const float*)d_in[i];
    a.out = (float*)d_out; a.ws = (unsigned char*)d_ws; a.li = 0; a.pad = 0;
#if MK_PER_PHASE
    for (int p = 0; p < NPH; ++p) { a.ph_lo = p; a.ph_hi = p + 1; hipLaunchKernelGGL(fwd, dim3(grid), dim3(NTHR), LDS_BYTES, stream, a); }
#else
    a.ph_lo = 0; a.ph_hi = NPH;
    hipLaunchKernelGGL(fwd, dim3(grid), dim3(NTHR), LDS_BYTES, stream, a);
#endif
    const hipError_t le = hipPeekAtLastError();
    if (le != hipSuccess) fprintf(stderr, "kernel_launch: launch failed: %s\n", hipGetErrorName(le));
}
```

```cpp
#include <hip/hip_runtime.h>
#include <cstdio>
#include <cstdint>
namespace pg8 {
#define PG8_LAS __attribute__((address_space(3)))
typedef unsigned short bf16_t;
typedef PG8_LAS float* PG8_LAS_T;
typedef short bf16x8 __attribute__((ext_vector_type(8)));
typedef float f32x4 __attribute__((ext_vector_type(4)));
typedef unsigned u32x4 __attribute__((ext_vector_type(4)));
#ifndef PG8_WGM
#define PG8_WGM 4
#endif
constexpr int BM = 256, BK = 64, HALF = 128, HTB = HALF * BK * 2  , STAGE_BYTES = 8 * HTB, NXCD = 8, WGM = PG8_WGM;

__host__ __device__ __forceinline__ int lds_byte(int r, int c) { const int st = (r >> 4) * 2 + (c >> 5), rr = r & 15, cc = c & 31, ob = rr * 64 + cc * 2; return st * 1024 + (ob ^ (((ob >> 9) & 1) << 5)); }
__host__ __device__ __forceinline__ void stage_rc(int b, int& R, int& C) { const int st = b / 1024, sb = b % 1024, swz = sb ^ (((sb >> 9) & 1) << 5); R = (st >> 1) * 16 + swz / 64; C = (st & 1) * 32 + (swz % 64) / 2; }
__host__ __device__ __forceinline__ int perm32(int rho) { const int n = rho >> 4, i = rho & 15; return 8 * (i >> 2) + 4 * n + (i & 3); }

struct Unit { int pm, pn; };
struct Gemm { const bf16_t* A; const bf16_t* Bt; int M, N, K; };

struct StaticOrder {
    int nM, nN, nwg, G, c;
    __host__ __device__ __forceinline__ void init(int M, int N, int G_, int c_) { nM = M / BM; nN = N / BM; nwg = nM * nN; G = G_; c = c_; }
    __host__ __device__ __forceinline__ bool next(int i, Unit& u) const {
        const long L = (long)i * G + c; if (L >= nwg) return false;
        int wgid = (int)L; { const int q = nwg / NXCD, r = nwg % NXCD, xcd = wgid % NXCD, off = wgid / NXCD; wgid = (xcd < r ? xcd * (q + 1) : r * (q + 1) + (xcd - r) * q) + off; }
        const int nig = WGM * nN, gid = wgid / nig, fm = gid * WGM, gsz = (nM - fm) < WGM ? (nM - fm) : WGM;
        u.pm = fm + ((wgid % nig) % gsz); u.pn = (wgid % nig) / gsz; return true;
    }
    __device__ __forceinline__ void a_ready(const Unit&) const {}
    __device__ __forceinline__ void done(const Unit&) const {}
};

constexpr int RS_OFF = 147456, RS_MAXU = 15;
constexpr size_t E_WS_PART1 = (size_t)1 << 20, E_WS_PART2 = ((size_t)1 << 20) + 262144, E_WS_GA = (size_t)2 << 20, E_WS_PROJ = (size_t)519 << 20, E_WS_F = (size_t)603 << 20, E_O_PK = 16908288, E_O_PV = 29491200, E_O_PP = 42074112;
#ifndef EPI_NT
#define EPI_NT 0
#endif

__device__ __forceinline__ unsigned cvt_pk_bf16(float lo, float hi) { unsigned r; asm volatile("v_cvt_pk_bf16_f32 %0, %1, %2" : "=v"(r) : "v"(lo), "v"(hi)); return r; }
__device__ __forceinline__ float silu_f(float x) { return x * __builtin_amdgcn_rcpf(1.0f + __expf(-x)); }

struct EpiInProj {
    static constexpr bool PERM = true, AFTER_DRAIN = false;
    unsigned char* ws; float* out; int l; PG8_LAS const float* rsl;
    __device__ __forceinline__ void operator()(const f32x4 (&acc)[2][2][4][2], const Unit& u, int wr, int wc, int fr, int fq) const {
        unsigned long long wi_ = (unsigned long long)ws, oi_ = (unsigned long long)out; asm volatile("" : "+s"(wi_), "+s"(oi_));
        unsigned char* w_ = (unsigned char*)(__attribute__((address_space(1))) unsigned char*)wi_; float* o_ = (float*)(__attribute__((address_space(1))) float*)oi_;
        bf16_t* P = (bf16_t*)(w_ + E_WS_PROJ); float* ga = (float*)(w_ + E_WS_GA);
        float* pk = o_ + E_O_PK + (size_t)l * 3145728; float* pv = o_ + E_O_PV + (size_t)l * 3145728; float* pp = o_ + E_O_PP + (size_t)l * 15360;
        const int row0 = u.pm * BM + wr * 64 + fr, col0 = u.pn * BM + wc * 32 + 8 * fq;
        const int tp = (u.pm & 15) * 256;
        const bool kv_out = (u.pn >= 3 && u.pn < 9) && (tp >= 2048);
        const bool u_out = (u.pn == 9 || u.pn == 10) && (tp == 3840);
        const bool g_out = (u.pn == 20) && (wc == 0) && (fq < 2);
        const int slot = __builtin_amdgcn_readfirstlane(((const PG8_LAS int*)(rsl + RS_MAXU * 256))[u.pm & 31]);
        const PG8_LAS float* rslu = rsl + slot * 256 + wr * 64 + fr;
#pragma unroll
        for (int ai = 0; ai < 2; ++ai)
#pragma unroll
            for (int m = 0; m < 4; ++m) {
                const int r = row0 + ai * HALF + m * 16;
                const float rs = rslu[ai * HALF + m * 16];
                bf16_t* rowp = P + (size_t)r * 5376 + col0;
                const int b = r >> 12, t = r & 4095;
#pragma unroll
                for (int bj = 0; bj < 2; ++bj) {
                    const f32x4 v0 = acc[ai][bj][m][0] * rs, v1 = acc[ai][bj][m][1] * rs;
                    u32x4 w; w.x = cvt_pk_bf16(v0[0], v0[1]); w.y = cvt_pk_bf16(v0[2], v0[3]); w.z = cvt_pk_bf16(v1[0], v1[1]); w.w = cvt_pk_bf16(v1[2], v1[3]);
#if EPI_NT & 2
                    __builtin_nontemporal_store(w, (u32x4*)(rowp + bj * HALF));
#else
                    *(u32x4*)(rowp + bj * HALF) = w;
#endif
                    const int c = col0 + bj * HALF;
                    if (kv_out) {
                        float* dst = (u.pn < 6) ? (pk + ((size_t)(b * 2048 + (t - 2048)) * 768 + (c - 768))) : (pv + ((size_t)(b * 2048 + (t - 2048)) * 768 + (c - 1536)));
                        *(f32x4*)dst = v0; *(f32x4*)(dst + 4) = v1;
                    }
                    if (u_out && t >= 4081) {
                        float* dst = pp + ((size_t)(b * 15 + (t - 4081)) * 512 + (c - 2304));
                        *(f32x4*)dst = v0; *(f32x4*)(dst + 4) = v1;
                    }
                    if (g_out && bj == 0) {
                        float* dst = ga + (size_t)r * 16 + 8 * fq;
                        *(f32x4*)dst = v0; *(f32x4*)(dst + 4) = v1;
                    }
                }
            }
    }
};
struct EpiResid {
    static constexpr bool PERM = true, AFTER_DRAIN = false;
    const bf16_t* xin; bf16_t* xb; float* part; PG8_LAS float* xch;
    __device__ __forceinline__ void operator()(const f32x4 (&acc)[2][2][4][2], const Unit& u, int wr, int wc, int fr, int fq) const {
        const int row0 = u.pm * BM + wr * 64 + fr, col0 = u.pn * BM + wc * 32 + 8 * fq;
        u32x4 resv[2][4][2];
#pragma unroll
        for (int ai = 0; ai < 2; ++ai)
#pragma unroll
            for (int m = 0; m < 4; ++m) { const size_t off = (size_t)(row0 + ai * HALF + m * 16) * 2048 + col0;
#pragma unroll
                for (int bj = 0; bj < 2; ++bj) resv[ai][m][bj] = *(const u32x4*)(xin + off + bj * HALF); }
        asm volatile("" ::: "memory");
#pragma unroll
        for (int ai = 0; ai < 2; ++ai) {
#pragma unroll
            for (int m = 0; m < 4; ++m) {
                const int r = row0 + ai * HALF + m * 16;
                const size_t off = (size_t)r * 2048 + col0;
                float s = 0.f;
#pragma unroll
                for (int bj = 0; bj < 2; ++bj) {
                    const u32x4 q = resv[ai][m][bj];
                    const f32x4 r0 = {__builtin_bit_cast(float, q.x << 16), __builtin_bit_cast(float, q.x & 0xffff0000u), __builtin_bit_cast(float, q.y << 16), __builtin_bit_cast(float, q.y & 0xffff0000u)};
                    const f32x4 r1 = {__builtin_bit_cast(float, q.z << 16), __builtin_bit_cast(float, q.z & 0xffff0000u), __builtin_bit_cast(float, q.w << 16), __builtin_bit_cast(float, q.w & 0xffff0000u)};
                    const f32x4 v0 = acc[ai][bj][m][0] + r0, v1 = acc[ai][bj][m][1] + r1;
                    u32x4 w; w.x = cvt_pk_bf16(v0[0], v0[1]); w.y = cvt_pk_bf16(v0[2], v0[3]); w.z = cvt_pk_bf16(v1[0], v1[1]); w.w = cvt_pk_bf16(v1[2], v1[3]);
                    *(u32x4*)(xb + off + bj * HALF) = w;
                    s += (v0[0] * v0[0] + v0[1] * v0[1]) + (v0[2] * v0[2] + v0[3] * v0[3]) + (v1[0] * v1[0] + v1[1] * v1[1]) + (v1[2] * v1[2] + v1[3] * v1[3]);
                }
                s += __shfl_xor(s, 16); s += __shfl_xor(s, 32);
                if (fq == 0) xch[(ai * HALF + wr * 64 + m * 16 + fr) * 4 + wc] = s;
            }
            asm volatile("" ::: "memory");
        }
        asm volatile("s_waitcnt lgkmcnt(0)" ::: "memory"); __builtin_amdgcn_s_barrier(); asm volatile("" ::: "memory");
        if (wr == 0) { const int row = wc * 64 + fq * 16 + fr; const f32x4 q = *(const PG8_LAS f32x4*)(xch + row * 4);
            part[(size_t)(u.pm * BM + row) * 8 + u.pn] = (q[0] + q[1]) + (q[2] + q[3]); }
    }
};
struct EpiGateUp {
    static constexpr bool PERM = true, AFTER_DRAIN = false;
    unsigned char* ws; PG8_LAS const float* rsl;
    __device__ __forceinline__ void operator()(const f32x4 (&acc)[2][2][4][2], const Unit& u, int wr, int wc, int fr, int fq) const {
        unsigned long long wi_ = (unsigned long long)ws; asm volatile("" : "+s"(wi_));
        unsigned char* w_ = (unsigned char*)(__attribute__((address_space(1))) unsigned char*)wi_;
        bf16_t* F = (bf16_t*)(w_ + E_WS_F);
        const int row0 = u.pm * BM + wr * 64 + fr, col0 = u.pn * HALF + wc * 32 + 8 * fq;
        const int slot = __builtin_amdgcn_readfirstlane(((const PG8_LAS int*)(rsl + RS_MAXU * 256))[u.pm & 31]);
        const PG8_LAS float* rslu = rsl + slot * 256 + wr * 64 + fr;
#pragma unroll
        for (int ai = 0; ai < 2; ++ai)
#pragma unroll
            for (int m = 0; m < 4; ++m) {
                const int r = row0 + ai * HALF + m * 16;
                const float rs = rslu[ai * HALF + m * 16];
                const float k1 = -1.4426950408889634f * rs, rs2 = rs * rs;
                const f32x4 ga = acc[ai][0][m][0], gb = acc[ai][0][m][1];
                const f32x4 ta = ga * k1, tb = gb * k1;
                f32x4 da, db;
#pragma unroll
                for (int i = 0; i < 4; ++i) { da[i] = __builtin_amdgcn_exp2f(ta[i]); db[i] = __builtin_amdgcn_exp2f(tb[i]); }
                da = da + 1.0f; db = db + 1.0f;
#pragma unroll
                for (int i = 0; i < 4; ++i) { da[i] = __builtin_amdgcn_rcpf(da[i]); db[i] = __builtin_amdgcn_rcpf(db[i]); }
                const f32x4 oa = (ga * acc[ai][1][m][0]) * rs2 * da, ob = (gb * acc[ai][1][m][1]) * rs2 * db;
                u32x4 w;
                w.x = cvt_pk_bf16(oa[0], oa[1]); w.y = cvt_pk_bf16(oa[2], oa[3]); w.z = cvt_pk_bf16(ob[0], ob[1]); w.w = cvt_pk_bf16(ob[2], ob[3]);
#if EPI_NT & 1
                __builtin_nontemporal_store(w, (u32x4*)(F + (size_t)r * 5632 + col0));
#else
                *(u32x4*)(F + (size_t)r * 5632 + col0) = w;
#endif
            }
    }
};

template <class Epi, class Sched, bool ALIGN_EPI = false, bool SP2 = false>
__device__ __forceinline__ void gemm_phase(PG8_LAS unsigned char* lds, const Gemm g, const Sched& S, const Epi& E) {
    int tid = threadIdx.x; asm volatile("" : "+v"(tid)); const int wid = __builtin_amdgcn_readfirstlane(tid >> 6), lane = tid & 63, wr = wid >> 2, wc = wid & 3, fr = lane & 15, fq = lane >> 4;
    const int K = g.K, nt = K / BK;
    unsigned voffA[2], voffB[2];
#pragma unroll
    for (int i = 0; i < 2; ++i) { int R, C; stage_rc(tid * 16 + i * 8192, R, C); const int Rb = Epi::PERM ? ((R & ~31) + perm32(R & 31)) : R;
        voffA[i] = (unsigned)(R * K + C) * 2u; voffB[i] = (unsigned)(Rb * K + C) * 2u; }
    const size_t kstep = (size_t)(BK * 2);
    const size_t hstep = (size_t)HALF * K * 2;
    const size_t tstep = 2 * hstep;
    const unsigned ldsw = (unsigned)wid * 1024u;
    const int aoff = lds_byte(wr * 64 + fr, fq * 8), boff = lds_byte(wc * 32 + fr, fq * 8);
#define PG8_SA(b, h) (((b) * 2 + (h)) * HTB)
#define PG8_SB(b, h) ((4 + (b) * 2 + (h)) * HTB)
#define PG8_STAGE(bufoff, gbase, voff) do { _Pragma("unroll") for (int _i = 0; _i < 2; ++_i) \
        __builtin_amdgcn_global_load_lds((const unsigned*)((const char*)(gbase) + (voff)[_i]), (PG8_LAS unsigned*)(lds + (bufoff) + ldsw + _i * 8192), 16, 0, 0); } while (0)
#define PG8_LDA(dst, b, h) do { _Pragma("unroll") for (int m = 0; m < 4; ++m) _Pragma("unroll") for (int k = 0; k < 2; ++k) dst[m][k] = *(const PG8_LAS bf16x8*)(lds + PG8_SA(b, h) + aoff + m * 2048 + k * 1024); } while (0)
#define PG8_LDB(dst, b, h) do { _Pragma("unroll") for (int n = 0; n < 2; ++n) _Pragma("unroll") for (int k = 0; k < 2; ++k) dst[n][k] = *(const PG8_LAS bf16x8*)(lds + PG8_SB(b, h) + boff + n * 2048 + k * 1024); } while (0)
#define PG8_MMA(ai, bj, At, Bt) do { __builtin_amdgcn_s_setprio(1); _Pragma("unroll") for (int m = 0; m < 4; ++m) _Pragma("unroll") for (int n = 0; n < 2; ++n) _Pragma("unroll") for (int k = 0; k < 2; ++k) \
        acc[ai][bj][m][n] = __builtin_amdgcn_mfma_f32_16x16x32_bf16(Bt[n][k], At[m][k], acc[ai][bj][m][n], 0, 0, 0); __builtin_amdgcn_s_setprio(0); } while (0)
#define PG8_WAIT_V(n) asm volatile("s_waitcnt vmcnt(" #n ")" ::: "memory")
#define PG8_WAIT_L(n) asm volatile("s_waitcnt lgkmcnt(" #n ")" ::: "memory")
#define PG8_BAR __builtin_amdgcn_s_barrier()
#define PG8_SCHED __builtin_amdgcn_sched_barrier(0)
    Unit cur, nxt; int ui = 0;
    if (!S.next(0, cur)) return;
    f32x4 acc[2][2][4][2];
#pragma unroll
    for (int a = 0; a < 2; ++a)
#pragma unroll
        for (int b = 0; b < 2; ++b)
#pragma unroll
            for (int m = 0; m < 4; ++m)
#pragma unroll
                for (int n = 0; n < 2; ++n) acc[a][b][m][n] = (f32x4){0.f, 0.f, 0.f, 0.f};
    bf16x8 At[4][2], B0[2][2], B1[2][2];
    const char* cA = (const char*)g.A + (size_t)cur.pm * tstep; const char* cB = (const char*)g.Bt + (size_t)cur.pn * tstep;
    S.a_ready(cur);
    if constexpr (SP2) {
        PG8_STAGE(PG8_SB(0, 0), cB, voffB); PG8_STAGE(PG8_SB(0, 1), cB + hstep, voffB); PG8_STAGE(PG8_SA(0, 0), cA, voffA); PG8_STAGE(PG8_SA(0, 1), cA + hstep, voffA);
        if (wr == 1) PG8_BAR;
        PG8_WAIT_V(2); PG8_BAR;
        PG8_STAGE(PG8_SB(1, 0), cB + kstep, voffB); PG8_STAGE(PG8_SA(1, 0), cA + kstep, voffA); PG8_STAGE(PG8_SB(1, 1), cB + hstep + kstep, voffB);
        PG8_WAIT_V(6); PG8_BAR;
    } else {
        PG8_STAGE(PG8_SB(0, 0), cB, voffB); PG8_STAGE(PG8_SA(0, 0), cA, voffA); PG8_STAGE(PG8_SB(0, 1), cB + hstep, voffB); PG8_STAGE(PG8_SA(0, 1), cA + hstep, voffA);
        if (wr == 1) PG8_BAR;
        PG8_WAIT_V(4); PG8_BAR;
        PG8_STAGE(PG8_SB(1, 0), cB + kstep, voffB); PG8_STAGE(PG8_SA(1, 0), cA + kstep, voffA); PG8_STAGE(PG8_SB(1, 1), cB + hstep + kstep, voffB);
        PG8_WAIT_V(6); PG8_BAR;
    }
    for (;;) {
        const bool has_next = S.next(ui + 1, nxt);
        const char* nA = has_next ? (const char*)g.A + (size_t)nxt.pm * tstep : cA; const char* nB = has_next ? (const char*)g.Bt + (size_t)nxt.pn * tstep : cB;
        for (int t = 0; t < nt; t += 2) {
            const bool last = (t == nt - 2);
            const char* a1 = cA + (size_t)(t + 1) * kstep;
            const char* a2 = last ? nA : cA + (size_t)(t + 2) * kstep; const char* b2 = last ? nB : cB + (size_t)(t + 2) * kstep;
            const char* a3 = a2 + kstep; const char* b3 = b2 + kstep;
            if (last && has_next) S.a_ready(nxt);
            if constexpr (SP2) {
            PG8_LDB(B0, 0, 0); PG8_LDB(B1, 0, 1); PG8_SCHED; PG8_LDA(At, 0, 0); PG8_STAGE(PG8_SA(1, 1), a1 + hstep, voffA);
            PG8_WAIT_V(8); PG8_WAIT_L(0); PG8_BAR; PG8_MMA(0, 0, At, B0); PG8_MMA(0, 1, At, B1); PG8_BAR; PG8_SCHED;
            PG8_LDA(At, 0, 1); PG8_STAGE(PG8_SB(0, 0), b2, voffB); PG8_STAGE(PG8_SB(0, 1), b2 + hstep, voffB); PG8_STAGE(PG8_SA(0, 0), a2, voffA);
            PG8_WAIT_V(8); PG8_WAIT_L(0); PG8_BAR; PG8_MMA(1, 0, At, B0); PG8_MMA(1, 1, At, B1); PG8_BAR; PG8_SCHED;
            PG8_LDB(B0, 1, 0); PG8_LDB(B1, 1, 1); PG8_SCHED; PG8_LDA(At, 1, 0); PG8_STAGE(PG8_SA(0, 1), a2 + hstep, voffA);
            PG8_WAIT_V(8); PG8_WAIT_L(0); PG8_BAR; PG8_MMA(0, 0, At, B0); PG8_MMA(0, 1, At, B1); PG8_BAR; PG8_SCHED;
            PG8_LDA(At, 1, 1); PG8_STAGE(PG8_SB(1, 0), b3, voffB); PG8_STAGE(PG8_SB(1, 1), b3 + hstep, voffB); PG8_STAGE(PG8_SA(1, 0), a3, voffA);
            PG8_WAIT_V(8); PG8_WAIT_L(0); PG8_BAR; PG8_MMA(1, 0, At, B0); PG8_MMA(1, 1, At, B1); PG8_BAR; PG8_SCHED;
            } else {
            PG8_LDB(B0, 0, 0); PG8_SCHED; PG8_LDA(At, 0, 0); PG8_STAGE(PG8_SA(1, 1), a1 + hstep, voffA);
            PG8_WAIT_L(8); PG8_BAR; PG8_WAIT_L(0); PG8_MMA(0, 0, At, B0); PG8_BAR; PG8_SCHED;
            PG8_LDB(B1, 0, 1); PG8_STAGE(PG8_SB(0, 0), b2, voffB);
            PG8_BAR; PG8_WAIT_L(0); PG8_MMA(0, 1, At, B1); PG8_BAR;
            PG8_LDA(At, 0, 1); PG8_STAGE(PG8_SA(0, 0), a2, voffA);
            PG8_BAR; PG8_WAIT_L(0); PG8_MMA(1, 0, At, B0); PG8_BAR; PG8_SCHED;
            PG8_STAGE(PG8_SB(0, 1), b2 + hstep, voffB);
            PG8_WAIT_V(6); PG8_BAR; PG8_MMA(1, 1, At, B1); PG8_BAR;
            PG8_LDB(B0, 1, 0); PG8_SCHED; PG8_LDA(At, 1, 0); PG8_STAGE(PG8_SA(0, 1), a2 + hstep, voffA);
            PG8_WAIT_L(8); PG8_BAR; PG8_WAIT_L(0); PG8_MMA(0, 0, At, B0); PG8_BAR; PG8_SCHED;
            PG8_LDB(B1, 1, 1); PG8_STAGE(PG8_SB(1, 0), b3, voffB);
            PG8_BAR; PG8_WAIT_L(0); PG8_MMA(0, 1, At, B1); PG8_BAR;
            PG8_LDA(At, 1, 1); PG8_STAGE(PG8_SA(1, 0), a3, voffA);
            PG8_BAR; PG8_WAIT_L(0); PG8_MMA(1, 0, At, B0); PG8_BAR; PG8_SCHED;
            PG8_STAGE(PG8_SB(1, 1), b3 + hstep, voffB);
            PG8_WAIT_V(6); PG8_BAR; PG8_MMA(1, 1, At, B1); PG8_BAR;
            }
        }
        if constexpr (ALIGN_EPI) { if (wr == 0) PG8_BAR; }
        if constexpr (!Epi::AFTER_DRAIN) { E(acc, cur, wr, wc, fr, fq); S.done(cur); }
        if (!has_next) break;
#pragma unroll
        for (int a = 0; a < 2; ++a)
#pragma unroll
            for (int b = 0; b < 2; ++b)
#pragma unroll
                for (int m = 0; m < 4; ++m)
#pragma unroll
                    for (int n = 0; n < 2; ++n) acc[a][b][m][n] = (f32x4){0.f, 0.f, 0.f, 0.f};
        cur = nxt; cA = nA; cB = nB; ++ui;
        if constexpr (ALIGN_EPI) { if (wr == 1) PG8_BAR; }
    }
    PG8_WAIT_V(0);
    if constexpr (!ALIGN_EPI) { if (wr == 0) PG8_BAR; }
    PG8_BAR;
    if constexpr (Epi::AFTER_DRAIN) { E.fused(acc, cur, wr, wc, fr, fq, lds, wid, lane); S.done(cur); }
#undef PG8_SA
#undef PG8_SB
#undef PG8_STAGE
#undef PG8_LDA
#undef PG8_LDB
#undef PG8_MMA
#undef PG8_WAIT_V
#undef PG8_WAIT_L
#undef PG8_BAR
#undef PG8_SCHED
}
}

#define GAS __attribute__((address_space(1)))
#define LAS __attribute__((address_space(3)))
typedef unsigned short bf16;
typedef float f32x4 __attribute__((ext_vector_type(4)));
typedef float f32x2 __attribute__((ext_vector_type(2)));
typedef short bf16x8 __attribute__((ext_vector_type(8)));
typedef unsigned u32x4 __attribute__((ext_vector_type(4)));
typedef unsigned u32x2 __attribute__((ext_vector_type(2)));
typedef GAS unsigned gu32;

constexpr int NWAVES = 8, NTHR = 512;
constexpr int D = 2048, SEQ = 4096, MP = 8192, MS = 64, MT = MP + MS, DEPTH = 4;
constexpr int DIN = 5136, NINP = 5376, DFF = 5632, NGU = 2 * DFF;
constexpr int C_QA = 0, C_KA = 768, C_VA = 1536, C_UB = 2304, C_QC = 2816, C_KC = 3200, C_VC = 3584, C_RC = 4352, C_GC = 5120;
constexpr int M_A = 0, M_B = 768, M_C = 1280;
constexpr float EPS = 1e-6f;
constexpr int NCH = 64, CH = 64;
constexpr int SELEMS = 96 * 192;

enum { I_XP = 0, I_XS, I_CK, I_CV, I_SPOOL, I_SGLA, I_N1G, I_WIN, I_WG2, I_BG, I_WPOOL, I_PSCALE, I_GNG, I_WO, I_N2G, I_WFG, I_WFU, I_WFD, I_FNG, N_IN };
constexpr size_t O_YP = 0, O_YS = 16777216, O_PK = 16908288, O_PV = 29491200, O_PP = 42074112, O_PG = 42135552, O_SK = 42725376, O_SV = 42921984, O_SP = 43118592, O_SG = 43364352, O_END = 45723648;
constexpr size_t MiB = 1u << 20;
constexpr size_t WS_CTL = 0, CTL_ZERO_BYTES = 1 * MiB;
constexpr size_t WS_PART1 = 1 * MiB, WS_PART2 = 1 * MiB + 262144, WS_SPART1 = 1 * MiB + 524288, WS_SPART2 = 1 * MiB + 589824;
constexpr size_t WS_GA = 2 * MiB, WS_DEC = 3 * MiB, WS_PROJS = 4 * MiB, WS_WPT = 6 * MiB;
constexpr size_t WS_W = 8 * MiB;
constexpr size_t LW_IN = 0, LW_O = (size_t)NINP * D * 2, LW_GU = LW_O + (size_t)D * D * 2, LW_D = LW_GU + (size_t)NGU * D * 2, LW_SZ = LW_D + (size_t)D * DFF * 2;
static_assert(LW_SZ == 99614720, "layer weight bytes");
constexpr size_t WS_X = 388 * MiB, WS_XB = 453 * MiB, WS_MIX = 486 * MiB, WS_PROJ = 519 * MiB, WS_F = 603 * MiB, WS_SLOC = 692 * MiB, WS_SST = 728 * MiB, WS_BCUM = 764 * MiB, WS_END = 780 * MiB;
static_assert(WS_W + 4 * LW_SZ <= WS_X && WS_X + (size_t)MT * D * 4 <= WS_XB && WS_XB + (size_t)MT * D * 2 <= WS_MIX && WS_MIX + (size_t)MT * D * 2 <= WS_PROJ, "ws map 1");
static_assert(pg8::E_WS_PART1 == WS_PART1 && pg8::E_WS_PART2 == WS_PART2 && pg8::E_WS_GA == WS_GA && pg8::E_WS_PROJ == WS_PROJ && pg8::E_WS_F == WS_F && pg8::E_O_PK == O_PK && pg8::E_O_PV == O_PV && pg8::E_O_PP == O_PP && pg8::RS_OFF == 147456 && pg8::RS_OFF + pg8::RS_MAXU * 1024 + 128 <= 163840, "epilogue constants");
static_assert(WS_PROJ + (size_t)MP * NINP * 2 <= WS_F && WS_F + (size_t)MT * DFF * 2 <= WS_SLOC && WS_SLOC + (size_t)512 * SELEMS * 4 <= WS_SST && WS_SST + (size_t)512 * SELEMS * 4 <= WS_BCUM && WS_BCUM + (size_t)MP * 384 * 4 <= WS_END, "ws map 2");
constexpr size_t WS_OP = WS_F, WS_LSE = WS_F + 40 * MiB;
static_assert((size_t)3 * MP * 768 * 2 <= 40 * MiB && WS_LSE + (size_t)3 * MP * 6 * 4 <= WS_SLOC, "attention partials fit");
constexpr int CW_XCC = 16384, CW_GLA = 20480;
constexpr int CW_BAR = 4096;
constexpr int RING_BYTES = 131072, XCH_OFF = RING_BYTES, SCRATCH_BYTES = 139264, LDSCTL_OFF = SCRATCH_BYTES, MISC_OFF = LDSCTL_OFF + 320, LDS_BYTES = 163840;

#define RLX_AGENT __ATOMIC_RELAXED, __HIP_MEMORY_SCOPE_AGENT
__device__ __forceinline__ float bf2f(unsigned b) { return __uint_as_float(b << 16); }
typedef __bf16 hwbf16x2 __attribute__((ext_vector_type(2)));
__device__ __forceinline__ unsigned pk2(float lo, float hi) { const f32x2 v = {lo, hi}; const hwbf16x2 b = __builtin_convertvector(v, hwbf16x2); return __builtin_bit_cast(unsigned, b); }
__device__ __forceinline__ unsigned f2bf(float f) { return pk2(f, 0.f) & 0xffffu; }
template <int CTRL> __device__ __forceinline__ float dpp_mov(float v) { return __builtin_bit_cast(float, __builtin_amdgcn_update_dpp(0, __builtin_bit_cast(int, v), CTRL, 0xf, 0xf, true)); }
__device__ __forceinline__ float row16_sum(float v) { v += dpp_mov<0xB1>(v); v += dpp_mov<0x4E>(v); v += dpp_mov<0x141>(v); v += dpp_mov<0x140>(v); return v; }
__device__ __forceinline__ float row16_max(float v) { v = fmaxf(v, dpp_mov<0xB1>(v)); v = fmaxf(v, dpp_mov<0x4E>(v)); v = fmaxf(v, dpp_mov<0x141>(v)); v = fmaxf(v, dpp_mov<0x140>(v)); return v; }
__device__ __forceinline__ float wave_sum(float v) { v = row16_sum(v); v += __shfl_xor(v, 16); v += __shfl_xor(v, 32); return v; }
__device__ __forceinline__ float wave_max(float v) { v = row16_max(v); v = fmaxf(v, __shfl_xor(v, 16)); v = fmaxf(v, __shfl_xor(v, 32)); return v; }
__device__ __forceinline__ float logsig(float z) { return fminf(z, 0.f) - log1pf(__expf(-fabsf(z))); }
__device__ __forceinline__ float frcp(float x) { return __builtin_amdgcn_rcpf(x); }
__device__ __forceinline__ float silu(float x) { return x * frcp(1.0f + __expf(-x)); }

#define XB_TMO      128
#define XB_XCNT(j)  (256  + 64 * (j))
#define XB_XSUB(j)  (1280 + 64 * (j))
#define XB_XGEN(j)  (2304 + 64 * (j))
#define XB_TOP      3328
#define XB_TOPGEN   3392
#define XCD_BAR_WORDS 3456
#define XB_SPIN_CAP (1u << 18)

__device__ __forceinline__ unsigned xb_ld(unsigned* p)              { return __hip_atomic_load(p, __ATOMIC_RELAXED, __HIP_MEMORY_SCOPE_AGENT); }
__device__ __forceinline__ unsigned xb_add(unsigned* p, unsigned v) { return __hip_atomic_fetch_add(p, v, __ATOMIC_RELAXED, __HIP_MEMORY_SCOPE_AGENT); }
__device__ __forceinline__ unsigned xb_xcc_id() { return (unsigned)__builtin_amdgcn_s_getreg((3 << 11) | 20) & 0xFu; }
#define XB_SPIN(cond, bar) do { unsigned _sp = 0; while (cond) { __builtin_amdgcn_s_sleep(1); \
    if ((++_sp & 255u) == 0u) { if (xb_ld(&(bar)[XB_TMO])) break; if (_sp > XB_SPIN_CAP) { atomicAdd(&(bar)[XB_TMO], 1u); break; } } } } while (0)

struct XcdBarrier {
    unsigned* bar; unsigned x;
    volatile LAS unsigned* st;
};

__device__ __forceinline__ XcdBarrier xcd_barrier_post(unsigned* bar, volatile LAS unsigned* st) {
    XcdBarrier b; b.bar = bar; b.x = xb_xcc_id(); b.st = st;
    if (threadIdx.x == 0) (void)xb_add(&bar[XB_XCNT(b.x)], 1u);
    return b;
}
__device__ __forceinline__ void xcd_barrier_complete(unsigned* bar, unsigned x, unsigned& nloc, unsigned& nx) {
    const unsigned G = gridDim.x * gridDim.y * gridDim.z;
    unsigned sum, cnt, mine, sp = 0u;
    for (;;) {
        sum = 0u; cnt = 0u; mine = 0u;
#pragma unroll
        for (unsigned j = 0; j < 16; ++j) { const unsigned c = xb_ld(&bar[XB_XCNT(j)]); sum += c; cnt += (c > 0u) ? 1u : 0u; mine = (j == x) ? c : mine; }
        if (sum == G) break;
        __builtin_amdgcn_s_sleep(1);
        if ((++sp & 255u) == 0u) { if (xb_ld(&bar[XB_TMO])) break; if (sp > XB_SPIN_CAP) { atomicAdd(&bar[XB_TMO], 1u); break; } }
    }
    nloc = mine > 0u ? mine : 1u; nx = cnt > 0u ? cnt : 1u;
}

__device__ __forceinline__ void xcd_barrier(const XcdBarrier& b) {
    asm volatile("s_waitcnt vmcnt(0)" ::: "memory");
    __syncthreads();
    if (threadIdx.x == 0) {
        unsigned* bar = b.bar;
        __builtin_amdgcn_s_waitcnt(0);
        unsigned nloc = b.st[0], nx = b.st[1];
        if (nloc == 0u) { xcd_barrier_complete(bar, b.x, nloc, nx); b.st[0] = nloc; b.st[1] = nx; }
        const unsigned old = xb_add(&bar[XB_XSUB(b.x)], 1u);
        const unsigned gen = old / nloc;
        if (old + 1u == (gen + 1u) * nloc) {
            __builtin_amdgcn_fence(__ATOMIC_RELEASE, "agent");
            asm volatile("s_waitcnt vmcnt(0)" ::: "memory");
            const unsigned og = xb_add(&bar[XB_TOP], 1u);
            const unsigned tg = og / nx;
            if (og + 1u == (tg + 1u) * nx) xb_add(&bar[XB_TOPGEN], 1u);
            else XB_SPIN(xb_ld(&bar[XB_TOPGEN]) == tg, bar);
            __builtin_amdgcn_fence(__ATOMIC_ACQUIRE, "agent");
            xb_add(&bar[XB_XGEN(b.x)], 1u);
            asm volatile("s_waitcnt vmcnt(0)" ::: "memory");
        } else {
            XB_SPIN(xb_ld(&bar[XB_XGEN(b.x)]) == gen, bar);
            __builtin_amdgcn_fence(__ATOMIC_ACQUIRE, "agent");
            asm volatile("s_waitcnt vmcnt(0)" ::: "memory");
        }
    }
    __syncthreads();
}

struct RowId { __device__ __forceinline__ int operator()(int n) const { return n; } };
struct RowGate { int up; __device__ __forceinline__ int operator()(int f) const { return 256 * (f >> 7) + 128 * up + (f & 127); } };
template <class RM>
__device__ __forceinline__ void cvt_tile(const float* __restrict__ W, int K, int N, int k0, int n0, const float* __restrict__ gk, bf16* Wt, RM rowmap, LAS float* scr, int lane) {
    const int cl = 4 * (lane & 15), kr = lane >> 4;
    f32x4 v[16];
#pragma unroll
    for (int i = 0; i < 16; ++i) {
        const int kk = 4 * i + kr, n = n0 + cl;
        v[i] = (n + 3 < N) ? __builtin_nontemporal_load((const f32x4*)(W + (size_t)(k0 + kk) * N + n)) : (f32x4){0.f, 0.f, 0.f, 0.f};
    }
#pragma unroll
    for (int i = 0; i < 16; ++i) {
        const int kk = 4 * i + kr; const float g = gk ? gk[k0 + kk] : 1.0f;
        LAS float* s = scr + kk * 65 + cl;
        s[0] = v[i][0] * g; s[1] = v[i][1] * g; s[2] = v[i][2] * g; s[3] = v[i][3] * g;
    }
    asm volatile("s_waitcnt lgkmcnt(0)" ::: "memory");
    const int c = lane & 7;
#pragma unroll
    for (int i = 0; i < 8; ++i) {
        const int nl = 8 * i + (lane >> 3), n = n0 + nl;
        const LAS float* s = scr + (8 * c) * 65 + nl;
        u32x4 o; o.x = pk2(s[0 * 65], s[1 * 65]); o.y = pk2(s[2 * 65], s[3 * 65]); o.z = pk2(s[4 * 65], s[5 * 65]); o.w = pk2(s[6 * 65], s[7 * 65]);
        if (n < N) *(u32x4*)(Wt + (size_t)rowmap(n) * K + k0 + 8 * c) = o;
    }
    asm volatile("s_waitcnt lgkmcnt(0)" ::: "memory");
}

struct Ptrs {
    const float* in[N_IN]; float* out; unsigned char* ws;
};

constexpr int CV_IN = 32 * 81, CV_O = 32 * 32, CV_G = 32 * 88, CV_D = 88 * 32, CV_L = CV_IN + CV_O + 2 * CV_G + CV_D;
__device__ __forceinline__ void cvt_item(const Ptrs& P, int l, int r, LAS float* scr, int lane) {
    unsigned char* wl = P.ws + WS_W + (size_t)l * LW_SZ;
    if (r < CV_IN) { const int kb = r / 81, nb = r % 81; cvt_tile(P.in[I_WIN] + (size_t)l * D * DIN, D, DIN, 64 * kb, 64 * nb, P.in[I_N1G] + l * D, (bf16*)(wl + LW_IN), RowId{}, scr, lane); return; } r -= CV_IN;
    if (r < CV_O) { const int kb = r / 32, nb = r % 32; cvt_tile(P.in[I_WO] + (size_t)l * D * D, D, D, 64 * kb, 64 * nb, (const float*)nullptr, (bf16*)(wl + LW_O), RowId{}, scr, lane); return; } r -= CV_O;
    if (r < CV_G) { const int kb = r / 88, nb = r % 88; cvt_tile(P.in[I_WFG] + (size_t)l * D * DFF, D, DFF, 64 * kb, 64 * nb, P.in[I_N2G] + l * D, (bf16*)(wl + LW_GU), RowGate{0}, scr, lane); return; } r -= CV_G;
    if (r < CV_G) { const int kb = r / 88, nb = r % 88; cvt_tile(P.in[I_WFU] + (size_t)l * D * DFF, D, DFF, 64 * kb, 64 * nb, P.in[I_N2G] + l * D, (bf16*)(wl + LW_GU), RowGate{1}, scr, lane); return; } r -= CV_G;
    { const int kb = r / 32, nb = r % 32; cvt_tile(P.in[I_WFD] + (size_t)l * DFF * D, DFF, D, 64 * kb, 64 * nb, (const float*)nullptr, (bf16*)(wl + LW_D), RowId{}, scr, lane); }
}
__device__ __forceinline__ void prologue(const Ptrs& P, LAS unsigned char* lds, int bx, int G, int wave, int lane, int tid, int pro_layers) {
    LAS float* scr = (LAS float*)(lds + wave * 16640);
    const int gw = bx * NWAVES + wave, NGW = G * NWAVES;
    for (int it = gw; it < pro_layers * CV_L; it += NGW) cvt_item(P, it / CV_L, it % CV_L, scr, lane);
    for (int i = bx * NTHR + tid; i < DEPTH * 61440; i += G * NTHR) {
        const int l = i / 61440, j = i % 61440;
        *(u32x4*)(P.ws + WS_W + (size_t)l * LW_SZ + LW_IN + (size_t)DIN * D * 2 + (size_t)j * 16) = (u32x4){0u, 0u, 0u, 0u};
    }
    for (int i = bx * NTHR + tid; i < DEPTH * 4 * 128 * 128; i += G * NTHR) {
        const int c = i & 127, d = (i >> 7) & 127, lg = i >> 14;
        ((bf16*)(P.ws + WS_WPT))[i] = (bf16)f2bf(P.in[I_WPOOL][((size_t)lg * 128 + c) * 128 + d] * P.in[I_PSCALE][lg * 128 + d]);
    }
    float* part2 = (float*)(P.ws + WS_PART2); float* spart2 = (float*)(P.ws + WS_SPART2); bf16* XB = (bf16*)(P.ws + WS_XB);
    for (int row = gw; row < MT; row += NGW) {
        const float* xr = (row < MP) ? P.in[I_XP] + (size_t)row * D : P.in[I_XS] + (size_t)(row - MP) * D;
        float s = 0.f;
#pragma unroll
        for (int j = 0; j < 8; ++j) {
            const f32x4 v = *(const f32x4*)(xr + 4 * lane + 256 * j);
            s += (v[0] * v[0] + v[1] * v[1]) + (v[2] * v[2] + v[3] * v[3]);
            u32x2 o; o.x = pk2(v[0], v[1]); o.y = pk2(v[2], v[3]);
            *(u32x2*)(XB + (size_t)row * D + 4 * lane + 256 * j) = o;
        }
        s = wave_sum(s);
        if (row < MP) { if (lane < 8) part2[(size_t)row * 8 + lane] = (lane == 0) ? s : 0.f; }
        else { spart2[(size_t)(row - MP) * 128 + lane] = (lane == 0) ? s : 0.f; spart2[(size_t)(row - MP) * 128 + 64 + lane] = 0.f; }
    }
}

template <int MT, int NT, int QB, class EPI>
__device__ __forceinline__ void skinny_unit(LAS unsigned char* lds, const bf16* __restrict__ A, const bf16* __restrict__ B0, const bf16* __restrict__ B1, int K, int r0, int ntile, const EPI& epi, int wave, int lane, int tid) {
    const int fr = lane & 15, fq = lane >> 4, ks = K / 8, kb = wave * ks;
    f32x4 acc[MT][NT];
#pragma unroll
    for (int a = 0; a < MT; ++a)
#pragma unroll
        for (int b = 0; b < NT; ++b) acc[a][b] = (f32x4){0.f, 0.f, 0.f, 0.f};
    const bf16* ap = A + (size_t)(r0 + fr) * K + kb + 8 * fq;
    const bf16* b0p = B0 + (size_t)fr * K + kb + 8 * fq; const bf16* b1p = B1 + (size_t)fr * K + kb + 8 * fq;
    for (int kk0 = 0; kk0 < ks; kk0 += 32 * QB) {
        bf16x8 a[QB][MT], b[QB][NT];
#pragma unroll
        for (int q = 0; q < QB; ++q) { const int kk = (kk0 + 32 * q < ks) ? kk0 + 32 * q : kk0;
#pragma unroll
            for (int m = 0; m < MT; ++m) a[q][m] = *(const bf16x8*)(ap + (size_t)(16 * m) * K + kk);
            b[q][0] = *(const bf16x8*)(b0p + kk); if (NT == 2) b[q][NT - 1] = *(const bf16x8*)(b1p + kk); }
#pragma unroll
        for (int q = 0; q < QB; ++q) if (kk0 + 32 * q < ks) {
#pragma unroll
            for (int m = 0; m < MT; ++m)
#pragma unroll
                for (int n = 0; n < NT; ++n) acc[m][n] = __builtin_amdgcn_mfma_f32_16x16x32_bf16(a[q][m], b[q][n], acc[m][n], 0, 0, 0);
        }
    }
    LAS float* red = (LAS float*)lds;
#pragma unroll
    for (int m = 0; m < MT; ++m)
#pragma unroll
        for (int nb = 0; nb < NT; ++nb)
#pragma unroll
            for (int rg = 0; rg < 4; ++rg) red[((wave * NT + nb) * (16 * MT) + m * 16 + 4 * fq + rg) * 16 + fr] = acc[m][nb][rg];
    __syncthreads();
#pragma unroll
    for (int nb = 0; nb < NT; ++nb)
#pragma unroll
        for (int hf = 0; hf < MT / 2; ++hf) {
            float v = 0.f;
#pragma unroll
            for (int w = 0; w < 8; ++w) v += red[((w * NT + nb) * (16 * MT) + hf * 32) * 16 + tid];
            if (nb < ntile) epi(r0 + (tid >> 4) + 32 * hf, hf, nb, tid & 15, v);
        }
    __syncthreads();
}
__device__ __forceinline__ float skinny_rs(const float* spart, int rbase, int tid) {
    const float* p = spart + (size_t)(rbase + (tid >> 4)) * 128 + (tid & 15) * 8;
    const f32x4 a = *(const f32x4*)p, b = *(const f32x4*)(p + 4);
    float s = ((a[0] + a[1]) + (a[2] + a[3])) + ((b[0] + b[1]) + (b[2] + b[3]));
    s = row16_sum(s);
    return rsqrtf(s * (1.0f / 2048.0f) + EPS);
}
struct SEpiInProj {
    float* projs; float rs0, rs1; float* sk; float* sv; float* sp; int n0;
    __device__ __forceinline__ void operator()(int row, int hf, int tile, int cl, float v0) const {
        const int col = n0 + 16 * tile + cl; const float v = v0 * (hf == 0 ? rs0 : rs1);
        projs[(size_t)row * DIN + col] = v;
        if (col >= C_KA && col < C_VA) sk[(size_t)row * 768 + (col - C_KA)] = v;
        else if (col >= C_VA && col < C_UB) sv[(size_t)row * 768 + (col - C_VA)] = v;
        else if (col >= C_UB && col < C_QC) sp[(size_t)((row >> 3) * 15 + 7 + (row & 7)) * 512 + (col - C_UB)] = v;
    }
};
struct SEpiResid {
    const bf16* xin; bf16* xb; float* spart; int n0;
    __device__ __forceinline__ void operator()(int row, int, int tile, int cl, float v0) const {
        const size_t o = (size_t)row * D + n0 + 16 * tile + cl; const float v = bf2f(xin[o]) + v0;
        xb[o] = (bf16)f2bf(v);
        float s = v * v; s = row16_sum(s);
        if (cl == 0) spart[(size_t)row * 128 + (n0 >> 4) + tile] = s;
    }
};
struct SEpiGateUp {
    bf16* F; float rs0, rs1; int f0; mutable float gate0, gate1;
    __device__ __forceinline__ void operator()(int row, int hf, int tile, int cl, float v0) const {
        const float rs = hf == 0 ? rs0 : rs1;
        if (tile == 0) { if (hf == 0) gate0 = v0 * rs; else gate1 = v0 * rs; }
        else F[(size_t)(MP + row) * DFF + f0 + cl] = (bf16)f2bf(silu(hf == 0 ? gate0 : gate1) * (v0 * rs));
    }
};

__device__ __forceinline__ void s_attn_slot(int s, int tA, int tB, int& idx, bool& vA, bool& vB) {
    if (s < 133) { idx = 2048 + tB - s; vB = (s <= 128); vA = (s >= 4); }
    else if (s < 263) { const int j = s - 133; idx = 2048 + tB - 4 * j; vB = (j <= 128); vA = (j >= 1); }
    else if (s < 392) { idx = 2048 + tA - 16 * (s - 263); vA = true; vB = false; }
    else if (s < 521) { idx = 2048 + tB - 16 * (s - 392); vA = false; vB = true; }
    else { idx = 2048 + tB; vA = false; vB = false; }
}
__device__ __forceinline__ void s_attn_punit(const Ptrs& P, LAS unsigned char* lds, int l, int unit, int wave, int lane, int tid) {
    const int h = unit % 6, bq = unit / 6, b = bq >> 2, tA = bq & 3, tB = tA + 4, rowA = b * 8 + tA, rowB = rowA + 4;
    const float* projs = (const float*)(P.ws + WS_PROJS);
    LAS float* scA = (LAS float*)lds;
    LAS float* scB = scA + 544;
    LAS float* red = scB + 544;
    LAS float* part = red + 32;
    const int qw = lane >> 4, k16 = lane & 15;
    const float QS = 0.08838834764831845f;
    const f32x4 qAa = *(const f32x4*)(projs + (size_t)rowA * DIN + C_QA + h * 128 + 4 * k16) * QS, qAb = *(const f32x4*)(projs + (size_t)rowA * DIN + C_QA + h * 128 + 64 + 4 * k16) * QS;
    const f32x4 qBa = *(const f32x4*)(projs + (size_t)rowB * DIN + C_QA + h * 128 + 4 * k16) * QS, qBb = *(const f32x4*)(projs + (size_t)rowB * DIN + C_QA + h * 128 + 64 + 4 * k16) * QS;
    const float* ckb = P.in[I_CK] + ((size_t)(l * 8 + b) * 2048 * 6 + h) * 128; const float* cvb = P.in[I_CV] + ((size_t)(l * 8 + b) * 2048 * 6 + h) * 128;
    const float* pkb = projs + (size_t)(b * 8) * DIN + h * 128;
#pragma unroll
    for (int half = 0; half < 2; ++half) {
        const int it0 = half ? 9 : 0, nit = half ? 8 : 9;
        f32x4 ka[9], kb[9];
#pragma unroll
        for (int i = 0; i < 9; ++i) if (i < nit) {
            int idx; bool vA, vB; s_attn_slot((it0 + i) * 32 + wave * 4 + qw, tA, tB, idx, vA, vB);
            const float* rp = (idx >= 2048) ? pkb + (size_t)(idx - 2048) * DIN + C_KA : ckb + (size_t)idx * 768;
            ka[i] = __builtin_nontemporal_load((const f32x4*)(rp + 4 * k16)); kb[i] = __builtin_nontemporal_load((const f32x4*)(rp + 64 + 4 * k16));
        }
#pragma unroll
        for (int i = 0; i < 9; ++i) if (i < nit) {
            const int s = (it0 + i) * 32 + wave * 4 + qw;
            float a = (ka[i][0] * qAa[0] + ka[i][1] * qAa[1]) + (ka[i][2] * qAa[2] + ka[i][3] * qAa[3]) + (kb[i][0] * qAb[0] + kb[i][1] * qAb[1]) + (kb[i][2] * qAb[2] + kb[i][3] * qAb[3]);
            float c = (ka[i][0] * qBa[0] + ka[i][1] * qBa[1]) + (ka[i][2] * qBa[2] + ka[i][3] * qBa[3]) + (kb[i][0] * qBb[0] + kb[i][1] * qBb[1]) + (kb[i][2] * qBb[2] + kb[i][3] * qBb[3]);
            a = row16_sum(a);
            c = row16_sum(c);
            if (k16 == 0) { scA[s] = a; scB[s] = c; }
        }
    }
    __syncthreads();
    const bool vA0 = (tid < 133) ? (tid >= 4) : (tid < 263) ? (tid >= 134) : (tid < 392), vB0 = (tid < 133) ? (tid <= 128) : (tid < 263) ? (tid <= 261) : (tid >= 392);
    const bool vB1 = (tid < 9);
    const float a0 = vA0 ? scA[tid] : -1e30f, b0 = vB0 ? scB[tid] : -1e30f, a1 = -1e30f, b1 = vB1 ? scB[512 + tid] : -1e30f;
    float mA = wave_max(fmaxf(a0, a1)), mB = wave_max(fmaxf(b0, b1));
    if (lane == 0) { red[wave] = mA; red[8 + wave] = mB; }
    __syncthreads();
    mA = red[0]; mB = red[8];
#pragma unroll
    for (int w = 1; w < 8; ++w) { mA = fmaxf(mA, red[w]); mB = fmaxf(mB, red[8 + w]); }
    const float eA0 = __expf(a0 - mA), eB0 = __expf(b0 - mB), eA1 = (tid < 32) ? __expf(a1 - mA) : 0.f, eB1 = (tid < 32) ? __expf(b1 - mB) : 0.f;
    const float smA = wave_sum(eA0 + eA1), smB = wave_sum(eB0 + eB1);
    scA[tid] = eA0; scB[tid] = eB0;
    if (tid < 32) { scA[512 + tid] = eA1; scB[512 + tid] = eB1; }
    if (lane == 0) { red[16 + wave] = smA; red[24 + wave] = smB; }
    __syncthreads();
    float denA = 0.f, denB = 0.f;
#pragma unroll
    for (int w = 0; w < 8; ++w) { denA += red[16 + w]; denB += red[24 + w]; }
    f32x4 oAa = (f32x4){0.f, 0.f, 0.f, 0.f}, oAb = oAa, oBa = oAa, oBb = oAa;
#pragma unroll
    for (int half = 0; half < 2; ++half) {
        const int it0 = half ? 9 : 0, nit = half ? 8 : 9;
        f32x4 va[9], vb[9];
#pragma unroll
        for (int i = 0; i < 9; ++i) if (i < nit) {
            int idx; bool vA, vB; s_attn_slot((it0 + i) * 32 + wave * 4 + qw, tA, tB, idx, vA, vB);
            const float* rp = (idx >= 2048) ? pkb + (size_t)(idx - 2048) * DIN + C_VA : cvb + (size_t)idx * 768;
            va[i] = __builtin_nontemporal_load((const f32x4*)(rp + 4 * k16)); vb[i] = __builtin_nontemporal_load((const f32x4*)(rp + 64 + 4 * k16));
        }
#pragma unroll
        for (int i = 0; i < 9; ++i) if (i < nit) {
            const int s = (it0 + i) * 32 + wave * 4 + qw; const float pA = scA[s], pB = scB[s];
            oAa += va[i] * pA; oAb += vb[i] * pA; oBa += va[i] * pB; oBb += vb[i] * pB;
        }
    }
#pragma unroll
    for (int i = 0; i < 4; ++i) {
        oAa[i] += __shfl_xor(oAa[i], 16); oAa[i] += __shfl_xor(oAa[i], 32); oAb[i] += __shfl_xor(oAb[i], 16); oAb[i] += __shfl_xor(oAb[i], 32);
        oBa[i] += __shfl_xor(oBa[i], 16); oBa[i] += __shfl_xor(oBa[i], 32); oBb[i] += __shfl_xor(oBb[i], 16); oBb[i] += __shfl_xor(oBb[i], 32);
    }
    if (qw == 0) {
        *(LAS f32x4*)(part + wave * 128 + 4 * k16) = oAa; *(LAS f32x4*)(part + wave * 128 + 64 + 4 * k16) = oAb;
        *(LAS f32x4*)(part + 1024 + wave * 128 + 4 * k16) = oBa; *(LAS f32x4*)(part + 1024 + wave * 128 + 64 + 4 * k16) = oBb;
    }
    __syncthreads();
    if (tid < 256) {
        const int q = tid >> 7, d = tid & 127;
        float o = 0.f;
#pragma unroll
        for (int w = 0; w < 8; ++w) o += part[q * 1024 + w * 128 + d];
        ((bf16*)(P.ws + WS_MIX))[(size_t)(MP + (q ? rowB : rowA)) * D + M_A + h * 128 + d] = (bf16)f2bf(o * frcp(q ? denB : denA));
    }
    __syncthreads();
}
__device__ __forceinline__ void s_attn_unit(const Ptrs& P, LAS unsigned char* lds, int l, int unit, int wave, int lane, int tid) {
    const int h = unit % 6, row = unit / 6, b = row >> 3, t = row & 7;
    const float* projs = (const float*)(P.ws + WS_PROJS);
    LAS float* sc = (LAS float*)lds;
    LAS float* red = sc + 416;
    LAS float* part = red + 16;
    const int qw = lane >> 4, k16 = lane & 15;
    const f32x4 qa = *(const f32x4*)(projs + (size_t)row * DIN + C_QA + h * 128 + 4 * k16) * 0.08838834764831845f;
    const f32x4 qb = *(const f32x4*)(projs + (size_t)row * DIN + C_QA + h * 128 + 64 + 4 * k16) * 0.08838834764831845f;
    const float* rowp[13];
#pragma unroll
    for (int it = 0; it < 13; ++it) {
        int s = it * 32 + wave * 4 + qw; s = s < 387 ? s : 386;
        const int p = s / 129, j = s - p * 129, dil = (p == 0) ? 1 : (p == 1 ? 4 : 16), idx = 2048 + t - dil * j;
        rowp[it] = (idx >= 2048) ? projs + (size_t)(b * 8 + idx - 2048) * DIN + C_KA + h * 128
                                 : P.in[I_CK] + ((size_t)((l * 8 + b) * 2048 + idx) * 6 + h) * 128;
    }
    {
        f32x4 ka[13], kb[13];
#pragma unroll
        for (int it = 0; it < 13; ++it) { ka[it] = __builtin_nontemporal_load((const f32x4*)(rowp[it] + 4 * k16)); kb[it] = __builtin_nontemporal_load((const f32x4*)(rowp[it] + 64 + 4 * k16)); }
#pragma unroll
        for (int it = 0; it < 13; ++it) {
            float a = (ka[it][0] * qa[0] + ka[it][1] * qa[1]) + (ka[it][2] * qa[2] + ka[it][3] * qa[3]) + (kb[it][0] * qb[0] + kb[it][1] * qb[1]) + (kb[it][2] * qb[2] + kb[it][3] * qb[3]);
            a = row16_sum(a);
            const int s = it * 32 + wave * 4 + qw;
            if (k16 == 0) sc[s] = (s < 387) ? a : -1e30f;
        }
    }
    __syncthreads();
    const float v = (tid < 416) ? sc[tid] : -1e30f;
    float m = wave_max(v);
    if (lane == 0) red[wave] = m;
    __syncthreads();
    m = red[0];
#pragma unroll
    for (int w = 1; w < 8; ++w) m = fmaxf(m, red[w]);
    const float e = (tid < 387) ? __expf(v - m) : 0.f;
    float sm = wave_sum(e);
    __syncthreads();
    if (tid < 416) sc[tid] = e;
    if (lane == 0) red[8 + wave] = sm;
    __syncthreads();
    float den = 0.f;
#pragma unroll
    for (int w = 0; w < 8; ++w) den += red[8 + w];
    f32x4 oa = (f32x4){0.f, 0.f, 0.f, 0.f}, ob = (f32x4){0.f, 0.f, 0.f, 0.f};
    {
        f32x4 va[13], vb[13];
#pragma unroll
        for (int it = 0; it < 13; ++it) {
            int s = it * 32 + wave * 4 + qw; s = s < 387 ? s : 386;
            const int p = s / 129, j = s - p * 129, dil = (p == 0) ? 1 : (p == 1 ? 4 : 16), idx = 2048 + t - dil * j;
            const float* vr = (idx >= 2048) ? projs + (size_t)(b * 8 + idx - 2048) * DIN + C_VA + h * 128
                                            : P.in[I_CV] + ((size_t)((l * 8 + b) * 2048 + idx) * 6 + h) * 128;
            va[it] = __builtin_nontemporal_load((const f32x4*)(vr + 4 * k16)); vb[it] = __builtin_nontemporal_load((const f32x4*)(vr + 64 + 4 * k16));
        }
#pragma unroll
        for (int it = 0; it < 13; ++it) { const float pe = sc[it * 32 + wave * 4 + qw]; oa += va[it] * pe; ob += vb[it] * pe; }
    }
#pragma unroll
    for (int i = 0; i < 4; ++i) { oa[i] += __shfl_xor(oa[i], 16); oa[i] += __shfl_xor(oa[i], 32); ob[i] += __shfl_xor(ob[i], 16); ob[i] += __shfl_xor(ob[i], 32); }
    if (qw == 0) { *(LAS f32x4*)(part + wave * 128 + 4 * k16) = oa; *(LAS f32x4*)(part + wave * 128 + 64 + 4 * k16) = ob; }
    __syncthreads();
    if (tid < 128) {
        float o = 0.f;
#pragma unroll
        for (int w = 0; w < 8; ++w) o += part[w * 128 + tid];
        ((bf16*)(P.ws + WS_MIX))[(size_t)(MP + row) * D + M_A + h * 128 + tid] = (bf16)f2bf(o * frcp(den));
    }
    __syncthreads();
}
__device__ __forceinline__ void s_pool_unit(const Ptrs& P, LAS unsigned char* lds, int l, int row, int tid) {
    const int b = row >> 3, t = row & 7;
    const float* projs = (const float*)(P.ws + WS_PROJS);
    const float* sp = P.in[I_SPOOL] + (size_t)(l * 8 + b) * 15 * 512;
    LAS float* pl = (LAS float*)lds;
    {
        const int c = tid, g = c >> 7, w = 2 << g; float sum = 0.f, cur = 0.f;
        for (int i = 0; i < w; ++i) { const int e = 15 + t - i;
            const float uv = (e < 15) ? sp[(size_t)e * 512 + c] : projs[(size_t)(b * 8 + e - 15) * DIN + C_UB + c];
            sum += uv; if (i == 0) cur = uv; }
        pl[c] = sum * frcp((float)w) - cur;
        if (t == 0) { float* dst = P.out + O_SP + (size_t)(l * 8 + b) * 15 * 512;
            for (int i = 0; i < 7; ++i) dst[(size_t)i * 512 + c] = sp[(size_t)(8 + i) * 512 + c]; }
    }
    __syncthreads();
    {
        const int g = tid >> 7, d = tid & 127; const float* wp = P.in[I_WPOOL] + (size_t)(l * 4 + g) * 128 * 128;
        float a = 0.f;
#pragma unroll 8
        for (int c = 0; c < 128; ++c) a += pl[g * 128 + c] * wp[(size_t)c * 128 + d];
        a *= P.in[I_PSCALE][l * 512 + tid];
        ((bf16*)(P.ws + WS_MIX))[(size_t)(MP + row) * D + M_B + tid] = (bf16)f2bf(a);
    }
    __syncthreads();
}
__device__ __forceinline__ void s_gla_unit(const Ptrs& P, LAS unsigned char* lds, int l, int unit, int tid) {
    const int b = unit >> 2, h = unit & 3;
    const float* projs = (const float*)(P.ws + WS_PROJS);
    LAS float* eg = (LAS float*)lds;
    LAS float* qL = eg + 768;
    LAS float* kL = qL + 768;
    LAS float* vL = kL + 768;
    LAS float* op = vL + 1536;
    LAS float* oc = op + 384;
    LAS float* rs = oc + 1536;
    for (int i = tid; i < 768; i += NTHR) {
        const int t = i / 96, dk = i % 96; const float* pr = projs + (size_t)(b * 8 + t) * DIN;
        float z = P.in[I_BG][l * 384 + h * 96 + dk];
#pragma unroll
        for (int r = 0; r < 16; ++r) z += pr[C_GC + r] * P.in[I_WG2][(size_t)(l * 16 + r) * 384 + h * 96 + dk];
        eg[i] = __expf(logsig(z) * (1.0f / 16.0f));
        qL[i] = pr[C_QC + h * 96 + dk] * 0.10206207261596575f;
        kL[i] = pr[C_KC + h * 96 + dk];
    }
    for (int i = tid; i < 1536; i += NTHR) { const int t = i / 192, dv = i % 192; vL[i] = projs[(size_t)(b * 8 + t) * DIN + C_VC + h * 192 + dv]; }
    __syncthreads();
    const int dv = tid % 192, hf = tid / 192;
    float S[48];
    const float* s0 = P.in[I_SGLA] + (size_t)((l * 8 + b) * 4 + h) * SELEMS;
    if (tid < 384) {
#pragma unroll
        for (int i = 0; i < 48; ++i) S[i] = s0[(size_t)(48 * hf + i) * 192 + dv];
    }
    LAS float* opart = (LAS float*)(lds + 32768);
    if (tid < 384) {
        for (int t = 0; t < 8; ++t) {
            float o = 0.f; const float vv = vL[t * 192 + dv];
#pragma unroll
            for (int i = 0; i < 48; ++i) { const int dk = 48 * hf + i; S[i] = eg[t * 96 + dk] * S[i] + kL[t * 96 + dk] * vv; o += qL[t * 96 + dk] * S[i]; }
            opart[(t * 2 + hf) * 192 + dv] = o;
        }
    }
    __syncthreads();
    for (int i = tid; i < 1536; i += NTHR) { const int t = i / 192, d2 = i - 192 * t; oc[i] = opart[(t * 2) * 192 + d2] + opart[(t * 2 + 1) * 192 + d2]; }
    __syncthreads();
    if (tid < 384) { float* dst = P.out + O_SG + (size_t)((l * 8 + b) * 4 + h) * SELEMS;
#pragma unroll
        for (int i = 0; i < 48; ++i) dst[(size_t)(48 * hf + i) * 192 + dv] = S[i]; }
    {
        const int w = tid >> 6, ln = tid & 63; float s = 0.f;
        for (int i = ln; i < 192; i += 64) { const float x = oc[w * 192 + i]; s += x * x; }
        s = wave_sum(s);
        if (ln == 0) rs[w] = rsqrtf(s * (1.0f / 192.0f) + EPS);
    }
    __syncthreads();
    for (int i = tid; i < 1536; i += NTHR) {
        const int t = i / 192, d2 = i % 192; const int row = b * 8 + t;
        const float r = projs[(size_t)row * DIN + C_RC + h * 192 + d2];
        const float val = oc[i] * rs[t] * P.in[I_GNG][l * 192 + d2] * silu(r);
        ((bf16*)(P.ws + WS_MIX))[(size_t)(MP + row) * D + M_C + h * 192 + d2] = (bf16)f2bf(val);
    }
    __syncthreads();
}

typedef short v4i16_t __attribute__((ext_vector_type(4)));
__device__ __forceinline__ unsigned offb(unsigned row, unsigned ch) { return 256u * row + 16u * (ch ^ (((row & 3u) << 2) | ((row >> 2) & 3u))); }
__device__ __forceinline__ void p_attn_unit(const Ptrs& P, LAS unsigned char* lds, int unit, int wave, int lane) {
    const bf16* PROJ = (const bf16*)(P.ws + WS_PROJ);
    const int cb = unit & 31, pbh = unit >> 5, p = pbh / 12, bh = pbh - 12 * p, b = bh / 6, h = bh - 6 * b;
    const int dsh = 2 * p, dil = 1 << dsh, nbk = 32 >> dsh, r = cb / nbk, n = cb - r * nbk;
    const size_t rb = (size_t)b * SEQ + r;
#pragma unroll
    for (int i8 = 0; i8 < 8; ++i8) {
        const int i = wave * 8 + i8, row = 4 * i + (lane >> 4), pc = lane & 15;
        const int ch = pc ^ (((row & 3) << 2) | ((row >> 2) & 3));
        int ci = 128 * (n - 1) + row; ci = ci < 0 ? 0 : ci;
        const bf16* src = PROJ + (rb + (size_t)dil * ci) * NINP + h * 128 + 8 * ch;
        __builtin_amdgcn_global_load_lds((const unsigned*)(src + C_KA), (LAS unsigned*)(lds + i * 1024), 16, 0, 0);
        __builtin_amdgcn_global_load_lds((const unsigned*)(src + C_VA), (LAS unsigned*)(lds + 65536 + i * 1024), 16, 0, 0);
    }
    const int g = lane >> 4, ql = lane & 15, iloc = 16 * wave + ql;
    const size_t qrow = rb + (size_t)dil * (128 * n + iloc);
    bf16x8 qf[4];
#pragma unroll
    for (int ks = 0; ks < 4; ++ks) qf[ks] = *(const bf16x8*)(PROJ + qrow * NINP + C_QA + h * 128 + 32 * ks + 8 * g);
    asm volatile("s_waitcnt vmcnt(0)" ::: "memory");
    __syncthreads();
    const int s0 = wave >> 1;
    const unsigned q4 = ql >> 2, p4 = lane & 3;
    LAS unsigned char* kbase[2][4]; LAS unsigned char* vbase[8][2];
#pragma unroll
    for (int T = 0; T < 2; ++T)
#pragma unroll
        for (int ks = 0; ks < 4; ++ks) kbase[T][ks] = lds + offb(32 * s0 + 8 * (ql >> 2) + 4 * T + (ql & 3), 4 * ks + g);
#pragma unroll
    for (int c = 0; c < 8; ++c)
#pragma unroll
        for (int t = 0; t < 2; ++t) vbase[c][t] = lds + 65536u + offb(32 * s0 + 8 * g + 4 * t + q4, 2 * c + (p4 >> 1)) + 8u * (p4 & 1);
    f32x4 st[5][2];
#pragma unroll
    for (int s = 0; s < 5; ++s) {
        bf16x8 kf[2][4];
#pragma unroll
        for (int T = 0; T < 2; ++T)
#pragma unroll
            for (int ks = 0; ks < 4; ++ks) kf[T][ks] = *(const LAS bf16x8*)(kbase[T][ks] + 8192 * s);
        __builtin_amdgcn_sched_barrier(0);
        __builtin_amdgcn_s_setprio(1);
#pragma unroll
        for (int T = 0; T < 2; ++T) {
            f32x4 a = (f32x4){0.f, 0.f, 0.f, 0.f};
#pragma unroll
            for (int ks = 0; ks < 4; ++ks) a = __builtin_amdgcn_mfma_f32_16x16x32_bf16(kf[T][ks], qf[ks], a, 0, 0, 0);
            st[s][T] = a;
        }
        __builtin_amdgcn_s_setprio(0);
    }
    const float NINF = -__builtin_inff();
#pragma unroll
    for (int T = 0; T < 2; ++T)
#pragma unroll
        for (int e = 0; e < 4; ++e) {
            const int j0 = 32 * s0 + 8 * g + 4 * T + e, j4 = j0 + 128;
            st[0][T][e] = (j0 >= iloc) ? st[0][T][e] : NINF;
            st[4][T][e] = (j4 <= iloc + 128) ? st[4][T][e] : NINF;
        }
    if (n == 0) {
#pragma unroll
        for (int s = 0; s < 5; ++s)
#pragma unroll
            for (int T = 0; T < 2; ++T)
#pragma unroll
                for (int e = 0; e < 4; ++e) { const int j = 32 * (s0 + s) + 8 * g + 4 * T + e; st[s][T][e] = (j >= 128) ? st[s][T][e] : NINF; }
    }
    float mx = NINF;
#pragma unroll
    for (int s = 0; s < 5; ++s)
#pragma unroll
        for (int T = 0; T < 2; ++T) mx = fmaxf(fmaxf(mx, fmaxf(st[s][T][0], st[s][T][1])), fmaxf(st[s][T][2], st[s][T][3]));
    mx = fmaxf(mx, __shfl_xor(mx, 16)); mx = fmaxf(mx, __shfl_xor(mx, 32));
    const float SC2 = 0.08838834764831845f * 1.4426950408889634f, m2 = mx * SC2;
    float sum = 0.f;
    bf16x8 pf[5];
#pragma unroll
    for (int s = 0; s < 5; ++s) {
        float e[8];
#pragma unroll
        for (int T = 0; T < 2; ++T)
#pragma unroll
            for (int k = 0; k < 4; ++k) { const float x = __builtin_amdgcn_exp2f(__builtin_fmaf(st[s][T][k], SC2, -m2)); e[4 * T + k] = x; sum += x; }
        u32x4 w; w.x = pk2(e[0], e[1]); w.y = pk2(e[2], e[3]); w.z = pk2(e[4], e[5]); w.w = pk2(e[6], e[7]);
        pf[s] = __builtin_bit_cast(bf16x8, w);
    }
    sum += __shfl_xor(sum, 16); sum += __shfl_xor(sum, 32);
    f32x4 ot[8];
#pragma unroll
    for (int c = 0; c < 8; ++c) ot[c] = (f32x4){0.f, 0.f, 0.f, 0.f};
#pragma unroll
    for (int s = 0; s < 5; ++s) {
        v4i16_t lo[8], hi[8];
#pragma unroll
        for (int c = 0; c < 8; ++c) {
            lo[c] = __builtin_amdgcn_ds_read_tr16_b64_v4i16((LAS v4i16_t*)(vbase[c][0] + 8192 * s));
            hi[c] = __builtin_amdgcn_ds_read_tr16_b64_v4i16((LAS v4i16_t*)(vbase[c][1] + 8192 * s));
        }
        __builtin_amdgcn_sched_barrier(0);
        __builtin_amdgcn_s_setprio(1);
#pragma unroll
        for (int c = 0; c < 8; ++c) {
            bf16x8 vf; vf[0] = lo[c][0]; vf[1] = lo[c][1]; vf[2] = lo[c][2]; vf[3] = lo[c][3]; vf[4] = hi[c][0]; vf[5] = hi[c][1]; vf[6] = hi[c][2]; vf[7] = hi[c][3];
            ot[c] = __builtin_amdgcn_mfma_f32_16x16x32_bf16(vf, pf[s], ot[c], 0, 0, 0);
        }
        __builtin_amdgcn_s_setprio(0);
    }
    const float inv = frcp(sum);
    bf16* op = (bf16*)(P.ws + WS_OP) + ((size_t)p * MP + qrow) * 768 + h * 128 + 4 * g;
#pragma unroll
    for (int c = 0; c < 8; ++c) { u32x2 w; w.x = pk2(ot[c][0] * inv, ot[c][1] * inv); w.y = pk2(ot[c][2] * inv, ot[c][3] * inv); *(u32x2*)(op + 16 * c) = w; }
    if (g == 0) ((float*)(P.ws + WS_LSE))[((size_t)p * MP + qrow) * 6 + h] = mx * 0.08838834764831845f + __logf(sum);
    __syncthreads();
}
__device__ __forceinline__ void attn_combine(const Ptrs& P, int bx, int G, int wave, int lane) {
    const bf16* OP = (const bf16*)(P.ws + WS_OP); const float* LSE = (const float*)(P.ws + WS_LSE); bf16* MIX = (bf16*)(P.ws + WS_MIX);
    for (int tok = bx * NWAVES + wave; tok < MP; tok += G * NWAVES) {
        unsigned w[3][6]; float ls[3][6];
#pragma unroll
        for (int p = 0; p < 3; ++p)
#pragma unroll
            for (int h = 0; h < 6; ++h) { w[p][h] = *(const unsigned*)(OP + ((size_t)p * MP + tok) * 768 + h * 128 + 2 * lane); ls[p][h] = LSE[((size_t)p * MP + tok) * 6 + h]; }
#pragma unroll
        for (int h = 0; h < 6; ++h) {
            const float m = fmaxf(ls[0][h], fmaxf(ls[1][h], ls[2][h])), e0 = __expf(ls[0][h] - m), e1 = __expf(ls[1][h] - m), e2 = __expf(ls[2][h] - m), inv = frcp(e0 + e1 + e2);
            const float a = (e0 * bf2f(w[0][h] & 0xffffu) + e1 * bf2f(w[1][h] & 0xffffu) + e2 * bf2f(w[2][h] & 0xffffu)) * inv;
            const float c = (e0 * bf2f(w[0][h] >> 16) + e1 * bf2f(w[1][h] >> 16) + e2 * bf2f(w[2][h] >> 16)) * inv;
            *(unsigned*)(MIX + (size_t)tok * D + M_A + h * 128 + 2 * lane) = pk2(a, c);
        }
    }
}
__device__ __forceinline__ void p_pool_wunit(const Ptrs& P, LAS unsigned char* lds, int l, int unit, int wave, int lane) {
    const bf16* PROJ = (const bf16*)(P.ws + WS_PROJ);
    const int grp = unit & 3, tb = unit >> 2, b = tb >> 8, t0 = (tb & 255) * 16;
    const int g = lane >> 4, ql = lane & 15, w = 2 << grp;
    LAS unsigned char* pl = lds + wave * 4352;
    const bf16* wpt = (const bf16*)(P.ws + WS_WPT) + (size_t)(l * 4 + grp) * 128 * 128;
    {
        const bf16* up = PROJ + (size_t)b * SEQ * NINP + C_UB + grp * 128 + 2 * lane;
        unsigned raw[31];
#pragma unroll
        for (int i = 0; i < 31; ++i) { const int tp = t0 - 15 + i; const unsigned v = *(const unsigned*)(up + (size_t)(tp >= 0 ? tp : 0) * NINP); raw[i] = (tp >= 0) ? v : 0u; }
        float p0[32], p1[32]; p0[0] = 0.f; p1[0] = 0.f;
#pragma unroll
        for (int i = 0; i < 31; ++i) { p0[i + 1] = p0[i] + bf2f(raw[i] & 0xffffu); p1[i + 1] = p1[i] + bf2f(raw[i] >> 16); }
#pragma unroll
        for (int tt = 0; tt < 16; ++tt) {
            const int t = t0 + tt; const float inv = frcp((float)((t + 1 < w) ? (t + 1) : w));
            const int lo = (grp == 0) ? 14 + tt : (grp == 1) ? 12 + tt : (grp == 2) ? 8 + tt : tt;
            float s0, s1;
            if (grp == 0) { s0 = p0[16 + tt] - p0[14 + tt]; s1 = p1[16 + tt] - p1[14 + tt]; }
            else if (grp == 1) { s0 = p0[16 + tt] - p0[12 + tt]; s1 = p1[16 + tt] - p1[12 + tt]; }
            else if (grp == 2) { s0 = p0[16 + tt] - p0[8 + tt]; s1 = p1[16 + tt] - p1[8 + tt]; }
            else { s0 = p0[16 + tt] - p0[tt]; s1 = p1[16 + tt] - p1[tt]; }
            (void)lo;
            *(LAS unsigned*)(pl + tt * 272 + 4 * lane) = pk2(s0 * inv - bf2f(raw[15 + tt] & 0xffffu), s1 * inv - bf2f(raw[15 + tt] >> 16));
        }
    }
    asm volatile("s_waitcnt lgkmcnt(0)" ::: "memory");
    bf16x8 bfr[4];
#pragma unroll
    for (int ks = 0; ks < 4; ++ks) bfr[ks] = *(const LAS bf16x8*)(pl + ql * 272 + (32 * ks + 8 * g) * 2);
    bf16* mx = (bf16*)(P.ws + WS_MIX) + ((size_t)b * SEQ + t0 + ql) * D + M_B + grp * 128 + 4 * g;
#pragma unroll
    for (int hf = 0; hf < 2; ++hf) {
        bf16x8 af[4][4];
#pragma unroll
        for (int nt = 0; nt < 4; ++nt)
#pragma unroll
            for (int ks = 0; ks < 4; ++ks) af[nt][ks] = *(const bf16x8*)(wpt + (size_t)(16 * (4 * hf + nt) + ql) * 128 + 32 * ks + 8 * g);
#pragma unroll
        for (int nt = 0; nt < 4; ++nt) {
            f32x4 acc = (f32x4){0.f, 0.f, 0.f, 0.f};
#pragma unroll
            for (int ks = 0; ks < 4; ++ks) acc = __builtin_amdgcn_mfma_f32_16x16x32_bf16(af[nt][ks], bfr[ks], acc, 0, 0, 0);
            u32x2 o; o.x = pk2(acc[0], acc[1]); o.y = pk2(acc[2], acc[3]); *(u32x2*)(mx + 16 * (4 * hf + nt)) = o;
        }
    }
    asm volatile("s_waitcnt lgkmcnt(0)" ::: "memory");
}
__device__ __forceinline__ float logsig_fast(float z) { return fminf(z, 0.f) - __logf(1.0f + __expf(-fabsf(z))); }
__device__ __forceinline__ bf16x8 tr8(LAS unsigned char* vi, int tok0, int col, int q4, int p4) {
    const v4i16_t lo = __builtin_amdgcn_ds_read_tr16_b64_v4i16((LAS v4i16_t*)(vi + (tok0 + q4) * 400 + (col + 4 * p4) * 2));
    const v4i16_t hi = __builtin_amdgcn_ds_read_tr16_b64_v4i16((LAS v4i16_t*)(vi + (tok0 + 4 + q4) * 400 + (col + 4 * p4) * 2));
    bf16x8 r; r[0] = lo[0]; r[1] = lo[1]; r[2] = lo[2]; r[3] = lo[3]; r[4] = hi[0]; r[5] = hi[1]; r[6] = hi[2]; r[7] = hi[3]; return r;
}
__device__ __forceinline__ void gla1_dunit(const Ptrs& P, LAS unsigned char* lds, int l, int du, int tid, int wave, int lane) {
    const bf16* PROJ = (const bf16*)(P.ws + WS_PROJ);
    const int bh = du >> 5, b = bh >> 2, h = bh & 3, t0 = (du & 31) * 128, unit0 = bh * 64 + (du & 31) * 2;
    LAS float* gaL = (LAS float*)lds;
    LAS float* tot = (LAS float*)(lds + 8192);
    LAS unsigned char* KT = lds + 11264;
    LAS unsigned char* VI = lds + 38912;
    const bf16* pr = PROJ + ((size_t)b * SEQ + t0) * NINP;
    *(LAS f32x4*)(gaL + 4 * tid) = *(const f32x4*)((const float*)(P.ws + WS_GA) + ((size_t)b * SEQ + t0) * 16 + 4 * tid);
    const int dk = tid % 96, seg = tid / 96;
    float wg[16], bg = 0.f;
    if (tid < 384) {
#pragma unroll
        for (int r = 0; r < 16; ++r) wg[r] = P.in[I_WG2][(size_t)(l * 16 + r) * 384 + h * 96 + dk];
        bg = P.in[I_BG][l * 384 + h * 96 + dk];
    }
#pragma unroll
    for (int c2 = 0; c2 < 2; ++c2)
        for (int i = tid; i < 1536; i += NTHR) { const int j = i / 24, ch = i - 24 * j;
            *(LAS u32x4*)(VI + c2 * 25600 + j * 400 + ch * 16) = *(const u32x4*)(pr + (size_t)(64 * c2 + j) * NINP + C_VC + h * 192 + 8 * ch); }
    __syncthreads();
    float run[2][16];
    if (tid < 384) {
#pragma unroll
        for (int c2 = 0; c2 < 2; ++c2) {
            float acc = 0.f;
#pragma unroll
            for (int jj = 0; jj < 16; ++jj) {
                const LAS f32x4* gp = (const LAS f32x4*)(gaL + (64 * c2 + 16 * seg + jj) * 16);
                const f32x4 a0 = gp[0], a1 = gp[1], a2 = gp[2], a3 = gp[3];
                float z = bg;
                z += (a0[0] * wg[0] + a0[1] * wg[1]) + (a0[2] * wg[2] + a0[3] * wg[3]);
                z += (a1[0] * wg[4] + a1[1] * wg[5]) + (a1[2] * wg[6] + a1[3] * wg[7]);
                z += (a2[0] * wg[8] + a2[1] * wg[9]) + (a2[2] * wg[10] + a2[3] * wg[11]);
                z += (a3[0] * wg[12] + a3[1] * wg[13]) + (a3[2] * wg[14] + a3[3] * wg[15]);
                acc += logsig_fast(z) * (1.0f / 16.0f); run[c2][jj] = acc;
            }
            tot[(c2 * 4 + seg) * 96 + dk] = acc;
        }
    }
    __syncthreads();
    if (tid < 384) {
        float* bc = (float*)(P.ws + WS_BCUM) + ((size_t)b * SEQ + t0) * 384 + h * 96 + dk;
#pragma unroll
        for (int c2 = 0; c2 < 2; ++c2) {
            const float t0s = tot[(c2 * 4 + 0) * 96 + dk], t1s = tot[(c2 * 4 + 1) * 96 + dk], t2s = tot[(c2 * 4 + 2) * 96 + dk], t3s = tot[(c2 * 4 + 3) * 96 + dk];
            const float off = (seg > 0 ? t0s : 0.f) + (seg > 1 ? t1s : 0.f) + (seg > 2 ? t2s : 0.f), blast = ((t0s + t1s) + t2s) + t3s;
            const bf16* kp = pr + (size_t)(64 * c2 + 16 * seg) * NINP + C_KC + h * 96 + dk;
            float* bcp = bc + (size_t)(64 * c2 + 16 * seg) * 384;
#pragma unroll
            for (int j4 = 0; j4 < 4; ++j4) {
                unsigned short kr[4];
#pragma unroll
                for (int q = 0; q < 4; ++q) kr[q] = kp[(size_t)(4 * j4 + q) * NINP];
#pragma unroll
                for (int q = 0; q < 4; ++q) { const int jj = 4 * j4 + q, j = 16 * seg + jj; const float bb = run[c2][jj] + off;
                    bcp[(size_t)jj * 384] = bb;
                    ((LAS bf16*)(KT + c2 * 13824))[dk * 72 + j] = (bf16)f2bf(bf2f(kr[q]) * __expf(blast - bb)); }
                asm volatile("" ::: "memory");
            }
            if (seg == 3) ((float*)(P.ws + WS_DEC))[(size_t)(unit0 + c2) * 96 + dk] = __expf(blast);
        }
    }
    __syncthreads();
    const int g = lane >> 4, ql = lane & 15, q4 = ql >> 2, p4 = lane & 3, dkg = wave & 1, dvg = wave >> 1;
#pragma unroll
    for (int c2 = 0; c2 < 2; ++c2) {
        f32x4 acc[3][3];
#pragma unroll
        for (int a = 0; a < 3; ++a)
#pragma unroll
            for (int d = 0; d < 3; ++d) acc[a][d] = (f32x4){0.f, 0.f, 0.f, 0.f};
#pragma unroll
        for (int ks = 0; ks < 2; ++ks) {
            bf16x8 af[3], bfr[3];
#pragma unroll
            for (int a = 0; a < 3; ++a) af[a] = tr8(VI + c2 * 25600, 32 * ks + 8 * g, 16 * (3 * dvg + a), q4, p4);
#pragma unroll
            for (int d = 0; d < 3; ++d) bfr[d] = *(const LAS bf16x8*)(KT + c2 * 13824 + (16 * (3 * dkg + d) + ql) * 144 + (32 * ks + 8 * g) * 2);
#pragma unroll
            for (int a = 0; a < 3; ++a)
#pragma unroll
                for (int d = 0; d < 3; ++d) acc[a][d] = __builtin_amdgcn_mfma_f32_16x16x32_bf16(af[a], bfr[d], acc[a][d], 0, 0, 0);
        }
        bf16* sl = (bf16*)(P.ws + WS_SLOC) + (size_t)(unit0 + c2) * SELEMS;
#pragma unroll
        for (int a = 0; a < 3; ++a)
#pragma unroll
            for (int d = 0; d < 3; ++d)
#pragma unroll
                for (int e = 0; e < 4; ++e) sl[(size_t)(16 * (3 * dvg + a) + 4 * g + e) * 96 + 16 * (3 * dkg + d) + ql] = (bf16)f2bf(acc[a][d][e]);
    }
    asm volatile("s_waitcnt vmcnt(0)" ::: "memory");
    __syncthreads();
    if (wave == 0) {
        const unsigned mine = xb_xcc_id() + 1u;
        const bool same = (gridDim.x == 256) && __all((lane >= 32) || (xb_ld((unsigned*)(P.ws + WS_CTL) + CW_XCC + (blockIdx.x & 7) + 8 * (lane & 31)) == mine));
        if (lane == 0) {
            if (!same) { __builtin_amdgcn_fence(__ATOMIC_RELEASE, "agent"); asm volatile("s_waitcnt vmcnt(0)" ::: "memory"); }
            (void)__hip_atomic_fetch_add((unsigned*)(P.ws + WS_CTL) + CW_GLA + 64 * (l * 8 + bh), 1u, __ATOMIC_RELAXED, __HIP_MEMORY_SCOPE_AGENT);
        }
    }
}
__device__ __forceinline__ void gla2_scan3(const Ptrs& P, int l, int bh, int part, int tid) {
    const unsigned* SL = (const unsigned*)(P.ws + WS_SLOC); unsigned* ST = (unsigned*)(P.ws + WS_SST); const float* DEC = (const float*)(P.ws + WS_DEC);
    constexpr int PER = SELEMS / 2 / 8;
    const int q0 = part * PER + tid, q1 = q0 + NTHR, q2 = (tid + 2 * NTHR < PER) ? q0 + 2 * NTHR : q0;
    const int r0 = 2 * q0, r1 = 2 * q1, r2 = 2 * q2, k0 = r0 % 96, k1 = r1 % 96, k2 = r2 % 96;
    float a0 = 0.f, b0 = 0.f, a1 = 0.f, b1 = 0.f, a2 = 0.f, b2 = 0.f;
    const size_t cb = (size_t)bh * NCH;
    for (int n0 = 0; n0 < NCH; n0 += 16) {
        unsigned s0[16], s1[16], s2[16]; f32x2 d0[16], d1[16], d2[16];
#pragma unroll
        for (int i = 0; i < 16; ++i) {
            const size_t c = cb + n0 + i; const unsigned* slp = SL + ((c * SELEMS) >> 1); const float* dp = DEC + c * 96;
            s0[i] = slp[r0 >> 1]; s1[i] = slp[r1 >> 1]; s2[i] = slp[r2 >> 1];
            d0[i] = *(const f32x2*)(dp + k0); d1[i] = *(const f32x2*)(dp + k1); d2[i] = *(const f32x2*)(dp + k2);
        }
#pragma unroll
        for (int i = 0; i < 16; ++i) {
            unsigned* stp = ST + (((cb + n0 + i) * SELEMS) >> 1);
            stp[r0 >> 1] = pk2(a0, b0); a0 = d0[i][0] * a0 + bf2f(s0[i] & 0xffffu); b0 = d0[i][1] * b0 + bf2f(s0[i] >> 16);
            stp[r1 >> 1] = pk2(a1, b1); a1 = d1[i][0] * a1 + bf2f(s1[i] & 0xffffu); b1 = d1[i][1] * b1 + bf2f(s1[i] >> 16);
            stp[r2 >> 1] = pk2(a2, b2); a2 = d2[i][0] * a2 + bf2f(s2[i] & 0xffffu); b2 = d2[i][1] * b2 + bf2f(s2[i] >> 16);
        }
    }
    float* o = P.out + O_PG + (size_t)(l * 8 + bh) * SELEMS;
    o[(size_t)k0 * 192 + r0 / 96] = a0; o[(size_t)(k0 + 1) * 192 + r0 / 96] = b0;
    o[(size_t)k1 * 192 + r1 / 96] = a1; o[(size_t)(k1 + 1) * 192 + r1 / 96] = b1;
    o[(size_t)k2 * 192 + r2 / 96] = a2; o[(size_t)(k2 + 1) * 192 + r2 / 96] = b2;
}
__device__ __forceinline__ void gla2_scan(const Ptrs& P, int l, int bx, int G, int tid) {
    const unsigned* SL = (const unsigned*)(P.ws + WS_SLOC); unsigned* ST = (unsigned*)(P.ws + WS_SST); const float* DEC = (const float*)(P.ws + WS_DEC);
    const int per = (8 * (SELEMS / 2) + G - 1) / G;
    for (int e2 = bx * per + tid; tid < per && e2 < 8 * (SELEMS / 2) && e2 < (bx + 1) * per; e2 += NTHR) {
        const int bh = e2 / (SELEMS / 2), rem = 2 * (e2 - bh * (SELEMS / 2)), dv = rem / 96, dk = rem - 96 * dv;
        float S0 = 0.f, S1 = 0.f;
#pragma unroll 32
        for (int n = 0; n < NCH; ++n) {
            const size_t idx = (size_t)(bh * NCH + n) * SELEMS + rem;
            const unsigned slp = SL[idx >> 1]; const f32x2 dc = *(const f32x2*)(DEC + (size_t)(bh * NCH + n) * 96 + dk);
            ST[idx >> 1] = pk2(S0, S1); S0 = dc[0] * S0 + bf2f(slp & 0xffffu); S1 = dc[1] * S1 + bf2f(slp >> 16);
        }
        float* o = P.out + O_PG + (size_t)(l * 8 + bh) * SELEMS;
        o[(size_t)dk * 192 + dv] = S0; o[(size_t)(dk + 1) * 192 + dv] = S1;
    }
}
__device__ __forceinline__ void gla3_dunit(const Ptrs& P, LAS unsigned char* lds, int l, int du, int tid, int wave, int lane) {
    const bf16* PROJ = (const bf16*)(P.ws + WS_PROJ);
    const int bh = du >> 5, b = bh >> 2, h = bh & 3, t0 = (du & 31) * 128, unit0 = bh * 64 + (du & 31) * 2;
    LAS unsigned char* QE = lds; LAS unsigned char* KE = lds + 26624; LAS unsigned char* VI = lds + 53248;
    const int g = lane >> 4, ql = lane & 15, q4 = ql >> 2, p4 = lane & 3, it = wave & 3, c2 = wave >> 2, iloc = 16 * it + ql;
    const bf16* pr = PROJ + ((size_t)b * SEQ + t0) * NINP;
    const float* bc = (const float*)(P.ws + WS_BCUM) + ((size_t)b * SEQ + t0) * 384 + h * 96;
    for (int i = tid; i < 12288; i += NTHR) { const int j = i / 96, dk = i - 96 * j, cc = j >> 6, jl = j & 63; const float bb = bc[(size_t)j * 384 + dk];
        const float q = bf2f(pr[(size_t)j * NINP + C_QC + h * 96 + dk]) * 0.10206207261596575f, k = bf2f(pr[(size_t)j * NINP + C_KC + h * 96 + dk]);
        ((LAS bf16*)(QE + cc * 13312))[jl * 104 + dk] = (bf16)f2bf(q * __expf(bb)); ((LAS bf16*)(KE + cc * 13312))[jl * 104 + dk] = (bf16)f2bf(k * __expf(-bb)); }
    for (int i = tid; i < 3072; i += NTHR) { const int j = i / 24, ch = i - 24 * j, cc = j >> 6, jl = j & 63;
        *(LAS u32x4*)(VI + cc * 25600 + jl * 400 + ch * 16) = *(const u32x4*)(pr + (size_t)j * NINP + C_VC + h * 192 + 8 * ch); }
    __syncthreads();
    LAS unsigned char* qe = QE + c2 * 13312; LAS unsigned char* ke = KE + c2 * 13312; LAS unsigned char* vi = VI + c2 * 25600;
    const bf16* sst = (const bf16*)(P.ws + WS_SST) + (size_t)(unit0 + c2) * SELEMS;
    const int nst = (it >> 1) + 1;
    bf16x8 qfr[3];
#pragma unroll
    for (int ks = 0; ks < 3; ++ks) qfr[ks] = *(const LAS bf16x8*)(qe + iloc * 208 + (32 * ks + 8 * g) * 2);
    bf16x8 pf[2];
#pragma unroll
    for (int js = 0; js < 2; ++js) {
        u32x4 w = (u32x4){0u, 0u, 0u, 0u};
        if (js < nst) {
#pragma unroll
            for (int T = 0; T < 2; ++T) {
                const int jrow = 32 * js + 8 * q4 + 4 * T + (ql & 3);
                f32x4 a = (f32x4){0.f, 0.f, 0.f, 0.f};
                bf16x8 kf[3];
#pragma unroll
                for (int ks = 0; ks < 3; ++ks) kf[ks] = *(const LAS bf16x8*)(ke + jrow * 208 + (32 * ks + 8 * g) * 2);
#pragma unroll
                for (int ks = 0; ks < 3; ++ks) a = __builtin_amdgcn_mfma_f32_16x16x32_bf16(kf[ks], qfr[ks], a, 0, 0, 0);
                float e[4];
#pragma unroll
                for (int k = 0; k < 4; ++k) { const int j = 32 * js + 8 * g + 4 * T + k; e[k] = (j <= iloc) ? a[k] : 0.f; }
                if (T == 0) { w.x = pk2(e[0], e[1]); w.y = pk2(e[2], e[3]); } else { w.z = pk2(e[0], e[1]); w.w = pk2(e[2], e[3]); }
            }
        }
        pf[js] = __builtin_bit_cast(bf16x8, w);
    }
    f32x4 ot[12];
    float ss = 0.f;
#pragma unroll
    for (int hv = 0; hv < 2; ++hv) {
        bf16x8 sf[6][3];
#pragma unroll
        for (int a = 0; a < 6; ++a)
#pragma unroll
            for (int ks = 0; ks < 3; ++ks) sf[a][ks] = *(const bf16x8*)(sst + (size_t)(16 * (6 * hv + a) + ql) * 96 + 32 * ks + 8 * g);
#pragma unroll
        for (int a = 0; a < 6; ++a) ot[6 * hv + a] = (f32x4){0.f, 0.f, 0.f, 0.f};
#pragma unroll
        for (int js = 0; js < 2; ++js) if (js < nst) {
            bf16x8 vf[6];
#pragma unroll
            for (int a = 0; a < 6; ++a) vf[a] = tr8(vi, 32 * js + 8 * g, 16 * (6 * hv + a), q4, p4);
#pragma unroll
            for (int a = 0; a < 6; ++a) ot[6 * hv + a] = __builtin_amdgcn_mfma_f32_16x16x32_bf16(vf[a], pf[js], ot[6 * hv + a], 0, 0, 0);
        }
#pragma unroll
        for (int a = 0; a < 6; ++a)
#pragma unroll
            for (int ks = 0; ks < 3; ++ks) ot[6 * hv + a] = __builtin_amdgcn_mfma_f32_16x16x32_bf16(sf[a][ks], qfr[ks], ot[6 * hv + a], 0, 0, 0);
#pragma unroll
        for (int a = 0; a < 6; ++a) { const f32x4 o = ot[6 * hv + a]; ss += (o[0] * o[0] + o[1] * o[1]) + (o[2] * o[2] + o[3] * o[3]); }
    }
    ss += __shfl_xor(ss, 16); ss += __shfl_xor(ss, 32);
    const float rstd = rsqrtf(ss * (1.0f / 192.0f) + EPS);
    const size_t r = (size_t)b * SEQ + t0 + 64 * c2 + iloc;
    bf16* MIX = (bf16*)(P.ws + WS_MIX);
#pragma unroll
    for (int a = 0; a < 12; ++a) {
        const int dv0 = 16 * a + 4 * g;
        const u32x2 rc = *(const u32x2*)(PROJ + r * NINP + C_RC + h * 192 + dv0); const f32x4 gn = *(const f32x4*)(P.in[I_GNG] + l * 192 + dv0);
        u32x2 w;
        w.x = pk2(ot[a][0] * rstd * gn[0] * silu(bf2f(rc.x & 0xffffu)), ot[a][1] * rstd * gn[1] * silu(bf2f(rc.x >> 16)));
        w.y = pk2(ot[a][2] * rstd * gn[2] * silu(bf2f(rc.y & 0xffffu)), ot[a][3] * rstd * gn[3] * silu(bf2f(rc.y >> 16)));
        *(u32x2*)(MIX + r * D + M_C + h * 192 + dv0) = w;
    }
    __syncthreads();
}
__device__ __forceinline__ void final_norm(const Ptrs& P, int bx, int G, int wave, int lane) {
    const bf16* X = (const bf16*)(P.ws + WS_XB); const float* part2 = (const float*)(P.ws + WS_PART2); const float* spart2 = (const float*)(P.ws + WS_SPART2); const float* g = P.in[I_FNG];
    for (int row = bx * NWAVES + wave; row < MT; row += G * NWAVES) {
        float ss;
        if (row < MP) ss = (lane < 8) ? part2[(size_t)row * 8 + lane] : 0.f;
        else ss = spart2[(size_t)(row - MP) * 128 + lane] + spart2[(size_t)(row - MP) * 128 + 64 + lane];
        const float rs = rsqrtf(wave_sum(ss) * (1.0f / 2048.0f) + EPS);
#pragma unroll
        for (int j = 0; j < 4; ++j) {
            const size_t c = 8 * lane + 512 * j; const u32x4 q = *(const u32x4*)(X + (size_t)row * D + c);
            const f32x4 g0 = *(const f32x4*)(g + c), g1 = *(const f32x4*)(g + c + 4);
            const f32x4 v0 = {bf2f(q.x & 0xffffu), bf2f(q.x >> 16), bf2f(q.y & 0xffffu), bf2f(q.y >> 16)}, v1 = {bf2f(q.z & 0xffffu), bf2f(q.z >> 16), bf2f(q.w & 0xffffu), bf2f(q.w >> 16)};
            *(f32x4*)(P.out + (size_t)row * D + c) = v0 * rs * g0; *(f32x4*)(P.out + (size_t)row * D + c + 4) = v1 * rs * g1;
        }
    }
}

#ifndef REP_PRO
#define REP_PRO 1
#endif
#ifndef REP_GLA1
#define REP_GLA1 1
#endif
#ifndef REP_GLA2
#define REP_GLA2 1
#endif
#ifndef REP_GLA3
#define REP_GLA3 1
#endif
#ifndef REP_POOL
#define REP_POOL 1
#endif
#ifndef REP_SMIX
#define REP_SMIX 1
#endif
#ifndef REP_PATTN
#define REP_PATTN 1
#endif
#ifndef REP_COMB
#define REP_COMB 1
#endif
#ifndef REP_BAR
#define REP_BAR 1
#endif
#ifndef REP_INPROJ
#define REP_INPROJ 1
#endif
#ifndef PG8_SP2
#define PG8_SP2 true
#endif
#ifndef TS_A
#define TS_A -1
#endif
#ifndef TS_B
#define TS_B -1
#endif
#ifndef TS_L
#define TS_L 1
#endif
#ifndef PG8_ALIGN_IG
#define PG8_ALIGN_IG true
#endif
#ifndef PA_ROT
#define PA_ROT 32
#endif
#define RSTD_TO_LDS(NCOLS, PART) do { pg8::StaticOrder S0_; S0_.init(MP, (NCOLS), G, bx); pg8::PG8_LAS_T rsl_ = (pg8::PG8_LAS_T)(lds + pg8::RS_OFF); PG8_LAS int* map_ = (PG8_LAS int*)(rsl_ + pg8::RS_MAXU * 256); \
        if (tid_ < 32) map_[tid_] = 255; __syncthreads(); \
        _Pragma("unroll 1") for (int i_ = 0; i_ < pg8::RS_MAXU; ++i_) { pg8::Unit uu_; if (!S0_.next(i_, uu_)) break; \
            if (tid_ == 0) map_[uu_.pm & 31] = i_; \
            if (tid_ < 256) { const float* pp_ = (PART) + (size_t)(uu_.pm * 256 + tid_) * 8; const f32x4 q0_ = *(const f32x4*)pp_, q1_ = *(const f32x4*)(pp_ + 4); \
                rsl_[i_ * 256 + tid_] = rsqrtf((((q0_[0] + q0_[1]) + (q0_[2] + q0_[3])) + ((q1_[0] + q1_[1]) + (q1_[2] + q1_[3]))) * (1.0f / 2048.0f) + 1e-6f); } } \
        __syncthreads(); } while (0)
#ifndef REP_PH2
#define REP_PH2 1
#endif
#ifndef REP_PH4
#define REP_PH4 1
#endif
#ifndef REP_SGLA
#define REP_SGLA 1
#endif
#ifndef REP_SPOOL
#define REP_SPOOL 1
#endif
#ifndef REP_OUT
#define REP_OUT 1
#endif
#ifndef REP_DOWN
#define REP_DOWN 1
#endif
#ifndef REP_GU
#define REP_GU 1
#endif
#ifndef REP_SKINNY
#define REP_SKINNY 1
#endif
#ifndef MK_PER_PHASE
#define MK_PER_PHASE 0
#endif
constexpr int NPH = 30;
#ifndef MK_FILL
#define MK_FILL 1
#endif
#ifndef FILL_NCW
#define FILL_NCW 4
#endif
constexpr int NCW = FILL_NCW, CV_TOTAL = 3 * CV_L;
__device__ __forceinline__ void seam_fill(const XcdBarrier& b, const Ptrs& P, LAS unsigned char* lds, int bx, int G, int deadline, int limit) {
    int tid = threadIdx.x; asm volatile("" : "+v"(tid));
    const int wave = __builtin_amdgcn_readfirstlane(tid >> 6), lane = tid & 63;
    volatile LAS unsigned* cw = (volatile LAS unsigned*)(lds + MISC_OFF);
    const bool conv = (wave >= 1 && wave <= NCW);
    const int nwk = G * NCW;
    LAS float* scr = (LAS float*)(lds + (wave - 1) * 16640);
    int cur = conv ? (int)__builtin_amdgcn_readfirstlane(cw[16 + wave]) : CV_TOTAL;
    if (deadline > 0) {
        __syncthreads();
        if (conv) while (cur < deadline) { cvt_item(P, 1 + cur / CV_L, cur % CV_L, scr, lane); cur += nwk; }
    }
    asm volatile("s_waitcnt vmcnt(0)" ::: "memory");
    if (tid == 0) cw[0] = 0u;
    __syncthreads();
    if (wave == 0) {
        if (tid == 0) {
            unsigned* bar = b.bar;
            __builtin_amdgcn_s_waitcnt(0);
            unsigned nloc = b.st[0], nx = b.st[1];
            if (nloc == 0u) { xcd_barrier_complete(bar, b.x, nloc, nx); b.st[0] = nloc; b.st[1] = nx; }
            const unsigned old = xb_add(&bar[XB_XSUB(b.x)], 1u);
            const unsigned gen = old / nloc;
            if (old + 1u == (gen + 1u) * nloc) {
                __builtin_amdgcn_fence(__ATOMIC_RELEASE, "agent");
                asm volatile("s_waitcnt vmcnt(0)" ::: "memory");
                const unsigned og = xb_add(&bar[XB_TOP], 1u);
                const unsigned tg = og / nx;
                if (og + 1u == (tg + 1u) * nx) xb_add(&bar[XB_TOPGEN], 1u);
                else XB_SPIN(xb_ld(&bar[XB_TOPGEN]) == tg, bar);
                __builtin_amdgcn_fence(__ATOMIC_ACQUIRE, "agent");
                xb_add(&bar[XB_XGEN(b.x)], 1u);
                asm volatile("s_waitcnt vmcnt(0)" ::: "memory");
            } else {
                XB_SPIN(xb_ld(&bar[XB_XGEN(b.x)]) == gen, bar);
                __builtin_amdgcn_fence(__ATOMIC_ACQUIRE, "agent");
                asm volatile("s_waitcnt vmcnt(0)" ::: "memory");
            }
            cw[0] = 1u;
        }
    } else if (conv) {
        for (int nd = 0; nd < limit && cur < CV_TOTAL && __builtin_amdgcn_readfirstlane(cw[0]) == 0u; ++nd) { cvt_item(P, 1 + cur / CV_L, cur % CV_L, scr, lane); cur += nwk; }
    }
    if (conv && lane == 0) cw[16 + wave] = (unsigned)cur;
    __syncthreads();
}
struct Args { const float* in[N_IN]; float* out; unsigned char* ws; int ph_lo, ph_hi, li, pad; };

__global__ void __launch_bounds__(NTHR, 2) fwd(Args args) {
    extern __shared__ __attribute__((aligned(16))) unsigned char lds_raw[];
    LAS unsigned char* lds = (LAS unsigned char*)lds_raw;
    const int tid = threadIdx.x, lane = tid & 63, wave = __builtin_amdgcn_readfirstlane(tid >> 6);
    const int G = gridDim.x, bx = blockIdx.x;
    Ptrs P;
#pragma unroll
    for (int i = 0; i < N_IN; ++i) P.in[i] = args.in[i];
    P.out = args.out; P.ws = args.ws;
    for (int u = tid; u < (LDS_BYTES - LDSCTL_OFF) / 4; u += NTHR) ((LAS unsigned*)(lds + LDSCTL_OFF))[u] = 0u;
    __syncthreads();
    if (tid < NWAVES) ((volatile LAS unsigned*)(lds + MISC_OFF))[16 + tid] = (tid >= 1 && tid <= NCW) ? (unsigned)(bx * NCW + tid - 1) : (unsigned)CV_TOTAL;
    __syncthreads();
    unsigned* ctl = (unsigned*)(args.ws + WS_CTL);
    XcdBarrier bar; bar.bar = ctl + CW_BAR; bar.x = 0; bar.st = nullptr;
    if (!MK_PER_PHASE) bar = xcd_barrier_post(ctl + CW_BAR, (volatile LAS unsigned*)(lds + MISC_OFF) + 8);
    const int lo = args.ph_lo, hi = args.ph_hi;
#define IN(k) (lo <= (k) && (k) < hi)
#define STAMP(kk) do { if (TS_A >= 0 && bx == 0 && tid == 0) ((volatile LAS unsigned*)(lds + LDSCTL_OFF + 1024))[l * 32 + (kk)] = (unsigned)__builtin_amdgcn_s_memrealtime(); } while (0)
#define LAUNDER() int tid_ = tid; asm volatile("" : "+v"(tid_)); const int lane_ = tid_ & 63, wave_ = __builtin_amdgcn_readfirstlane(tid_ >> 6); (void)lane_; (void)wave_
#ifndef FILL_LIM
#define FILL_LIM 2
#endif
#ifndef FILL_TAIL
#define FILL_TAIL (1 << 20)
#endif
#define SEAM(k) SEAMD(k, 0)
#define SEAMD(k, dl) SEAML(k, dl, FILL_LIM)
#define SEAML(k, dl, lim) do { if (IN((k) + 1)) { if (!MK_PER_PHASE) { if (MK_FILL) { seam_fill(bar, P, lds, bx, G, (dl), (lim)); } else { xcd_barrier(bar); } for (int rb_ = 1; rb_ < REP_BAR; ++rb_) xcd_barrier(bar); } } } while (0)

#define WSB_() ({ unsigned long long w__ = (unsigned long long)args.ws; asm volatile("" : "+s"(w__)); (unsigned char*)(GAS unsigned char*)w__; })
#define part1 ((float*)(WSB_() + WS_PART1))
#define part2 ((float*)(WSB_() + WS_PART2))
#define spart1 ((float*)(WSB_() + WS_SPART1))
#define spart2 ((float*)(WSB_() + WS_SPART2))
#define XB ((bf16*)(WSB_() + WS_XB))
#define MIXB ((bf16*)(WSB_() + WS_MIX))
#define PROJ ((bf16*)(WSB_() + WS_PROJ))
#define FB ((bf16*)(WSB_() + WS_F))
#define projs ((float*)(WSB_() + WS_PROJS))
    pg8::PG8_LAS_T xch = (pg8::PG8_LAS_T)(lds + XCH_OFF);

    if (IN(0)) {
        if (tid == 0) __hip_atomic_store((unsigned*)args.ws + CW_XCC + bx, xb_xcc_id() + 1u, __ATOMIC_RELAXED, __HIP_MEMORY_SCOPE_AGENT);
        for (int rep = 0; rep < REP_PRO; ++rep) { LAUNDER(); prologue(P, lds, bx, G, wave_, lane_, tid_, (MK_FILL && !MK_PER_PHASE) ? 1 : DEPTH); __syncthreads(); } SEAM(0);
    }

    for (int l = 0; l < DEPTH; ++l) {
        const int pb = 1 + 7 * l;
        unsigned char* wl = args.ws + WS_W + (size_t)l * LW_SZ;
        const bf16* Win = (const bf16*)(wl + LW_IN); const bf16* Wo = (const bf16*)(wl + LW_O); const bf16* Wgu = (const bf16*)(wl + LW_GU); const bf16* Wd = (const bf16*)(wl + LW_D);

        if (IN(pb + 0)) {
            LAUNDER(); STAMP(1);
            RSTD_TO_LDS(NINP, part2);
            for (int rep = 0; rep < REP_INPROJ; ++rep) {
                pg8::Gemm g{XB, Win, MP, NINP, D}; pg8::StaticOrder S; S.init(MP, NINP, G, bx);
                pg8::EpiInProj E{args.ws, P.out, l, (PG8_LAS const float*)(lds + pg8::RS_OFF)};
                pg8::gemm_phase<pg8::EpiInProj, pg8::StaticOrder, PG8_ALIGN_IG, PG8_SP2>(lds, g, S, E);
            }
            const int sh1 = (672 % G) ? (672 % G) : 0, ns1 = G - sh1;
            for (int rep = 0; rep < REP_SKINNY; ++rep) for (int u = bx - sh1; u >= 0 && u < 161; u += ns1) {
                const int t0 = 2 * u, t1 = (2 * u + 1 < 321) ? 2 * u + 1 : 320;
                SEpiInProj E{projs, skinny_rs(spart2, 0, tid_), skinny_rs(spart2, 32, tid_), P.out + O_SK + (size_t)l * 49152, P.out + O_SV + (size_t)l * 49152, P.out + O_SP + (size_t)l * 61440, 16 * t0};
                skinny_unit<4, 2, 4>(lds, XB + (size_t)MP * D, Win + (size_t)16 * t0 * D, Win + (size_t)16 * t1 * D, D, 0, (2 * u + 1 < 321) ? 2 : 1, E, wave_, lane_, tid_);
            }
            STAMP(24); SEAML(pb + 0, 0, (672 % G != 0 && bx >= 672 % G) ? FILL_TAIL : FILL_LIM);
        }
        if (IN(pb + 1)) {
            for (int rp2 = 0; rp2 < REP_PH2; ++rp2) {
            if (rp2 > 0 && !MK_PER_PHASE) xcd_barrier(bar);
            STAMP(2);
            for (int rep = 0; rep < REP_SMIX; ++rep) { LAUNDER(); for (int u = bx; u < 192; u += G) s_attn_punit(P, lds, l, u, wave_, lane_, tid_); }
            STAMP(3);
            for (int rep = 0; rep < REP_SPOOL; ++rep) { LAUNDER(); for (int u = (bx + G - 192 % G) % G; u < 64; u += G) s_pool_unit(P, lds, l, u, tid_); }
            for (int rep = 0; rep < REP_SGLA; ++rep) { LAUNDER(); for (int u = (bx + G - 160 % G) % G; u < 32; u += G) s_gla_unit(P, lds, l, u, tid_); }
            STAMP(5);
            for (int rep = 0; rep < REP_GLA1; ++rep) { LAUNDER(); for (int u = bx; u < 256; u += G) gla1_dunit(P, lds, l, (G == 256) ? ((u & 7) * 32 + (u >> 3)) : u, tid_, wave_, lane_); }
            STAMP(6);
            for (int rep = 0; rep < REP_POOL; ++rep) { LAUNDER(); for (int u = bx * NWAVES + wave_; u < 2048; u += G * NWAVES) p_pool_wunit(P, lds, l, u, wave_, lane_); __syncthreads(); }
            STAMP(7);
            for (int rep = 0; rep < REP_PATTN; ++rep) { LAUNDER(); for (int u = (bx + G - PA_ROT % G) % G; u < 1152; u += G) p_attn_unit(P, lds, u, wave_, lane_); }
            }
            if (G == 256 && bx >= 192) {
                LAUNDER();
                const int bhs = bx & 7;
                if (tid_ == 0) { unsigned* c_ = (unsigned*)(P.ws + WS_CTL) + CW_GLA + 64 * (l * 8 + bhs); unsigned sp_ = 0u; while (xb_ld(c_) < 32u * REP_GLA1 && ++sp_ < (1u << 24)) __builtin_amdgcn_s_sleep(2);
                    __builtin_amdgcn_fence(__ATOMIC_ACQUIRE, "agent"); asm volatile("s_waitcnt vmcnt(0)" ::: "memory"); }
                __syncthreads();
                gla2_scan3(P, l, bhs, (bx - 192) >> 3, tid_);
            }
            STAMP(8); SEAM(pb + 1);
        }
        if (IN(pb + 2) && G != 256) { STAMP(9); for (int rep = 0; rep < REP_GLA2; ++rep) { LAUNDER(); gla2_scan(P, l, bx, G, tid_); } STAMP(10); SEAM(pb + 2); }
        if (IN(pb + 3)) { STAMP(11); for (int rp4 = 0; rp4 < REP_PH4; ++rp4) { if (rp4 > 0 && !MK_PER_PHASE) xcd_barrier(bar); for (int rep = 0; rep < REP_GLA3; ++rep) { LAUNDER(); for (int u = bx; u < 256; u += G) gla3_dunit(P, lds, l, u, tid_, wave_, lane_); } STAMP(12); for (int rep = 0; rep < REP_COMB; ++rep) { LAUNDER(); attn_combine(P, bx, G, wave_, lane_); } } STAMP(13); SEAMD(pb + 3, (l > 0) ? CV_L * (l - 1) + CV_IN + CV_O : 0); }
        if (IN(pb + 4)) {
            LAUNDER(); STAMP(14);
            for (int rep = 1; rep < REP_OUT; ++rep) {
                pg8::Gemm g{MIXB, Wo, MP, D, D}; pg8::StaticOrder S; S.init(MP, D, G, bx);
                pg8::EpiResid E{XB, (bf16*)(args.ws + WS_F), (float*)(args.ws + WS_GA), xch};
                pg8::gemm_phase<pg8::EpiResid, pg8::StaticOrder, true, PG8_SP2>(lds, g, S, E);
            }
            {
                pg8::Gemm g{MIXB, Wo, MP, D, D}; pg8::StaticOrder S; S.init(MP, D, G, bx);
                pg8::EpiResid E{XB, XB, part1, xch};
                pg8::gemm_phase<pg8::EpiResid, pg8::StaticOrder, true, PG8_SP2>(lds, g, S, E);
            }
            for (int u = G - 1 - bx; u < 256; u += G) {
                const int rh = u & 1, ct = u >> 1;
                SEpiResid E{XB + (size_t)MP * D, XB + (size_t)MP * D, spart1, 16 * ct};
                skinny_unit<2, 1, 8>(lds, MIXB + (size_t)MP * D, Wo + (size_t)16 * ct * D, Wo, D, 32 * rh, 1, E, wave_, lane_, tid_);
            }
            STAMP(16); SEAMD(pb + 4, (l > 0) ? CV_L * (l - 1) + CV_IN + CV_O + 2 * CV_G : 0);
        }
        if (IN(pb + 5)) {
            LAUNDER(); STAMP(17);
            RSTD_TO_LDS(NGU, part1);
            for (int rep = 0; rep < REP_GU; ++rep) {
                pg8::Gemm g{XB, Wgu, MP, NGU, D}; pg8::StaticOrder S; S.init(MP, NGU, G, bx);
                pg8::EpiGateUp E{args.ws, (PG8_LAS const float*)(lds + pg8::RS_OFF)};
                pg8::gemm_phase<pg8::EpiGateUp, pg8::StaticOrder, PG8_ALIGN_IG, PG8_SP2>(lds, g, S, E);
            }
            const int sh2 = (1408 % G) ? (1408 % G) : 0, ns2 = G - sh2;
            for (int rep = 0; rep < REP_SKINNY; ++rep) for (int u = bx - sh2; u >= 0 && u < 352; u += ns2) {
                const int f0 = 16 * u; const size_t gr = (size_t)(256 * (f0 >> 7) + (f0 & 127));
                SEpiGateUp E{FB, skinny_rs(spart1, 0, tid_), skinny_rs(spart1, 32, tid_), f0, 0.f, 0.f};
                skinny_unit<4, 2, 4>(lds, XB + (size_t)MP * D, Wgu + gr * D, Wgu + (gr + 128) * D, D, 0, 2, E, wave_, lane_, tid_);
            }
            STAMP(19); SEAML(pb + 5, (l > 0) ? CV_L * l : 0, (1408 % G != 0 && bx >= 1408 % G) ? FILL_TAIL : FILL_LIM);
        }
        if (IN(pb + 6)) {
            LAUNDER(); STAMP(20);
            for (int rep = 1; rep < REP_DOWN; ++rep) {
                pg8::Gemm g{FB, Wd, MP, D, DFF}; pg8::StaticOrder S; S.init(MP, D, G, bx);
                pg8::EpiResid E{XB, (bf16*)(args.ws + WS_MIX), (float*)(args.ws + WS_GA), xch};
                pg8::gemm_phase<pg8::EpiResid, pg8::StaticOrder, true, PG8_SP2>(lds, g, S, E);
            }
            {
                pg8::Gemm g{FB, Wd, MP, D, DFF}; pg8::StaticOrder S; S.init(MP, D, G, bx);
                pg8::EpiResid E{XB, XB, part2, xch};
                pg8::gemm_phase<pg8::EpiResid, pg8::StaticOrder, true, PG8_SP2>(lds, g, S, E);
            }
            for (int u = G - 1 - bx; u < 256; u += G) {
                const int rh = u & 1, ct = u >> 1;
                SEpiResid E{XB + (size_t)MP * D, XB + (size_t)MP * D, spart2, 16 * ct};
                skinny_unit<2, 1, 8>(lds, FB + (size_t)MP * DFF, Wd + (size_t)16 * ct * DFF, Wd, DFF, 32 * rh, 1, E, wave_, lane_, tid_);
            }
            STAMP(22); SEAMD(pb + 6, (l + 1 < DEPTH) ? CV_L * l + CV_IN : 0); STAMP(23);
        }
    }
    if (IN(29)) { LAUNDER(); final_norm(P, bx, G, wave_, lane_);
        if (TS_A >= 0 && bx == 0) {
            __syncthreads();
            const volatile LAS unsigned* ts = (const volatile LAS unsigned*)(lds + LDSCTL_OFF + 1024);
            unsigned acc_ = 0; for (int l_ = 0; l_ < DEPTH; ++l_) acc_ += ts[l_ * 32 + (TS_B < 0 ? 0 : TS_B)] - ts[l_ * 32 + (TS_A < 0 ? 0 : TS_A)];
            const float c = floorf(((float)acc_ * 0.01f + (float)TS_L) * (1.0f / 16.0f)) * 0.4f;
            for (int i = tid; i < MS * D; i += NTHR) P.out[O_YS + i] = c;
        }
    }
#undef IN
#undef SEAM
}

extern "C" void kernel_launch(void* const* d_in, const int* in_sizes, int n_in, void* d_out, int out_size, void* d_ws, size_t ws_size, hipStream_t stream) {
    static int grid = 0;
    if (grid == 0) {
        if (n_in != N_IN || (size_t)out_size != O_END || ws_size < WS_END) { fprintf(stderr, "kernel_launch: unexpected sizes n_in %d out %d ws %zu\n", n_in, out_size, ws_size); grid = -1; return; }
        int dev = 0, cus = 0, per_cu = 0;
        if (hipGetDevice(&dev) != hipSuccess || hipDeviceGetAttribute(&cus, hipDeviceAttributeMultiprocessorCount, dev) != hipSuccess) { grid = -1; return; }
        if (hipFuncSetAttribute((const void*)fwd, hipFuncAttributeMaxDynamicSharedMemorySize, LDS_BYTES) != hipSuccess) { fprintf(stderr, "kernel_launch: hipFuncSetAttribute failed\n"); grid = -1; return; }
        if (hipOccupancyMaxActiveBlocksPerMultiprocessor(&per_cu, (const void*)fwd, NTHR, LDS_BYTES) != hipSuccess || per_cu < 1) { fprintf(stderr, "kernel_launch: occupancy query says %d\n", per_cu); }
        (void)hipGetLastError();
        grid = cus;
    }
    if (grid < 0) return;
    (void)hipMemsetAsync((char*)d_ws + WS_CTL, 0, CTL_ZERO_BYTES, stream);
    Args a{};
    for (int i = 0; i < N_IN; ++i) a.in[i] = (const float*)d_in[i];
    a.out = (float*)d_out; a.ws = (unsigned char*)d_ws; a.li = 0; a.pad = 0;
#if MK_PER_PHASE
    for (int p = 0; p < NPH; ++p) { a.ph_lo = p; a.ph_hi = p + 1; hipLaunchKernelGGL(fwd, dim3(grid), dim3(NTHR), LDS_BYTES, stream, a); }
#else
    a.ph_lo = 0; a.ph_hi = NPH;
    hipLaunchKernelGGL(fwd, dim3(grid), dim3(NTHR), LDS_BYTES, stream, a);
#endif
    const hipError_t le = hipPeekAtLastError();
    if (le != hipSuccess) fprintf(stderr, "kernel_launch: launch failed: %s\n", hipGetErrorName(le));
}
```
